# Optimizing an MI355X kernel written in HIP

```python
import math
import jax, jax.numpy as jnp
from jax import lax
import numpy as np

D_MODEL = 1024
BATCH = 4
SEQ = 4096
DEPTH = 1

DA_HEADS = 4
DA_HEAD_DIM = 64
DA_WIDTH = DA_HEADS * 2 * DA_HEAD_DIM
SB_HEADS = 8
SB_HEAD_DIM = 64
SB_WIDTH = SB_HEADS * SB_HEAD_DIM
ROPE_THETA = 10000.0
Q_BLOCK = 128
IN_SIZES = (DA_WIDTH, DA_WIDTH, DA_WIDTH, SB_WIDTH, SB_WIDTH, SB_WIDTH, D_MODEL, D_MODEL)
IN_WIDTH = 3 * DA_WIDTH + 3 * SB_WIDTH + 2 * D_MODEL
N_EXPERTS = 32
TOP_K = 4
D_FF = D_MODEL
SWIGLU_LIMIT = 7.0
SWIGLU_ALPHA = 1.702
MOE_BLOCK = 256
NORM_EPS = 1e-5

kernel_name = "hybrid_diffattn_stickbreak_moe"


def rms_norm(x, g):
    xf = x.astype(jnp.float32)
    y = xf * lax.rsqrt(jnp.mean(xf * xf, axis=-1, keepdims=True) + NORM_EPS)
    return (y * g.astype(jnp.float32)).astype(x.dtype)


def rope_tables(seq, dim):
    inv = 1.0 / (ROPE_THETA ** (jnp.arange(0, dim, 2, dtype=jnp.float32) / dim))
    ang = jnp.arange(seq, dtype=jnp.float32)[:, None] * inv[None, :]
    return jnp.cos(ang), jnp.sin(ang)


def apply_rope(x, cos, sin):
    xf = x.astype(jnp.float32)
    x1, x2 = jnp.split(xf, 2, axis=-1)
    c = cos[None, :, None, :]
    s = sin[None, :, None, :]
    return jnp.concatenate([x1 * c - x2 * s, x2 * c + x1 * s], axis=-1).astype(x.dtype)


def to_blocks(t):
    b, s = t.shape[:2]
    return jnp.moveaxis(t.reshape(b, s // Q_BLOCK, Q_BLOCK, *t.shape[2:]), 1, 0)


def from_blocks(t):
    t = jnp.moveaxis(t, 0, 1)
    return t.reshape(t.shape[0], t.shape[1] * t.shape[2], *t.shape[3:])


def diff_attention(q, k, v, lam, lambda_init, subln_g):
    b, s = q.shape[:2]
    nb = s // Q_BLOCK
    scale = DA_HEAD_DIM ** -0.5
    k_pos = jnp.arange(s)

    def block(args):
        qb, i = args
        q_pos = i * Q_BLOCK + jnp.arange(Q_BLOCK)
        sc = jnp.einsum('bqhd,bkhd->bhqk', qb, k, preferred_element_type=jnp.float32) * scale
        mask = k_pos[None, :] <= q_pos[:, None]
        p = jax.nn.softmax(jnp.where(mask, sc, -jnp.inf), axis=-1)
        p = p.reshape(b, DA_HEADS, 2, Q_BLOCK, s)
        w = p[:, :, 0] - lam * p[:, :, 1]
        return jnp.einsum('bhqk,bkhe->bqhe', w.astype(v.dtype), v)

    o = from_blocks(lax.map(block, (to_blocks(q), jnp.arange(nb))))
    o = rms_norm(o, subln_g) * (1.0 - lambda_init)
    return o.reshape(b, s, DA_WIDTH)


def stick_breaking_attention(q, k, v):
    b, s = q.shape[:2]
    nb = s // Q_BLOCK
    scale = SB_HEAD_DIM ** -0.5
    k_pos = jnp.arange(s)

    def block(args):
        qb, i = args
        q_pos = i * Q_BLOCK + jnp.arange(Q_BLOCK)
        z = jnp.einsum('bqhd,bkhd->bhqk', qb, k, preferred_element_type=jnp.float32) * scale
        mask = k_pos[None, :] < q_pos[:, None]
        log_1m = jnp.where(mask, jax.nn.log_sigmoid(-z), 0.0)
        suffix = lax.cumsum(log_1m, axis=3, reverse=True) - log_1m
        a = jnp.where(mask, jnp.exp(jax.nn.log_sigmoid(z) + suffix), 0.0)
        return jnp.einsum('bhqk,bkhd->bqhd', a.astype(v.dtype), v)

    o = from_blocks(lax.map(block, (to_blocks(q), jnp.arange(nb))))
    return o.reshape(b, s, SB_WIDTH)


def moe_ffn(h, w_router, b_router, w_gate, b_gate, w_up, b_up, w_down, b_down):
    n, d = h.shape
    logits = (h @ w_router + b_router).astype(jnp.float32)
    top_val, top_idx = lax.top_k(logits, TOP_K)
    gates = jax.nn.softmax(top_val, axis=-1).astype(h.dtype)
    m = n * TOP_K
    flat_e = top_idx.reshape(m)
    flat_tok = jnp.arange(m, dtype=jnp.int32) // TOP_K
    flat_g = gates.reshape(m)
    order = jnp.argsort(flat_e)
    sorted_e = flat_e[order]
    counts = jnp.bincount(flat_e, length=N_EXPERTS)
    padded = (counts + MOE_BLOCK - 1) // MOE_BLOCK * MOE_BLOCK
    starts = jnp.cumsum(counts) - counts
    pad_ends = jnp.cumsum(padded)
    pad_starts = pad_ends - padded
    dest = pad_starts[sorted_e] + jnp.arange(m, dtype=jnp.int32) - starts[sorted_e]
    n_blocks = (m + MOE_BLOCK - 1) // MOE_BLOCK + N_EXPERTS
    p_rows = n_blocks * MOE_BLOCK
    row_tok = jnp.zeros((p_rows,), jnp.int32).at[dest].set(flat_tok[order])
    row_gate = jnp.zeros((p_rows,), h.dtype).at[dest].set(flat_g[order])
    blk_e = jnp.minimum(
        jnp.searchsorted(pad_ends, jnp.arange(n_blocks, dtype=jnp.int32) * MOE_BLOCK, side='right'),
        N_EXPERTS - 1)
    xs = h[row_tok].reshape(n_blocks, MOE_BLOCK, d)

    def expert_block(args):
        xb, e = args
        g = xb @ w_gate[e] + b_gate[e]
        u = xb @ w_up[e] + b_up[e]
        g = jnp.minimum(g, SWIGLU_LIMIT)
        u = jnp.clip(u, -SWIGLU_LIMIT, SWIGLU_LIMIT)
        glu = g * jax.nn.sigmoid(SWIGLU_ALPHA * g)
        return ((u + 1.0) * glu) @ w_down[e] + b_down[e]

    out = lax.map(expert_block, (xs, blk_e)).reshape(p_rows, d)
    return jnp.zeros_like(h).at[row_tok].add(out * row_gate[:, None])


def setup_inputs(seed: int = 0) -> dict:
    key = jax.random.key(seed)
    ks = jax.random.split(key, 24)
    f32 = jnp.float32
    L, D, E, F = DEPTH, D_MODEL, N_EXPERTS, D_FF

    def nrm(k, shape, scale):
        return jax.random.normal(k, shape, f32) * scale

    return {
        "x": nrm(ks[0], (BATCH, SEQ, D), 1.0),
        "norm_mix_g": 1.0 + nrm(ks[1], (L, D), 0.01),
        "w_in": nrm(ks[2], (L, D, IN_WIDTH), D ** -0.5),
        "lambda_q1": nrm(ks[3], (L, DA_HEAD_DIM), 0.1),
        "lambda_k1": nrm(ks[4], (L, DA_HEAD_DIM), 0.1),
        "lambda_q2": nrm(ks[5], (L, DA_HEAD_DIM), 0.1),
        "lambda_k2": nrm(ks[6], (L, DA_HEAD_DIM), 0.1),
        "da_subln_g": 1.0 + nrm(ks[7], (L, 2 * DA_HEAD_DIM), 0.01),
        "w_da_out": nrm(ks[8], (L, DA_WIDTH, D), DA_WIDTH ** -0.5),
        "w_sb_out": nrm(ks[9], (L, SB_WIDTH, D), SB_WIDTH ** -0.5),
        "w_o": nrm(ks[10], (L, D, D), D ** -0.5),
        "norm_ffn_g": 1.0 + nrm(ks[11], (L, D), 0.01),
        "w_router": nrm(ks[12], (L, D, E), D ** -0.5),
        "b_router": nrm(ks[13], (L, E), 0.01),
        "w_gate": nrm(ks[14], (L, E, D, F), D ** -0.5),
        "b_gate": nrm(ks[15], (L, E, F), 0.01),
        "w_up": nrm(ks[16], (L, E, D, F), D ** -0.5),
        "b_up": nrm(ks[17], (L, E, F), 0.01),
        "w_down": nrm(ks[18], (L, E, F, D), F ** -0.5),
        "b_down": nrm(ks[19], (L, E, D), 0.01),
        "norm_final_g": 1.0 + nrm(ks[20], (D,), 0.01),
    }


def reference(x, norm_mix_g, w_in, lambda_q1, lambda_k1, lambda_q2, lambda_k2, da_subln_g,
              w_da_out, w_sb_out, w_o, norm_ffn_g, w_router, b_router, w_gate, b_gate,
              w_up, b_up, w_down, b_down, norm_final_g):
    b, s, d = x.shape
    cos, sin = rope_tables(s, DA_HEAD_DIM)
    split_points = np.cumsum(IN_SIZES)[:-1].tolist()
    for l in range(DEPTH):
        lambda_init = 0.8 - 0.6 * math.exp(-0.3 * l)
        h = rms_norm(x, norm_mix_g[l])
        proj = h @ w_in[l]
        qa, ka, va, qb, kb, vb, ga, gb = jnp.split(proj, split_points, axis=-1)
        qa = apply_rope(qa.reshape(b, s, 2 * DA_HEADS, DA_HEAD_DIM), cos, sin)
        ka = apply_rope(ka.reshape(b, s, 2 * DA_HEADS, DA_HEAD_DIM), cos, sin)
        va = va.reshape(b, s, DA_HEADS, 2 * DA_HEAD_DIM)
        lam = (jnp.exp(jnp.sum(lambda_q1[l].astype(jnp.float32) * lambda_k1[l].astype(jnp.float32)))
               - jnp.exp(jnp.sum(lambda_q2[l].astype(jnp.float32) * lambda_k2[l].astype(jnp.float32)))
               + lambda_init)
        ya = diff_attention(qa, ka, va, lam, lambda_init, da_subln_g[l]) @ w_da_out[l]
        yb = stick_breaking_attention(qb.reshape(b, s, SB_HEADS, SB_HEAD_DIM),
                                      kb.reshape(b, s, SB_HEADS, SB_HEAD_DIM),
                                      vb.reshape(b, s, SB_HEADS, SB_HEAD_DIM)) @ w_sb_out[l]
        mix = jax.nn.sigmoid(ga) * ya + jax.nn.sigmoid(gb) * yb
        x = x + mix @ w_o[l]
        h = rms_norm(x, norm_ffn_g[l]).reshape(b * s, d)
        y = moe_ffn(h, w_router[l], b_router[l], w_gate[l], b_gate[l], w_up[l], b_up[l],
                    w_down[l], b_down[l])
        x = x + y.reshape(b, s, d)
    return rms_norm(x, norm_final_g)
```

```cpp
#include <hip/hip_runtime.h>
#include <cstdio>
#include <cstdint>
namespace pg8 {
#define PG8_LAS __attribute__((address_space(3)))
typedef unsigned short bf16_t;
typedef short bf16x8 __attribute__((ext_vector_type(8)));
typedef float f32x4 __attribute__((ext_vector_type(4)));
typedef unsigned u32x4 __attribute__((ext_vector_type(4)));
constexpr int BM = 256, BK = 64, HALF = 128, HTB = HALF * BK * 2  , STAGE_BYTES = 8 * HTB, NXCD = 8, WGM = 8;

__host__ __device__ __forceinline__ int lds_byte(int r, int c) { const int st = (r >> 4) * 2 + (c >> 5), rr = r & 15, cc = c & 31, ob = rr * 64 + cc * 2; return st * 1024 + (ob ^ (((ob >> 9) & 1) << 5)); }
__host__ __device__ __forceinline__ void stage_rc(int b, int& R, int& C) { const int st = b / 1024, sb = b % 1024, swz = sb ^ (((sb >> 9) & 1) << 5); R = (st >> 1) * 16 + swz / 64; C = (st & 1) * 32 + (swz % 64) / 2; }
__host__ __device__ __forceinline__ int perm32(int rho) { const int n = rho >> 4, i = rho & 15; return 8 * (i >> 2) + 4 * n + (i & 3); }

struct Unit { int pm, pn, pb, e; };
struct Gemm { const bf16_t* A; const bf16_t* Bt; int M, N, K; };

struct StaticOrder {
    int nM, nN, nwg, G, c;
    __host__ __device__ void init(int M, int N, int G_, int c_) { nM = M / BM; nN = N / BM; nwg = nM * nN; G = G_; c = c_; }
    __host__ __device__ bool next(int i, Unit& u) const {
        const long L = (long)i * G + c; if (L >= nwg) return false;
        int wgid = (int)L; { const int q = nwg / NXCD, r = nwg % NXCD, xcd = wgid % NXCD, off = wgid / NXCD; wgid = (xcd < r ? xcd * (q + 1) : r * (q + 1) + (xcd - r) * q) + off; }
        const int nig = WGM * nN, gid = wgid / nig, fm = gid * WGM, gsz = (nM - fm) < WGM ? (nM - fm) : WGM;
        u.pm = fm + ((wgid % nig) % gsz); u.pn = (wgid % nig) / gsz; u.pb = u.pn; u.e = 0; return true;
    }
    __device__ __forceinline__ void a_ready(const Unit&) const {}
    __device__ __forceinline__ void done(const Unit&) const {}
};

__device__ __forceinline__ unsigned cvt_pk_bf16(float lo, float hi) { unsigned r; asm volatile("v_cvt_pk_bf16_f32 %0, %1, %2" : "=v"(r) : "v"(lo), "v"(hi)); return r; }
__device__ __forceinline__ u32x4 pack8(const f32x4 a, const f32x4 b) { u32x4 w; w.x = cvt_pk_bf16(a[0], a[1]); w.y = cvt_pk_bf16(a[2], a[3]); w.z = cvt_pk_bf16(b[0], b[1]); w.w = cvt_pk_bf16(b[2], b[3]); return w; }
__device__ __forceinline__ float bf_lo(unsigned w) { return __uint_as_float(w << 16); }
__device__ __forceinline__ float bf_hi(unsigned w) { return __uint_as_float(w & 0xffff0000u); }
__device__ __forceinline__ void unpack8(const u32x4 w, f32x4& a, f32x4& b) { a = (f32x4){bf_lo(w.x), bf_hi(w.x), bf_lo(w.y), bf_hi(w.y)}; b = (f32x4){bf_lo(w.z), bf_hi(w.z), bf_lo(w.w), bf_hi(w.w)}; }
__device__ __forceinline__ float sigmoidf_(float x) { return __builtin_amdgcn_rcpf(1.0f + __expf(-x)); }
__device__ __forceinline__ f32x4 sig4(const f32x4 v) { return (f32x4){sigmoidf_(v[0]), sigmoidf_(v[1]), sigmoidf_(v[2]), sigmoidf_(v[3])}; }

struct EpiPlain {
    static constexpr bool PERM = true, AFTER_DRAIN = false;
    bf16_t* O; int ldc;
    __device__ __forceinline__ void operator()(const f32x4 (&acc)[2][2][4][2], const Unit& u, int wr, int wc, int fr, int fq) const {
        const int row0 = u.pm * BM + wr * 64 + fr, col0 = u.pn * BM + wc * 32 + 8 * fq;
#pragma unroll
        for (int ai = 0; ai < 2; ++ai)
#pragma unroll
            for (int m = 0; m < 4; ++m) { bf16_t* rowp = O + (size_t)(row0 + ai * HALF + m * 16) * ldc + col0;
#pragma unroll
                for (int bj = 0; bj < 2; ++bj) *(u32x4*)(rowp + bj * HALF) = pack8(acc[ai][bj][m][0], acc[ai][bj][m][1]); }
    }
};

struct EpiInProj {
    static constexpr bool PERM = true, AFTER_DRAIN = false;
    bf16_t* P; const float* rope; float qscale;
    __device__ __forceinline__ void operator()(const f32x4 (&acc)[2][2][4][2], const Unit& u, int wr, int wc, int fr, int fq) const {
        const int row0 = u.pm * BM + wr * 64 + fr;
        if (u.pn < 4) {
            const float qs = (u.pn < 2) ? qscale : 1.0f;
            const int colbase = u.pn * BM + wc * 64 + 8 * fq;
#pragma unroll
            for (int ai = 0; ai < 2; ++ai)
#pragma unroll
                for (int m = 0; m < 4; ++m) { const int row = row0 + ai * HALF + m * 16, pos = row & 4095;
                    const float* cp = rope + pos * 32 + 8 * fq; const float* sp = cp + 4096 * 32;
                    const f32x4 c0 = *(const f32x4*)cp, c1 = *(const f32x4*)(cp + 4), s0 = *(const f32x4*)sp, s1 = *(const f32x4*)(sp + 4);
                    const f32x4 a0 = acc[ai][0][m][0], a1 = acc[ai][0][m][1], b0 = acc[ai][1][m][0], b1 = acc[ai][1][m][1];
                    const f32x4 y10 = (a0 * c0 - b0 * s0) * qs, y11 = (a1 * c1 - b1 * s1) * qs, y20 = (b0 * c0 + a0 * s0) * qs, y21 = (b1 * c1 + a1 * s1) * qs;
                    bf16_t* rowp = P + (size_t)row * 5120 + colbase;
                    *(u32x4*)(rowp) = pack8(y10, y11); *(u32x4*)(rowp + 32) = pack8(y20, y21); }
        } else {
            const int col0 = u.pn * BM + wc * 32 + 8 * fq; const bool gate = u.pn >= 12; const float sc = (u.pn == 6 || u.pn == 7) ? 0.125f : 1.0f;
#pragma unroll
            for (int ai = 0; ai < 2; ++ai)
#pragma unroll
                for (int m = 0; m < 4; ++m) { bf16_t* rowp = P + (size_t)(row0 + ai * HALF + m * 16) * 5120 + col0;
#pragma unroll
                    for (int bj = 0; bj < 2; ++bj) { f32x4 v0 = acc[ai][bj][m][0], v1 = acc[ai][bj][m][1];
                        if (gate) { v0 = sig4(v0); v1 = sig4(v1); } else { v0 = v0 * sc; v1 = v1 * sc; }
                        *(u32x4*)(rowp + bj * HALF) = pack8(v0, v1); } }
        }
    }
};

template <int SECOND> struct EpiMix {
    static constexpr bool PERM = true, AFTER_DRAIN = false;
    const bf16_t* P; bf16_t* MX;
    __device__ __forceinline__ void operator()(const f32x4 (&acc)[2][2][4][2], const Unit& u, int wr, int wc, int fr, int fq) const {
        const int row0 = u.pm * BM + wr * 64 + fr, col0 = u.pn * BM + wc * 32 + 8 * fq;
#pragma unroll
        for (int ai = 0; ai < 2; ++ai)
#pragma unroll
            for (int m = 0; m < 4; ++m) { const size_t row = (size_t)(row0 + ai * HALF + m * 16);
#pragma unroll
                for (int bj = 0; bj < 2; ++bj) { const int c = col0 + bj * HALF;
                    const u32x4 gw = *(const u32x4*)(P + row * 5120 + (SECOND ? 4096 : 3072) + c); f32x4 g0, g1; unpack8(gw, g0, g1);
                    f32x4 v0 = acc[ai][bj][m][0] * g0, v1 = acc[ai][bj][m][1] * g1;
                    if (SECOND) { const u32x4 ow = *(const u32x4*)(MX + row * 1024 + c); f32x4 o0, o1; unpack8(ow, o0, o1); v0 = v0 + o0; v1 = v1 + o1; }
                    *(u32x4*)(MX + row * 1024 + c) = pack8(v0, v1); } }
    }
};

struct EpiResid {
    static constexpr bool PERM = false, AFTER_DRAIN = false;
    const float* X; float* O; int ldc;
    __device__ __forceinline__ void operator()(const f32x4 (&acc)[2][2][4][2], const Unit& u, int wr, int wc, int fr, int fq) const {
        const int row0 = u.pm * BM + wr * 64 + fr, col0 = u.pn * BM + wc * 32 + 4 * fq;
#pragma unroll
        for (int ai = 0; ai < 2; ++ai)
#pragma unroll
            for (int m = 0; m < 4; ++m) { const size_t off = (size_t)(row0 + ai * HALF + m * 16) * ldc + col0;
#pragma unroll
                for (int bj = 0; bj < 2; ++bj)
#pragma unroll
                    for (int n = 0; n < 2; ++n) { const f32x4 xv = *(const f32x4*)(X + off + bj * HALF + n * 16); *(f32x4*)(O + off + bj * HALF + n * 16) = xv + acc[ai][bj][m][n]; } }
    }
};

struct EpiMoe1 {
    static constexpr bool PERM = true, AFTER_DRAIN = false;
    bf16_t* ACT; const float* bg; const float* bu;
    __device__ __forceinline__ void operator()(const f32x4 (&acc)[2][2][4][2], const Unit& u, int wr, int wc, int fr, int fq) const {
        const int row0 = u.pm * BM + wr * 64 + fr, f0 = u.pn * HALF + wc * 32 + 8 * fq;
        const f32x4 bg0 = *(const f32x4*)(bg + u.e * 1024 + f0), bg1 = *(const f32x4*)(bg + u.e * 1024 + f0 + 4);
        const f32x4 bu0 = *(const f32x4*)(bu + u.e * 1024 + f0), bu1 = *(const f32x4*)(bu + u.e * 1024 + f0 + 4);
#pragma unroll
        for (int ai = 0; ai < 2; ++ai)
#pragma unroll
            for (int m = 0; m < 4; ++m) { f32x4 r[2];
#pragma unroll
                for (int n = 0; n < 2; ++n) { const f32x4 gv = acc[ai][0][m][n] + (n ? bg1 : bg0), uv = acc[ai][1][m][n] + (n ? bu1 : bu0);
#pragma unroll
                    for (int e = 0; e < 4; ++e) { const float g = fminf(gv[e], 7.0f), uu = fminf(fmaxf(uv[e], -7.0f), 7.0f); r[n][e] = (uu + 1.0f) * (g * sigmoidf_(1.702f * g)); } }
                *(u32x4*)(ACT + (size_t)(row0 + ai * HALF + m * 16) * 1024 + f0) = pack8(r[0], r[1]); }
    }
};
struct EpiMoe2 {
    static constexpr bool PERM = true, AFTER_DRAIN = false;
    bf16_t* Y; const float* bd; const float* rg;
    __device__ __forceinline__ void operator()(const f32x4 (&acc)[2][2][4][2], const Unit& u, int wr, int wc, int fr, int fq) const {
        const int row0 = u.pm * BM + wr * 64 + fr, col0 = u.pn * BM + wc * 32 + 8 * fq;
        f32x4 bv[2][2];
#pragma unroll
        for (int bj = 0; bj < 2; ++bj)
#pragma unroll
            for (int n = 0; n < 2; ++n) bv[bj][n] = *(const f32x4*)(bd + u.e * 1024 + col0 + bj * HALF + 4 * n);
#pragma unroll
        for (int ai = 0; ai < 2; ++ai)
#pragma unroll
            for (int m = 0; m < 4; ++m) { const int row = row0 + ai * HALF + m * 16; const float g = rg[row];
#pragma unroll
                for (int bj = 0; bj < 2; ++bj) *(u32x4*)(Y + (size_t)row * 1024 + col0 + bj * HALF) = pack8((acc[ai][bj][m][0] + bv[bj][0]) * g, (acc[ai][bj][m][1] + bv[bj][1]) * g); }
    }
};
struct MoeOrder {
    int nU, npn, G, c; const PG8_LAS int* tile_e;
    __device__ __forceinline__ bool next(int i, Unit& u) const {
        const int x = c & 7, slot = i * (G >> 3) + (c >> 3), per = (nU + 7) >> 3;
        if (slot >= per) return false; const int id = x * per + slot; if (id >= nU) return false;
        const int t = id / npn, pn = id - t * npn, e = tile_e[t];
        u.pm = t; u.pn = pn; u.e = e; u.pb = e * npn + pn; return true;
    }
    __device__ __forceinline__ void a_ready(const Unit&) const {}
    __device__ __forceinline__ void done(const Unit&) const {}
};
template <class Epi, class Sched, bool ALIGN_EPI = false, bool SP2 = false>
__device__ __forceinline__ void gemm_phase(PG8_LAS unsigned char* lds, const Gemm g, const Sched& S, const Epi& E) {
    const int tid = threadIdx.x, wid = __builtin_amdgcn_readfirstlane(tid >> 6), lane = tid & 63, wr = wid >> 2, wc = wid & 3, fr = lane & 15, fq = lane >> 4;
    const int K = g.K, nt = K / BK;
    unsigned voffA[2], voffB[2];
#pragma unroll
    for (int i = 0; i < 2; ++i) { int R, C; stage_rc(tid * 16 + i * 8192, R, C); const int Rb = Epi::PERM ? ((R & ~31) + perm32(R & 31)) : R;
        voffA[i] = (unsigned)(R * K + C) * 2u; voffB[i] = (unsigned)(Rb * K + C) * 2u; }
    const size_t kstep = (size_t)(BK * 2);
    const size_t hstep = (size_t)HALF * K * 2;
    const size_t tstep = 2 * hstep;
    const unsigned ldsw = (unsigned)wid * 1024u;
    const int aoff = lds_byte(wr * 64 + fr, fq * 8), boff = lds_byte(wc * 32 + fr, fq * 8);
#define PG8_SA(b, h) (((b) * 2 + (h)) * HTB)
#define PG8_SB(b, h) ((4 + (b) * 2 + (h)) * HTB)
#define PG8_STAGE(bufoff, gbase, voff) do { _Pragma("unroll") for (int _i = 0; _i < 2; ++_i) \
        __builtin_amdgcn_global_load_lds((const unsigned*)((const char*)(gbase) + (voff)[_i]), (PG8_LAS unsigned*)(lds + (bufoff) + ldsw + _i * 8192), 16, 0, 0); } while (0)
#define PG8_LDA(dst, b, h) do { _Pragma("unroll") for (int m = 0; m < 4; ++m) _Pragma("unroll") for (int k = 0; k < 2; ++k) dst[m][k] = *(const PG8_LAS bf16x8*)(lds + PG8_SA(b, h) + aoff + m * 2048 + k * 1024); } while (0)
#define PG8_LDB(dst, b, h) do { _Pragma("unroll") for (int n = 0; n < 2; ++n) _Pragma("unroll") for (int k = 0; k < 2; ++k) dst[n][k] = *(const PG8_LAS bf16x8*)(lds + PG8_SB(b, h) + boff + n * 2048 + k * 1024); } while (0)
#define PG8_MMA(ai, bj, At, Bt) do { __builtin_amdgcn_s_setprio(1); _Pragma("unroll") for (int m = 0; m < 4; ++m) _Pragma("unroll") for (int n = 0; n < 2; ++n) _Pragma("unroll") for (int k = 0; k < 2; ++k) \
        acc[ai][bj][m][n] = __builtin_amdgcn_mfma_f32_16x16x32_bf16(Bt[n][k], At[m][k], acc[ai][bj][m][n], 0, 0, 0); __builtin_amdgcn_s_setprio(0); } while (0)
#define PG8_WAIT_V(n) asm volatile("s_waitcnt vmcnt(" #n ")" ::: "memory")
#define PG8_WAIT_L(n) asm volatile("s_waitcnt lgkmcnt(" #n ")" ::: "memory")
#define PG8_BAR __builtin_amdgcn_s_barrier()
#define PG8_SCHED __builtin_amdgcn_sched_barrier(0)
    Unit cur, nxt; int ui = 0;
    if (!S.next(0, cur)) return;
    f32x4 acc[2][2][4][2];
#pragma unroll
    for (int a = 0; a < 2; ++a)
#pragma unroll
        for (int b = 0; b < 2; ++b)
#pragma unroll
            for (int m = 0; m < 4; ++m)
#pragma unroll
                for (int n = 0; n < 2; ++n) acc[a][b][m][n] = (f32x4){0.f, 0.f, 0.f, 0.f};
    bf16x8 At[4][2], B0[2][2], B1[2][2];
    const char* cA = (const char*)g.A + (size_t)cur.pm * tstep; const char* cB = (const char*)g.Bt + (size_t)cur.pb * tstep;
    S.a_ready(cur);
    if constexpr (SP2) {
        PG8_STAGE(PG8_SB(0, 0), cB, voffB); PG8_STAGE(PG8_SB(0, 1), cB + hstep, voffB); PG8_STAGE(PG8_SA(0, 0), cA, voffA); PG8_STAGE(PG8_SA(0, 1), cA + hstep, voffA);
        if (wr == 1) PG8_BAR;
        PG8_WAIT_V(2); PG8_BAR;
        PG8_STAGE(PG8_SB(1, 0), cB + kstep, voffB); PG8_STAGE(PG8_SA(1, 0), cA + kstep, voffA); PG8_STAGE(PG8_SB(1, 1), cB + hstep + kstep, voffB);
        PG8_WAIT_V(6); PG8_BAR;
    } else {
        PG8_STAGE(PG8_SB(0, 0), cB, voffB); PG8_STAGE(PG8_SA(0, 0), cA, voffA); PG8_STAGE(PG8_SB(0, 1), cB + hstep, voffB); PG8_STAGE(PG8_SA(0, 1), cA + hstep, voffA);
        if (wr == 1) PG8_BAR;
        PG8_WAIT_V(4); PG8_BAR;
        PG8_STAGE(PG8_SB(1, 0), cB + kstep, voffB); PG8_STAGE(PG8_SA(1, 0), cA + kstep, voffA); PG8_STAGE(PG8_SB(1, 1), cB + hstep + kstep, voffB);
        PG8_WAIT_V(6); PG8_BAR;
    }
    for (;;) {
        const bool has_next = S.next(ui + 1, nxt);
        const char* nA = has_next ? (const char*)g.A + (size_t)nxt.pm * tstep : cA; const char* nB = has_next ? (const char*)g.Bt + (size_t)nxt.pb * tstep : cB;
        for (int t = 0; t < nt; t += 2) {
            const bool last = (t == nt - 2);
            const char* a1 = cA + (size_t)(t + 1) * kstep;
            const char* a2 = last ? nA : cA + (size_t)(t + 2) * kstep; const char* b2 = last ? nB : cB + (size_t)(t + 2) * kstep;
            const char* a3 = a2 + kstep; const char* b3 = b2 + kstep;
            if (last && has_next) S.a_ready(nxt);
            if constexpr (SP2) {
            PG8_LDB(B0, 0, 0); PG8_LDB(B1, 0, 1); PG8_SCHED; PG8_LDA(At, 0, 0); PG8_STAGE(PG8_SA(1, 1), a1 + hstep, voffA);
            PG8_WAIT_V(8); PG8_WAIT_L(0); PG8_BAR; PG8_MMA(0, 0, At, B0); PG8_MMA(0, 1, At, B1); PG8_BAR; PG8_SCHED;
            PG8_LDA(At, 0, 1); PG8_STAGE(PG8_SB(0, 0), b2, voffB); PG8_STAGE(PG8_SB(0, 1), b2 + hstep, voffB); PG8_STAGE(PG8_SA(0, 0), a2, voffA);
            PG8_WAIT_V(8); PG8_WAIT_L(0); PG8_BAR; PG8_MMA(1, 0, At, B0); PG8_MMA(1, 1, At, B1); PG8_BAR; PG8_SCHED;
            PG8_LDB(B0, 1, 0); PG8_LDB(B1, 1, 1); PG8_SCHED; PG8_LDA(At, 1, 0); PG8_STAGE(PG8_SA(0, 1), a2 + hstep, voffA);
            PG8_WAIT_V(8); PG8_WAIT_L(0); PG8_BAR; PG8_MMA(0, 0, At, B0); PG8_MMA(0, 1, At, B1); PG8_BAR; PG8_SCHED;
            PG8_LDA(At, 1, 1); PG8_STAGE(PG8_SB(1, 0), b3, voffB); PG8_STAGE(PG8_SB(1, 1), b3 + hstep, voffB); PG8_STAGE(PG8_SA(1, 0), a3, voffA);
            PG8_WAIT_V(8); PG8_WAIT_L(0); PG8_BAR; PG8_MMA(1, 0, At, B0); PG8_MMA(1, 1, At, B1); PG8_BAR; PG8_SCHED;
            } else {
            PG8_LDB(B0, 0, 0); PG8_SCHED; PG8_LDA(At, 0, 0); PG8_STAGE(PG8_SA(1, 1), a1 + hstep, voffA);
            PG8_WAIT_L(8); PG8_BAR; PG8_WAIT_L(0); PG8_MMA(0, 0, At, B0); PG8_BAR; PG8_SCHED;
            PG8_LDB(B1, 0, 1); PG8_STAGE(PG8_SB(0, 0), b2, voffB);
            PG8_BAR; PG8_WAIT_L(0); PG8_MMA(0, 1, At, B1); PG8_BAR;
            PG8_LDA(At, 0, 1); PG8_STAGE(PG8_SA(0, 0), a2, voffA);
            PG8_BAR; PG8_WAIT_L(0); PG8_MMA(1, 0, At, B0); PG8_BAR; PG8_SCHED;
            PG8_STAGE(PG8_SB(0, 1), b2 + hstep, voffB);
            PG8_WAIT_V(6); PG8_BAR; PG8_MMA(1, 1, At, B1); PG8_BAR;
            PG8_LDB(B0, 1, 0); PG8_SCHED; PG8_LDA(At, 1, 0); PG8_STAGE(PG8_SA(0, 1), a2 + hstep, voffA);
            PG8_WAIT_L(8); PG8_BAR; PG8_WAIT_L(0); PG8_MMA(0, 0, At, B0); PG8_BAR; PG8_SCHED;
            PG8_LDB(B1, 1, 1); PG8_STAGE(PG8_SB(1, 0), b3, voffB);
            PG8_BAR; PG8_WAIT_L(0); PG8_MMA(0, 1, At, B1); PG8_BAR;
            PG8_LDA(At, 1, 1); PG8_STAGE(PG8_SA(1, 0), a3, voffA);
            PG8_BAR; PG8_WAIT_L(0); PG8_MMA(1, 0, At, B0); PG8_BAR; PG8_SCHED;
            PG8_STAGE(PG8_SB(1, 1), b3 + hstep, voffB);
            PG8_WAIT_V(6); PG8_BAR; PG8_MMA(1, 1, At, B1); PG8_BAR;
            }
        }
        if constexpr (ALIGN_EPI) { if (wr == 0) PG8_BAR; }
        if constexpr (!Epi::AFTER_DRAIN) { E(acc, cur, wr, wc, fr, fq); S.done(cur); }
        if (!has_next) break;
#pragma unroll
        for (int a = 0; a < 2; ++a)
#pragma unroll
            for (int b = 0; b < 2; ++b)
#pragma unroll
                for (int m = 0; m < 4; ++m)
#pragma unroll
                    for (int n = 0; n < 2; ++n) acc[a][b][m][n] = (f32x4){0.f, 0.f, 0.f, 0.f};
        cur = nxt; cA = nA; cB = nB; ++ui;
        if constexpr (ALIGN_EPI) { if (wr == 1) PG8_BAR; }
    }
    PG8_WAIT_V(0);
    if constexpr (!ALIGN_EPI) { if (wr == 0) PG8_BAR; }
    PG8_BAR;
    if constexpr (Epi::AFTER_DRAIN) { E.fused(acc, cur, wr, wc, fr, fq, lds, wid, lane); S.done(cur); }
#undef PG8_SA
#undef PG8_SB
#undef PG8_STAGE
#undef PG8_LDA
#undef PG8_LDB
#undef PG8_MMA
#undef PG8_WAIT_V
#undef PG8_WAIT_L
#undef PG8_BAR
#undef PG8_SCHED
}
}

#ifndef PG8_SP2
#define PG8_SP2 true
#endif
#ifndef PG8_ALIGN
#define PG8_ALIGN true
#endif
#include <hip/hip_bf16.h>
#include <cmath>
namespace attn_body {
using bf16=__hip_bfloat16;
using bf16x8=__attribute__((ext_vector_type(8)))short;
using s16x4=__attribute__((ext_vector_type(4)))short;
using f32x16=__attribute__((ext_vector_type(16)))float;
using u32x4=__attribute__((ext_vector_type(4)))unsigned;
constexpr int BATCH=4,NHEAD=16,SEQ=4096,D=64,DM=NHEAD*D;
constexpr int NW=8,QBLK=32,QB=QBLK*NW,KVBLK=64,NQB=SEQ/QB;
constexpr int ATTN_PITCH=DM, ATTN_UNIT_ROWS=QB;
__device__ __forceinline__ int crow(int r,int hi){return (r&3)+8*(r>>2)+4*hi;}
#define SBAR() __builtin_amdgcn_sched_barrier(0)
__device__ __forceinline__ void cmask(f32x16&p0,f32x16&p1,int jb,int qrel,int hi){
  const float NEG=-INFINITY; int kb=64*jb+4*hi;
  #pragma unroll
  for(int r=0;r<16;++r){int kv=kb+(r&3)+8*(r>>2); if(kv>qrel)p0[r]=NEG; if(kv+32>qrel)p1[r]=NEG;}
}

constexpr int NSLOT=3, SLOTB=8192;
constexpr int LDS_K=0, LDS_V=NSLOT*SLOTB, LDS_WS=2*NSLOT*SLOTB, LDS_OST=LDS_WS+NW*64*4, LDS_BYTES=LDS_OST+NW*4096;
constexpr float C2=0.125f*1.4426950408889634f;
__device__ __forceinline__ void glds16(const void*gsrc,unsigned lds_dst){unsigned keep;
  asm volatile("s_mov_b32 %0, m0\n\ts_mov_b32 m0, %2\n\ts_nop 0\n\tglobal_load_lds_dwordx4 %1, off\n\ts_mov_b32 m0, %0":"=&s"(keep):"v"(gsrc),"s"(lds_dst):"memory");}
__device__ __forceinline__ float max3f(float a,float b,float c){float r;asm("v_max3_f32 %0, %1, %2, %3":"=v"(r):"v"(a),"v"(b),"v"(c));return r;}
__device__ __forceinline__ float max2f(float a,float b){float r;asm("v_max_f32_e32 %0, %1, %2":"=v"(r):"v"(a),"v"(b));return r;}
__device__ __forceinline__ float fadd_s(float a,float b){float r;asm("v_add_f32_e32 %0, %1, %2":"=v"(r):"v"(a),"v"(b));return r;}
__device__ __forceinline__ float fsub_s(float a,float b){float r;asm("v_sub_f32_e32 %0, %1, %2":"=v"(r):"v"(a),"v"(b));return r;}
typedef float f32x2_t __attribute__((ext_vector_type(2))); typedef __bf16 bf16x2_t __attribute__((ext_vector_type(2)));
__device__ __forceinline__ unsigned cvtpk_s(float lo,float hi){f32x2_t v={lo,hi};bf16x2_t b=__builtin_convertvector(v,bf16x2_t);return __builtin_bit_cast(unsigned,b);}
#define WAIT_BAR(N) asm volatile("s_waitcnt vmcnt(" #N ") lgkmcnt(0)\n\ts_barrier":::"memory")

__device__ __forceinline__ void qkt(f32x16&p0,f32x16&p1,const char*Kslot,const bf16x8*qr,const f32x16&negm,int r32,int hi){
  const char*kb=Kslot+hi*1024+r32*16;
  #pragma unroll
  for(int d0=0;d0<4;++d0){
    const bf16x8 b0=*reinterpret_cast<const bf16x8*>(kb+d0*2048);
    const bf16x8 b1=*reinterpret_cast<const bf16x8*>(kb+d0*2048+512);
    if(d0==0){p0=__builtin_amdgcn_mfma_f32_32x32x16_bf16(b0,qr[0],negm,0,0,0);p1=__builtin_amdgcn_mfma_f32_32x32x16_bf16(b1,qr[0],negm,0,0,0);}
    else{p0=__builtin_amdgcn_mfma_f32_32x32x16_bf16(b0,qr[d0],p0,0,0,0);p1=__builtin_amdgcn_mfma_f32_32x32x16_bf16(b1,qr[d0],p1,0,0,0);}}
}
typedef __attribute__((address_space(3))) const char* lds_cptr;
typedef short v4i16_t __attribute__((ext_vector_type(4)));
__device__ __forceinline__ void kload8(bf16x8*kf,lds_cptr kp){
  kf[0]=*(const __attribute__((address_space(3))) bf16x8*)(kp);      kf[1]=*(const __attribute__((address_space(3))) bf16x8*)(kp+512);
  kf[2]=*(const __attribute__((address_space(3))) bf16x8*)(kp+2048); kf[3]=*(const __attribute__((address_space(3))) bf16x8*)(kp+2560);
  kf[4]=*(const __attribute__((address_space(3))) bf16x8*)(kp+4096); kf[5]=*(const __attribute__((address_space(3))) bf16x8*)(kp+4608);
  kf[6]=*(const __attribute__((address_space(3))) bf16x8*)(kp+6144); kf[7]=*(const __attribute__((address_space(3))) bf16x8*)(kp+6656);
}
__device__ __forceinline__ void kload2(bf16x8*kf,lds_cptr kp,int j){ kf[2*j]=*(const __attribute__((address_space(3))) bf16x8*)(kp+j*2048); kf[2*j+1]=*(const __attribute__((address_space(3))) bf16x8*)(kp+j*2048+512); }
__device__ __forceinline__ s16x4 vtr(lds_cptr p){ return __builtin_bit_cast(s16x4,__builtin_amdgcn_ds_read_tr16_b64_v4i16((__attribute__((address_space(3))) v4i16_t*)p)); }
__device__ __forceinline__ float rowmax(const f32x16&p0,const f32x16&p1){
  float a=max3f(p0[0],p0[1],p1[0]),b=max3f(p0[2],p0[3],p1[1]);a=max3f(a,p1[2],p1[3]);
  #pragma unroll
  for(int r=4;r<16;r+=4){a=max3f(a,p0[r],p0[r+1]);b=max3f(b,p0[r+2],p0[r+3]);a=max3f(a,p1[r],p1[r+1]);b=max3f(b,p1[r+2],p1[r+3]);}
  const float m=max2f(a,b);
  auto rr=__builtin_amdgcn_permlane32_swap(__float_as_uint(m),__float_as_uint(m),false,false);
  return max2f(__uint_as_float(rr[0]),__uint_as_float(rr[1]));
}
__device__ __forceinline__ void pv(f32x16*o,int vb,bf16x8 pa0,bf16x8 pa1,bf16x8 pa2,bf16x8 pa3){
  #pragma unroll
  for(int d0=0;d0<2;++d0){s16x4 lo[4],hi[4];
    #pragma unroll
    for(int ks=0;ks<4;++ks){
      asm volatile("ds_read_b64_tr_b16 %0,%1 offset:%c2":"=&v"(lo[ks]):"v"(vb),"i"(d0*4096+ks*1024):"memory");
      asm volatile("ds_read_b64_tr_b16 %0,%1 offset:%c2":"=&v"(hi[ks]):"v"(vb),"i"(d0*4096+ks*1024+512):"memory");}
    asm volatile("s_waitcnt lgkmcnt(0)":::"memory");SBAR();
    #define PK(k) (bf16x8){lo[k][0],lo[k][1],lo[k][2],lo[k][3],hi[k][0],hi[k][1],hi[k][2],hi[k][3]}
    o[d0]=__builtin_amdgcn_mfma_f32_32x32x16_bf16(pa0,PK(0),o[d0],0,0,0);
    o[d0]=__builtin_amdgcn_mfma_f32_32x32x16_bf16(pa1,PK(1),o[d0],0,0,0);
    o[d0]=__builtin_amdgcn_mfma_f32_32x32x16_bf16(pa2,PK(2),o[d0],0,0,0);
    o[d0]=__builtin_amdgcn_mfma_f32_32x32x16_bf16(pa3,PK(3),o[d0],0,0,0);
    #undef PK
  }
}

#ifndef ATTN_STORE16
#define ATTN_STORE16(p,v) (*(u32x4*)(p)=(v))
#endif
template<int THRL,int QP,int KP,int VP,int OP> __device__ __forceinline__ void attn_unit(int b,int qb,const bf16*Q,const bf16*__restrict__ K,const bf16*__restrict__ V,bf16*O,char*shm){
  int tid_=threadIdx.x; asm volatile("":"+v"(tid_));
  const int tid=tid_,lane=tid&63,r32=lane&31,hi=lane>>5; const int wid=__builtin_amdgcn_readfirstlane(tid>>6);
  const long rowbase=(long)b*SEQ; const int q0=qb*QB;
  const bf16*Qw=Q+(rowbase+q0+wid*QBLK)*QP;
  const bf16*Kh=K+rowbase*KP,*Vh=V+rowbase*VP;
  const unsigned lds0=(unsigned)(uintptr_t)shm;
  float*wsf=(float*)(shm+LDS_WS)+wid*64;
  const bf16*ksrc=Kh+(long)lane*KP+wid*8;
  const bf16*vsrc=Vh+(long)(16*(wid&3)+(lane>>2))*VP+(wid>>2)*32+(lane&3)*8;
  const unsigned kdst=lds0+LDS_K+wid*1024, vdst=lds0+LDS_V+wid*1024;
  #define DMA_K(t,slot) glds16(ksrc+(long)(t)*KVBLK*KP,(unsigned)__builtin_amdgcn_readfirstlane(kdst+(slot)))
  #define DMA_V(t,slot) glds16(vsrc+(long)(t)*KVBLK*VP,(unsigned)__builtin_amdgcn_readfirstlane(vdst+(slot)))
  const int vb0=(int)(lds0+LDS_V)+((lane>>4)&1)*32+(lane&3)*8+(4*hi+((lane&15)>>2))*64;
  const char*Kbase=shm+LDS_K; bf16x8 kf[8];
  const lds_cptr shm3=(lds_cptr)shm; const lds_cptr kp0=shm3+LDS_K+hi*1024+r32*16; const lds_cptr vp0=shm3+LDS_V+((lane>>4)&1)*32+(lane&3)*8+(4*hi+((lane&15)>>2))*64;
  const int NT=(q0+QB)/KVBLK;
  DMA_K(0,0);DMA_V(0,0);DMA_K(1,SLOTB);
  bf16x8 qr[4];
  #pragma unroll
  for(int d0=0;d0<4;++d0)qr[d0]=*reinterpret_cast<const bf16x8*>(&Qw[(long)r32*QP+d0*16+hi*8]);
  float mhat=0.f,l_reg=0.f;f32x16 o[2];o[0]=f32x16{};o[1]=f32x16{};f32x16 negm=f32x16{};asm volatile("":"+v"(negm));
  const int qrel=wid*QBLK+r32;
  #define CMASK(P0,P1,t) do{int jb_=(t)-(NT-4); if(jb_>=0)cmask(P0,P1,jb_,qrel,hi);}while(0)
  bool resc=false;
  #define START(P0,P1) do{ const float rm=rowmax(P0,P1); resc=false; \
    { const float dl=rm; mhat=fadd_s(mhat,dl); \
      _Pragma("unroll") for(int r=0;r<16;++r){P0[r]=fsub_s(P0[r],dl);P1[r]=fsub_s(P1[r],dl);} \
      _Pragma("unroll") for(int r=0;r<16;++r)negm[r]=-mhat; asm volatile("":"+v"(negm)); } \
    _Pragma("unroll") for(int r=0;r<16;++r)P0[r]=__builtin_amdgcn_exp2f(P0[r]); }while(0)
  #define RESC() do{ if(resc){ asm volatile("s_waitcnt lgkmcnt(0)":::"memory"); \
      _Pragma("unroll") for(int d_=0;d_<2;++d_) _Pragma("unroll") for(int r=0;r<16;++r)o[d_][r]*=wsf[crow(r,hi)]; } }while(0)
  f32x16 pA0,pA1,pB0,pB1;
  int sl_prev=0,sl_cur=0,sl_next=SLOTB;
  #define ROT() do{sl_prev=sl_cur;sl_cur=sl_next;sl_next=(sl_next==(NSLOT-1)*SLOTB)?0:sl_next+SLOTB;}while(0)
  DMA_K(2,2*SLOTB);
  WAIT_BAR(3);
  qkt(pA0,pA1,Kbase,qr,negm,r32,hi);asm volatile("s_nop 15\n\ts_nop 7":"+v"(pA0),"+v"(pA1));CMASK(pA0,pA1,0);
  START(pA0,pA1);
  _Pragma("unroll") for(int r=0;r<16;++r)pA1[r]=__builtin_amdgcn_exp2f(pA1[r]);
  WAIT_BAR(0);
  DMA_K(3,0);DMA_V(1,SLOTB);
  ROT();
  kload8(kf,kp0+sl_cur);
  WAIT_BAR(2);
  s16x4 vlo[8],vhi[8]; u32x4 pw0,pw1,pw2,pw3;
  #define PKW(P,B) cvtpk_s(P[B],P[B+1])
  #define PAF(k) __builtin_bit_cast(bf16x8,pw##k)
  #define VFR(i) (bf16x8){vlo[i][0],vlo[i][1],vlo[i][2],vlo[i][3],vhi[i][0],vhi[i][1],vhi[i][2],vhi[i][3]}
  #define PIN(x) asm volatile("":"+v"(x))
  #define MX3(a,b,c) __builtin_fmaxf(__builtin_fmaxf((a),(b)),(c))
  #define GAPA(MF,A0,A1,A2,A3,W0,W1,PW) do{ MF; sacc+=A0; sacc+=A1; sacc+=A2; sacc+=A3; PIN(sacc); W0; W1; PIN(PW); SBAR(); }while(0)
  #define EX(v) __builtin_amdgcn_exp2f(v)
  #define GAPB(MF,X,B) do{ MF; X[B]=EX(X[B]); X[B+1]=EX(X[B+1]); X[B+2]=EX(X[B+2]); X[B+3]=EX(X[B+3]); PIN(X); SBAR(); }while(0)
  #define VRD(i) do{ vlo[i]=vtr(vp_+(((i)>>2)*4096+((i)&3)*1024)); vhi[i]=vtr(vp_+(((i)>>2)*4096+((i)&3)*1024+512)); }while(0)
  #define KRD(G,j) do{ if(G){ kload2(kf,kp0+sl_next,j); SBAR(); } }while(0)
  #define STEP(C0,C1,P0,P1,t,GK,GV,GL) do{ SBAR(); \
    const lds_cptr vp_=vp0+sl_prev; \
    VRD(0); SBAR(); float sacc=(P0[0]+P0[1]); \
    GAPA(C0=__builtin_amdgcn_mfma_f32_32x32x16_bf16(kf[0],qr[0],negm,0,0,0), P0[2],P0[3],P0[4],P0[5],     pw0[0]=PKW(P0,0), pw0[1]=PKW(P0,2), pw0); \
    VRD(4); SBAR(); GAPA(C1=__builtin_amdgcn_mfma_f32_32x32x16_bf16(kf[1],qr[0],negm,0,0,0), P0[6],P0[7],P0[8],P0[9],     pw0[2]=PKW(P0,4), pw0[3]=PKW(P0,6), pw0); \
    VRD(1); SBAR(); GAPA(C0=__builtin_amdgcn_mfma_f32_32x32x16_bf16(kf[2],qr[1],C0,0,0,0),   P0[10],P0[11],P0[12],P0[13], pw1[0]=PKW(P0,8), pw1[1]=PKW(P0,10), pw1); \
    VRD(5); SBAR(); GAPA(C1=__builtin_amdgcn_mfma_f32_32x32x16_bf16(kf[3],qr[1],C1,0,0,0),   P0[14],P0[15],P1[0],P1[1],   pw1[2]=PKW(P0,12),pw1[3]=PKW(P0,14), pw1); \
    VRD(2); SBAR(); GAPA(C0=__builtin_amdgcn_mfma_f32_32x32x16_bf16(kf[4],qr[2],C0,0,0,0),   P1[2],P1[3],P1[4],P1[5],     pw2[0]=PKW(P1,0), pw2[1]=PKW(P1,2), pw2); \
    VRD(6); SBAR(); GAPA(C1=__builtin_amdgcn_mfma_f32_32x32x16_bf16(kf[5],qr[2],C1,0,0,0),   P1[6],P1[7],P1[8],P1[9],     pw2[2]=PKW(P1,4), pw2[3]=PKW(P1,6), pw2); \
    VRD(3); SBAR(); GAPA(C0=__builtin_amdgcn_mfma_f32_32x32x16_bf16(kf[6],qr[3],C0,0,0,0),   P1[10],P1[11],P1[12],P1[13], pw3[0]=PKW(P1,8), pw3[1]=PKW(P1,10), pw3); \
    VRD(7); SBAR(); GAPA(C1=__builtin_amdgcn_mfma_f32_32x32x16_bf16(kf[7],qr[3],C1,0,0,0),   P1[14],P1[15],0.f,0.f,       pw3[2]=PKW(P1,12),pw3[3]=PKW(P1,14), pw3); \
    l_reg+=sacc; \
    if(GK){DMA_K((t)+3,sl_cur);} if(GV){DMA_V((t)+1,sl_next);} \
    CMASK(C0,C1,t); \
    { float a=MX3(C0[0],C0[1],C1[0]),b=MX3(C0[2],C0[3],C1[1]); a=MX3(a,C1[2],C1[3]); \
      _Pragma("unroll") for(int r=4;r<16;r+=4){a=MX3(a,C0[r],C0[r+1]);b=MX3(b,C0[r+2],C0[r+3]);a=MX3(a,C1[r],C1[r+1]);b=MX3(b,C1[r+2],C1[r+3]);} \
      float rm=__builtin_fmaxf(a,b); { auto rr=__builtin_amdgcn_permlane32_swap(__float_as_uint(rm),__float_as_uint(rm),false,false); rm=__builtin_fmaxf(__uint_as_float(rr[0]),__uint_as_float(rr[1])); } \
      resc=false; \
      if(__builtin_expect(__any(rm>(float)THRL),0)){ const float dl=__builtin_fmaxf(rm,0.f); mhat+=dl; \
        _Pragma("unroll") for(int r=0;r<16;++r){C0[r]-=dl;C1[r]-=dl;} \
        _Pragma("unroll") for(int r=0;r<16;++r)negm[r]=-mhat; asm volatile("":"+v"(negm)); \
        const float f=__builtin_amdgcn_exp2f(-dl); l_reg*=f; if(hi==0)wsf[r32]=f; resc=true; } } \
    SBAR(); \
    GAPB(o[0]=__builtin_amdgcn_mfma_f32_32x32x16_bf16(PAF(0),VFR(0),o[0],0,0,0), C0,0); \
    GAPB(o[1]=__builtin_amdgcn_mfma_f32_32x32x16_bf16(PAF(0),VFR(4),o[1],0,0,0), C0,4); \
    KRD(GL,0); GAPB(o[0]=__builtin_amdgcn_mfma_f32_32x32x16_bf16(PAF(1),VFR(1),o[0],0,0,0), C0,8); \
    KRD(GL,1); GAPB(o[1]=__builtin_amdgcn_mfma_f32_32x32x16_bf16(PAF(1),VFR(5),o[1],0,0,0), C0,12); \
    KRD(GL,2); GAPB(o[0]=__builtin_amdgcn_mfma_f32_32x32x16_bf16(PAF(2),VFR(2),o[0],0,0,0), C1,0); \
    KRD(GL,3); GAPB(o[1]=__builtin_amdgcn_mfma_f32_32x32x16_bf16(PAF(2),VFR(6),o[1],0,0,0), C1,4); \
    GAPB(o[0]=__builtin_amdgcn_mfma_f32_32x32x16_bf16(PAF(3),VFR(3),o[0],0,0,0), C1,8); \
    GAPB(o[1]=__builtin_amdgcn_mfma_f32_32x32x16_bf16(PAF(3),VFR(7),o[1],0,0,0), C1,12); \
    }while(0)
  int t=1;
  #undef CMASK
  #define CMASK(P0,P1,t) do{}while(0)
  for(;t+5<NT;t+=2){
    STEP(pB0,pB1,pA0,pA1,t,true,true,true);     WAIT_BAR(2); RESC(); ROT();
    STEP(pA0,pA1,pB0,pB1,t+1,true,true,true);   WAIT_BAR(2); RESC(); ROT();
  }
  #undef CMASK
  int hi_b=hi,qrel_b=qrel; asm volatile("":"+v"(hi_b),"+v"(qrel_b));
  #define CMASK(P0,P1,t) do{int jb_=(t)-(NT-4); if(jb_>=0)cmask(P0,P1,jb_,qrel_b,hi_b);}while(0)
  #define ENDW(tt) do{ if((tt)+3<NT){WAIT_BAR(2);} else if((tt)+2<NT){WAIT_BAR(1);} else {WAIT_BAR(0);} }while(0)
  for(;t+1<NT;t+=2){
    STEP(pB0,pB1,pA0,pA1,t,(t+3<NT),(t+1<NT),(t+1<NT));       ENDW(t);   RESC(); ROT();
    STEP(pA0,pA1,pB0,pB1,t+1,(t+4<NT),(t+2<NT),(t+2<NT));     ENDW(t+1); RESC(); ROT();
  }
  STEP(pB0,pB1,pA0,pA1,NT-1,false,false,false); RESC();
  { float sacc=pB0[0]+pB0[1]; _Pragma("unroll") for(int r=2;r<16;++r)sacc+=pB0[r]; _Pragma("unroll") for(int r=0;r<16;++r)sacc+=pB1[r]; l_reg+=sacc;
    pw0=(u32x4){PKW(pB0,0),PKW(pB0,2),PKW(pB0,4),PKW(pB0,6)};pw1=(u32x4){PKW(pB0,8),PKW(pB0,10),PKW(pB0,12),PKW(pB0,14)};pw2=(u32x4){PKW(pB1,0),PKW(pB1,2),PKW(pB1,4),PKW(pB1,6)};pw3=(u32x4){PKW(pB1,8),PKW(pB1,10),PKW(pB1,12),PKW(pB1,14)};
    SBAR(); pv(o,vb0+sl_cur,PAF(0),PAF(1),PAF(2),PAF(3)); }
  #undef PKW
  #undef PAF
  #undef VFR
  #undef PIN
  #undef MX3
  #undef GAPA
  #undef GAPB
  #undef EX
  #undef VRD
  #undef KRD
  #undef STEP
  #undef ENDW
  {auto rr=__builtin_amdgcn_permlane32_swap(__float_as_uint(l_reg),__float_as_uint(l_reg),false,false);l_reg=__uint_as_float(rr[0])+__uint_as_float(rr[1]);}
  if(hi==0)wsf[32+r32]=l_reg;asm volatile("s_waitcnt lgkmcnt(0)":::"memory");
  float rli[16];
  #pragma unroll
  for(int r=0;r<16;++r)rli[r]=__builtin_amdgcn_rcpf(wsf[32+crow(r,hi)]);
  bf16*Ow=O+(rowbase+q0+wid*QBLK)*OP;
  { bf16*stg=(bf16*)(shm+LDS_OST)+wid*2048;
    #pragma unroll
    for(int r=0;r<16;++r){const int orow=crow(r,hi);
      #pragma unroll
      for(int d0=0;d0<2;++d0)stg[orow*64+d0*32+r32]=__float2bfloat16(o[d0][r]*rli[r]);}
    asm volatile("s_waitcnt lgkmcnt(0)":::"memory");
    #pragma unroll
    for(int i=0;i<4;++i){const int row=i*8+(lane>>3),ch=lane&7; const u32x4 v=*(const u32x4*)(stg+row*64+ch*8); ATTN_STORE16(Ow+(long)row*OP+ch*8,v);} }
  asm volatile("s_waitcnt lgkmcnt(0)\n\ts_barrier":::"memory");
  #undef DMA_K
  #undef DMA_V
  #undef CMASK
  #undef START
  #undef RESC
  #undef ROT
}
constexpr int ATTN_LDS_BYTES=LDS_BYTES;
#undef SBAR
#undef WAIT_BAR
}
#define GAS __attribute__((address_space(1)))
#define LAS __attribute__((address_space(3)))
typedef unsigned short bf16;
typedef unsigned v4u __attribute__((ext_vector_type(4)));
typedef float f32x4 __attribute__((ext_vector_type(4)));
typedef short bf16x8 __attribute__((ext_vector_type(8)));
typedef GAS unsigned gu32;
typedef GAS unsigned long long gu64;
#define RLX_AGENT __ATOMIC_RELAXED, __HIP_MEMORY_SCOPE_AGENT
#define LDS_WAIT() asm volatile("s_waitcnt lgkmcnt(0)" ::: "memory")
#define VM_WAIT() asm volatile("s_waitcnt vmcnt(0)" ::: "memory")
__device__ __forceinline__ unsigned long long rt() { return __builtin_amdgcn_s_memrealtime(); }
__device__ __forceinline__ unsigned f2bf(float f) { unsigned u = __builtin_bit_cast(unsigned, f); return (u + 0x7fffu + ((u >> 16) & 1u)) >> 16; }
__device__ __forceinline__ unsigned pk2(float lo, float hi) { return f2bf(lo) | (f2bf(hi) << 16); }

#define XB_TMO      128
#define XB_XCNT(j)  (256  + 64 * (j))
#define XB_XSUB(j)  (1280 + 64 * (j))
#define XB_XGEN(j)  (2304 + 64 * (j))
#define XB_TOP      3328
#define XB_TOPGEN   3392
#define XCD_BAR_WORDS 3456
#define XB_SPIN_CAP (1u << 18)

__device__ __forceinline__ unsigned xb_ld(unsigned* p)              { return __hip_atomic_load(p, __ATOMIC_RELAXED, __HIP_MEMORY_SCOPE_AGENT); }
__device__ __forceinline__ unsigned xb_add(unsigned* p, unsigned v) { return __hip_atomic_fetch_add(p, v, __ATOMIC_RELAXED, __HIP_MEMORY_SCOPE_AGENT); }
__device__ __forceinline__ unsigned xb_xcc_id() { return (unsigned)__builtin_amdgcn_s_getreg((3 << 11) | 20) & 0xFu; }
#define XB_SPIN(cond, bar) do { unsigned _sp = 0; while (cond) { __builtin_amdgcn_s_sleep(1); \
    if ((++_sp & 255u) == 0u) { if (xb_ld(&(bar)[XB_TMO])) break; if (_sp > XB_SPIN_CAP) { atomicAdd(&(bar)[XB_TMO], 1u); break; } } } } while (0)

struct XcdBarrier {
    unsigned* bar; unsigned x;
    volatile LAS unsigned* st;
};

__device__ __forceinline__ XcdBarrier xcd_barrier_post(unsigned* bar, volatile LAS unsigned* st) {
    XcdBarrier b; b.bar = bar; b.x = xb_xcc_id(); b.st = st;
    if (threadIdx.x == 0) (void)xb_add(&bar[XB_XCNT(b.x)], 1u);
    return b;
}
__device__ __forceinline__ void xcd_barrier_complete(unsigned* bar, unsigned x, unsigned& nloc, unsigned& nx) {
    const unsigned G = gridDim.x * gridDim.y * gridDim.z;
    unsigned sum, cnt, mine, sp = 0u;
    for (;;) {
        sum = 0u; cnt = 0u; mine = 0u;
#pragma unroll
        for (unsigned j = 0; j < 16; ++j) { const unsigned c = xb_ld(&bar[XB_XCNT(j)]); sum += c; cnt += (c > 0u) ? 1u : 0u; mine = (j == x) ? c : mine; }
        if (sum == G) break;
        __builtin_amdgcn_s_sleep(1);
        if ((++sp & 255u) == 0u) { if (xb_ld(&bar[XB_TMO])) break; if (sp > XB_SPIN_CAP) { atomicAdd(&bar[XB_TMO], 1u); break; } }
    }
    nloc = mine > 0u ? mine : 1u; nx = cnt > 0u ? cnt : 1u;
}

__device__ __forceinline__ void xcd_barrier(const XcdBarrier& b) {
    asm volatile("s_waitcnt vmcnt(0)" ::: "memory");
    __syncthreads();
    if (threadIdx.x == 0) {
        unsigned* bar = b.bar;
        __builtin_amdgcn_s_waitcnt(0);
        unsigned nloc = b.st[0], nx = b.st[1];
        if (nloc == 0u) { xcd_barrier_complete(bar, b.x, nloc, nx); b.st[0] = nloc; b.st[1] = nx; }
        const unsigned old = xb_add(&bar[XB_XSUB(b.x)], 1u);
        const unsigned gen = old / nloc;
        if (old + 1u == (gen + 1u) * nloc) {
            __builtin_amdgcn_fence(__ATOMIC_RELEASE, "agent");
            asm volatile("s_waitcnt vmcnt(0)" ::: "memory");
            const unsigned og = xb_add(&bar[XB_TOP], 1u);
            const unsigned tg = og / nx;
            if (og + 1u == (tg + 1u) * nx) xb_add(&bar[XB_TOPGEN], 1u);
            else XB_SPIN(xb_ld(&bar[XB_TOPGEN]) == tg, bar);
            __builtin_amdgcn_fence(__ATOMIC_ACQUIRE, "agent");
            xb_add(&bar[XB_XGEN(b.x)], 1u);
            asm volatile("s_waitcnt vmcnt(0)" ::: "memory");
        } else {
            XB_SPIN(xb_ld(&bar[XB_XGEN(b.x)]) == gen, bar);
            __builtin_amdgcn_fence(__ATOMIC_ACQUIRE, "agent");
            asm volatile("s_waitcnt vmcnt(0)" ::: "memory");
        }
    }
    __syncthreads();
}
constexpr int NWAVES = 8;
constexpr int BATCH = 4, T = 4096, D = 1024, M = BATCH * T;
constexpr int NPROJ = 5120;
constexpr int NE = 32, TOPK = 4, FF = 1024;
constexpr int MAXT = (M * TOPK) / 256 + NE;
constexpr float EPS = 1e-5f;
constexpr float LAMBDA_INIT = 0.2f;

constexpr size_t MiB = 1u << 20;
constexpr size_t WS_CTL = 0, CTL_ZERO_BYTES = 1 * MiB;
constexpr size_t WS_ROPE = 1 * MiB;
constexpr size_t WS_ROUTE = 2 * MiB;
constexpr size_t WS_WGU = 4 * MiB;
constexpr size_t WS_WD = 132 * MiB;
constexpr size_t WS_WIN = 196 * MiB;
constexpr size_t WS_WDA = 206 * MiB, WS_WSB = 207 * MiB, WS_WO = 208 * MiB;
constexpr size_t WS_A0 = 210 * MiB;
constexpr size_t WS_H = WS_A0;
constexpr size_t WS_P = WS_A0 + 32 * MiB;
constexpr size_t WS_VBT = WS_A0 + 192 * MiB;
constexpr size_t WS_ODA = WS_A0 + 208 * MiB;
constexpr size_t WS_DA = WS_A0 + 240 * MiB;
constexpr size_t WS_SB = WS_A0 + 256 * MiB;
constexpr size_t WS_XS = WS_A0;
constexpr size_t WS_ACT = WS_A0 + 144 * MiB;
constexpr size_t WS_END = WS_A0 + 288 * MiB;
static_assert(WS_SB + 16 * MiB <= WS_END && WS_END <= 512 * MiB, "d_ws map");
constexpr int CW_TMO = 0, CW_CODE = 1;
constexpr int CW_CNT = 1024;
constexpr int CW_BAR = 4096;

constexpr int RING_OFF = 0, RING_BYTES = 131072;
constexpr int RT_STRIDE = 36, RT_BYTES = 1024 * RT_STRIDE * 4;
constexpr int LDSCTL_OFF = 147456, MISC_OFF = LDSCTL_OFF + 320, TAB_OFF = LDSCTL_OFF + 1024;
constexpr int LDS_BYTES = 163840;
static_assert(RT_BYTES <= LDSCTL_OFF && TAB_OFF + 4 * (40 + MAXT) <= LDS_BYTES, "LDS map");
struct Frame {
    LAS unsigned char* lds;
    volatile LAS unsigned* MISC;
    gu32* ctl;
    int tid, lane, wave;
    int vcu, G;
};
__device__ __forceinline__ float wave_sum(float v) {
#pragma unroll
    for (int o = 1; o < 64; o <<= 1) v += __shfl_xor(v, o);
    return v;
}
__device__ __forceinline__ void transpose_block(const float* W, int ldw, bf16* WT, int ldt, LAS float* scr, int lane) {
#pragma unroll 8
    for (int i = 0; i < 32; ++i) { const int kk = 2 * i + (lane >> 5); scr[kk * 33 + (lane & 31)] = W[(size_t)kk * ldw + (lane & 31)]; }
    LDS_WAIT(); asm volatile("" ::: "memory");
    const int c = lane & 7;
#pragma unroll
    for (int j = 0; j < 4; ++j) { const int n = (lane >> 3) + 8 * j; const LAS float* s = scr + (8 * c) * 33 + n;
        v4u o; o.x = pk2(s[0 * 33], s[1 * 33]); o.y = pk2(s[2 * 33], s[3 * 33]); o.z = pk2(s[4 * 33], s[5 * 33]); o.w = pk2(s[6 * 33], s[7 * 33]);
        *(GAS v4u*)(WT + (size_t)n * ldt + 8 * c) = o; }
    LDS_WAIT(); asm volatile("" ::: "memory");
}
__device__ __forceinline__ void rms_row_to_bf16(int lane, const float* xrow, const float* g, bf16* orow) {
    const GAS f32x4* xr = (const GAS f32x4*)xrow + lane; const GAS f32x4* gr = (const GAS f32x4*)g + lane;
    f32x4 v[4]; float s = 0.f;
#pragma unroll
    for (int j = 0; j < 4; ++j) { v[j] = xr[64 * j]; s += (v[j].x * v[j].x + v[j].y * v[j].y) + (v[j].z * v[j].z + v[j].w * v[j].w); }
    const float rstd = 1.f / sqrtf(wave_sum(s) * (1.f / D) + EPS);
    GAS unsigned long long* o8 = (GAS unsigned long long*)orow + lane;
#pragma unroll
    for (int j = 0; j < 4; ++j) { const f32x4 gg = gr[64 * j]; const f32x4 y = v[j] * rstd * gg;
        o8[64 * j] = (unsigned long long)pk2(y.x, y.y) | ((unsigned long long)pk2(y.z, y.w) << 32); }
}

struct Args { const float* in[21]; float* out; unsigned char* ws; int ph_lo, ph_hi; };
__device__ const float INV_FREQ[32] = {1.000000000e+00f, 7.498942018e-01f, 5.623413324e-01f, 4.216965139e-01f, 3.162277639e-01f, 2.371373922e-01f, 1.778279394e-01f, 1.333521456e-01f, 1.000000015e-01f, 7.498941571e-02f, 5.623412877e-02f, 4.216964915e-02f, 3.162277862e-02f, 2.371373586e-02f, 1.778279431e-02f, 1.333521493e-02f, 9.999999776e-03f, 7.498942316e-03f, 5.623413250e-03f, 4.216964822e-03f, 3.162277862e-03f, 2.371373819e-03f, 1.778279431e-03f, 1.333521446e-03f, 1.000000047e-03f, 7.498941850e-04f, 5.623413017e-04f, 4.216965463e-04f, 3.162277862e-04f, 2.371373848e-04f, 1.778279402e-04f, 1.333521504e-04f};

__device__ __forceinline__ void p0_prologue(Frame& F, const Args& a, unsigned char* ws) {
    LAS float* scr = (LAS float*)(F.lds + RING_OFF + F.wave * 16384);
    const int gw = F.vcu * NWAVES + F.wave, NGW = F.G * NWAVES;
    const float* x = a.in[0]; const float* g_mix = a.in[1]; const float* w_in = a.in[2];
    const float* w_da = a.in[8]; const float* w_sb = a.in[9]; const float* w_o = a.in[10];
    const float* w_gate = a.in[14]; const float* w_up = a.in[16]; const float* w_down = a.in[18];
    bf16* WIN = (bf16*)(ws + WS_WIN); bf16* WDA = (bf16*)(ws + WS_WDA); bf16* WSB = (bf16*)(ws + WS_WSB); bf16* WO = (bf16*)(ws + WS_WO);
    bf16* WGU = (bf16*)(ws + WS_WGU); bf16* WD = (bf16*)(ws + WS_WD);
    constexpr int I_IN = 16 * 160, I_DA = 8 * 32, I_SB = 8 * 32, I_O = 16 * 32, I_EXP = 16 * 32;
    constexpr int NITEMS = I_IN + I_DA + I_SB + I_O + 96 * I_EXP;
    for (int it = gw; it < NITEMS; it += NGW) {
        int r = it;
        if (r < I_IN) { const int kb = r / 160, nb = r % 160, n0 = 32 * nb; int drow = n0;
            if (n0 < 1024) { const int pn = n0 >> 8, w = n0 & 255; drow = 256 * pn + 128 * ((w >> 5) & 1) + 32 * (w >> 6); }
            transpose_block(w_in + (size_t)(64 * kb) * NPROJ + n0, NPROJ, WIN + (size_t)drow * 1024 + 64 * kb, 1024, scr, F.lane); continue; }
        r -= I_IN;
        if (r < I_DA) { const int kb = r / 32, nb = r % 32; transpose_block(w_da + (size_t)(64 * kb) * 1024 + 32 * nb, 1024, WDA + (size_t)(32 * nb) * 512 + 64 * kb, 512, scr, F.lane); continue; }
        r -= I_DA;
        if (r < I_SB) { const int kb = r / 32, nb = r % 32; transpose_block(w_sb + (size_t)(64 * kb) * 1024 + 32 * nb, 1024, WSB + (size_t)(32 * nb) * 512 + 64 * kb, 512, scr, F.lane); continue; }
        r -= I_SB;
        if (r < I_O) { const int kb = r / 32, nb = r % 32; transpose_block(w_o + (size_t)(64 * kb) * 1024 + 32 * nb, 1024, WO + (size_t)(32 * nb) * 1024 + 64 * kb, 1024, scr, F.lane); continue; }
        r -= I_O;
        { const int mat = r / I_EXP, q = r % I_EXP, kb = q / 32, nb = q % 32, n0 = 32 * nb, e = mat / 3, kind = mat % 3;
          const size_t eoff = (size_t)e * 1024 * 1024;
          if (kind == 0)      transpose_block(w_gate + eoff + (size_t)(64 * kb) * 1024 + n0, 1024, WGU + ((size_t)e * 2048 + 256 * (n0 >> 7) + (n0 & 127)) * 1024 + 64 * kb, 1024, scr, F.lane);
          else if (kind == 1) transpose_block(w_up + eoff + (size_t)(64 * kb) * 1024 + n0, 1024, WGU + ((size_t)e * 2048 + 256 * (n0 >> 7) + 128 + (n0 & 127)) * 1024 + 64 * kb, 1024, scr, F.lane);
          else                transpose_block(w_down + eoff + (size_t)(64 * kb) * 1024 + n0, 1024, WD + ((size_t)e * 1024 + n0) * 1024 + 64 * kb, 1024, scr, F.lane); }
    }
    bf16* H = (bf16*)(ws + WS_H);
    for (int m = gw; m < M; m += NGW) rms_row_to_bf16(F.lane, x + (size_t)m * D, g_mix, H + (size_t)m * D);
    float* rope = (float*)(ws + WS_ROPE);
    for (int idx = gw * 64 + F.lane; idx < 4096 * 32; idx += NGW * 64) { const int pos = idx >> 5, i = idx & 31;
        const float ang = (float)pos * INV_FREQ[i];
        const double rev = (double)ang * 0.15915494309189535; const double fr = rev - __builtin_rint(rev); const float rf = (float)fr;
        rope[idx] = __builtin_amdgcn_cosf(rf); rope[4096 * 32 + idx] = __builtin_amdgcn_sinf(rf); }
}

typedef float f32x16 __attribute__((ext_vector_type(16)));
typedef short s16x4 __attribute__((ext_vector_type(4)));
__device__ __forceinline__ int crow_(int r, int hi) { return (r & 3) + 8 * (r >> 2) + 4 * hi; }
__device__ __forceinline__ unsigned cvtpk2(float lo, float hi) { unsigned r; asm volatile("v_cvt_pk_bf16_f32 %0, %1, %2" : "=v"(r) : "v"(lo), "v"(hi)); return r; }
__device__ __forceinline__ void sb_item(int b, int h, int qt, const bf16* P, const bf16* VT, bf16* O, int lane_) {
    int lane = lane_; asm volatile("" : "+v"(lane));
    const int r32 = lane & 31, hi = lane >> 5;
    const int q0 = qt * 32; const size_t tokq = (size_t)b * T + q0 + r32;
    const bf16* Qp = P + tokq * NPROJ + 1536 + h * 64 + hi * 8;
    bf16x8 qf[4];
#pragma unroll
    for (int d0 = 0; d0 < 4; ++d0) qf[d0] = *(const bf16x8*)(Qp + d0 * 16);
    f32x16 o0, o1;
#pragma unroll
    for (int r = 0; r < 16; ++r) { o0[r] = 0.f; o1[r] = 0.f; }
    float R = 0.f;
    const bf16* Kb = P + ((size_t)b * T + r32) * NPROJ + 2048 + h * 64 + hi * 8;
    const bf16* Vb = VT + (size_t)(h * 64 + r32) * M + (size_t)b * T + 4 * hi;
    for (int kt = qt; kt >= 0; --kt) {
        const int kv0 = kt * 32;
        bf16x8 kf[4];
#pragma unroll
        for (int d0 = 0; d0 < 4; ++d0) kf[d0] = *(const bf16x8*)(Kb + (size_t)kv0 * NPROJ + d0 * 16);
        s16x4 vl[2][2], vh[2][2];
#pragma unroll
        for (int s = 0; s < 2; ++s)
#pragma unroll
            for (int d0 = 0; d0 < 2; ++d0) { const bf16* vp = Vb + (size_t)(d0 * 32) * M + kv0 + 16 * s; vl[s][d0] = *(const s16x4*)vp; vh[s][d0] = *(const s16x4*)(vp + 8); }
        f32x16 sc;
#pragma unroll
        for (int r = 0; r < 16; ++r) sc[r] = 0.f;
#pragma unroll
        for (int d0 = 0; d0 < 4; ++d0) sc = __builtin_amdgcn_mfma_f32_32x32x16_bf16(kf[d0], qf[d0], sc, 0, 0, 0);
        const int lim = (kt == qt) ? r32 : 64;
        float c[16];
#pragma unroll
        for (int r = 0; r < 16; ++r) { const float z = sc[r]; const float sp = fmaxf(z, 0.f) + __logf(1.0f + __expf(-fabsf(z))); c[r] = (crow_(r, hi) < lim) ? sp : 0.f; }
        float g[4], gp[4], Tt[4], A[4];
#pragma unroll
        for (int m = 0; m < 4; ++m) { g[m] = (c[4 * m] + c[4 * m + 1]) + (c[4 * m + 2] + c[4 * m + 3]); gp[m] = __shfl_xor(g[m], 32); Tt[m] = g[m] + gp[m]; }
        const float suf3 = 0.f, suf2 = Tt[3], suf1 = suf2 + Tt[2], suf0 = suf1 + Tt[1];
        A[0] = suf0 + (hi ? 0.f : gp[0]); A[1] = suf1 + (hi ? 0.f : gp[1]); A[2] = suf2 + (hi ? 0.f : gp[2]); A[3] = suf3 + (hi ? 0.f : gp[3]);
        float av[16];
#pragma unroll
        for (int m = 0; m < 4; ++m) { float run = R + A[m];
#pragma unroll
            for (int e = 3; e >= 0; --e) { const int r = 4 * m + e; run += c[r]; av[r] = (crow_(r, hi) < lim) ? __expf(sc[r] - run) : 0.f; } }
        R += suf0 + Tt[0];
        v4u pw0, pw1;
        pw0.x = cvtpk2(av[0], av[1]); pw0.y = cvtpk2(av[2], av[3]); pw0.z = cvtpk2(av[4], av[5]); pw0.w = cvtpk2(av[6], av[7]);
        pw1.x = cvtpk2(av[8], av[9]); pw1.y = cvtpk2(av[10], av[11]); pw1.z = cvtpk2(av[12], av[13]); pw1.w = cvtpk2(av[14], av[15]);
        const bf16x8 pf0 = __builtin_bit_cast(bf16x8, pw0), pf1 = __builtin_bit_cast(bf16x8, pw1);
#define VF(s, d0) (bf16x8){vl[s][d0][0], vl[s][d0][1], vl[s][d0][2], vl[s][d0][3], vh[s][d0][0], vh[s][d0][1], vh[s][d0][2], vh[s][d0][3]}
        o0 = __builtin_amdgcn_mfma_f32_32x32x16_bf16(VF(0, 0), pf0, o0, 0, 0, 0);
        o1 = __builtin_amdgcn_mfma_f32_32x32x16_bf16(VF(0, 1), pf0, o1, 0, 0, 0);
        o0 = __builtin_amdgcn_mfma_f32_32x32x16_bf16(VF(1, 0), pf1, o0, 0, 0, 0);
        o1 = __builtin_amdgcn_mfma_f32_32x32x16_bf16(VF(1, 1), pf1, o1, 0, 0, 0);
#undef VF
    }
    bf16* Op = O + tokq * 512 + h * 64 + 4 * hi;
#pragma unroll
    for (int gi = 0; gi < 4; ++gi) {
        *(unsigned long long*)(Op + 8 * gi) = (unsigned long long)cvtpk2(o0[4 * gi], o0[4 * gi + 1]) | ((unsigned long long)cvtpk2(o0[4 * gi + 2], o0[4 * gi + 3]) << 32);
        *(unsigned long long*)(Op + 32 + 8 * gi) = (unsigned long long)cvtpk2(o1[4 * gi], o1[4 * gi + 1]) | ((unsigned long long)cvtpk2(o1[4 * gi + 2], o1[4 * gi + 3]) << 32);
    }
}

__global__ void __launch_bounds__(NWAVES * 64, 2) mk_fwd(Args args) {
    extern __shared__ __attribute__((aligned(16))) unsigned char lds[];
    Frame F;
    F.lds = (LAS unsigned char*)lds;
    F.MISC = (volatile LAS unsigned*)(F.lds + MISC_OFF);
    F.tid = threadIdx.x; F.lane = F.tid & 63; F.wave = __builtin_amdgcn_readfirstlane(F.tid >> 6);
    F.G = gridDim.x; { const int bx = blockIdx.x; F.vcu = (F.G % 8 == 0) ? (bx % 8) * (F.G / 8) + bx / 8 : bx; }
    unsigned char* ws = args.ws;
    F.ctl = (gu32*)(ws + WS_CTL);
    for (int u = F.tid; u < (LDS_BYTES - LDSCTL_OFF) / 4; u += NWAVES * 64) ((LAS unsigned*)(F.lds + LDSCTL_OFF))[u] = 0u;
    __syncthreads();
    const int lo = args.ph_lo, hi_ = args.ph_hi;
    const bool one_launch = (hi_ - lo) > 1;
    XcdBarrier bar; bar.bar = (unsigned*)(F.ctl + CW_BAR); bar.x = 0; bar.st = nullptr;
    if (one_launch) bar = xcd_barrier_post((unsigned*)(F.ctl + CW_BAR), F.MISC + 8);
#ifndef PH_MASK
#define PH_MASK 0xffff
#endif
#define IN(k) ((((PH_MASK) >> (k)) & 1) && lo <= (k) && (k) < hi_)
#define SEAM(k) do { if (IN(k) && IN((k) + 1)) xcd_barrier(bar); } while (0)
    const int gw = F.vcu * NWAVES + F.wave, NGW = F.G * NWAVES;

    bf16* WIN = (bf16*)(ws + WS_WIN); bf16* WDA = (bf16*)(ws + WS_WDA); bf16* WSB = (bf16*)(ws + WS_WSB); bf16* WO = (bf16*)(ws + WS_WO);
    bf16* WGU = (bf16*)(ws + WS_WGU); bf16* WD = (bf16*)(ws + WS_WD);
    bf16* H = (bf16*)(ws + WS_H); bf16* P = (bf16*)(ws + WS_P); bf16* VBT = (bf16*)(ws + WS_VBT); bf16* ODA = (bf16*)(ws + WS_ODA);
    bf16* DA = (bf16*)(ws + WS_DA); bf16* SBO = (bf16*)(ws + WS_SB); bf16* MX = (bf16*)(ws + WS_H); bf16* H2 = (bf16*)(ws + WS_ODA);
    bf16* XS = (bf16*)(ws + WS_XS); bf16* ACT = (bf16*)(ws + WS_ACT); bf16* YS = (bf16*)(ws + WS_XS);
    float* rope = (float*)(ws + WS_ROPE);
    int* tok_e = (int*)(ws + WS_ROUTE); int* tok_pos = tok_e + M * 4; float* tok_gate = (float*)(tok_pos + M * 4); float* row_gate = tok_gate + M * 4;
    float* X1 = args.out;

    if (IN(0)) { p0_prologue(F, args, ws); }
    SEAM(0);
    if (IN(1)) {
        { pg8::Gemm g{H, WIN, M, NPROJ, D}; pg8::StaticOrder S; S.init(M, NPROJ, F.G, (int)blockIdx.x);
          pg8::EpiInProj E{P, rope, 0.125f * 1.4426950408889634f};
          pg8::gemm_phase<pg8::EpiInProj, pg8::StaticOrder, true, true>(F.lds + RING_OFF, g, S, E); }
        { pg8::Gemm g{WIN + (size_t)2560 * 1024, H, 512, M, D}; pg8::StaticOrder S; S.init(512, M, F.G, (int)blockIdx.x);
          pg8::EpiPlain E{VBT, M};
          pg8::gemm_phase<pg8::EpiPlain, pg8::StaticOrder, true, true>(F.lds + RING_OFF, g, S, E); }
    }
    SEAM(1);
    if (IN(2)) {
        for (int i = 0; i < 4; ++i) {
            const int bh = F.vcu >> 2, s = F.vcu & 3; const int qb = (i == 0) ? s : (i == 1) ? 7 - s : (i == 2) ? 8 + s : 15 - s;
            const int b = bh >> 4, vh = bh & 15;
            if (bh < BATCH * 16)
                attn_body::attn_unit<8, NPROJ, NPROJ, NPROJ, 1024>(b, qb, (const attn_body::bf16*)(P + (vh >> 1) * 64), (const attn_body::bf16*)(P + 512 + (vh >> 1) * 64),
                    (const attn_body::bf16*)(P + 1024 + (vh >> 2) * 128 + (vh & 1) * 64), (attn_body::bf16*)(ODA + vh * 64), (char*)lds + RING_OFF);
        }
        for (int w = gw; w < 2048; w += NGW) { const int bh = w >> 6, j = w & 63; sb_item(bh >> 3, bh & 7, j, P, VBT, SBO, F.lane); sb_item(bh >> 3, bh & 7, 127 - j, P, VBT, SBO, F.lane); }
    }
    SEAM(2);
    if (IN(3)) {
        const float* lq1 = args.in[3]; const float* lk1 = args.in[4]; const float* lq2 = args.in[5]; const float* lk2 = args.in[6]; const float* sg = args.in[7];
        const float lam = __expf(wave_sum(lq1[F.lane] * lk1[F.lane])) - __expf(wave_sum(lq2[F.lane] * lk2[F.lane])) + LAMBDA_INIT;
        const int l = F.lane, hh = l >> 4, c0 = 8 * (l & 15), half = c0 >> 6, cc = c0 & 63;
        const f32x4 ga = *(const f32x4*)(sg + c0), gb = *(const f32x4*)(sg + c0 + 4);
        for (int m = gw; m < M; m += NGW) {
            const v4u w0 = *(const v4u*)(ODA + (size_t)m * 1024 + (4 * hh + half) * 64 + cc), w1 = *(const v4u*)(ODA + (size_t)m * 1024 + (4 * hh + 2 + half) * 64 + cc);
            f32x4 a0, a1, b0, b1; pg8::unpack8(w0, a0, a1); pg8::unpack8(w1, b0, b1);
            const f32x4 d0 = a0 - b0 * lam, d1 = a1 - b1 * lam;
            float ss = (d0[0] * d0[0] + d0[1] * d0[1]) + (d0[2] * d0[2] + d0[3] * d0[3]) + (d1[0] * d1[0] + d1[1] * d1[1]) + (d1[2] * d1[2] + d1[3] * d1[3]);
            ss += __shfl_xor(ss, 1); ss += __shfl_xor(ss, 2); ss += __shfl_xor(ss, 4); ss += __shfl_xor(ss, 8);
            const float rs = (1.0f - LAMBDA_INIT) / sqrtf(ss * (1.0f / 128.0f) + EPS);
            *(v4u*)(DA + (size_t)m * 512 + hh * 128 + c0) = pg8::pack8(d0 * rs * ga, d1 * rs * gb);
        }
    }
    SEAM(3);
    if (IN(4)) {
        { pg8::Gemm g{DA, WDA, M, D, 512}; pg8::StaticOrder S; S.init(M, D, F.G, (int)blockIdx.x); pg8::EpiMix<0> E{P, MX};
          pg8::gemm_phase<pg8::EpiMix<0>, pg8::StaticOrder, true, true>(F.lds + RING_OFF, g, S, E); }
        { pg8::Gemm g{SBO, WSB, M, D, 512}; pg8::StaticOrder S; S.init(M, D, F.G, (int)blockIdx.x); pg8::EpiMix<1> E{P, MX};
          pg8::gemm_phase<pg8::EpiMix<1>, pg8::StaticOrder, true, true>(F.lds + RING_OFF, g, S, E); }
    }
    SEAM(4);
    if (IN(5)) {
        pg8::Gemm g{MX, WO, M, D, D}; pg8::StaticOrder S; S.init(M, D, F.G, (int)blockIdx.x); pg8::EpiResid E{args.in[0], X1, D};
        pg8::gemm_phase<pg8::EpiResid, pg8::StaticOrder, true, true>(F.lds + RING_OFF, g, S, E);
    }
    SEAM(5);
    if (IN(6)) {
        const float* g_ffn = args.in[11]; const float* w_r = args.in[12]; const float* b_r = args.in[13];
        LAS float* RT = (LAS float*)(F.lds);
        for (int idx = F.tid; idx < 1024 * 8; idx += NWAVES * 64) { const int i = idx >> 3, q = idx & 7; *(LAS f32x4*)(RT + i * RT_STRIDE + 4 * q) = *(const f32x4*)(w_r + i * 32 + 4 * q); }
        __syncthreads();
        for (int m = gw; m < M; m += NGW) {
            float s = 0.f;
#pragma unroll
            for (int t = 0; t < 16; ++t) { const float xv = X1[(size_t)m * D + F.lane + 64 * t]; s += xv * xv; }
            const float rstd = 1.f / sqrtf(wave_sum(s) * (1.f / D) + EPS);
            float lg[32];
#pragma unroll
            for (int e = 0; e < 32; ++e) lg[e] = 0.f;
#pragma unroll 1
            for (int t = 0; t < 16; ++t) { const int i = F.lane + 64 * t; const float hv = X1[(size_t)m * D + i] * rstd * g_ffn[i]; H2[(size_t)m * D + i] = (bf16)f2bf(hv);
                const LAS float* wr = RT + i * RT_STRIDE;
#pragma unroll
                for (int q = 0; q < 8; ++q) { const f32x4 w4 = *(const LAS f32x4*)(wr + 4 * q); lg[4 * q] += hv * w4[0]; lg[4 * q + 1] += hv * w4[1]; lg[4 * q + 2] += hv * w4[2]; lg[4 * q + 3] += hv * w4[3]; } }
#pragma unroll
            for (int e = 0; e < 32; ++e) lg[e] = wave_sum(lg[e]) + b_r[e];
            int sel[4]; float sv[4];
#pragma unroll
            for (int k = 0; k < 4; ++k) { float best = -INFINITY; int bi = 0;
#pragma unroll
                for (int e = 0; e < 32; ++e) { if (lg[e] > best) { best = lg[e]; bi = e; } }
                sel[k] = bi; sv[k] = best;
#pragma unroll
                for (int e = 0; e < 32; ++e) lg[e] = (e == bi) ? -INFINITY : lg[e]; }
            const float p1 = __expf(sv[1] - sv[0]), p2 = __expf(sv[2] - sv[0]), p3 = __expf(sv[3] - sv[0]); const float inv = 1.0f / (1.0f + p1 + p2 + p3);
            if (F.lane < 4) { const int k = F.lane; const int e = (k == 0) ? sel[0] : (k == 1) ? sel[1] : (k == 2) ? sel[2] : sel[3];
                const float gt = ((k == 0) ? 1.0f : (k == 1) ? p1 : (k == 2) ? p2 : p3) * inv;
                const unsigned pos = __hip_atomic_fetch_add((unsigned*)(F.ctl + CW_CNT + 64 * e), 1u, __ATOMIC_RELAXED, __HIP_MEMORY_SCOPE_AGENT);
                tok_e[m * 4 + k] = e; tok_pos[m * 4 + k] = (int)pos; tok_gate[m * 4 + k] = gt; }
        }
        __syncthreads();
    }
    SEAM(6);
    LAS int* TAB = (LAS int*)(F.lds + TAB_OFF);
    if (IN(7) || IN(8) || IN(9) || IN(10)) {
        if (F.tid == 0) { int t0 = 0;
            for (int e = 0; e < NE; ++e) { const int c = (int)__hip_atomic_load((unsigned*)(F.ctl + CW_CNT + 64 * e), __ATOMIC_RELAXED, __HIP_MEMORY_SCOPE_AGENT); const int nt = (c + 255) >> 8;
                TAB[e] = t0; for (int t = 0; t < nt; ++t) TAB[40 + t0 + t] = e; t0 += nt; }
            TAB[32] = t0; }
        __syncthreads();
    }
    if (IN(7)) {
        for (int a = gw; a < M * TOPK; a += NGW) { const int m = a >> 2; const int e = tok_e[a], pos = tok_pos[a]; const int slot = TAB[e] * 256 + pos;
            const v4u* src = (const v4u*)(H2 + (size_t)m * D); v4u* dst = (v4u*)(XS + (size_t)slot * D);
            dst[F.lane] = src[F.lane]; dst[64 + F.lane] = src[64 + F.lane];
            if (F.lane == 0) row_gate[slot] = tok_gate[a]; }
    }
    SEAM(7);
    if (IN(8)) {
        const int nT = __builtin_amdgcn_readfirstlane(TAB[32]);
        pg8::Gemm g{XS, WGU, MAXT * 256, 2048, D}; pg8::MoeOrder S{nT * 8, 8, F.G, (int)blockIdx.x, (const LAS int*)(TAB + 40)};
        pg8::EpiMoe1 E{ACT, args.in[15], args.in[17]};
        pg8::gemm_phase<pg8::EpiMoe1, pg8::MoeOrder, true, true>(F.lds + RING_OFF, g, S, E);
    }
    SEAM(8);
    if (IN(9)) {
        const int nT = __builtin_amdgcn_readfirstlane(TAB[32]);
        pg8::Gemm g{ACT, WD, MAXT * 256, 1024, FF}; pg8::MoeOrder S{nT * 4, 4, F.G, (int)blockIdx.x, (const LAS int*)(TAB + 40)};
        pg8::EpiMoe2 E{YS, args.in[19], row_gate};
        pg8::gemm_phase<pg8::EpiMoe2, pg8::MoeOrder, true, true>(F.lds + RING_OFF, g, S, E);
    }
    SEAM(9);
    if (IN(10)) {
        const float* g_fin = args.in[20];
        unsigned poison = (__hip_atomic_load(F.ctl + CW_TMO, RLX_AGENT) != 0u) || (__hip_atomic_load((gu32*)((unsigned*)(F.ctl + CW_BAR) + XB_TMO), RLX_AGENT) != 0u);
        for (int m = gw; m < M; m += NGW) {
            f32x4 v[4];
#pragma unroll
            for (int j = 0; j < 4; ++j) v[j] = *(const f32x4*)(X1 + (size_t)m * D + 4 * F.lane + 256 * j);
#pragma unroll
            for (int k = 0; k < 4; ++k) { const int e = tok_e[m * 4 + k], pos = tok_pos[m * 4 + k]; const size_t slot = (size_t)TAB[e] * 256 + pos;
#pragma unroll
                for (int j = 0; j < 4; ++j) { const unsigned long long w = *(const unsigned long long*)(YS + slot * D + 4 * F.lane + 256 * j); const unsigned wl = (unsigned)w, wh = (unsigned)(w >> 32);
                    v[j] = v[j] + (f32x4){pg8::bf_lo(wl), pg8::bf_hi(wl), pg8::bf_lo(wh), pg8::bf_hi(wh)}; } }
            float s = 0.f;
#pragma unroll
            for (int j = 0; j < 4; ++j) s += (v[j].x * v[j].x + v[j].y * v[j].y) + (v[j].z * v[j].z + v[j].w * v[j].w);
            const float rstd = 1.f / sqrtf(wave_sum(s) * (1.f / D) + EPS);
#pragma unroll
            for (int j = 0; j < 4; ++j) { const f32x4 gg = *(const f32x4*)(g_fin + 4 * F.lane + 256 * j); f32x4 o = v[j] * rstd * gg;
                if (poison) { const float q = __builtin_nanf(""); o = (f32x4){q, q, q, q}; }
                *(f32x4*)(args.out + (size_t)m * D + 4 * F.lane + 256 * j) = o; }
        }
    }
#undef IN
#undef SEAM
}

#ifndef MK_ONE_LAUNCH
#define MK_ONE_LAUNCH 0
#endif
constexpr int N_PHASES = 11;
extern "C" void kernel_launch(void* const* d_in, const int* in_sizes, int n_in, void* d_out, int out_size, void* d_ws, size_t ws_size, hipStream_t stream) {
    static int grid = 0;
    if (grid == 0) {
        if (n_in != 21 || in_sizes[0] != M * D || out_size != M * D || ws_size < WS_END) { fprintf(stderr, "kernel_launch: unexpected shapes: n_in %d in0 %d out %d ws %zu (need %zu); nothing launched\n", n_in, n_in > 0 ? in_sizes[0] : -1, out_size, ws_size, (size_t)WS_END); grid = -1; return; }
        int dev = 0, cus = 0, per_cu = 0;
        if (hipGetDevice(&dev) != hipSuccess || hipDeviceGetAttribute(&cus, hipDeviceAttributeMultiprocessorCount, dev) != hipSuccess) { grid = -1; return; }
        if (hipFuncSetAttribute((const void*)mk_fwd, hipFuncAttributeMaxDynamicSharedMemorySize, LDS_BYTES) != hipSuccess) { fprintf(stderr, "kernel_launch: hipFuncSetAttribute failed\n"); grid = -1; return; }
        if (hipOccupancyMaxActiveBlocksPerMultiprocessor(&per_cu, (const void*)mk_fwd, NWAVES * 64, LDS_BYTES) != hipSuccess || per_cu < 1) { fprintf(stderr, "kernel_launch: occupancy query says %d blocks per CU\n", per_cu); (void)hipGetLastError(); grid = -1; return; }
        grid = cus;
        if (grid != 256) fprintf(stderr, "kernel_launch: note: %d CUs\n", grid);
    }
    if (grid < 0) return;
    if (hipMemsetAsync((char*)d_ws + WS_CTL, 0, CTL_ZERO_BYTES, stream) != hipSuccess) return;
    Args a{};
    for (int i = 0; i < 21; ++i) a.in[i] = (const float*)d_in[i];
    a.out = (float*)d_out; a.ws = (unsigned char*)d_ws;
#if MK_ONE_LAUNCH
    a.ph_lo = 0; a.ph_hi = N_PHASES;
    hipLaunchKernelGGL(mk_fwd, dim3(grid), dim3(NWAVES * 64), LDS_BYTES, stream, a);
#else
    for (int p = 0; p < N_PHASES; ++p) { a.ph_lo = p; a.ph_hi = p + 1; hipLaunchKernelGGL(mk_fwd, dim3(grid), dim3(NWAVES * 64), LDS_BYTES, stream, a); }
#endif
}
```

```cpp
#include <hip/hip_runtime.h>
#include <cstdio>
#include <cstdint>
__device__ __forceinline__ int lane_id_now() { int l; asm volatile("v_mbcnt_lo_u32_b32 %0, -1, 0\n\tv_mbcnt_hi_u32_b32 %0, -1, %0" : "=v"(l)); return l; }
namespace pg8 {
#define PG8_LAS __attribute__((address_space(3)))
typedef unsigned short bf16_t;
typedef short bf16x8 __attribute__((ext_vector_type(8)));
typedef float f32x4 __attribute__((ext_vector_type(4)));
typedef unsigned u32x4 __attribute__((ext_vector_type(4)));
constexpr int BM = 256, BK = 64, HALF = 128, HTB = HALF * BK * 2  , STAGE_BYTES = 8 * HTB, NXCD = 8, WGM = 8;

__host__ __device__ __forceinline__ int lds_byte(int r, int c) { const int st = (r >> 4) * 2 + (c >> 5), rr = r & 15, cc = c & 31, ob = rr * 64 + cc * 2; return st * 1024 + (ob ^ (((ob >> 9) & 1) << 5)); }
__host__ __device__ __forceinline__ void stage_rc(int b, int& R, int& C) { const int st = b / 1024, sb = b % 1024, swz = sb ^ (((sb >> 9) & 1) << 5); R = (st >> 1) * 16 + swz / 64; C = (st & 1) * 32 + (swz % 64) / 2; }
__host__ __device__ __forceinline__ int perm32(int rho) { const int n = rho >> 4, i = rho & 15; return 8 * (i >> 2) + 4 * n + (i & 3); }

struct Unit { int pm, pn, pb, e, lt, cnt, full, ui; };
struct Gemm { const bf16_t* A; const bf16_t* Bt; int M, N, K; const bf16_t* A2; const bf16_t* Bt2; };

struct StaticOrder {
    int nM, nN, nwg, G, c;
    __host__ __device__ __forceinline__ void init(int M, int N, int G_, int c_) { nM = M / BM; nN = N / BM; nwg = nM * nN; G = G_; c = c_; }
    __host__ __device__ __forceinline__ bool next(int i, Unit& u) const {
        const long L = (long)i * G + c; if (L >= nwg) return false;
        int wgid = (int)L; { const int q = nwg / NXCD, r = nwg % NXCD, xcd = wgid % NXCD, off = wgid / NXCD; wgid = (xcd < r ? xcd * (q + 1) : r * (q + 1) + (xcd - r) * q) + off; }
        const int nig = WGM * nN, gid = wgid / nig, fm = gid * WGM, gsz = (nM - fm) < WGM ? (nM - fm) : WGM;
        u.pm = fm + ((wgid % nig) % gsz); u.pn = (wgid % nig) / gsz; u.pb = u.pn; u.e = 0; u.lt = 0; u.cnt = 0; u.full = 1; u.ui = i; return true;
    }
    static constexpr bool DUAL = false, GATHER = false, HALFSKIP = false, FP8 = false, BCH = false; static constexpr int fsc = 0, nb64 = 0, ebytes = 0;
    __device__ __forceinline__ void a_ready(const Unit&) const {}
    __device__ __forceinline__ void done(const Unit&) const {}
};

__device__ __forceinline__ unsigned cvt_pk_bf16(float lo, float hi) { unsigned r; asm volatile("v_cvt_pk_bf16_f32 %0, %1, %2" : "=v"(r) : "v"(lo), "v"(hi)); return r; }
__device__ __forceinline__ u32x4 pack8(const f32x4 a, const f32x4 b) { u32x4 w; w.x = cvt_pk_bf16(a[0], a[1]); w.y = cvt_pk_bf16(a[2], a[3]); w.z = cvt_pk_bf16(b[0], b[1]); w.w = cvt_pk_bf16(b[2], b[3]); return w; }
__device__ __forceinline__ float bf_lo(unsigned w) { return __uint_as_float(w << 16); }
__device__ __forceinline__ float bf_hi(unsigned w) { return __uint_as_float(w & 0xffff0000u); }
__device__ __forceinline__ void unpack8(const u32x4 w, f32x4& a, f32x4& b) { a = (f32x4){bf_lo(w.x), bf_hi(w.x), bf_lo(w.y), bf_hi(w.y)}; b = (f32x4){bf_lo(w.z), bf_hi(w.z), bf_lo(w.w), bf_hi(w.w)}; }
__device__ __forceinline__ float sigmoidf_(float x) { return __builtin_amdgcn_rcpf(1.0f + __expf(-x)); }
__device__ __forceinline__ f32x4 sig4(const f32x4 v) { return (f32x4){sigmoidf_(v[0]), sigmoidf_(v[1]), sigmoidf_(v[2]), sigmoidf_(v[3])}; }

struct EpiPlain {
    static constexpr bool PERM = true, AFTER_DRAIN = false, PREFETCH = false; struct Pref {};
    bf16_t* O; int ldc;
    __device__ __forceinline__ void operator()(const f32x4 (&acc)[2][2][4][2], const Unit& u, int wr, int wc, int fr, int fq) const {
        const int row0 = u.pm * BM + wr * 64 + fr, col0 = u.pn * BM + wc * 32 + 8 * fq;
#pragma unroll
        for (int ai = 0; ai < 2; ++ai)
#pragma unroll
            for (int m = 0; m < 4; ++m) { bf16_t* rowp = O + (size_t)(row0 + ai * HALF + m * 16) * ldc + col0;
#pragma unroll
                for (int bj = 0; bj < 2; ++bj) *(u32x4*)(rowp + bj * HALF) = pack8(acc[ai][bj][m][0], acc[ai][bj][m][1]); }
    }
};

struct EpiInProj {
    static constexpr bool PERM = true, AFTER_DRAIN = false, PREFETCH = false; struct Pref {};
    bf16_t* P; const float* rope; float qscale;
    __device__ __forceinline__ void operator()(const f32x4 (&acc)[2][2][4][2], const Unit& u, int wr, int wc, int fr, int fq) const {
        const int row0 = u.pm * BM + wr * 64 + fr;
        if (u.pn < 4) {
            const float qs = (u.pn < 2) ? qscale : 1.0f;
            const int colbase = u.pn * BM + wc * 64 + 8 * fq;
#pragma unroll
            for (int ai = 0; ai < 2; ++ai)
#pragma unroll
                for (int m = 0; m < 4; ++m) { const int row = row0 + ai * HALF + m * 16, pos = row & 4095;
                    const float* cp = rope + pos * 32 + 8 * fq; const float* sp = cp + 4096 * 32;
                    const f32x4 c0 = *(const f32x4*)cp, c1 = *(const f32x4*)(cp + 4), s0 = *(const f32x4*)sp, s1 = *(const f32x4*)(sp + 4);
                    const f32x4 a0 = acc[ai][0][m][0], a1 = acc[ai][0][m][1], b0 = acc[ai][1][m][0], b1 = acc[ai][1][m][1];
                    const f32x4 y10 = (a0 * c0 - b0 * s0) * qs, y11 = (a1 * c1 - b1 * s1) * qs, y20 = (b0 * c0 + a0 * s0) * qs, y21 = (b1 * c1 + a1 * s1) * qs;
                    bf16_t* rowp = P + (size_t)row * 5120 + colbase;
                    *(u32x4*)(rowp) = pack8(y10, y11); *(u32x4*)(rowp + 32) = pack8(y20, y21); }
        } else {
            const int col0 = u.pn * BM + wc * 32 + 8 * fq; const bool gate = u.pn >= 12; const float sc = (u.pn == 6 || u.pn == 7) ? 0.125f * 1.4426950408889634f : 1.0f;
            if (gate) {
#pragma unroll
                for (int ai = 0; ai < 2; ++ai)
#pragma unroll
                    for (int m = 0; m < 4; ++m) { unsigned char* rowb = (unsigned char*)P + (size_t)(row0 + ai * HALF + m * 16) * 10240 + 6144 + (col0 - 3072);
#pragma unroll
                        for (int bj = 0; bj < 2; ++bj) { const f32x4 v0 = sig4(acc[ai][bj][m][0]) * 255.0f + 0.5f, v1 = sig4(acc[ai][bj][m][1]) * 255.0f + 0.5f;
                            const unsigned lo = (unsigned)v0[0] | ((unsigned)v0[1] << 8) | ((unsigned)v0[2] << 16) | ((unsigned)v0[3] << 24), hi = (unsigned)v1[0] | ((unsigned)v1[1] << 8) | ((unsigned)v1[2] << 16) | ((unsigned)v1[3] << 24);
                            *(unsigned long long*)(rowb + bj * HALF) = (unsigned long long)lo | ((unsigned long long)hi << 32); } }
            } else {
#pragma unroll
            for (int ai = 0; ai < 2; ++ai)
#pragma unroll
                for (int m = 0; m < 4; ++m) { bf16_t* rowp = P + (size_t)(row0 + ai * HALF + m * 16) * 5120 + col0;
#pragma unroll
                    for (int bj = 0; bj < 2; ++bj) { const f32x4 v0 = acc[ai][bj][m][0] * sc, v1 = acc[ai][bj][m][1] * sc;
                        *(u32x4*)(rowp + bj * HALF) = pack8(v0, v1); } }
            }
        }
    }
};

template <int SECOND> struct EpiMix {
    static constexpr bool PERM = true, AFTER_DRAIN = false, PREFETCH = true;
    struct Pref { unsigned long long g[4][2]; };
    const bf16_t* P; bf16_t* MX;
    __device__ __forceinline__ void prefetch(Pref& pf, const Unit& u, int wr, int wc, int fr, int fq) const {
        const int row0 = u.pm * BM + wr * 64 + fr, col0 = u.pn * BM + wc * 32 + 8 * fq;
#pragma unroll
        for (int m = 0; m < 4; ++m)
#pragma unroll
            for (int bj = 0; bj < 2; ++bj) pf.g[m][bj] = *(const unsigned long long*)((const unsigned char*)P + (size_t)(row0 + m * 16) * 10240 + 6144 + (SECOND ? 1024 : 0) + col0 + bj * HALF);
    }
    __device__ __forceinline__ void operator()(const f32x4 (&acc)[2][2][4][2], const Unit& u, int wr, int wc, int fr, int fq, const Pref& pf) const {
        const int row0 = u.pm * BM + wr * 64 + fr, col0 = u.pn * BM + wc * 32 + 8 * fq;
        unsigned long long g1[4][2];
#pragma unroll
        for (int m = 0; m < 4; ++m)
#pragma unroll
            for (int bj = 0; bj < 2; ++bj) g1[m][bj] = *(const unsigned long long*)((const unsigned char*)P + (size_t)(row0 + HALF + m * 16) * 10240 + 6144 + (SECOND ? 1024 : 0) + col0 + bj * HALF);
#pragma unroll
        for (int ai = 0; ai < 2; ++ai)
#pragma unroll
            for (int m = 0; m < 4; ++m) { const size_t row = (size_t)(row0 + ai * HALF + m * 16);
#pragma unroll
                for (int bj = 0; bj < 2; ++bj) { const int c = col0 + bj * HALF;
                    const unsigned long long gq = ai ? g1[m][bj] : pf.g[m][bj]; const unsigned gl = (unsigned)gq, gh = (unsigned)(gq >> 32);
                    const f32x4 g0 = (f32x4){(float)(gl & 255u), (float)((gl >> 8) & 255u), (float)((gl >> 16) & 255u), (float)(gl >> 24)} * (1.0f / 255.0f);
                    const f32x4 g1 = (f32x4){(float)(gh & 255u), (float)((gh >> 8) & 255u), (float)((gh >> 16) & 255u), (float)(gh >> 24)} * (1.0f / 255.0f);
                    f32x4 v0 = acc[ai][bj][m][0] * g0, v1 = acc[ai][bj][m][1] * g1;
                    if (SECOND) { const u32x4 ow = *(const u32x4*)(MX + row * 1024 + c); f32x4 o0, o1; unpack8(ow, o0, o1); v0 = v0 + o0; v1 = v1 + o1; }
                    *(u32x4*)(MX + row * 1024 + c) = pack8(v0, v1); } }
    }
};

struct EpiResid {
    static constexpr bool PERM = false, AFTER_DRAIN = false, PREFETCH = false; struct Pref {};
    const float* X; float* O; int ldc;
    __device__ __forceinline__ void operator()(const f32x4 (&acc)[2][2][4][2], const Unit& u, int wr, int wc, int fr, int fq) const {
        const int row0 = u.pm * BM + wr * 64 + fr, col0 = u.pn * BM + wc * 32 + 4 * fq;
#pragma unroll
        for (int ai = 0; ai < 2; ++ai)
#pragma unroll
            for (int m = 0; m < 4; ++m) { const size_t off = (size_t)(row0 + ai * HALF + m * 16) * ldc + col0;
#pragma unroll
                for (int bj = 0; bj < 2; ++bj)
#pragma unroll
                    for (int n = 0; n < 2; ++n) { const f32x4 xv = *(const f32x4*)(X + off + bj * HALF + n * 16); *(f32x4*)(O + off + bj * HALF + n * 16) = xv + acc[ai][bj][m][n]; } }
    }
};

typedef float f32x2 __attribute__((ext_vector_type(2)));
__device__ __forceinline__ unsigned long long pack8_f8(f32x4 a, f32x4 b, float s) {
    float v[8] = {a[0] * s, a[1] * s, a[2] * s, a[3] * s, b[0] * s, b[1] * s, b[2] * s, b[3] * s};
#pragma unroll
    for (int i = 0; i < 8; ++i) v[i] = __builtin_amdgcn_fmed3f(v[i], -448.0f, 448.0f);
    int lo = 0, hi = 0;
    lo = __builtin_amdgcn_cvt_pk_fp8_f32(v[0], v[1], lo, false); lo = __builtin_amdgcn_cvt_pk_fp8_f32(v[2], v[3], lo, true);
    hi = __builtin_amdgcn_cvt_pk_fp8_f32(v[4], v[5], hi, false); hi = __builtin_amdgcn_cvt_pk_fp8_f32(v[6], v[7], hi, true);
    return (unsigned long long)(unsigned)lo | ((unsigned long long)(unsigned)hi << 32);
}
struct EpiResidBf {
    static constexpr bool PERM = true, AFTER_DRAIN = false, PREFETCH = false; struct Pref {};
    const float* X; bf16_t* O; int ldx, ldo; unsigned char* O8; int ld8; float s8;
    __device__ __forceinline__ void operator()(const f32x4 (&acc)[2][2][4][2], const Unit& u, int wr, int wc, int fr, int fq) const {
        const int row0 = u.pm * BM + wr * 64 + fr, col0 = u.pn * BM + wc * 32 + 8 * fq;
#pragma unroll
        for (int ai = 0; ai < 2; ++ai)
#pragma unroll
            for (int m = 0; m < 4; ++m) { const size_t row = (size_t)(row0 + ai * HALF + m * 16);
#pragma unroll
                for (int bj = 0; bj < 2; ++bj) { const float* xp = X + row * ldx + col0 + bj * HALF; const f32x4 x0 = *(const f32x4*)xp, x1v = *(const f32x4*)(xp + 4);
                    const f32x4 y0 = x0 + acc[ai][bj][m][0], y1 = x1v + acc[ai][bj][m][1];
                    *(u32x4*)(O + row * ldo + col0 + bj * HALF) = pack8(y0, y1);
                    *(unsigned long long*)(O8 + row * ld8 + col0 + bj * HALF) = pack8_f8(y0, y1, s8); } }
    }
};

struct EpiMoe1 {
    static constexpr bool PERM = true, AFTER_DRAIN = false, PREFETCH = false; struct Pref {};
    static constexpr bool STAGE = true;
    unsigned char* ACT; float sact; const float* bg; const float* bu; const float* rstd; const PG8_LAS int* tokl; PG8_LAS float* stg;
    __device__ __forceinline__ void stage(const Unit& u, int wid, int lane) const {
        PG8_LAS float* sb = stg + (u.ui & 1) * 512; const float* src;
        if (wid < 4) src = rstd + tokl[u.ui * 256 + wid * 64 + lane];
        else src = ((wid < 6) ? bg : bu) + u.e * 1024 + u.pn * HALF + (wid & 1) * 64 + lane;
        __builtin_amdgcn_global_load_lds((const unsigned*)src, (PG8_LAS unsigned*)(sb + wid * 64), 4, 0, 0);
    }
    __device__ __forceinline__ void operator()(const f32x4 (&acc)[2][2][4][2], const Unit& u, int wr, int wc, int fr, int fq) const {
        int fr_ = fr, fq_ = fq; asm volatile("" : "+v"(fr_), "+v"(fq_) : "v"(acc[0][0][0][0]));
        const int lrow0 = wr * 64 + fr_, f0 = u.pn * HALF + wc * 32 + 8 * fq_;
        const PG8_LAS float* sb = stg + (u.ui & 1) * 512; const int cl = wc * 32 + 8 * fq_;
        const f32x4 bg0 = *(const PG8_LAS f32x4*)(sb + 256 + cl), bg1 = *(const PG8_LAS f32x4*)(sb + 256 + cl + 4);
        const f32x4 bu0 = *(const PG8_LAS f32x4*)(sb + 384 + cl), bu1 = *(const PG8_LAS f32x4*)(sb + 384 + cl + 4);
#pragma unroll
        for (int ai = 0; ai < 2; ++ai)
#pragma unroll
            for (int m = 0; m < 4; ++m) { int w8[2] = {0, 0}; const int lr = lrow0 + ai * HALF + m * 16; const float rs = sb[lr]; const f32x2 rs2 = {rs, rs};
#pragma unroll
                for (int n = 0; n < 2; ++n) { const f32x4 ag = acc[ai][0][m][n], au = acc[ai][1][m][n], bgn = n ? bg1 : bg0, bun = n ? bu1 : bu0;
#pragma unroll
                    for (int h = 0; h < 2; ++h) {
                        const f32x2 gv = __builtin_elementwise_fma((f32x2){ag[2 * h], ag[2 * h + 1]}, rs2, (f32x2){bgn[2 * h], bgn[2 * h + 1]});
                        const f32x2 uv = __builtin_elementwise_fma((f32x2){au[2 * h], au[2 * h + 1]}, rs2, (f32x2){bun[2 * h], bun[2 * h + 1]});
                        const f32x2 g = {fminf(gv[0], 7.0f), fminf(gv[1], 7.0f)};
                        const f32x2 uu = {__builtin_amdgcn_fmed3f(uv[0], -7.0f, 7.0f), __builtin_amdgcn_fmed3f(uv[1], -7.0f, 7.0f)};
                        const f32x2 t = g * (f32x2){-1.702f * 1.4426950408889634f, -1.702f * 1.4426950408889634f};
                        const f32x2 den = (f32x2){__builtin_amdgcn_exp2f(t[0]), __builtin_amdgcn_exp2f(t[1])} + (f32x2){1.0f, 1.0f};
                        const f32x2 gs = g * (f32x2){__builtin_amdgcn_rcpf(den[0]), __builtin_amdgcn_rcpf(den[1])};
                        const f32x2 r = __builtin_elementwise_fma(uu, (f32x2){sact, sact}, (f32x2){sact, sact}) * gs;
                        w8[n] = h ? __builtin_amdgcn_cvt_pk_fp8_f32(r[0], r[1], w8[n], true) : __builtin_amdgcn_cvt_pk_fp8_f32(r[0], r[1], w8[n], false); } }
                *(unsigned long long*)(ACT + ((size_t)u.pm * BM + lr) * 1024 + f0) = (unsigned long long)(unsigned)w8[0] | ((unsigned long long)(unsigned)w8[1] << 32); }
    }
};
struct EpiMoe2 {
    static constexpr bool PERM = true, AFTER_DRAIN = false, PREFETCH = false; struct Pref {};
    static constexpr bool STAGE = true;
    unsigned char* Y; float sy; const float* bd; const float* lg; PG8_LAS float* stg;
    __device__ __forceinline__ void stage(const Unit& u, int wid, int lane) const {
        PG8_LAS float* sb = stg + (u.ui & 1) * 512; const float* src;
        if (wid < 4) { const int p = u.lt * 256 + wid * 64 + lane; src = lg + u.e * 16384 + (p < u.cnt ? p : 0); }
        else src = bd + u.e * 1024 + u.pn * BM + (wid - 4) * 64 + lane;
        __builtin_amdgcn_global_load_lds((const unsigned*)src, (PG8_LAS unsigned*)(sb + wid * 64), 4, 0, 0);
    }
    __device__ __forceinline__ void operator()(const f32x4 (&acc)[2][2][4][2], const Unit& u, int wr, int wc, int fr, int fq) const {
        int fr_ = fr, fq_ = fq; asm volatile("" : "+v"(fr_), "+v"(fq_) : "v"(acc[0][0][0][0]));
        const int lrow0 = wr * 64 + fr_, col0 = u.pn * BM + wc * 32 + 8 * fq_;
        const PG8_LAS float* sb = stg + (u.ui & 1) * 512; f32x4 bv[2][2];
#pragma unroll
        for (int bj = 0; bj < 2; ++bj)
#pragma unroll
            for (int n = 0; n < 2; ++n) bv[bj][n] = *(const PG8_LAS f32x4*)(sb + 256 + wc * 32 + 8 * fq_ + bj * HALF + 4 * n);
#pragma unroll
        for (int ai = 0; ai < 2; ++ai)
#pragma unroll
            for (int m = 0; m < 4; ++m) { const int lr = lrow0 + ai * HALF + m * 16, p = u.lt * 256 + lr; const float g = (p < u.cnt) ? sb[lr] * sy : 0.f; const size_t row = (size_t)u.pm * BM + lr;
#pragma unroll
                for (int bj = 0; bj < 2; ++bj) *(unsigned long long*)(Y + row * 1024 + col0 + bj * HALF) = pack8_f8((acc[ai][bj][m][0] + bv[bj][0]) * g, (acc[ai][bj][m][1] + bv[bj][1]) * g, 1.0f); }
    }
};
struct MoeOrder {
    static constexpr bool DUAL = false, GATHER = false, HALFSKIP = false, FP8 = true, BCH = true;
    int npn, G, c; const PG8_LAS int* tab; int fsc = 0x7F7F7F7F; unsigned* rdy = nullptr; unsigned* tmo = nullptr; int mode = 0; PG8_LAS unsigned* pkl = nullptr; int nb64 = 0, ebytes = 0;
    __device__ __forceinline__ bool next(int i, Unit& u) const {
        const int x = c & 7, cu_ = (mode == 2) ? (G >> 3) - 1 - (c >> 3) : (c >> 3), slot = i * (G >> 3) + cu_, j = slot / npn, pn = slot - j * npn;
        if (j >= __builtin_amdgcn_readfirstlane(tab[744 + x])) return false;
        const int t = __builtin_amdgcn_readfirstlane(tab[360 + x * 48 + j]), e = __builtin_amdgcn_readfirstlane(tab[40 + t]);
        u.pm = t; u.pn = pn; u.e = e; u.pb = e * npn + pn; u.lt = t - __builtin_amdgcn_readfirstlane(tab[e]); u.cnt = __builtin_amdgcn_readfirstlane(tab[328 + e]);
        u.full = (u.cnt - u.lt * 256 > 128) ? 1 : 0; u.ui = i; return true;
    }
    __device__ __forceinline__ bool next_v(int i, int& e, int& lt, int& cnt) const {
        const int x = c & 7, cu_ = (mode == 2) ? (G >> 3) - 1 - (c >> 3) : (c >> 3), slot = i * (G >> 3) + cu_, j = slot / npn;
        e = 0; lt = 0; cnt = 0;
        if (j >= tab[744 + x]) return false;
        const int t = tab[360 + x * 48 + j]; e = tab[40 + t]; lt = t - tab[e]; cnt = tab[328 + e]; return true;
    }
    __device__ __forceinline__ void a_ready(const Unit& u) const {
        if (mode != 2) return;
        unsigned sp = 0u;
        while ((unsigned)__builtin_amdgcn_readfirstlane((int)__hip_atomic_load(rdy + 16 * u.pm, __ATOMIC_RELAXED, __HIP_MEMORY_SCOPE_AGENT)) < 64u) {
            __builtin_amdgcn_s_sleep(1);
            if ((++sp & 255u) == 0u) { if (__hip_atomic_load(tmo, __ATOMIC_RELAXED, __HIP_MEMORY_SCOPE_AGENT) != 0u) break; if (sp > (1u << 18)) { __hip_atomic_fetch_add(tmo, 1u, __ATOMIC_RELAXED, __HIP_MEMORY_SCOPE_AGENT); break; } } }
        asm volatile("" ::: "memory");
    }
    static constexpr bool PEEK = true;
    __device__ __forceinline__ void peek(const Unit& u, int wid) const { if (mode == 2) __builtin_amdgcn_global_load_lds((const unsigned*)(rdy + 16 * u.pm), (PG8_LAS unsigned*)(pkl + wid * 64), 4, 0, 16); }
    __device__ __forceinline__ void a_ready_pk(const Unit& u, int wid) const {
        if (mode != 2) return;
        if ((unsigned)__builtin_amdgcn_readfirstlane((int)pkl[wid * 64]) >= 64u) return;
        a_ready(u);
    }
    __device__ __forceinline__ void done(const Unit& u) const {
        if (mode != 1) return;
        asm volatile("s_waitcnt vmcnt(0)" ::: "memory");
        if (__builtin_amdgcn_mbcnt_hi(~0u, __builtin_amdgcn_mbcnt_lo(~0u, 0u)) == 0u) __hip_atomic_fetch_add(rdy + 16 * u.pm, 1u, __ATOMIC_RELAXED, __HIP_MEMORY_SCOPE_AGENT);
    }
};
struct MoeOrderG : MoeOrder {
    static constexpr bool GATHER = true;
    const PG8_LAS int* tokl; int pitch;
    __device__ __forceinline__ int row_token(int ui, int r) const { return tokl[ui * 256 + r]; }
};
struct DupOrder {
    static constexpr bool DUAL = false, GATHER = false, HALFSKIP = false, FP8 = false, BCH = false; static constexpr int fsc = 0, nb64 = 0, ebytes = 0;
    StaticOrder S; int n, reps;
    __device__ __forceinline__ bool next(int i, Unit& u) const { if (i >= n * reps) return false; return S.next(i % n, u); }
    __device__ __forceinline__ void a_ready(const Unit&) const {}
    __device__ __forceinline__ void done(const Unit&) const {}
};
struct DualOrder {
    static constexpr bool DUAL = true, GATHER = false, HALFSKIP = false, FP8 = false, BCH = false; static constexpr int fsc = 0, nb64 = 0, ebytes = 0;
    StaticOrder S; int reps;
    __device__ __forceinline__ bool next(int i, Unit& u) const { if (i >= 2 * reps) return false; if (!S.next(0, u)) return false; u.e = i & 1; return true; }
    __device__ __forceinline__ void a_ready(const Unit&) const {}
    __device__ __forceinline__ void done(const Unit&) const {}
};
typedef int pg8_i32x4 __attribute__((ext_vector_type(4)));
typedef int pg8_i32x8 __attribute__((ext_vector_type(8)));
__device__ __forceinline__ pg8_i32x8 pg8_cat8(bf16x8 a, bf16x8 b) { const pg8_i32x4 x = __builtin_bit_cast(pg8_i32x4, a), y = __builtin_bit_cast(pg8_i32x4, b); return __builtin_shufflevector(x, y, 0, 1, 2, 3, 4, 5, 6, 7); }
template <class S, class = void> struct sched_has_peek { static constexpr bool value = false; };
template <class S> struct sched_has_peek<S, decltype((void)S::PEEK)> { static constexpr bool value = S::PEEK; };
template <class E, class = void> struct epi_has_stage { static constexpr bool value = false; };
template <class E> struct epi_has_stage<E, decltype((void)E::STAGE)> { static constexpr bool value = E::STAGE; };
template <class Epi, class Sched, bool ALIGN_EPI = false, bool SP2 = false>
__device__ __forceinline__ void gemm_phase(PG8_LAS unsigned char* lds, const Gemm g, const Sched& S, const Epi& E, int wave_) {
    const int wid = wave_, lane = lane_id_now(), tid = wid * 64 + lane, wr = wid >> 2, wc = wid & 3, fr = lane & 15, fq = lane >> 4;
    const int K = g.K; int nt = K / BK; asm volatile("" : "+s"(nt));
    unsigned voffA[2], voffB[2];
#pragma unroll
    for (int i = 0; i < 2; ++i) { int R, C; stage_rc(tid * 16 + i * 8192, R, C); const int Rb = Epi::PERM ? ((R & ~31) + perm32(R & 31)) : R;
        voffA[i] = (unsigned)(R * K + C) * 2u; voffB[i] = Sched::BCH ? (unsigned)((C >> 5) * S.nb64 + Rb * 64 + ((2 * C) & 63)) : (unsigned)(Rb * K + C) * 2u; }
    int gR[2] = {0, 0}, gC[2] = {0, 0}; unsigned cvo[2][2] = {{0u, 0u}, {0u, 0u}};
    if constexpr (Sched::GATHER) { static_assert(SP2, "GATHER is written for the SP2 loop");
#pragma unroll
        for (int i = 0; i < 2; ++i) stage_rc(tid * 16 + i * 8192, gR[i], gC[i]); }
#define PG8_GVO(dst, ui_) do { _Pragma("unroll") for (int h_ = 0; h_ < 2; ++h_) _Pragma("unroll") for (int i_ = 0; i_ < 2; ++i_) dst[h_][i_] = (unsigned)(S.row_token(ui_, h_ * HALF + gR[i_]) * S.pitch + gC[i_]) * 2u; } while (0)
#define PG8_STAGE_A(bufoff, base, half, v0, v1) do { if constexpr (Sched::GATHER) { const unsigned vv_[2] = {v0, v1}; PG8_STAGE(bufoff, base, vv_); } else { PG8_STAGE(bufoff, (base) + (half) * hstep, voffA); } } while (0)
    const size_t kstep = (size_t)(BK * 2);
    const size_t kstepB = Sched::BCH ? (size_t)2 * S.nb64 : (size_t)(BK * 2), hstepB = Sched::BCH ? (size_t)HALF * 64 : (size_t)HALF * K * 2;
    const size_t hstep = (size_t)HALF * K * 2;
    const size_t tstep = 2 * hstep;
    const unsigned ldsw = (unsigned)wid * 1024u;
    const int aoff = lds_byte(wr * 64 + fr, fq * 8), boff = lds_byte(wc * 32 + fr, fq * 8);
#define PG8_SA(b, h) (((b) * 2 + (h)) * HTB)
#define PG8_SB(b, h) ((4 + (b) * 2 + (h)) * HTB)
#define PG8_STAGE(bufoff, gbase, voff) do { _Pragma("unroll") for (int _i = 0; _i < 2; ++_i) { unsigned vo_ = (voff)[_i]; const char* gb_ = (const char*)(gbase); if constexpr (Sched::FP8) asm volatile("" : "+v"(vo_), "+s"(gb_)); \
        __builtin_amdgcn_global_load_lds((const unsigned*)(gb_ + vo_), (PG8_LAS unsigned*)(lds + (bufoff) + ldsw + _i * 8192), 16, 0, 0); } } while (0)
#define PG8_LDA(dst, b, h) do { _Pragma("unroll") for (int m = 0; m < 4; ++m) _Pragma("unroll") for (int k = 0; k < 2; ++k) dst[m][k] = *(const PG8_LAS bf16x8*)(lds + PG8_SA(b, h) + aoff + m * 2048 + k * 1024); } while (0)
#define PG8_LDB(dst, b, h) do { _Pragma("unroll") for (int n = 0; n < 2; ++n) _Pragma("unroll") for (int k = 0; k < 2; ++k) dst[n][k] = *(const PG8_LAS bf16x8*)(lds + PG8_SB(b, h) + boff + n * 2048 + k * 1024); } while (0)
#define PG8_MMA(ai, bj, At, Bt) do { __builtin_amdgcn_s_setprio(1); _Pragma("unroll") for (int m = 0; m < 4; ++m) _Pragma("unroll") for (int n = 0; n < 2; ++n) { if constexpr (Sched::FP8) { \
        acc[ai][bj][m][n] = __builtin_amdgcn_mfma_scale_f32_16x16x128_f8f6f4(pg8_cat8(Bt[n][0], Bt[n][1]), pg8_cat8(At[m][0], At[m][1]), acc[ai][bj][m][n], 0, 0, 0, S.fsc, 0, S.fsc); } else { _Pragma("unroll") for (int k = 0; k < 2; ++k) \
        acc[ai][bj][m][n] = __builtin_amdgcn_mfma_f32_16x16x32_bf16(Bt[n][k], At[m][k], acc[ai][bj][m][n], 0, 0, 0); } } __builtin_amdgcn_s_setprio(0); } while (0)
#define PG8_WAIT_V(n) asm volatile("s_waitcnt vmcnt(" #n ")" ::: "memory")
#define PG8_WAIT_L(n) asm volatile("s_waitcnt lgkmcnt(" #n ")" ::: "memory")
#define PG8_BAR __builtin_amdgcn_s_barrier()
#define PG8_SCHED __builtin_amdgcn_sched_barrier(0)
    Unit cur, nxt; int ui = 0;
    if (!S.next(0, cur)) return;
    f32x4 acc[2][2][4][2];
#pragma unroll
    for (int a = 0; a < 2; ++a)
#pragma unroll
        for (int b = 0; b < 2; ++b)
#pragma unroll
            for (int m = 0; m < 4; ++m)
#pragma unroll
                for (int n = 0; n < 2; ++n) acc[a][b][m][n] = (f32x4){0.f, 0.f, 0.f, 0.f};
    bf16x8 At[4][2], B0[2][2], B1[2][2];
    const char* cA = (const char*)((Sched::DUAL && cur.e) ? g.A2 : g.A) + (Sched::GATHER ? (size_t)0 : (size_t)cur.pm * tstep);
    if constexpr (Sched::GATHER) PG8_GVO(cvo, 0);
    const char* cB = (const char*)((Sched::DUAL && cur.e) ? g.Bt2 : g.Bt) + (Sched::BCH ? (size_t)cur.e * S.ebytes + (size_t)cur.pn * (2 * hstepB) : (size_t)cur.pb * tstep);
    if constexpr (epi_has_stage<Epi>::value) E.stage(cur, wid, lane_id_now());
    typename Epi::Pref pf_{}; if constexpr (Epi::PREFETCH) E.prefetch(pf_, cur, wr, wc, fr, fq);
    S.a_ready(cur);
    if constexpr (SP2) {
        PG8_STAGE(PG8_SB(0, 0), cB, voffB); PG8_STAGE(PG8_SB(0, 1), cB + hstepB, voffB); PG8_STAGE_A(PG8_SA(0, 0), cA, 0, cvo[0][0], cvo[0][1]); PG8_STAGE_A(PG8_SA(0, 1), cA, 1, cvo[1][0], cvo[1][1]);
        if (wr == 1) PG8_BAR;
        PG8_WAIT_V(2); PG8_BAR;
        PG8_STAGE(PG8_SB(1, 0), cB + kstepB, voffB); PG8_STAGE_A(PG8_SA(1, 0), cA + kstep, 0, cvo[0][0], cvo[0][1]); PG8_STAGE(PG8_SB(1, 1), cB + hstepB + kstepB, voffB);
        PG8_WAIT_V(6); PG8_BAR;
    } else {
        PG8_STAGE(PG8_SB(0, 0), cB, voffB); PG8_STAGE(PG8_SA(0, 0), cA, voffA); PG8_STAGE(PG8_SB(0, 1), cB + hstepB, voffB); PG8_STAGE(PG8_SA(0, 1), cA + hstep, voffA);
        if (wr == 1) PG8_BAR;
        PG8_WAIT_V(4); PG8_BAR;
        PG8_STAGE(PG8_SB(1, 0), cB + kstepB, voffB); PG8_STAGE(PG8_SA(1, 0), cA + kstep, voffA); PG8_STAGE(PG8_SB(1, 1), cB + hstepB + kstepB, voffB);
        PG8_WAIT_V(6); PG8_BAR;
    }
    for (;;) {
        const bool has_next = S.next(ui + 1, nxt);
        if constexpr (sched_has_peek<Sched>::value) { if (has_next) S.peek(nxt, wid); }
        const char* nA = has_next ? (const char*)((Sched::DUAL && nxt.e) ? g.A2 : g.A) + (Sched::GATHER ? (size_t)0 : (size_t)nxt.pm * tstep) : cA; const char* nB = has_next ? (const char*)((Sched::DUAL && nxt.e) ? g.Bt2 : g.Bt) + (Sched::BCH ? (size_t)nxt.e * S.ebytes + (size_t)nxt.pn * (2 * hstepB) : (size_t)nxt.pb * tstep) : cB;
        for (int t = 0; t < nt; t += 2) {
            const bool last = (t == nt - 2);
            const char* a1 = cA + (size_t)(t + 1) * kstep;
            const char* a2 = last ? nA : cA + (size_t)(t + 2) * kstep; const char* b2 = last ? nB : cB + (size_t)(t + 2) * kstepB;
            const char* a3 = a2 + kstep; const char* b3 = b2 + kstepB;
            if (last && has_next) { if constexpr (sched_has_peek<Sched>::value) S.a_ready_pk(nxt, wid); else S.a_ready(nxt); }
            if constexpr (SP2) {
            PG8_LDB(B0, 0, 0); PG8_LDB(B1, 0, 1); PG8_SCHED; PG8_LDA(At, 0, 0); PG8_STAGE_A(PG8_SA(1, 1), a1, 1, cvo[1][0], cvo[1][1]); if constexpr (Sched::GATHER) { if (last && has_next) PG8_GVO(cvo, ui + 1); }
            PG8_WAIT_V(8); PG8_WAIT_L(0); PG8_BAR; PG8_MMA(0, 0, At, B0); PG8_MMA(0, 1, At, B1); PG8_BAR; PG8_SCHED;
            if (!Sched::HALFSKIP || cur.full) PG8_LDA(At, 0, 1); PG8_STAGE(PG8_SB(0, 0), b2, voffB); PG8_STAGE(PG8_SB(0, 1), b2 + hstepB, voffB); PG8_STAGE_A(PG8_SA(0, 0), a2, 0, cvo[0][0], cvo[0][1]);
            PG8_WAIT_V(8); PG8_WAIT_L(0); PG8_BAR; if (!Sched::HALFSKIP || cur.full) { PG8_MMA(1, 0, At, B0); PG8_MMA(1, 1, At, B1); } PG8_BAR; PG8_SCHED;
            PG8_LDB(B0, 1, 0); PG8_LDB(B1, 1, 1); PG8_SCHED; PG8_LDA(At, 1, 0); PG8_STAGE_A(PG8_SA(0, 1), a2, 1, cvo[1][0], cvo[1][1]);
            PG8_WAIT_V(8); PG8_WAIT_L(0); PG8_BAR; PG8_MMA(0, 0, At, B0); PG8_MMA(0, 1, At, B1); PG8_BAR; PG8_SCHED;
            if (!Sched::HALFSKIP || cur.full) PG8_LDA(At, 1, 1); PG8_STAGE(PG8_SB(1, 0), b3, voffB); PG8_STAGE(PG8_SB(1, 1), b3 + hstepB, voffB); PG8_STAGE_A(PG8_SA(1, 0), a3, 0, cvo[0][0], cvo[0][1]);
            PG8_WAIT_V(8); PG8_WAIT_L(0); PG8_BAR; if (!Sched::HALFSKIP || cur.full) { PG8_MMA(1, 0, At, B0); PG8_MMA(1, 1, At, B1); } PG8_BAR; PG8_SCHED;
            } else {
            PG8_LDB(B0, 0, 0); PG8_SCHED; PG8_LDA(At, 0, 0); PG8_STAGE(PG8_SA(1, 1), a1 + hstep, voffA);
            PG8_WAIT_L(8); PG8_BAR; PG8_WAIT_L(0); PG8_MMA(0, 0, At, B0); PG8_BAR; PG8_SCHED;
            PG8_LDB(B1, 0, 1); PG8_STAGE(PG8_SB(0, 0), b2, voffB);
            PG8_BAR; PG8_WAIT_L(0); PG8_MMA(0, 1, At, B1); PG8_BAR;
            PG8_LDA(At, 0, 1); PG8_STAGE(PG8_SA(0, 0), a2, voffA);
            PG8_BAR; PG8_WAIT_L(0); PG8_MMA(1, 0, At, B0); PG8_BAR; PG8_SCHED;
            PG8_STAGE(PG8_SB(0, 1), b2 + hstepB, voffB);
            PG8_WAIT_V(6); PG8_BAR; PG8_MMA(1, 1, At, B1); PG8_BAR;
            PG8_LDB(B0, 1, 0); PG8_SCHED; PG8_LDA(At, 1, 0); PG8_STAGE(PG8_SA(0, 1), a2 + hstep, voffA);
            PG8_WAIT_L(8); PG8_BAR; PG8_WAIT_L(0); PG8_MMA(0, 0, At, B0); PG8_BAR; PG8_SCHED;
            PG8_LDB(B1, 1, 1); PG8_STAGE(PG8_SB(1, 0), b3, voffB);
            PG8_BAR; PG8_WAIT_L(0); PG8_MMA(0, 1, At, B1); PG8_BAR;
            PG8_LDA(At, 1, 1); PG8_STAGE(PG8_SA(1, 0), a3, voffA);
            PG8_BAR; PG8_WAIT_L(0); PG8_MMA(1, 0, At, B0); PG8_BAR; PG8_SCHED;
            PG8_STAGE(PG8_SB(1, 1), b3 + hstepB, voffB);
            PG8_WAIT_V(6); PG8_BAR; PG8_MMA(1, 1, At, B1); PG8_BAR;
            }
        }
        if constexpr (ALIGN_EPI) { if (wr == 0) PG8_BAR; }
        if constexpr (!Epi::AFTER_DRAIN) { if constexpr (Epi::PREFETCH) E(acc, cur, wr, wc, fr, fq, pf_); else E(acc, cur, wr, wc, fr, fq); S.done(cur); }
        if (!has_next) break;
#pragma unroll
        for (int a = 0; a < 2; ++a)
#pragma unroll
            for (int b = 0; b < 2; ++b)
#pragma unroll
                for (int m = 0; m < 4; ++m)
#pragma unroll
                    for (int n = 0; n < 2; ++n) acc[a][b][m][n] = (f32x4){0.f, 0.f, 0.f, 0.f};
        cur = nxt; cA = nA; cB = nB; ++ui;
        if constexpr (epi_has_stage<Epi>::value) E.stage(cur, wid, lane_id_now());
        if constexpr (ALIGN_EPI) { if (wr == 1) PG8_BAR; }
    }
    PG8_WAIT_V(0);
    if constexpr (!ALIGN_EPI) { if (wr == 0) PG8_BAR; }
    PG8_BAR;
    if constexpr (Epi::AFTER_DRAIN) { E.fused(acc, cur, wr, wc, fr, fq, lds, wid, lane); S.done(cur); }
#undef PG8_SA
#undef PG8_SB
#undef PG8_STAGE
#undef PG8_STAGE_A
#undef PG8_GVO
#undef PG8_LDA
#undef PG8_LDB
#undef PG8_MMA
#undef PG8_WAIT_V
#undef PG8_WAIT_L
#undef PG8_BAR
#undef PG8_SCHED
}
}

#ifndef PG8_SP2
#define PG8_SP2 true
#endif
#ifndef PG8_ALIGN
#define PG8_ALIGN true
#endif
#include <hip/hip_bf16.h>
#include <cmath>
namespace attn_body {
using bf16=__hip_bfloat16;
using bf16x8=__attribute__((ext_vector_type(8)))short;
using s16x4=__attribute__((ext_vector_type(4)))short;
using f32x16=__attribute__((ext_vector_type(16)))float;
using u32x4=__attribute__((ext_vector_type(4)))unsigned;
constexpr int BATCH=4,NHEAD=16,SEQ=4096,D=64,DM=NHEAD*D;
constexpr int NW=8,QBLK=32,QB=QBLK*NW,KVBLK=64,NQB=SEQ/QB;
constexpr int ATTN_PITCH=DM, ATTN_UNIT_ROWS=QB;
__device__ __forceinline__ int crow(int r,int hi){return (r&3)+8*(r>>2)+4*hi;}
#define SBAR() __builtin_amdgcn_sched_barrier(0)
__device__ __forceinline__ void cmask(f32x16&p0,f32x16&p1,int jb,int qrel,int hi){
  const float NEG=-INFINITY; int kb=64*jb+4*hi;
  #pragma unroll
  for(int r=0;r<16;++r){int kv=kb+(r&3)+8*(r>>2); if(kv>qrel)p0[r]=NEG; if(kv+32>qrel)p1[r]=NEG;}
}

constexpr int NSLOT=3, SLOTB=8192;
constexpr int LDS_K=0, LDS_V=NSLOT*SLOTB, LDS_WS=2*NSLOT*SLOTB, LDS_OST=LDS_WS+NW*64*4, LDS_BYTES=LDS_OST+NW*4096;
constexpr float C2=0.125f*1.4426950408889634f;
__device__ __forceinline__ void glds16(const void*gsrc,unsigned lds_dst){unsigned keep;
  asm volatile("s_mov_b32 %0, m0\n\ts_mov_b32 m0, %2\n\ts_nop 0\n\tglobal_load_lds_dwordx4 %1, off\n\ts_mov_b32 m0, %0":"=&s"(keep):"v"(gsrc),"s"(lds_dst):"memory");}
__device__ __forceinline__ float max3f(float a,float b,float c){float r;asm("v_max3_f32 %0, %1, %2, %3":"=v"(r):"v"(a),"v"(b),"v"(c));return r;}
__device__ __forceinline__ float max2f(float a,float b){float r;asm("v_max_f32_e32 %0, %1, %2":"=v"(r):"v"(a),"v"(b));return r;}
__device__ __forceinline__ float fadd_s(float a,float b){float r;asm("v_add_f32_e32 %0, %1, %2":"=v"(r):"v"(a),"v"(b));return r;}
__device__ __forceinline__ float fsub_s(float a,float b){float r;asm("v_sub_f32_e32 %0, %1, %2":"=v"(r):"v"(a),"v"(b));return r;}
typedef float f32x2_t __attribute__((ext_vector_type(2))); typedef __bf16 bf16x2_t __attribute__((ext_vector_type(2)));
__device__ __forceinline__ unsigned cvtpk_s(float lo,float hi){f32x2_t v={lo,hi};bf16x2_t b=__builtin_convertvector(v,bf16x2_t);return __builtin_bit_cast(unsigned,b);}
#define WAIT_BAR(N) asm volatile("s_waitcnt vmcnt(" #N ") lgkmcnt(0)\n\ts_barrier":::"memory")

__device__ __forceinline__ void qkt(f32x16&p0,f32x16&p1,const char*Kslot,const bf16x8*qr,const f32x16&negm,int r32,int hi){
  const char*kb=Kslot+hi*1024+r32*16;
  #pragma unroll
  for(int d0=0;d0<4;++d0){
    const bf16x8 b0=*reinterpret_cast<const bf16x8*>(kb+d0*2048);
    const bf16x8 b1=*reinterpret_cast<const bf16x8*>(kb+d0*2048+512);
    if(d0==0){p0=__builtin_amdgcn_mfma_f32_32x32x16_bf16(b0,qr[0],negm,0,0,0);p1=__builtin_amdgcn_mfma_f32_32x32x16_bf16(b1,qr[0],negm,0,0,0);}
    else{p0=__builtin_amdgcn_mfma_f32_32x32x16_bf16(b0,qr[d0],p0,0,0,0);p1=__builtin_amdgcn_mfma_f32_32x32x16_bf16(b1,qr[d0],p1,0,0,0);}}
}
typedef __attribute__((address_space(3))) const char* lds_cptr;
typedef short v4i16_t __attribute__((ext_vector_type(4)));
__device__ __forceinline__ void kload8(bf16x8*kf,lds_cptr kp){
  kf[0]=*(const __attribute__((address_space(3))) bf16x8*)(kp);      kf[1]=*(const __attribute__((address_space(3))) bf16x8*)(kp+512);
  kf[2]=*(const __attribute__((address_space(3))) bf16x8*)(kp+2048); kf[3]=*(const __attribute__((address_space(3))) bf16x8*)(kp+2560);
  kf[4]=*(const __attribute__((address_space(3))) bf16x8*)(kp+4096); kf[5]=*(const __attribute__((address_space(3))) bf16x8*)(kp+4608);
  kf[6]=*(const __attribute__((address_space(3))) bf16x8*)(kp+6144); kf[7]=*(const __attribute__((address_space(3))) bf16x8*)(kp+6656);
}
__device__ __forceinline__ void kload2(bf16x8*kf,lds_cptr kp,int j){ kf[2*j]=*(const __attribute__((address_space(3))) bf16x8*)(kp+j*2048); kf[2*j+1]=*(const __attribute__((address_space(3))) bf16x8*)(kp+j*2048+512); }
__device__ __forceinline__ s16x4 vtr(lds_cptr p){ return __builtin_bit_cast(s16x4,__builtin_amdgcn_ds_read_tr16_b64_v4i16((__attribute__((address_space(3))) v4i16_t*)p)); }
__device__ __forceinline__ float rowmax(const f32x16&p0,const f32x16&p1){
  float a=max3f(p0[0],p0[1],p1[0]),b=max3f(p0[2],p0[3],p1[1]);a=max3f(a,p1[2],p1[3]);
  #pragma unroll
  for(int r=4;r<16;r+=4){a=max3f(a,p0[r],p0[r+1]);b=max3f(b,p0[r+2],p0[r+3]);a=max3f(a,p1[r],p1[r+1]);b=max3f(b,p1[r+2],p1[r+3]);}
  const float m=max2f(a,b);
  auto rr=__builtin_amdgcn_permlane32_swap(__float_as_uint(m),__float_as_uint(m),false,false);
  return max2f(__uint_as_float(rr[0]),__uint_as_float(rr[1]));
}
__device__ __forceinline__ void pv(f32x16*o,int vb,bf16x8 pa0,bf16x8 pa1,bf16x8 pa2,bf16x8 pa3){
  #pragma unroll
  for(int d0=0;d0<2;++d0){s16x4 lo[4],hi[4];
    #pragma unroll
    for(int ks=0;ks<4;++ks){
      asm volatile("ds_read_b64_tr_b16 %0,%1 offset:%c2":"=&v"(lo[ks]):"v"(vb),"i"(d0*4096+ks*1024):"memory");
      asm volatile("ds_read_b64_tr_b16 %0,%1 offset:%c2":"=&v"(hi[ks]):"v"(vb),"i"(d0*4096+ks*1024+512):"memory");}
    asm volatile("s_waitcnt lgkmcnt(0)":::"memory");SBAR();
    #define PK(k) (bf16x8){lo[k][0],lo[k][1],lo[k][2],lo[k][3],hi[k][0],hi[k][1],hi[k][2],hi[k][3]}
    o[d0]=__builtin_amdgcn_mfma_f32_32x32x16_bf16(pa0,PK(0),o[d0],0,0,0);
    o[d0]=__builtin_amdgcn_mfma_f32_32x32x16_bf16(pa1,PK(1),o[d0],0,0,0);
    o[d0]=__builtin_amdgcn_mfma_f32_32x32x16_bf16(pa2,PK(2),o[d0],0,0,0);
    o[d0]=__builtin_amdgcn_mfma_f32_32x32x16_bf16(pa3,PK(3),o[d0],0,0,0);
    #undef PK
  }
}

#ifndef ATTN_STORE16
#define ATTN_STORE16(p,v) (*(u32x4*)(p)=(v))
#endif
template<int THRL,int QP,int KP,int VP,int OP> __device__ __forceinline__ void attn_unit(int wave_,int b,int qb,const bf16*Q,const bf16*__restrict__ K,const bf16*__restrict__ V,bf16*O,char*shm){
  int lane_=lane_id_now(); asm volatile("":"+v"(lane_));
  const int wid=wave_,lane=lane_,tid=wid*64+lane,r32=lane&31,hi=lane>>5;
  const long rowbase=(long)b*SEQ; const int q0=qb*QB;
  const bf16*Qw=Q+(rowbase+q0+wid*QBLK)*QP;
  const bf16*Kh=K+rowbase*KP,*Vh=V+rowbase*VP;
  const unsigned lds0=(unsigned)(uintptr_t)shm;
  float*wsf=(float*)(shm+LDS_WS)+wid*64;
  const bf16*ksrc=Kh+(long)lane*KP+wid*8;
  const bf16*vsrc=Vh+(long)(16*(wid&3)+(lane>>2))*VP+(wid>>2)*32+(lane&3)*8;
  const unsigned kdst=lds0+LDS_K+wid*1024, vdst=lds0+LDS_V+wid*1024;
  #define DMA_K(t,slot) glds16(ksrc+(long)(t)*KVBLK*KP,(unsigned)__builtin_amdgcn_readfirstlane(kdst+(slot)))
  #define DMA_V(t,slot) glds16(vsrc+(long)(t)*KVBLK*VP,(unsigned)__builtin_amdgcn_readfirstlane(vdst+(slot)))
  const int vb0=(int)(lds0+LDS_V)+((lane>>4)&1)*32+(lane&3)*8+(4*hi+((lane&15)>>2))*64;
  const char*Kbase=shm+LDS_K; bf16x8 kf[8];
  const lds_cptr shm3=(lds_cptr)shm; const lds_cptr kp0=shm3+LDS_K+hi*1024+r32*16; const lds_cptr vp0=shm3+LDS_V+((lane>>4)&1)*32+(lane&3)*8+(4*hi+((lane&15)>>2))*64;
  const int NT=(q0+QB)/KVBLK;
  DMA_K(0,0);DMA_V(0,0);DMA_K(1,SLOTB);
  bf16x8 qr[4];
  #pragma unroll
  for(int d0=0;d0<4;++d0)qr[d0]=*reinterpret_cast<const bf16x8*>(&Qw[(long)r32*QP+d0*16+hi*8]);
  float mhat=0.f,l_reg=0.f;f32x16 o[2];o[0]=f32x16{};o[1]=f32x16{};f32x16 negm=f32x16{};asm volatile("":"+v"(negm));
  const int qrel=wid*QBLK+r32;
  #define CMASK(P0,P1,t) do{int jb_=(t)-(NT-4); if(jb_>=0)cmask(P0,P1,jb_,qrel,hi);}while(0)
  bool resc=false;
  #define START(P0,P1) do{ const float rm=rowmax(P0,P1); resc=false; \
    { const float dl=rm; mhat=fadd_s(mhat,dl); \
      _Pragma("unroll") for(int r=0;r<16;++r){P0[r]=fsub_s(P0[r],dl);P1[r]=fsub_s(P1[r],dl);} \
      _Pragma("unroll") for(int r=0;r<16;++r)negm[r]=-mhat; asm volatile("":"+v"(negm)); } \
    _Pragma("unroll") for(int r=0;r<16;++r)P0[r]=__builtin_amdgcn_exp2f(P0[r]); }while(0)
  #define RESC() do{ if(resc){ asm volatile("s_waitcnt lgkmcnt(0)":::"memory"); \
      _Pragma("unroll") for(int d_=0;d_<2;++d_) _Pragma("unroll") for(int r=0;r<16;++r)o[d_][r]*=wsf[crow(r,hi)]; } }while(0)
  f32x16 pA0,pA1,pB0,pB1;
  int sl_prev=0,sl_cur=0,sl_next=SLOTB;
  #define ROT() do{sl_prev=sl_cur;sl_cur=sl_next;sl_next=(sl_next==(NSLOT-1)*SLOTB)?0:sl_next+SLOTB;}while(0)
  DMA_K(2,2*SLOTB);
  WAIT_BAR(3);
  qkt(pA0,pA1,Kbase,qr,negm,r32,hi);asm volatile("s_nop 15\n\ts_nop 7":"+v"(pA0),"+v"(pA1));CMASK(pA0,pA1,0);
  START(pA0,pA1);
  _Pragma("unroll") for(int r=0;r<16;++r)pA1[r]=__builtin_amdgcn_exp2f(pA1[r]);
  WAIT_BAR(0);
  DMA_K(3,0);DMA_V(1,SLOTB);
  ROT();
  kload8(kf,kp0+sl_cur);
  WAIT_BAR(2);
  s16x4 vlo[8],vhi[8]; u32x4 pw0,pw1,pw2,pw3;
  #define PKW(P,B) cvtpk_s(P[B],P[B+1])
  #define PAF(k) __builtin_bit_cast(bf16x8,pw##k)
  #define VFR(i) (bf16x8){vlo[i][0],vlo[i][1],vlo[i][2],vlo[i][3],vhi[i][0],vhi[i][1],vhi[i][2],vhi[i][3]}
  #define PIN(x) asm volatile("":"+v"(x))
  #define MX3(a,b,c) __builtin_fmaxf(__builtin_fmaxf((a),(b)),(c))
  #define GAPA(MF,A0,A1,A2,A3,W0,W1,PW) do{ MF; sacc+=A0; sacc+=A1; sacc+=A2; sacc+=A3; PIN(sacc); W0; W1; PIN(PW); SBAR(); }while(0)
  #define EX(v) __builtin_amdgcn_exp2f(v)
  #define GAPB(MF,X,B) do{ MF; X[B]=EX(X[B]); X[B+1]=EX(X[B+1]); X[B+2]=EX(X[B+2]); X[B+3]=EX(X[B+3]); PIN(X); SBAR(); }while(0)
  #define VRD(i) do{ vlo[i]=vtr(vp_+(((i)>>2)*4096+((i)&3)*1024)); vhi[i]=vtr(vp_+(((i)>>2)*4096+((i)&3)*1024+512)); }while(0)
  #define KRD(G,j) do{ if(G){ kload2(kf,kp0+sl_next,j); SBAR(); } }while(0)
  #define STEP(C0,C1,P0,P1,t,GK,GV,GL) do{ SBAR(); \
    const lds_cptr vp_=vp0+sl_prev; \
    VRD(0); SBAR(); float sacc=(P0[0]+P0[1]); \
    GAPA(C0=__builtin_amdgcn_mfma_f32_32x32x16_bf16(kf[0],qr[0],negm,0,0,0), P0[2],P0[3],P0[4],P0[5],     pw0[0]=PKW(P0,0), pw0[1]=PKW(P0,2), pw0); \
    VRD(4); SBAR(); GAPA(C1=__builtin_amdgcn_mfma_f32_32x32x16_bf16(kf[1],qr[0],negm,0,0,0), P0[6],P0[7],P0[8],P0[9],     pw0[2]=PKW(P0,4), pw0[3]=PKW(P0,6), pw0); \
    VRD(1); SBAR(); GAPA(C0=__builtin_amdgcn_mfma_f32_32x32x16_bf16(kf[2],qr[1],C0,0,0,0),   P0[10],P0[11],P0[12],P0[13], pw1[0]=PKW(P0,8), pw1[1]=PKW(P0,10), pw1); \
    VRD(5); SBAR(); GAPA(C1=__builtin_amdgcn_mfma_f32_32x32x16_bf16(kf[3],qr[1],C1,0,0,0),   P0[14],P0[15],P1[0],P1[1],   pw1[2]=PKW(P0,12),pw1[3]=PKW(P0,14), pw1); \
    VRD(2); SBAR(); GAPA(C0=__builtin_amdgcn_mfma_f32_32x32x16_bf16(kf[4],qr[2],C0,0,0,0),   P1[2],P1[3],P1[4],P1[5],     pw2[0]=PKW(P1,0), pw2[1]=PKW(P1,2), pw2); \
    VRD(6); SBAR(); GAPA(C1=__builtin_amdgcn_mfma_f32_32x32x16_bf16(kf[5],qr[2],C1,0,0,0),   P1[6],P1[7],P1[8],P1[9],     pw2[2]=PKW(P1,4), pw2[3]=PKW(P1,6), pw2); \
    VRD(3); SBAR(); GAPA(C0=__builtin_amdgcn_mfma_f32_32x32x16_bf16(kf[6],qr[3],C0,0,0,0),   P1[10],P1[11],P1[12],P1[13], pw3[0]=PKW(P1,8), pw3[1]=PKW(P1,10), pw3); \
    VRD(7); SBAR(); GAPA(C1=__builtin_amdgcn_mfma_f32_32x32x16_bf16(kf[7],qr[3],C1,0,0,0),   P1[14],P1[15],0.f,0.f,       pw3[2]=PKW(P1,12),pw3[3]=PKW(P1,14), pw3); \
    l_reg+=sacc; \
    if(GK){DMA_K((t)+3,sl_cur);} if(GV){DMA_V((t)+1,sl_next);} \
    CMASK(C0,C1,t); \
    { float a=MX3(C0[0],C0[1],C1[0]),b=MX3(C0[2],C0[3],C1[1]); a=MX3(a,C1[2],C1[3]); \
      _Pragma("unroll") for(int r=4;r<16;r+=4){a=MX3(a,C0[r],C0[r+1]);b=MX3(b,C0[r+2],C0[r+3]);a=MX3(a,C1[r],C1[r+1]);b=MX3(b,C1[r+2],C1[r+3]);} \
      float rm=__builtin_fmaxf(a,b); { auto rr=__builtin_amdgcn_permlane32_swap(__float_as_uint(rm),__float_as_uint(rm),false,false); rm=__builtin_fmaxf(__uint_as_float(rr[0]),__uint_as_float(rr[1])); } \
      resc=false; \
      if(__builtin_expect(__any(rm>(float)THRL),0)){ const float dl=__builtin_fmaxf(rm,0.f); mhat+=dl; \
        _Pragma("unroll") for(int r=0;r<16;++r){C0[r]-=dl;C1[r]-=dl;} \
        _Pragma("unroll") for(int r=0;r<16;++r)negm[r]=-mhat; asm volatile("":"+v"(negm)); \
        const float f=__builtin_amdgcn_exp2f(-dl); l_reg*=f; if(hi==0)wsf[r32]=f; resc=true; } } \
    SBAR(); \
    GAPB(o[0]=__builtin_amdgcn_mfma_f32_32x32x16_bf16(PAF(0),VFR(0),o[0],0,0,0), C0,0); \
    GAPB(o[1]=__builtin_amdgcn_mfma_f32_32x32x16_bf16(PAF(0),VFR(4),o[1],0,0,0), C0,4); \
    KRD(GL,0); GAPB(o[0]=__builtin_amdgcn_mfma_f32_32x32x16_bf16(PAF(1),VFR(1),o[0],0,0,0), C0,8); \
    KRD(GL,1); GAPB(o[1]=__builtin_amdgcn_mfma_f32_32x32x16_bf16(PAF(1),VFR(5),o[1],0,0,0), C0,12); \
    KRD(GL,2); GAPB(o[0]=__builtin_amdgcn_mfma_f32_32x32x16_bf16(PAF(2),VFR(2),o[0],0,0,0), C1,0); \
    KRD(GL,3); GAPB(o[1]=__builtin_amdgcn_mfma_f32_32x32x16_bf16(PAF(2),VFR(6),o[1],0,0,0), C1,4); \
    GAPB(o[0]=__builtin_amdgcn_mfma_f32_32x32x16_bf16(PAF(3),VFR(3),o[0],0,0,0), C1,8); \
    GAPB(o[1]=__builtin_amdgcn_mfma_f32_32x32x16_bf16(PAF(3),VFR(7),o[1],0,0,0), C1,12); \
    }while(0)
  int t=1;
  #undef CMASK
  #define CMASK(P0,P1,t) do{}while(0)
  for(;t+5<NT;t+=2){
    STEP(pB0,pB1,pA0,pA1,t,true,true,true);     WAIT_BAR(2); RESC(); ROT();
    STEP(pA0,pA1,pB0,pB1,t+1,true,true,true);   WAIT_BAR(2); RESC(); ROT();
  }
  #undef CMASK
  int hi_b=hi,qrel_b=qrel; asm volatile("":"+v"(hi_b),"+v"(qrel_b));
  #define CMASK(P0,P1,t) do{int jb_=(t)-(NT-4); if(jb_>=0)cmask(P0,P1,jb_,qrel_b,hi_b);}while(0)
  #define ENDW(tt) do{ if((tt)+3<NT){WAIT_BAR(2);} else if((tt)+2<NT){WAIT_BAR(1);} else {WAIT_BAR(0);} }while(0)
  for(;t+1<NT;t+=2){
    STEP(pB0,pB1,pA0,pA1,t,(t+3<NT),(t+1<NT),(t+1<NT));       ENDW(t);   RESC(); ROT();
    STEP(pA0,pA1,pB0,pB1,t+1,(t+4<NT),(t+2<NT),(t+2<NT));     ENDW(t+1); RESC(); ROT();
  }
  STEP(pB0,pB1,pA0,pA1,NT-1,false,false,false); RESC();
  { float sacc=pB0[0]+pB0[1]; _Pragma("unroll") for(int r=2;r<16;++r)sacc+=pB0[r]; _Pragma("unroll") for(int r=0;r<16;++r)sacc+=pB1[r]; l_reg+=sacc;
    pw0=(u32x4){PKW(pB0,0),PKW(pB0,2),PKW(pB0,4),PKW(pB0,6)};pw1=(u32x4){PKW(pB0,8),PKW(pB0,10),PKW(pB0,12),PKW(pB0,14)};pw2=(u32x4){PKW(pB1,0),PKW(pB1,2),PKW(pB1,4),PKW(pB1,6)};pw3=(u32x4){PKW(pB1,8),PKW(pB1,10),PKW(pB1,12),PKW(pB1,14)};
    SBAR(); pv(o,vb0+sl_cur,PAF(0),PAF(1),PAF(2),PAF(3)); }
  #undef PKW
  #undef PAF
  #undef VFR
  #undef PIN
  #undef MX3
  #undef GAPA
  #undef GAPB
  #undef EX
  #undef VRD
  #undef KRD
  #undef STEP
  #undef ENDW
  {auto rr=__builtin_amdgcn_permlane32_swap(__float_as_uint(l_reg),__float_as_uint(l_reg),false,false);l_reg=__uint_as_float(rr[0])+__uint_as_float(rr[1]);}
  if(hi==0)wsf[32+r32]=l_reg;asm volatile("s_waitcnt lgkmcnt(0)":::"memory");
  float rli[16];
  #pragma unroll
  for(int r=0;r<16;++r)rli[r]=__builtin_amdgcn_rcpf(wsf[32+crow(r,hi)]);
  bf16*Ow=O+(rowbase+q0+wid*QBLK)*OP;
  { bf16*stg=(bf16*)(shm+LDS_OST)+wid*2048;
    #pragma unroll
    for(int r=0;r<16;++r){const int orow=crow(r,hi);
      #pragma unroll
      for(int d0=0;d0<2;++d0)stg[orow*64+d0*32+r32]=__float2bfloat16(o[d0][r]*rli[r]);}
    asm volatile("s_waitcnt lgkmcnt(0)":::"memory");
    #pragma unroll
    for(int i=0;i<4;++i){const int row=i*8+(lane>>3),ch=lane&7; const u32x4 v=*(const u32x4*)(stg+row*64+ch*8); ATTN_STORE16(Ow+(long)row*OP+ch*8,v);} }
  asm volatile("s_waitcnt lgkmcnt(0)\n\ts_barrier":::"memory");
  #undef DMA_K
  #undef DMA_V
  #undef CMASK
  #undef START
  #undef RESC
  #undef ROT
}
template<int THRL,int QP,int KP,int VP,int OP> __device__ __forceinline__ void attn_unit2(int wave_,int b,int qb,const bf16*Q,const bf16*__restrict__ K,const bf16*__restrict__ V,bf16*O,char*shm){
  int lane_=lane_id_now(); asm volatile("":"+v"(lane_));
  const int wid=wave_,lane=lane_,tid=wid*64+lane,r32=lane&31,hi=lane>>5;
  const long rowbase=(long)b*SEQ; const int q0=qb*QB;
  const bf16*Qw=Q+(rowbase+q0+wid*QBLK)*QP;
  const bf16*Kh=K+rowbase*KP,*Vh=V+rowbase*VP;
  const unsigned lds0=(unsigned)(uintptr_t)shm;
  constexpr int LDS2_V2=2*NSLOT*SLOTB, LDS2_WS=3*NSLOT*SLOTB, LDS2_OST=LDS2_WS+NW*64*4, V2OFF=LDS2_V2-LDS_V;
  float*wsf=(float*)(shm+LDS2_WS)+wid*64;
  const bf16*ksrc=Kh+(long)lane*KP+wid*8;
  const bf16*vsrc=Vh+(long)(16*(wid&3)+(lane>>2))*VP+(wid>>2)*32+(lane&3)*8;
  const unsigned kdst=lds0+LDS_K+wid*1024, vdst=lds0+LDS_V+wid*1024, vdst2=lds0+LDS2_V2+wid*1024;
  #define DMA_K(t,slot) glds16(ksrc+(long)(t)*KVBLK*KP,(unsigned)__builtin_amdgcn_readfirstlane(kdst+(slot)))
  #define DMA_V(t,slot) do{ glds16(vsrc+(long)(t)*KVBLK*VP,(unsigned)__builtin_amdgcn_readfirstlane(vdst+(slot))); glds16(vsrc+64+(long)(t)*KVBLK*VP,(unsigned)__builtin_amdgcn_readfirstlane(vdst2+(slot))); }while(0)
  const int vb0=(int)(lds0+LDS_V)+((lane>>4)&1)*32+(lane&3)*8+(4*hi+((lane&15)>>2))*64;
  const char*Kbase=shm+LDS_K; bf16x8 kf[8];
  const lds_cptr shm3=(lds_cptr)shm; const lds_cptr kp0=shm3+LDS_K+hi*1024+r32*16; const lds_cptr vp0=shm3+LDS_V+((lane>>4)&1)*32+(lane&3)*8+(4*hi+((lane&15)>>2))*64;
  const int NT=(q0+QB)/KVBLK;
  DMA_K(0,0);DMA_V(0,0);DMA_K(1,SLOTB);
  bf16x8 qr[4];
  #pragma unroll
  for(int d0=0;d0<4;++d0)qr[d0]=*reinterpret_cast<const bf16x8*>(&Qw[(long)r32*QP+d0*16+hi*8]);
  float mhat=0.f,l_reg=0.f;f32x16 o[4];o[0]=f32x16{};o[1]=f32x16{};o[2]=f32x16{};o[3]=f32x16{};const f32x16 negm=f32x16{};
  const int qrel=wid*QBLK+r32;
  #define CMASK(P0,P1,t) do{int jb_=(t)-(NT-4); if(jb_>=0)cmask(P0,P1,jb_,qrel,hi);}while(0)
  bool resc=false;
  #define START(P0,P1) do{ const float rm=rowmax(P0,P1); resc=false; \
    { const float dl=rm; mhat=fadd_s(mhat,dl); \
      _Pragma("unroll") for(int r=0;r<16;++r){P0[r]=fsub_s(P0[r],dl);P1[r]=fsub_s(P1[r],dl);} \
      } \
    _Pragma("unroll") for(int r=0;r<16;++r)P0[r]=__builtin_amdgcn_exp2f(P0[r]); }while(0)
  #define RESC() do{ if(resc){ asm volatile("s_waitcnt lgkmcnt(0)":::"memory"); \
      _Pragma("unroll") for(int d_=0;d_<4;++d_) _Pragma("unroll") for(int r=0;r<16;++r)o[d_][r]*=wsf[crow(r,hi)]; } }while(0)
  f32x16 pA0,pA1,pB0,pB1;
  int sl_prev=0,sl_cur=0,sl_next=SLOTB;
  #define ROT() do{sl_prev=sl_cur;sl_cur=sl_next;sl_next=(sl_next==(NSLOT-1)*SLOTB)?0:sl_next+SLOTB;}while(0)
  DMA_K(2,2*SLOTB);
  WAIT_BAR(4);
  qkt(pA0,pA1,Kbase,qr,negm,r32,hi);asm volatile("s_nop 15\n\ts_nop 7":"+v"(pA0),"+v"(pA1));CMASK(pA0,pA1,0);
  START(pA0,pA1);
  _Pragma("unroll") for(int r=0;r<16;++r)pA1[r]=__builtin_amdgcn_exp2f(pA1[r]);
  WAIT_BAR(0);
  DMA_K(3,0);DMA_V(1,SLOTB);
  ROT();
  kload8(kf,kp0+sl_cur);
  WAIT_BAR(3);
  s16x4 vlo[4],vhi[4]; u32x4 pw0,pw1,pw2,pw3;
  #define PKW(P,B) cvtpk_s(P[B],P[B+1])
  #define PAF(k) __builtin_bit_cast(bf16x8,pw##k)
  #define VFR(i) (bf16x8){vlo[i][0],vlo[i][1],vlo[i][2],vlo[i][3],vhi[i][0],vhi[i][1],vhi[i][2],vhi[i][3]}
  #define PIN(x) asm volatile("":"+v"(x))
  #define MX3(a,b,c) __builtin_fmaxf(__builtin_fmaxf((a),(b)),(c))
  #define GAPA(MF,A0,A1,A2,A3,W0,W1,PW) do{ MF; sacc+=A0; sacc+=A1; sacc+=A2; sacc+=A3; PIN(sacc); W0; W1; PIN(PW); SBAR(); }while(0)
  #define EX(v) __builtin_amdgcn_exp2f(v)
  #define GAPB(MF,X,B) do{ MF; X[B]=EX(X[B]); X[B+1]=EX(X[B+1]); X[B+2]=EX(X[B+2]); X[B+3]=EX(X[B+3]); PIN(X); SBAR(); }while(0)
  #define VRD(i) do{ vlo[i]=vtr(vp_+(((i)>>2)*4096+((i)&3)*1024)); vhi[i]=vtr(vp_+(((i)>>2)*4096+((i)&3)*1024+512)); }while(0)
  #define VLD(S,i,OFF) do{ vlo[S]=vtr(vp_+(OFF)+(((i)>>2)*4096+((i)&3)*1024)); vhi[S]=vtr(vp_+(OFF)+(((i)>>2)*4096+((i)&3)*1024+512)); }while(0)
  #define GAPB3(MF,X,B,LD) do{ MF; LD; X[B]=EX(X[B]); X[B+1]=EX(X[B+1]); X[B+2]=EX(X[B+2]); X[B+3]=EX(X[B+3]); PIN(X); SBAR(); }while(0)
  #define KRD(G,j) do{ if(G){ kload2(kf,kp0+sl_next,j); SBAR(); } }while(0)
  #define STEP(C0,C1,P0,P1,t,GK,GV,GL) do{ SBAR(); \
    const lds_cptr vp_=vp0+sl_prev; \
    VLD(0,0,0); SBAR(); float sacc=(P0[0]+P0[1]); \
    GAPA(C0=__builtin_amdgcn_mfma_f32_32x32x16_bf16(kf[0],qr[0],C0,0,0,0), P0[2],P0[3],P0[4],P0[5],     pw0[0]=PKW(P0,0), pw0[1]=PKW(P0,2), pw0); \
    VLD(1,4,0); SBAR(); GAPA(C1=__builtin_amdgcn_mfma_f32_32x32x16_bf16(kf[1],qr[0],C1,0,0,0), P0[6],P0[7],P0[8],P0[9],     pw0[2]=PKW(P0,4), pw0[3]=PKW(P0,6), pw0); \
    VLD(2,1,0); SBAR(); GAPA(C0=__builtin_amdgcn_mfma_f32_32x32x16_bf16(kf[2],qr[1],C0,0,0,0),   P0[10],P0[11],P0[12],P0[13], pw1[0]=PKW(P0,8), pw1[1]=PKW(P0,10), pw1); \
    VLD(3,5,0); SBAR(); GAPA(C1=__builtin_amdgcn_mfma_f32_32x32x16_bf16(kf[3],qr[1],C1,0,0,0),   P0[14],P0[15],P1[0],P1[1],   pw1[2]=PKW(P0,12),pw1[3]=PKW(P0,14), pw1); \
    GAPA(C0=__builtin_amdgcn_mfma_f32_32x32x16_bf16(kf[4],qr[2],C0,0,0,0),   P1[2],P1[3],P1[4],P1[5],     pw2[0]=PKW(P1,0), pw2[1]=PKW(P1,2), pw2); \
    GAPA(C1=__builtin_amdgcn_mfma_f32_32x32x16_bf16(kf[5],qr[2],C1,0,0,0),   P1[6],P1[7],P1[8],P1[9],     pw2[2]=PKW(P1,4), pw2[3]=PKW(P1,6), pw2); \
    GAPA(C0=__builtin_amdgcn_mfma_f32_32x32x16_bf16(kf[6],qr[3],C0,0,0,0),   P1[10],P1[11],P1[12],P1[13], pw3[0]=PKW(P1,8), pw3[1]=PKW(P1,10), pw3); \
    GAPA(C1=__builtin_amdgcn_mfma_f32_32x32x16_bf16(kf[7],qr[3],C1,0,0,0),   P1[14],P1[15],0.f,0.f,       pw3[2]=PKW(P1,12),pw3[3]=PKW(P1,14), pw3); \
    l_reg+=sacc; \
    if(GK){DMA_K((t)+3,sl_cur);} if(GV){DMA_V((t)+1,sl_next);} \
    CMASK(C0,C1,t); \
    { float a=MX3(C0[0],C0[1],C1[0]),b=MX3(C0[2],C0[3],C1[1]); a=MX3(a,C1[2],C1[3]); \
      _Pragma("unroll") for(int r=4;r<16;r+=4){a=MX3(a,C0[r],C0[r+1]);b=MX3(b,C0[r+2],C0[r+3]);a=MX3(a,C1[r],C1[r+1]);b=MX3(b,C1[r+2],C1[r+3]);} \
      float rm=__builtin_fmaxf(a,b); { auto rr=__builtin_amdgcn_permlane32_swap(__float_as_uint(rm),__float_as_uint(rm),false,false); rm=__builtin_fmaxf(__uint_as_float(rr[0]),__uint_as_float(rr[1])); } \
      resc=false; \
      if(__builtin_expect(__any(rm>(float)THRL),0)){ const float dl=__builtin_fmaxf(rm,0.f); mhat+=dl; \
        _Pragma("unroll") for(int r=0;r<16;++r){C0[r]-=dl;C1[r]-=dl;} \
        \
        const float f=__builtin_amdgcn_exp2f(-dl); l_reg*=f; if(hi==0)wsf[r32]=f; resc=true; } } \
    SBAR(); \
    GAPB3(o[0]=__builtin_amdgcn_mfma_f32_32x32x16_bf16(PAF(0),VFR(0),o[0],0,0,0), C0,0, VLD(0,2,0)); \
    GAPB3(o[1]=__builtin_amdgcn_mfma_f32_32x32x16_bf16(PAF(0),VFR(1),o[1],0,0,0), C0,4, VLD(1,6,0)); \
    KRD(GL,0); GAPB3(o[0]=__builtin_amdgcn_mfma_f32_32x32x16_bf16(PAF(1),VFR(2),o[0],0,0,0), C0,8, VLD(2,3,0)); \
    KRD(GL,1); GAPB3(o[1]=__builtin_amdgcn_mfma_f32_32x32x16_bf16(PAF(1),VFR(3),o[1],0,0,0), C0,12, VLD(3,7,0)); \
    KRD(GL,2); GAPB3(o[0]=__builtin_amdgcn_mfma_f32_32x32x16_bf16(PAF(2),VFR(0),o[0],0,0,0), C1,0, VLD(0,0,V2OFF)); \
    KRD(GL,3); GAPB3(o[1]=__builtin_amdgcn_mfma_f32_32x32x16_bf16(PAF(2),VFR(1),o[1],0,0,0), C1,4, VLD(1,4,V2OFF)); \
    GAPB3(o[0]=__builtin_amdgcn_mfma_f32_32x32x16_bf16(PAF(3),VFR(2),o[0],0,0,0), C1,8, VLD(2,1,V2OFF)); \
    GAPB3(o[1]=__builtin_amdgcn_mfma_f32_32x32x16_bf16(PAF(3),VFR(3),o[1],0,0,0), C1,12, VLD(3,5,V2OFF)); \
    const float nm_=-mhat; \
    o[2]=__builtin_amdgcn_mfma_f32_32x32x16_bf16(PAF(0),VFR(0),o[2],0,0,0); VLD(0,2,V2OFF); P0[0]=nm_;P0[1]=nm_;P0[2]=nm_;P0[3]=nm_; PIN(P0); SBAR(); \
    o[3]=__builtin_amdgcn_mfma_f32_32x32x16_bf16(PAF(0),VFR(1),o[3],0,0,0); VLD(1,6,V2OFF); P0[4]=nm_;P0[5]=nm_;P0[6]=nm_;P0[7]=nm_; PIN(P0); SBAR(); \
    o[2]=__builtin_amdgcn_mfma_f32_32x32x16_bf16(PAF(1),VFR(2),o[2],0,0,0); VLD(2,3,V2OFF); P0[8]=nm_;P0[9]=nm_;P0[10]=nm_;P0[11]=nm_; PIN(P0); SBAR(); \
    o[3]=__builtin_amdgcn_mfma_f32_32x32x16_bf16(PAF(1),VFR(3),o[3],0,0,0); VLD(3,7,V2OFF); P0[12]=nm_;P0[13]=nm_;P0[14]=nm_;P0[15]=nm_; PIN(P0); SBAR(); \
    o[2]=__builtin_amdgcn_mfma_f32_32x32x16_bf16(PAF(2),VFR(0),o[2],0,0,0); P1[0]=nm_;P1[1]=nm_;P1[2]=nm_;P1[3]=nm_; PIN(P1); SBAR(); \
    o[3]=__builtin_amdgcn_mfma_f32_32x32x16_bf16(PAF(2),VFR(1),o[3],0,0,0); P1[4]=nm_;P1[5]=nm_;P1[6]=nm_;P1[7]=nm_; PIN(P1); SBAR(); \
    o[2]=__builtin_amdgcn_mfma_f32_32x32x16_bf16(PAF(3),VFR(2),o[2],0,0,0); P1[8]=nm_;P1[9]=nm_;P1[10]=nm_;P1[11]=nm_; PIN(P1); SBAR(); \
    o[3]=__builtin_amdgcn_mfma_f32_32x32x16_bf16(PAF(3),VFR(3),o[3],0,0,0); P1[12]=nm_;P1[13]=nm_;P1[14]=nm_;P1[15]=nm_; PIN(P1); SBAR(); \
    }while(0)
  _Pragma("unroll") for(int r=0;r<16;++r){pB0[r]=-mhat;pB1[r]=-mhat;}
  int t=1;
  #undef CMASK
  #define CMASK(P0,P1,t) do{}while(0)
  for(;t+5<NT;t+=2){
    STEP(pB0,pB1,pA0,pA1,t,true,true,true);     WAIT_BAR(3); RESC(); ROT();
    STEP(pA0,pA1,pB0,pB1,t+1,true,true,true);   WAIT_BAR(3); RESC(); ROT();
  }
  #undef CMASK
  int hi_b=hi,qrel_b=qrel; asm volatile("":"+v"(hi_b),"+v"(qrel_b));
  #define CMASK(P0,P1,t) do{int jb_=(t)-(NT-4); if(jb_>=0)cmask(P0,P1,jb_,qrel_b,hi_b);}while(0)
  #define ENDW(tt) do{ if((tt)+3<NT){WAIT_BAR(3);} else if((tt)+2<NT){WAIT_BAR(2);} else {WAIT_BAR(0);} }while(0)
  for(;t+1<NT;t+=2){
    STEP(pB0,pB1,pA0,pA1,t,(t+3<NT),(t+1<NT),(t+1<NT));       ENDW(t);   RESC(); ROT();
    STEP(pA0,pA1,pB0,pB1,t+1,(t+4<NT),(t+2<NT),(t+2<NT));     ENDW(t+1); RESC(); ROT();
  }
  STEP(pB0,pB1,pA0,pA1,NT-1,false,false,false); RESC();
  { float sacc=pB0[0]+pB0[1]; _Pragma("unroll") for(int r=2;r<16;++r)sacc+=pB0[r]; _Pragma("unroll") for(int r=0;r<16;++r)sacc+=pB1[r]; l_reg+=sacc;
    pw0=(u32x4){PKW(pB0,0),PKW(pB0,2),PKW(pB0,4),PKW(pB0,6)};pw1=(u32x4){PKW(pB0,8),PKW(pB0,10),PKW(pB0,12),PKW(pB0,14)};pw2=(u32x4){PKW(pB1,0),PKW(pB1,2),PKW(pB1,4),PKW(pB1,6)};pw3=(u32x4){PKW(pB1,8),PKW(pB1,10),PKW(pB1,12),PKW(pB1,14)};
    SBAR(); pv(o,vb0+sl_cur,PAF(0),PAF(1),PAF(2),PAF(3)); pv(o+2,vb0+V2OFF+sl_cur,PAF(0),PAF(1),PAF(2),PAF(3)); }
  #undef PKW
  #undef PAF
  #undef VFR
  #undef PIN
  #undef MX3
  #undef GAPA
  #undef GAPB
  #undef EX
  #undef VRD
  #undef KRD
  #undef VLD
  #undef GAPB3
  #undef STEP
  #undef ENDW
  {auto rr=__builtin_amdgcn_permlane32_swap(__float_as_uint(l_reg),__float_as_uint(l_reg),false,false);l_reg=__uint_as_float(rr[0])+__uint_as_float(rr[1]);}
  if(hi==0)wsf[32+r32]=l_reg;asm volatile("s_waitcnt lgkmcnt(0)":::"memory");
  float rli[16];
  #pragma unroll
  for(int r=0;r<16;++r)rli[r]=__builtin_amdgcn_rcpf(wsf[32+crow(r,hi)]);
  bf16*Ow=O+(rowbase+q0+wid*QBLK)*OP;
  { bf16*stg=(bf16*)(shm+LDS2_OST)+wid*2048;
    #pragma unroll
    for(int hh=0;hh<2;++hh){
      #pragma unroll
      for(int r=0;r<16;++r){const int orow=crow(r,hi);
        #pragma unroll
        for(int d0=0;d0<2;++d0)stg[orow*64+d0*32+r32]=__float2bfloat16(o[2*hh+d0][r]*rli[r]);}
      asm volatile("s_waitcnt lgkmcnt(0)":::"memory");
      #pragma unroll
      for(int i=0;i<4;++i){const int row=i*8+(lane>>3),ch=lane&7; const u32x4 v=*(const u32x4*)(stg+row*64+ch*8); ATTN_STORE16(Ow+(long)row*OP+hh*64+ch*8,v);}
      asm volatile("s_waitcnt lgkmcnt(0)":::"memory"); } }
  asm volatile("s_waitcnt lgkmcnt(0)\n\ts_barrier":::"memory");
  #undef DMA_K
  #undef DMA_V
  #undef CMASK
  #undef START
  #undef RESC
  #undef ROT
}
constexpr int ATTN_LDS_BYTES=LDS_BYTES;
#undef SBAR
#undef WAIT_BAR
}
#define GAS __attribute__((address_space(1)))
#define LAS __attribute__((address_space(3)))
typedef unsigned short bf16;
typedef unsigned v4u __attribute__((ext_vector_type(4)));
typedef float f32x4 __attribute__((ext_vector_type(4)));
typedef short bf16x8 __attribute__((ext_vector_type(8)));
typedef GAS unsigned gu32;
typedef GAS unsigned long long gu64;
#define RLX_AGENT __ATOMIC_RELAXED, __HIP_MEMORY_SCOPE_AGENT
#define LDS_WAIT() asm volatile("s_waitcnt lgkmcnt(0)" ::: "memory")
#define VM_WAIT() asm volatile("s_waitcnt vmcnt(0)" ::: "memory")
__device__ __forceinline__ unsigned long long rt() { return __builtin_amdgcn_s_memrealtime(); }
__device__ __forceinline__ unsigned f2bf(float f) { unsigned u = __builtin_bit_cast(unsigned, f); return (u + 0x7fffu + ((u >> 16) & 1u)) >> 16; }
__device__ __forceinline__ unsigned pk2(float lo, float hi) { return f2bf(lo) | (f2bf(hi) << 16); }

#define XB_TMO      128
#define XB_XCNT(j)  (256  + 64 * (j))
#define XB_XSUB(j)  (1280 + 64 * (j))
#define XB_XGEN(j)  (2304 + 64 * (j))
#define XB_TOP      3328
#define XB_TOPGEN   3392
#define XCD_BAR_WORDS 3456
#define XB_SPIN_CAP (1u << 18)

__device__ __forceinline__ unsigned xb_ld(unsigned* p)              { return __hip_atomic_load(p, __ATOMIC_RELAXED, __HIP_MEMORY_SCOPE_AGENT); }
__device__ __forceinline__ unsigned xb_add(unsigned* p, unsigned v) { return __hip_atomic_fetch_add(p, v, __ATOMIC_RELAXED, __HIP_MEMORY_SCOPE_AGENT); }
__device__ __forceinline__ unsigned xb_xcc_id() { return (unsigned)__builtin_amdgcn_s_getreg((3 << 11) | 20) & 0xFu; }
#define XB_SPIN(cond, bar) do { unsigned _sp = 0; while (cond) { __builtin_amdgcn_s_sleep(1); \
    if ((++_sp & 255u) == 0u) { if (xb_ld(&(bar)[XB_TMO])) break; if (_sp > XB_SPIN_CAP) { atomicAdd(&(bar)[XB_TMO], 1u); break; } } } } while (0)

struct XcdBarrier {
    unsigned* bar; unsigned x;
    volatile LAS unsigned* st;
};

__device__ __forceinline__ XcdBarrier xcd_barrier_post(unsigned* bar, volatile LAS unsigned* st) {
    XcdBarrier b; b.bar = bar; b.x = xb_xcc_id(); b.st = st;
    if (threadIdx.x == 0) { const unsigned r_ = xb_add(&bar[XB_XCNT(b.x)], 1u); st[2] = r_; st[3] = b.x; }
    return b;
}
__device__ __forceinline__ void xcd_barrier_complete(unsigned* bar, unsigned x, unsigned& nloc, unsigned& nx, unsigned& regular) {
    const unsigned G = gridDim.x * gridDim.y * gridDim.z;
    unsigned sum, cnt, mine, sp = 0u;
    for (;;) {
        sum = 0u; cnt = 0u; mine = 0u; regular = 1u;
#pragma unroll
        for (unsigned j = 0; j < 16; ++j) { const unsigned c = xb_ld(&bar[XB_XCNT(j)]); sum += c; cnt += (c > 0u) ? 1u : 0u; mine = (j == x) ? c : mine; regular &= (c == 0u || c == 32u) ? 1u : 0u; }
        if (sum == G) break;
        __builtin_amdgcn_s_sleep(1);
        if ((++sp & 255u) == 0u) { if (xb_ld(&bar[XB_TMO])) break; if (sp > XB_SPIN_CAP) { atomicAdd(&bar[XB_TMO], 1u); break; } }
    }
    nloc = mine > 0u ? mine : 1u; nx = cnt > 0u ? cnt : 1u; regular = (regular != 0u && cnt == 8u && sum == G) ? 1u : 0u;
}

__device__ __forceinline__ void xcd_barrier(const XcdBarrier& b, int wave_) {
    asm volatile("s_waitcnt vmcnt(0)" ::: "memory");
    __syncthreads();
    if (wave_ == 0 && lane_id_now() == 0) {
        unsigned* bar = b.bar;
        __builtin_amdgcn_s_waitcnt(0);
        unsigned nloc = b.st[0], nx = b.st[1];
        if (nloc == 0u) { unsigned reg_; xcd_barrier_complete(bar, b.x, nloc, nx, reg_); b.st[0] = nloc; b.st[1] = nx; b.st[5] = reg_; }
        const unsigned old = xb_add(&bar[XB_XSUB(b.x)], 1u);
        const unsigned gen = old / nloc;
        if (old + 1u == (gen + 1u) * nloc) {
            __builtin_amdgcn_fence(__ATOMIC_RELEASE, "agent");
            asm volatile("s_waitcnt vmcnt(0)" ::: "memory");
            const unsigned og = xb_add(&bar[XB_TOP], 1u);
            const unsigned tg = og / nx;
            if (og + 1u == (tg + 1u) * nx) xb_add(&bar[XB_TOPGEN], 1u);
            else XB_SPIN(xb_ld(&bar[XB_TOPGEN]) == tg, bar);
            __builtin_amdgcn_fence(__ATOMIC_ACQUIRE, "agent");
            xb_add(&bar[XB_XGEN(b.x)], 1u);
            asm volatile("s_waitcnt vmcnt(0)" ::: "memory");
        } else {
            XB_SPIN(xb_ld(&bar[XB_XGEN(b.x)]) == gen, bar);
            __builtin_amdgcn_fence(__ATOMIC_ACQUIRE, "agent");
            asm volatile("s_waitcnt vmcnt(0)" ::: "memory");
        }
    }
    __syncthreads();
}
constexpr int NWAVES = 8;
constexpr int BATCH = 4, T = 4096, D = 1024, M = BATCH * T;
constexpr int NPROJ = 5120;
constexpr int NE = 32, TOPK = 4, FF = 1024;
constexpr int MAXT = (M * TOPK) / 256 + NE;
constexpr float EPS = 1e-5f;
constexpr float F8_XSCALE = 32.0f, F8_WSCALE = 512.0f, F8_ASCALE = 8.0f, F8_YSCALE = 64.0f;
constexpr float LAMBDA_INIT = 0.2f;

constexpr size_t MiB = 1u << 20;
constexpr size_t WS_CTL = 0, CTL_ZERO_BYTES = 128 * 1024;
constexpr size_t WS_ROPE = 1 * MiB;
constexpr size_t WS_ROUTE = 2 * MiB;
constexpr size_t WS_WLG = 3 * MiB;
constexpr size_t WS_WGU = 4 * MiB;
constexpr size_t WS_WD = 132 * MiB;
constexpr size_t WS_WIN = 196 * MiB;
constexpr size_t WS_WDA = 206 * MiB, WS_WSB = 207 * MiB, WS_WO = 208 * MiB;
constexpr size_t WS_A0 = 210 * MiB;
constexpr size_t WS_H = WS_A0;
constexpr size_t WS_P = WS_A0 + 32 * MiB;
constexpr size_t WS_VBT = WS_A0 + 192 * MiB;
constexpr size_t WS_ODA = WS_A0 + 208 * MiB;
constexpr size_t WS_DA = WS_A0 + 240 * MiB;
constexpr size_t WS_SB = WS_A0 + 256 * MiB;
constexpr size_t WS_YS = WS_A0 + 144 * MiB;
constexpr size_t WS_ACT = WS_A0;
constexpr size_t WS_LIST = WS_A0 + 288 * MiB;
constexpr size_t WS_END = WS_A0 + 292 * MiB;
static_assert(WS_SB + 16 * MiB <= WS_END && WS_END <= 512 * MiB, "d_ws map");
constexpr int CW_TMO = 0, CW_CODE = 1;
constexpr int CW_CNT = 1024;
constexpr int CW_BAR = 4096;
constexpr int CW_RANK = 8192;
constexpr int CW_GRP = 9216;
constexpr int CW_XL = 13312;
constexpr int CW_RDY = 14336;
static_assert((CW_RDY + 16 * MAXT) * 4 <= (int)CTL_ZERO_BYTES, "control words");

constexpr int RING_OFF = 0, RING_BYTES = 131072;
constexpr int RT_STRIDE = 36, RT_BYTES = 1024 * RT_STRIDE * 4;
constexpr int LDSCTL_OFF = 147456, MISC_OFF = LDSCTL_OFF + 320, TAB_OFF = LDSCTL_OFF + 1024;
constexpr int JUNK_OFF = RING_BYTES, TOK_OFF = RING_BYTES;
constexpr int EPISTG_OFF = LDSCTL_OFF + 4096;
constexpr int LDS_BYTES = 163840;
static_assert(RT_BYTES <= LDSCTL_OFF && TAB_OFF + 4 * 768 <= LDS_BYTES && TOK_OFF + 16384 <= LDSCTL_OFF, "LDS map");
#define LANE_NOW (lane_id_now())
struct Frame {
    LAS unsigned char* lds;
    volatile LAS unsigned* MISC;
    gu32* ctl;
    int wave;
    int vcu, G;
};
__device__ __forceinline__ float wave_sum(float v) {
#pragma unroll
    for (int o = 1; o < 64; o <<= 1) v += __shfl_xor(v, o);
    return v;
}
__device__ __forceinline__ unsigned cvtpk2(float lo, float hi) { unsigned r; asm volatile("v_cvt_pk_bf16_f32 %0, %1, %2" : "=v"(r) : "v"(lo), "v"(hi)); return r; }
__device__ __forceinline__ void tb_load(float (&tv)[32], const float* W, int ldw, int lane) {
#pragma unroll
    for (int i = 0; i < 32; ++i) tv[i] = __builtin_nontemporal_load(W + (size_t)(2 * i + (lane >> 5)) * ldw + (lane & 31));
}
__device__ __forceinline__ void tb_finish(const float (&tv)[32], bf16* WT, int ldt, const float* gk, LAS float* scr, int lane) {
    if (gk) {
#pragma unroll
        for (int i = 0; i < 32; ++i) scr[(2 * i + (lane >> 5)) * 33 + (lane & 31)] = tv[i] * gk[2 * i + (lane >> 5)];
    } else {
#pragma unroll
        for (int i = 0; i < 32; ++i) scr[(2 * i + (lane >> 5)) * 33 + (lane & 31)] = tv[i];
    }
    LDS_WAIT(); asm volatile("" ::: "memory");
    const int c = lane & 7;
#pragma unroll
    for (int j = 0; j < 4; ++j) { const int n = (lane >> 3) + 8 * j; const LAS float* s = scr + (8 * c) * 33 + n;
        v4u o; o.x = cvtpk2(s[0 * 33], s[1 * 33]); o.y = cvtpk2(s[2 * 33], s[3 * 33]); o.z = cvtpk2(s[4 * 33], s[5 * 33]); o.w = cvtpk2(s[6 * 33], s[7 * 33]);
        __builtin_nontemporal_store(o, (GAS v4u*)(WT + (size_t)n * ldt + 8 * c)); }
    LDS_WAIT(); asm volatile("" ::: "memory");
}
struct XItem { const float* src; int ldw; bf16* dst; int ldt; const float* gk; bf16* dst2; float f8; };
__device__ __forceinline__ void tb_load64(float (&tv)[64], const float* W, int ldw, int lane) {
#pragma unroll
    for (int i = 0; i < 64; ++i) tv[i] = __builtin_nontemporal_load(W + (size_t)i * ldw + lane);
}
__device__ __forceinline__ void tb_finish64(const float (&tv)[64], const XItem& it, LAS float* scr, int lane) {
    if (it.f8 != 0.f) {
#pragma unroll
        for (int i = 0; i < 64; ++i) scr[i * 65 + lane] = __builtin_amdgcn_fmed3f(tv[i] * (it.gk ? it.gk[i] * it.f8 : it.f8), -448.0f, 448.0f);
        LDS_WAIT(); asm volatile("" ::: "memory");
        const int c4 = lane & 3;
#pragma unroll
        for (int j = 0; j < 4; ++j) { const int n = (lane >> 2) + 16 * j; const LAS float* s = scr + (16 * c4) * 65 + n; int w[4];
#pragma unroll
            for (int q = 0; q < 4; ++q) { int t = 0; t = __builtin_amdgcn_cvt_pk_fp8_f32(s[(4 * q) * 65], s[(4 * q + 1) * 65], t, false); t = __builtin_amdgcn_cvt_pk_fp8_f32(s[(4 * q + 2) * 65], s[(4 * q + 3) * 65], t, true); w[q] = t; }
            v4u o; o.x = (unsigned)w[0]; o.y = (unsigned)w[1]; o.z = (unsigned)w[2]; o.w = (unsigned)w[3];
            __builtin_nontemporal_store(o, (GAS v4u*)((unsigned char*)it.dst + (size_t)n * 64 + 16 * c4)); }
        LDS_WAIT(); asm volatile("" ::: "memory");
        return;
    }
    if (it.gk) {
#pragma unroll
        for (int i = 0; i < 64; ++i) scr[i * 65 + lane] = tv[i] * it.gk[i];
    } else {
#pragma unroll
        for (int i = 0; i < 64; ++i) scr[i * 65 + lane] = tv[i];
    }
    LDS_WAIT(); asm volatile("" ::: "memory");
    const int c = lane & 7;
#pragma unroll
    for (int j = 0; j < 8; ++j) { const int n = (lane >> 3) + 8 * j; const LAS float* s = scr + (8 * c) * 65 + n;
        v4u o; o.x = cvtpk2(s[0 * 65], s[1 * 65]); o.y = cvtpk2(s[2 * 65], s[3 * 65]); o.z = cvtpk2(s[4 * 65], s[5 * 65]); o.w = cvtpk2(s[6 * 65], s[7 * 65]);
        bf16* rowp = (j < 4) ? it.dst + (size_t)n * it.ldt : it.dst2 + (size_t)(n - 32) * it.ldt;
        *(GAS v4u*)(rowp + 8 * c) = o; }
    LDS_WAIT(); asm volatile("" ::: "memory");
}
__device__ __forceinline__ void rms_row_to_bf16(int lane, const float* xrow, const float* g, bf16* orow) {
    const GAS f32x4* xr = (const GAS f32x4*)xrow + lane; const GAS f32x4* gr = (const GAS f32x4*)g + lane;
    f32x4 v[4]; float s = 0.f;
#pragma unroll
    for (int j = 0; j < 4; ++j) { v[j] = xr[64 * j]; s += (v[j].x * v[j].x + v[j].y * v[j].y) + (v[j].z * v[j].z + v[j].w * v[j].w); }
    const float rstd = 1.f / sqrtf(wave_sum(s) * (1.f / D) + EPS);
    GAS unsigned long long* o8 = (GAS unsigned long long*)orow + lane;
#pragma unroll
    for (int j = 0; j < 4; ++j) { const f32x4 gg = gr[64 * j]; const f32x4 y = v[j] * rstd * gg;
        o8[64 * j] = (unsigned long long)cvtpk2(y.x, y.y) | ((unsigned long long)cvtpk2(y.z, y.w) << 32); }
}

struct Args { const float* in[21]; float* out; unsigned char* ws; int ph_lo, ph_hi; };
__device__ const float INV_FREQ[32] = {1.000000000e+00f, 7.498942018e-01f, 5.623413324e-01f, 4.216965139e-01f, 3.162277639e-01f, 2.371373922e-01f, 1.778279394e-01f, 1.333521456e-01f, 1.000000015e-01f, 7.498941571e-02f, 5.623412877e-02f, 4.216964915e-02f, 3.162277862e-02f, 2.371373586e-02f, 1.778279431e-02f, 1.333521493e-02f, 9.999999776e-03f, 7.498942316e-03f, 5.623413250e-03f, 4.216964822e-03f, 3.162277862e-03f, 2.371373819e-03f, 1.778279431e-03f, 1.333521446e-03f, 1.000000047e-03f, 7.498941850e-04f, 5.623413017e-04f, 4.216965463e-04f, 3.162277862e-04f, 2.371373848e-04f, 1.778279402e-04f, 1.333521504e-04f};

__device__ __forceinline__ void p0_prologue(Frame& F, const Args& a, unsigned char* ws) {
    LAS float* scr = (LAS float*)(F.lds + RING_OFF + F.wave * 16384);
    const int gw = F.vcu * NWAVES + F.wave, NGW = F.G * NWAVES;
    const float* x = a.in[0]; const float* g_mix = a.in[1]; const float* w_in = a.in[2];
    const float* w_da = a.in[8]; const float* w_sb = a.in[9]; const float* w_o = a.in[10];
    const float* w_gate = a.in[14]; const float* w_up = a.in[16]; const float* w_down = a.in[18]; const float* g_ffn_p = a.in[11];
    bf16* WIN = (bf16*)(ws + WS_WIN); bf16* WDA = (bf16*)(ws + WS_WDA); bf16* WSB = (bf16*)(ws + WS_WSB); bf16* WO = (bf16*)(ws + WS_WO);
    bf16* WGU = (bf16*)(ws + WS_WGU); bf16* WD = (bf16*)(ws + WS_WD);
    constexpr int I_IN = 16 * 80, I_DA = 8 * 16, I_SB = 8 * 16, I_O = 16 * 16, I_EXP = 16 * 16;
    constexpr int NITEMS = I_IN + I_DA + I_SB + I_O + 96 * I_EXP;
    auto item = [&](int it) -> XItem {
        int r = it;
        if (r < I_IN) { const int kb = r / 80, nb = r % 80, n0 = 64 * nb;
            if (n0 < 1024) { const int pn = n0 >> 8, w = n0 & 255, drow = 256 * pn + 32 * (w >> 6);
                return XItem{w_in + (size_t)(64 * kb) * NPROJ + n0, NPROJ, WIN + (size_t)drow * 1024 + 64 * kb, 1024, nullptr, WIN + (size_t)(drow + 128) * 1024 + 64 * kb, 0.f}; }
            return XItem{w_in + (size_t)(64 * kb) * NPROJ + n0, NPROJ, WIN + (size_t)n0 * 1024 + 64 * kb, 1024, nullptr, WIN + (size_t)(n0 + 32) * 1024 + 64 * kb, 0.f}; }
        r -= I_IN;
        if (r < I_DA) { const int kb = r / 16, n0 = 64 * (r % 16); return XItem{w_da + (size_t)(64 * kb) * 1024 + n0, 1024, WDA + (size_t)n0 * 512 + 64 * kb, 512, nullptr, WDA + (size_t)(n0 + 32) * 512 + 64 * kb, 0.f}; }
        r -= I_DA;
        if (r < I_SB) { const int kb = r / 16, n0 = 64 * (r % 16); return XItem{w_sb + (size_t)(64 * kb) * 1024 + n0, 1024, WSB + (size_t)n0 * 512 + 64 * kb, 512, nullptr, WSB + (size_t)(n0 + 32) * 512 + 64 * kb, 0.f}; }
        r -= I_SB;
        if (r < I_O) { const int kb = r / 16, n0 = 64 * (r % 16); return XItem{w_o + (size_t)(64 * kb) * 1024 + n0, 1024, WO + (size_t)n0 * 1024 + 64 * kb, 1024, nullptr, WO + (size_t)(n0 + 32) * 1024 + 64 * kb, 0.f}; }
        r -= I_O;
        const int mat = r / I_EXP, q = r % I_EXP, kb = q / 16, n0 = 64 * (q % 16), e = mat / 3, kind = mat % 3;
        const size_t eoff = (size_t)e * 1024 * 1024;
        if (kind == 2) { unsigned char* d = (unsigned char*)WD + (((size_t)e * 16 + kb) * 1024 + n0) * 64; return XItem{w_down + eoff + (size_t)(64 * kb) * 1024 + n0, 1024, (bf16*)d, 1024, nullptr, (bf16*)d, F8_WSCALE}; }
        unsigned char* d = (unsigned char*)WGU + (((size_t)e * 16 + kb) * 2048 + 256 * (n0 >> 7) + (kind == 1 ? 128 : 0) + (n0 & 127)) * 64;
        return XItem{(kind == 0 ? w_gate : w_up) + eoff + (size_t)(64 * kb) * 1024 + n0, 1024, (bf16*)d, 1024, g_ffn_p + 64 * kb, (bf16*)d, F8_WSCALE};
    };
    { LAS float* scr64 = (LAS float*)(F.lds + F.wave * 16640);
      float tvn[64]; XItem nx = item(gw < NITEMS ? gw : 0);
      if (gw < NITEMS) tb_load64(tvn, nx.src, nx.ldw, LANE_NOW);
      for (int it = gw; it < NITEMS; it += NGW) {
          const XItem cu = nx; float tv[64];
#pragma unroll
          for (int i = 0; i < 64; ++i) tv[i] = tvn[i];
          if (it + NGW < NITEMS) { nx = item(it + NGW); tb_load64(tvn, nx.src, nx.ldw, LANE_NOW); }
          tb_finish64(tv, cu, scr64, LANE_NOW);
      } }
    bf16* H = (bf16*)(ws + WS_H);
    { const int lane_ = LANE_NOW; const GAS f32x4* gr = (const GAS f32x4*)g_mix + lane_; f32x4 gg[4];
#pragma unroll
      for (int j = 0; j < 4; ++j) gg[j] = gr[64 * j];
      for (int mb = gw; mb < M; mb += 8 * NGW) { f32x4 v[8][4];
#pragma unroll
          for (int i = 0; i < 8; ++i) { const int mm = (mb + i * NGW < M) ? mb + i * NGW : mb; const GAS f32x4* xr = (const GAS f32x4*)(x + (size_t)mm * D) + lane_;
#pragma unroll
              for (int j = 0; j < 4; ++j) v[i][j] = __builtin_nontemporal_load(xr + 64 * j); }
#pragma unroll
          for (int i = 0; i < 8; ++i) { const int mrow = mb + i * NGW; if (mrow >= M) break; float s = 0.f;
#pragma unroll
              for (int j = 0; j < 4; ++j) s += (v[i][j].x * v[i][j].x + v[i][j].y * v[i][j].y) + (v[i][j].z * v[i][j].z + v[i][j].w * v[i][j].w);
              const float rstd = 1.f / sqrtf(wave_sum(s) * (1.f / D) + EPS);
              GAS unsigned long long* o8 = (GAS unsigned long long*)(H + (size_t)mrow * D) + lane_;
#pragma unroll
              for (int j = 0; j < 4; ++j) { const f32x4 y = v[i][j] * rstd * gg[j]; o8[64 * j] = (unsigned long long)cvtpk2(y.x, y.y) | ((unsigned long long)cvtpk2(y.z, y.w) << 32); } } } }
    { const float* w_r = a.in[12]; float* WLG = (float*)(ws + WS_WLG);
      for (int idx = gw * 64 + LANE_NOW; idx < 1024 * 32; idx += NGW * 64) { const int k = idx >> 5, e = idx & 31;
          WLG[(size_t)((((k >> 6) * 4 + ((k >> 4) & 3)) * 4 + ((k >> 2) & 3)) * 32 + e) * 4 + (k & 3)] = w_r[idx] * g_ffn_p[k]; } }
    float* rope = (float*)(ws + WS_ROPE);
    for (int idx = gw * 64 + LANE_NOW; idx < 4096 * 32; idx += NGW * 64) { const int pos = idx >> 5, i = idx & 31;
        const float ang = (float)pos * INV_FREQ[i];
        const double rev = (double)ang * 0.15915494309189535; const double fr = rev - __builtin_rint(rev); const float rf = (float)fr;
        rope[idx] = __builtin_amdgcn_cosf(rf); rope[4096 * 32 + idx] = __builtin_amdgcn_sinf(rf); }
}

typedef float f32x16 __attribute__((ext_vector_type(16)));
typedef short s16x4 __attribute__((ext_vector_type(4)));
__device__ __forceinline__ int crow_(int r, int hi) { return (r & 3) + 8 * (r >> 2) + 4 * hi; }
__device__ __forceinline__ void sb_item(int b, int h, int qt, const bf16* P, const bf16* VT, bf16* O, int lane_) {
    int lane = lane_; asm volatile("" : "+v"(lane));
    const int r32 = lane & 31, hi = lane >> 5;
    const int q0 = qt * 32; const size_t tokq = (size_t)b * T + q0 + r32;
    const bf16* Qp = P + tokq * NPROJ + 1536 + h * 64 + hi * 8;
    bf16x8 qf[4];
#pragma unroll
    for (int d0 = 0; d0 < 4; ++d0) qf[d0] = *(const bf16x8*)(Qp + d0 * 16);
    f32x16 o0, o1;
#pragma unroll
    for (int r = 0; r < 16; ++r) { o0[r] = 0.f; o1[r] = 0.f; }
    float R = 0.f;
    const bf16* Kb = P + ((size_t)b * T + r32) * NPROJ + 2048 + h * 64 + hi * 8;
    const bf16* Vb = VT + (size_t)(h * 64 + r32) * M + (size_t)b * T + 4 * hi;
    bf16x8 kfN[4]; s16x4 vlN[2][2], vhN[2][2];
#define SB_LOAD(kt_) do { const int kv0_ = (kt_) * 32; \
        _Pragma("unroll") for (int d0 = 0; d0 < 4; ++d0) kfN[d0] = *(const bf16x8*)(Kb + (size_t)kv0_ * NPROJ + d0 * 16); \
        _Pragma("unroll") for (int s = 0; s < 2; ++s) _Pragma("unroll") for (int d0 = 0; d0 < 2; ++d0) { const bf16* vp = Vb + (size_t)(d0 * 32) * M + kv0_ + 16 * s; vlN[s][d0] = *(const s16x4*)vp; vhN[s][d0] = *(const s16x4*)(vp + 8); } } while (0)
    SB_LOAD(qt);
    for (int kt = qt; kt >= 0; --kt) {
        bf16x8 kf[4]; s16x4 vl[2][2], vh[2][2];
#pragma unroll
        for (int d0 = 0; d0 < 4; ++d0) kf[d0] = kfN[d0];
#pragma unroll
        for (int s = 0; s < 2; ++s)
#pragma unroll
            for (int d0 = 0; d0 < 2; ++d0) { vl[s][d0] = vlN[s][d0]; vh[s][d0] = vhN[s][d0]; }
        if (kt > 0) SB_LOAD(kt - 1);
        f32x16 sc;
#pragma unroll
        for (int r = 0; r < 16; ++r) sc[r] = 0.f;
#pragma unroll
        for (int d0 = 0; d0 < 4; ++d0) sc = __builtin_amdgcn_mfma_f32_32x32x16_bf16(kf[d0], qf[d0], sc, 0, 0, 0);
        const int lim = (kt == qt) ? r32 : 64;
        float c[16];
#pragma unroll
        for (int r = 0; r < 16; ++r) { const float z = sc[r]; const float sp = fmaxf(z, 0.f) + __logf(1.0f + __expf(-fabsf(z))); c[r] = (crow_(r, hi) < lim) ? sp : 0.f; }
        float g[4], gp[4], Tt[4], A[4];
#pragma unroll
        for (int m = 0; m < 4; ++m) { g[m] = (c[4 * m] + c[4 * m + 1]) + (c[4 * m + 2] + c[4 * m + 3]); gp[m] = __shfl_xor(g[m], 32); Tt[m] = g[m] + gp[m]; }
        const float suf3 = 0.f, suf2 = Tt[3], suf1 = suf2 + Tt[2], suf0 = suf1 + Tt[1];
        A[0] = suf0 + (hi ? 0.f : gp[0]); A[1] = suf1 + (hi ? 0.f : gp[1]); A[2] = suf2 + (hi ? 0.f : gp[2]); A[3] = suf3 + (hi ? 0.f : gp[3]);
        float av[16];
#pragma unroll
        for (int m = 0; m < 4; ++m) { float run = R + A[m];
#pragma unroll
            for (int e = 3; e >= 0; --e) { const int r = 4 * m + e; run += c[r]; av[r] = (crow_(r, hi) < lim) ? __expf(sc[r] - run) : 0.f; } }
        R += suf0 + Tt[0];
        const bool sb_done = __all(R > 96.0f);
        v4u pw0, pw1;
        pw0.x = cvtpk2(av[0], av[1]); pw0.y = cvtpk2(av[2], av[3]); pw0.z = cvtpk2(av[4], av[5]); pw0.w = cvtpk2(av[6], av[7]);
        pw1.x = cvtpk2(av[8], av[9]); pw1.y = cvtpk2(av[10], av[11]); pw1.z = cvtpk2(av[12], av[13]); pw1.w = cvtpk2(av[14], av[15]);
        const bf16x8 pf0 = __builtin_bit_cast(bf16x8, pw0), pf1 = __builtin_bit_cast(bf16x8, pw1);
#define VF(s, d0) (bf16x8){vl[s][d0][0], vl[s][d0][1], vl[s][d0][2], vl[s][d0][3], vh[s][d0][0], vh[s][d0][1], vh[s][d0][2], vh[s][d0][3]}
        o0 = __builtin_amdgcn_mfma_f32_32x32x16_bf16(VF(0, 0), pf0, o0, 0, 0, 0);
        o1 = __builtin_amdgcn_mfma_f32_32x32x16_bf16(VF(0, 1), pf0, o1, 0, 0, 0);
        o0 = __builtin_amdgcn_mfma_f32_32x32x16_bf16(VF(1, 0), pf1, o0, 0, 0, 0);
        o1 = __builtin_amdgcn_mfma_f32_32x32x16_bf16(VF(1, 1), pf1, o1, 0, 0, 0);
#undef VF
        if (sb_done) break;
    }
#undef SB_LOAD
    bf16* Op = O + tokq * 512 + h * 64 + 4 * hi;
#pragma unroll
    for (int gi = 0; gi < 4; ++gi) {
        *(unsigned long long*)(Op + 8 * gi) = (unsigned long long)cvtpk2(o0[4 * gi], o0[4 * gi + 1]) | ((unsigned long long)cvtpk2(o0[4 * gi + 2], o0[4 * gi + 3]) << 32);
        *(unsigned long long*)(Op + 32 + 8 * gi) = (unsigned long long)cvtpk2(o1[4 * gi], o1[4 * gi + 1]) | ((unsigned long long)cvtpk2(o1[4 * gi + 2], o1[4 * gi + 3]) << 32);
    }
}


constexpr int SBL_KST = 448 * 16, SBL_V = 8 * SBL_KST, SBL_FLAG = 2 * SBL_V;
__device__ __forceinline__ void sb_unit(int wave, int b, int h, int qblk, const bf16* P, bf16* O, char* shm) {
    int lane = LANE_NOW; asm volatile("" : "+v"(lane));
    const int r32 = lane & 31, hi = lane >> 5;
    const int q0 = qblk * 256; const size_t tokq = (size_t)b * T + q0 + wave * 32 + r32;
    const int nb = (qblk == 0) ? 0 : 6;
    const unsigned lds0 = (unsigned)(uintptr_t)shm;
    typedef __attribute__((address_space(3))) const char* lptr;
    const lptr shm3 = (lptr)shm;
    volatile LAS unsigned* flags = (volatile LAS unsigned*)((LAS unsigned char*)shm3 + SBL_FLAG);
    const bf16* Kh = P + (size_t)b * T * NPROJ + 2048 + h * 64 + wave * 8;
    const bf16* Vh = P + (size_t)b * T * NPROJ + 2560 + h * 64 + (wave >> 2) * 32 + (lane & 3) * 8;
#define SB_DMA(start_, n64_) do { \
        for (int j_ = 0; j_ < (n64_); ++j_) { int rk_ = (start_) + 64 * j_ + lane; rk_ = rk_ < 0 ? 0 : rk_; int rv_ = (start_) + 64 * j_ + 16 * (wave & 3) + (lane >> 2); rv_ = rv_ < 0 ? 0 : rv_; \
            attn_body::glds16(Kh + (size_t)rk_ * NPROJ, (unsigned)__builtin_amdgcn_readfirstlane(lds0 + wave * SBL_KST + j_ * 1024)); \
            attn_body::glds16(Vh + (size_t)rv_ * NPROJ, (unsigned)__builtin_amdgcn_readfirstlane(lds0 + SBL_V + j_ * 8192 + wave * 1024)); } } while (0)
    int start = q0 - 32 * nb;
    SB_DMA(start, 7);
    if (wave == 0 && lane == 0) { flags[0] = 0u; flags[1] = 0u; }
    const bf16* Qp = P + tokq * NPROJ + 1536 + h * 64 + hi * 8;
    bf16x8 qf[4];
#pragma unroll
    for (int d0 = 0; d0 < 4; ++d0) qf[d0] = *(const bf16x8*)(Qp + d0 * 16);
    f32x16 o0, o1;
#pragma unroll
    for (int r = 0; r < 16; ++r) { o0[r] = 0.f; o1[r] = 0.f; }
    float R = 1.0f; bool done = false;
    const lptr kb = shm3 + hi * SBL_KST + r32 * 16;
    const lptr vb = shm3 + SBL_V + (4 * hi + ((lane & 15) >> 2)) * 64 + ((lane >> 4) & 1) * 32 + (lane & 3) * 8;
    for (int c = 0; ; ++c) {
        asm volatile("s_waitcnt vmcnt(0) lgkmcnt(0)\n\ts_barrier" ::: "memory");
        for (int jt = (c == 0) ? nb + wave : 7; jt >= 0 && !done; --jt) {
            if (start + 32 * jt < 0) break;
            bf16x8 kf[4];
#pragma unroll
            for (int d0 = 0; d0 < 4; ++d0) kf[d0] = *(const __attribute__((address_space(3))) bf16x8*)(kb + d0 * (2 * SBL_KST) + jt * 512);
            s16x4 vl[2][2], vh[2][2];
#pragma unroll
            for (int s = 0; s < 2; ++s)
#pragma unroll
                for (int d0 = 0; d0 < 2; ++d0) { const lptr vp = vb + (jt >> 1) * 8192 + d0 * 4096 + ((jt & 1) * 32 + 16 * s) * 64;
                    vl[s][d0] = __builtin_bit_cast(s16x4, __builtin_amdgcn_ds_read_tr16_b64_v4i16((__attribute__((address_space(3))) attn_body::v4i16_t*)vp));
                    vh[s][d0] = __builtin_bit_cast(s16x4, __builtin_amdgcn_ds_read_tr16_b64_v4i16((__attribute__((address_space(3))) attn_body::v4i16_t*)(vp + 512))); }
            f32x16 sc;
#pragma unroll
            for (int r = 0; r < 16; ++r) sc[r] = 0.f;
#pragma unroll
            for (int d0 = 0; d0 < 4; ++d0) sc = __builtin_amdgcn_mfma_f32_32x32x16_bf16(kf[d0], qf[d0], sc, 0, 0, 0);
            const int lim = (c == 0 && jt == nb + wave) ? r32 : 64;
            float cc[16];
#pragma unroll
            for (int r = 0; r < 16; ++r) { const float sg = __builtin_amdgcn_rcpf(1.0f + __builtin_amdgcn_exp2f(sc[r])); cc[r] = (crow_(r, hi) < lim) ? sg : 1.0f; }
            float g[4], gp[4], Tt[4], A[4];
#pragma unroll
            for (int m = 0; m < 4; ++m) { g[m] = (cc[4 * m] * cc[4 * m + 1]) * (cc[4 * m + 2] * cc[4 * m + 3]); gp[m] = __shfl_xor(g[m], 32); Tt[m] = g[m] * gp[m]; }
            const float suf3 = 1.0f, suf2 = Tt[3], suf1 = suf2 * Tt[2], suf0 = suf1 * Tt[1];
            A[0] = suf0 * (hi ? 1.0f : gp[0]); A[1] = suf1 * (hi ? 1.0f : gp[1]); A[2] = suf2 * (hi ? 1.0f : gp[2]); A[3] = suf3 * (hi ? 1.0f : gp[3]);
            float av[16];
#pragma unroll
            for (int m = 0; m < 4; ++m) { float run = R * A[m];
#pragma unroll
                for (int e = 3; e >= 0; --e) { const int r = 4 * m + e; av[r] = (1.0f - cc[r]) * run; run *= cc[r]; } }
            R *= suf0 * Tt[0];
            done = __all(R < 0x1p-120f);
            v4u pw0, pw1;
            pw0.x = cvtpk2(av[0], av[1]); pw0.y = cvtpk2(av[2], av[3]); pw0.z = cvtpk2(av[4], av[5]); pw0.w = cvtpk2(av[6], av[7]);
            pw1.x = cvtpk2(av[8], av[9]); pw1.y = cvtpk2(av[10], av[11]); pw1.z = cvtpk2(av[12], av[13]); pw1.w = cvtpk2(av[14], av[15]);
            const bf16x8 pf0 = __builtin_bit_cast(bf16x8, pw0), pf1 = __builtin_bit_cast(bf16x8, pw1);
#define VF(s, d0) (bf16x8){vl[s][d0][0], vl[s][d0][1], vl[s][d0][2], vl[s][d0][3], vh[s][d0][0], vh[s][d0][1], vh[s][d0][2], vh[s][d0][3]}
            o0 = __builtin_amdgcn_mfma_f32_32x32x16_bf16(VF(0, 0), pf0, o0, 0, 0, 0);
            o1 = __builtin_amdgcn_mfma_f32_32x32x16_bf16(VF(0, 1), pf0, o1, 0, 0, 0);
            o0 = __builtin_amdgcn_mfma_f32_32x32x16_bf16(VF(1, 0), pf1, o0, 0, 0, 0);
            o1 = __builtin_amdgcn_mfma_f32_32x32x16_bf16(VF(1, 1), pf1, o1, 0, 0, 0);
#undef VF
        }
        if (start <= 0) done = true;
        const int fb = c & 1;
        if (!done && lane == 0) flags[fb] = 1u;
        asm volatile("s_waitcnt lgkmcnt(0)\n\ts_barrier" ::: "memory");
        const unsigned want = flags[fb];
        if (wave == 0 && lane == 0) flags[fb ^ 1] = 0u;
        if (__builtin_amdgcn_readfirstlane(want) == 0u) break;
        start -= 256; SB_DMA(start, 4);
    }
    asm volatile("s_waitcnt lgkmcnt(0)\n\ts_barrier" ::: "memory");
#undef SB_DMA
    bf16* Op = O + tokq * 512 + h * 64 + 4 * hi;
#pragma unroll
    for (int gi = 0; gi < 4; ++gi) {
        *(unsigned long long*)(Op + 8 * gi) = (unsigned long long)cvtpk2(o0[4 * gi], o0[4 * gi + 1]) | ((unsigned long long)cvtpk2(o0[4 * gi + 2], o0[4 * gi + 3]) << 32);
        *(unsigned long long*)(Op + 32 + 8 * gi) = (unsigned long long)cvtpk2(o1[4 * gi], o1[4 * gi + 1]) | ((unsigned long long)cvtpk2(o1[4 * gi + 2], o1[4 * gi + 3]) << 32);
    }
}

__device__ __forceinline__ void cnt_barrier(unsigned* word, unsigned target, unsigned* bar, int wave_) {
    asm volatile("s_waitcnt vmcnt(0)" ::: "memory");
    __syncthreads();
    if (wave_ == 0 && lane_id_now() == 0) {
        __builtin_amdgcn_s_waitcnt(0);
        (void)xb_add(word, 1u);
        XB_SPIN(xb_ld(word) < target, bar);
        __builtin_amdgcn_fence(__ATOMIC_ACQUIRE, "agent");
        asm volatile("s_waitcnt vmcnt(0)" ::: "memory");
    }
    __syncthreads();
}
#define CG_WORD() ((int)__builtin_amdgcn_readfirstlane((int)F.MISC[12]))

__global__ void __launch_bounds__(NWAVES * 64, 2) mk_fwd(Args args) {
    extern __shared__ __attribute__((aligned(16))) unsigned char lds[];
    Frame F;
    F.lds = (LAS unsigned char*)lds;
    F.MISC = (volatile LAS unsigned*)(F.lds + MISC_OFF);
    F.wave = __builtin_amdgcn_readfirstlane((int)threadIdx.x >> 6);
    F.G = gridDim.x; { const int bx = blockIdx.x; F.vcu = (F.G % 8 == 0) ? (bx % 8) * (F.G / 8) + bx / 8 : bx; }
    unsigned char* ws = args.ws;
    F.ctl = (gu32*)(ws + WS_CTL);
    for (int u = (F.wave * 64 + LANE_NOW); u < (LDS_BYTES - LDSCTL_OFF) / 4; u += NWAVES * 64) ((LAS unsigned*)(F.lds + LDSCTL_OFF))[u] = 0u;
    __syncthreads();
    const int lo = args.ph_lo, hi_ = args.ph_hi;
    const bool one_launch = (hi_ - lo) > 1;
    XcdBarrier bar; bar.bar = (unsigned*)(F.ctl + CW_BAR); bar.x = 0; bar.st = nullptr;
    if (one_launch) bar = xcd_barrier_post((unsigned*)(F.ctl + CW_BAR), F.MISC + 8);
#ifndef PH_MASK
#define PH_MASK 0xffff
#endif
#define IN(k) ((((PH_MASK) >> (k)) & 1) && lo <= (k) && (k) < hi_)
#ifndef MK_PREFETCH
#define MK_PREFETCH 0
#endif
#ifndef PROBE_DUP
#define PROBE_DUP -1
#endif
#define NREP(k) ((PROBE_DUP == (k)) ? 2 : 1)
#define LSEAM(k, word, target) do { if (IN(k) && IN((k) + 1)) { if (grouped) cnt_barrier((unsigned*)(F.ctl + (word)), (target), (unsigned*)(F.ctl + CW_BAR), F.wave); else xcd_barrier(bar, F.wave); } } while (0)
#define SEAM(k) do { if (IN(k) && IN((k) + 1)) { xcd_barrier(bar, F.wave); if (PROBE_DUP == 20) xcd_barrier(bar, F.wave); } } while (0)
    const int gw = F.vcu * NWAVES + F.wave, NGW = F.G * NWAVES;

    bf16* WIN = (bf16*)(ws + WS_WIN); bf16* WDA = (bf16*)(ws + WS_WDA); bf16* WSB = (bf16*)(ws + WS_WSB); bf16* WO = (bf16*)(ws + WS_WO);
    bf16* WGU = (bf16*)(ws + WS_WGU); bf16* WD = (bf16*)(ws + WS_WD);
    bf16* H = (bf16*)(ws + WS_H); bf16* P = (bf16*)(ws + WS_P); bf16* VBT = (bf16*)(ws + WS_VBT); bf16* ODA = (bf16*)(ws + WS_ODA);
    bf16* DA = (bf16*)(ws + WS_DA); bf16* SBO = (bf16*)(ws + WS_SB); bf16* MX = (bf16*)(ws + WS_H);
    bf16* ACT = (bf16*)(ws + WS_ACT); bf16* YS = (bf16*)(ws + WS_YS);
    float* rope = (float*)(ws + WS_ROPE);
    int* tok_e = (int*)(ws + WS_ROUTE); int* tok_pos = tok_e + M * 4;
    float* rstd_tok = (float*)(ws + WS_ROUTE + 768 * 1024);
    int* list_tok = (int*)(ws + WS_LIST); float* list_gate = (float*)(ws + WS_LIST + 2 * MiB);
    bf16* X1 = (bf16*)args.out; constexpr int X1P = 2 * D;

    if (IN(0)) for (int rep_ = 0; rep_ < NREP(0); ++rep_) { p0_prologue(F, args, ws); }
    SEAM(0);
    if (IN(1)) {
        { pg8::Gemm g{H, WIN, M, NPROJ, D}; pg8::DupOrder S; S.S.init(M, NPROJ, F.G, (int)blockIdx.x); S.n = 5; S.reps = NREP(21);
          pg8::EpiInProj E{P, rope, 0.125f * 1.4426950408889634f};
          pg8::gemm_phase<pg8::EpiInProj, pg8::DupOrder, true, true>(F.lds + RING_OFF, g, S, E, F.wave); }
#ifdef SB_WAVE_FORM
        for (int rep_ = 0; rep_ < NREP(11); ++rep_)
        { pg8::Gemm g{WIN + (size_t)2560 * 1024, H, 512, M, D}; pg8::StaticOrder S; S.init(512, M, F.G, (int)blockIdx.x);
          pg8::EpiPlain E{VBT, M};
          pg8::gemm_phase<pg8::EpiPlain, pg8::StaticOrder, true, true>(F.lds + RING_OFF, g, S, E, F.wave); }
    #endif
    }
    SEAM(1);
    if (IN(2)) {
#ifndef DA_SPLIT_V
        for (int rep_ = 0; rep_ < NREP(2); ++rep_)
        for (int i = 0; i < 2; ++i) {
            const int bh = F.vcu >> 3, s = F.vcu & 7; const int qb = (i == 0) ? s : 15 - s;
            const int b = bh >> 3, hq = bh & 7;
            if (bh < BATCH * 8)
                attn_body::attn_unit2<8, NPROJ, NPROJ, NPROJ, 1024>(F.wave, b, qb, (const attn_body::bf16*)(P + hq * 64), (const attn_body::bf16*)(P + 512 + hq * 64),
                    (const attn_body::bf16*)(P + 1024 + (hq >> 1) * 128), (attn_body::bf16*)(ODA + hq * 128), (char*)lds + RING_OFF);
        }
#else
        for (int rep_ = 0; rep_ < NREP(2); ++rep_)
        for (int i = 0; i < 4; ++i) {
            const int bh = F.vcu >> 2, s = F.vcu & 3; const int qb = (i == 0) ? s : (i == 1) ? 7 - s : (i == 2) ? 8 + s : 15 - s;
            const int b = bh >> 4, vh = bh & 15;
            if (bh < BATCH * 16)
                attn_body::attn_unit<8, NPROJ, NPROJ, NPROJ, 1024>(F.wave, b, qb, (const attn_body::bf16*)(P + (vh >> 1) * 64), (const attn_body::bf16*)(P + 512 + (vh >> 1) * 64),
                    (const attn_body::bf16*)(P + 1024 + (vh >> 2) * 128 + (vh & 1) * 64), (attn_body::bf16*)(ODA + vh * 64), (char*)lds + RING_OFF);
        }
#endif
#ifndef SB_WAVE_FORM
        for (int rep_ = 0; rep_ < NREP(12); ++rep_)
        for (int i = 0; i < 2; ++i) {
            const int bh = F.vcu >> 3, s = F.vcu & 7; const int qblk = (i == 0) ? s : 15 - s;
            if (bh < BATCH * 8) sb_unit(F.wave, bh >> 3, bh & 7, qblk, P, SBO, (char*)lds + RING_OFF);
        }
#else
        for (int rep_ = 0; rep_ < NREP(12); ++rep_)
        for (int w = gw; w < 2048; w += NGW) { const int bh = w >> 6, j = w & 63; sb_item(bh >> 3, bh & 7, j, P, VBT, SBO, LANE_NOW); sb_item(bh >> 3, bh & 7, 127 - j, P, VBT, SBO, LANE_NOW); }
#endif
    }
    SEAM(2);
    { const bool reg_ = one_launch && F.MISC[13] != 0u && F.G == 256 && PROBE_DUP < 0 && F.MISC[10] < 32u && F.MISC[11] < 8u;
      if (F.wave == 0 && LANE_NOW == 0) F.MISC[12] = reg_ ? (0x10000u | (8u * F.MISC[10] + F.MISC[11])) : (unsigned)blockIdx.x;
      __syncthreads(); }
    const bool grouped = (CG_WORD() >> 16) != 0; const int cg = CG_WORD() & 0xffff;
    int gpm, gpn; { pg8::StaticOrder S_; S_.init(M, D, F.G, cg); pg8::Unit u_; S_.next(0, u_); gpm = u_.pm; gpn = u_.pn; }
    if (IN(3)) for (int rep_ = 0; rep_ < NREP(3); ++rep_) {
        const float* lq1 = args.in[3]; const float* lk1 = args.in[4]; const float* lq2 = args.in[5]; const float* lk2 = args.in[6]; const float* sg = args.in[7];
        const float lam = __expf(wave_sum(lq1[LANE_NOW] * lk1[LANE_NOW])) - __expf(wave_sum(lq2[LANE_NOW] * lk2[LANE_NOW])) + LAMBDA_INIT;
        const int l = LANE_NOW, hh = l >> 4, c0 = 8 * (l & 15), half = c0 >> 6, cc = c0 & 63;
        const f32x4 ga = *(const f32x4*)(sg + c0), gb = *(const f32x4*)(sg + c0 + 4);
        const int m_lo = grouped ? gpm * 256 + gpn * 64 + F.wave : gw, m_hi = grouped ? gpm * 256 + gpn * 64 + 64 : M, m_st = grouped ? NWAVES : NGW;
        for (int mb = m_lo; mb < m_hi; mb += 8 * m_st) {
          v4u w0s[8], w1s[8];
#pragma unroll
          for (int i = 0; i < 8; ++i) { const int mm = (mb + i * m_st < m_hi) ? mb + i * m_st : mb;
              w0s[i] = __builtin_nontemporal_load((const v4u*)(ODA + (size_t)mm * 1024 + (4 * hh + half) * 64 + cc)); w1s[i] = __builtin_nontemporal_load((const v4u*)(ODA + (size_t)mm * 1024 + (4 * hh + 2 + half) * 64 + cc)); }
#pragma unroll
          for (int i = 0; i < 8; ++i) { const int m = mb + i * m_st; if (m >= m_hi) break;
            const v4u w0 = w0s[i], w1 = w1s[i];
            f32x4 a0, a1, b0, b1; pg8::unpack8(w0, a0, a1); pg8::unpack8(w1, b0, b1);
            const f32x4 d0 = a0 - b0 * lam, d1 = a1 - b1 * lam;
            float ss = (d0[0] * d0[0] + d0[1] * d0[1]) + (d0[2] * d0[2] + d0[3] * d0[3]) + (d1[0] * d1[0] + d1[1] * d1[1]) + (d1[2] * d1[2] + d1[3] * d1[3]);
            ss += __shfl_xor(ss, 1); ss += __shfl_xor(ss, 2); ss += __shfl_xor(ss, 4); ss += __shfl_xor(ss, 8);
            const float rs = (1.0f - LAMBDA_INIT) / sqrtf(ss * (1.0f / 128.0f) + EPS);
            *(v4u*)(DA + (size_t)m * 512 + hh * 128 + c0) = pg8::pack8(d0 * rs * ga, d1 * rs * gb);
          }
        }
    }
    LSEAM(3, CW_GRP + 64 * gpm, 4u);
    if (IN(4)) {
        { pg8::StaticOrder S0; S0.init(M, D, F.G, cg); pg8::Unit u0;
          if (MK_PREFETCH && S0.next(0, u0)) { const char* gbase = (const char*)(P + (size_t)u0.pm * 256 * NPROJ + 3072 + u0.pn * 256); const int tid_ = F.wave * 64 + LANE_NOW;
#pragma unroll
            for (int i = 0; i < 4; ++i) { const int line = tid_ + 512 * (i & 1), row = line >> 2, seg = line & 3;
                attn_body::glds16(gbase + (size_t)row * (NPROJ * 2) + (i >> 1) * 2048 + seg * 128, (unsigned)__builtin_amdgcn_readfirstlane((unsigned)(uintptr_t)lds + JUNK_OFF + F.wave * 1024)); } } }
        { pg8::Gemm g{DA, WDA, M, D, 512, nullptr, nullptr}; pg8::DupOrder S; S.S.init(M, D, F.G, cg); S.n = 1; S.reps = NREP(24); pg8::EpiMix<0> E{P, MX};
          pg8::gemm_phase<pg8::EpiMix<0>, pg8::DupOrder, true, true>(F.lds + RING_OFF, g, S, E, F.wave); }
        { pg8::Gemm g{SBO, WSB, M, D, 512, nullptr, nullptr}; pg8::DupOrder S; S.S.init(M, D, F.G, cg); S.n = 1; S.reps = NREP(24); pg8::EpiMix<1> E{P, MX};
          pg8::gemm_phase<pg8::EpiMix<1>, pg8::DupOrder, true, true>(F.lds + RING_OFF, g, S, E, F.wave); }
    }
    LSEAM(4, CW_GRP + 64 * gpm, 8u);
    if (IN(5)) for (int rep_ = 0; rep_ < NREP(5); ++rep_) {
        pg8::Gemm g{MX, WO, M, D, D}; pg8::StaticOrder S; S.init(M, D, F.G, cg); pg8::EpiResidBf E{args.in[0], X1, D, X1P, (unsigned char*)args.out + 2048, 4096, F8_XSCALE};
        { pg8::Unit u0;
          if (MK_PREFETCH && S.next(0, u0)) { const char* xbase = (const char*)(args.in[0] + (size_t)u0.pm * 256 * D + u0.pn * 256); const int tid_ = F.wave * 64 + LANE_NOW;
#pragma unroll
            for (int i = 0; i < 4; ++i) { const int line = tid_ + 512 * i, row = line >> 3, seg = line & 7;
                attn_body::glds16(xbase + (size_t)row * (D * 4) + seg * 128, (unsigned)__builtin_amdgcn_readfirstlane((unsigned)(uintptr_t)lds + JUNK_OFF + F.wave * 1024)); } } }
        pg8::gemm_phase<pg8::EpiResidBf, pg8::StaticOrder, true, true>(F.lds + RING_OFF, g, S, E, F.wave);
    }
    LSEAM(5, CW_GRP + 64 * gpm, 12u);
    if (IN(6)) for (int rep_ = 0; rep_ < NREP(6); ++rep_) {
        const int cnt_bank = (rep_ + 1 < NREP(6)) ? 4096 * 16 : 0;
        const float* g_ffn = args.in[11]; const float* w_r = args.in[12]; const float* b_r = args.in[13];
        LAS float* WL = (LAS float*)(F.lds);
        LAS float* LG = (LAS float*)(F.lds + RING_BYTES);
        LAS float* RS = (LAS float*)(F.lds + RING_BYTES + 8192);
        LAS unsigned* LC = (LAS unsigned*)(F.lds + LDSCTL_OFF + 8192);
        LAS int* PEND = (LAS int*)(F.lds + LDSCTL_OFF + 8192 + 512) + F.wave * 128;
        const int tid_ = F.wave * 64 + LANE_NOW, lane = LANE_NOW;
        if (tid_ < 64) LC[tid_] = 0u;
        for (int reps_ = 0; reps_ < NREP(60); ++reps_)
        { const char* wlg = (const char*)(ws + WS_WLG) + F.wave * 1024 + lane * 16; const unsigned wl0 = (unsigned)(uintptr_t)F.lds + (unsigned)F.wave * 1024u;
#pragma unroll
          for (int j = 0; j < 16; ++j) attn_body::glds16(wlg + j * 8192, (unsigned)__builtin_amdgcn_readfirstlane(wl0 + j * 8192u));
          asm volatile("s_waitcnt vmcnt(0)" ::: "memory"); }
        __syncthreads();
        const int tok0 = grouped ? (gpm * 4 + gpn) * 64 : F.vcu * 64;
        for (int repa_ = 0; repa_ < NREP(61); ++repa_)
        {
            const int tg = F.wave >> 1, eh = F.wave & 1, tl = lane & 15, kq = lane >> 4;
            const bf16* xrow = X1 + (size_t)(tok0 + 16 * tg + tl) * X1P + 16 * kq;
            const LAS float* wl = WL + (size_t)(kq * 4 * 32 + 16 * eh + tl) * 4;
            f32x4 acc = {0.f, 0.f, 0.f, 0.f}; float ss = 0.f;
            v4u awa[16][2];
#pragma unroll
            for (int jj = 0; jj < 16; ++jj) { awa[jj][0] = *(const v4u*)(xrow + 64 * jj); awa[jj][1] = *(const v4u*)(xrow + 64 * jj + 8); }
#pragma unroll
            for (int jj = 0; jj < 16; ++jj) { const v4u aw0 = awa[jj][0], aw1 = awa[jj][1];
                float a[16];
                a[0] = pg8::bf_lo(aw0.x); a[1] = pg8::bf_hi(aw0.x); a[2] = pg8::bf_lo(aw0.y); a[3] = pg8::bf_hi(aw0.y); a[4] = pg8::bf_lo(aw0.z); a[5] = pg8::bf_hi(aw0.z); a[6] = pg8::bf_lo(aw0.w); a[7] = pg8::bf_hi(aw0.w);
                a[8] = pg8::bf_lo(aw1.x); a[9] = pg8::bf_hi(aw1.x); a[10] = pg8::bf_lo(aw1.y); a[11] = pg8::bf_hi(aw1.y); a[12] = pg8::bf_lo(aw1.z); a[13] = pg8::bf_hi(aw1.z); a[14] = pg8::bf_lo(aw1.w); a[15] = pg8::bf_hi(aw1.w);
#pragma unroll
                for (int iq = 0; iq < 4; ++iq) { const f32x4 b4 = *(const LAS f32x4*)(wl + (size_t)jj * 2048 + iq * 128);
#pragma unroll
                    for (int i = 0; i < 4; ++i) { ss += a[4 * iq + i] * a[4 * iq + i]; acc = __builtin_amdgcn_mfma_f32_16x16x4f32(a[4 * iq + i], b4[i], acc, 0, 0, 0); } } }
            ss += __shfl_xor(ss, 16); ss += __shfl_xor(ss, 32);
            const float rstd = 1.f / sqrtf(ss * (1.f / D) + EPS);
            if (eh == 0 && kq == 0) rstd_tok[tok0 + 16 * tg + tl] = rstd;
            const float bias = b_r[16 * eh + tl];
#pragma unroll
            for (int r = 0; r < 4; ++r) { const float rs = __shfl(rstd, 4 * kq + r); LG[(16 * tg + 4 * kq + r) * 32 + 16 * eh + tl] = acc[r] * rs + bias; }
        }
        __syncthreads();
        for (int it = 0; it < 8; ++it) { const int tl = F.wave * 8 + it, mtok = tok0 + tl;
            const float cur = LG[tl * 32 + (lane >> 1)];
            int sel[4]; float sv[4];
            for (int rept_ = 0; rept_ < NREP(64); ++rept_)
            { const int eme = lane >> 1; int rank = 0;
#pragma unroll
              for (int j = 0; j < 32; ++j) { const float vj = __int_as_float(__builtin_amdgcn_readlane(__float_as_int(cur), 2 * j)); rank += (vj > cur || (vj == cur && j < eme)) ? 1 : 0; }
#pragma unroll
              for (int k = 0; k < 4; ++k) { const unsigned long long bal = __ballot(rank == k); const int ln = __ffsll((long long)bal) - 1; sel[k] = ln >> 1; sv[k] = __int_as_float(__builtin_amdgcn_readlane(__float_as_int(cur), ln)); } }
            const float p1 = __expf(sv[1] - sv[0]), p2 = __expf(sv[2] - sv[0]), p3 = __expf(sv[3] - sv[0]); const float inv = 1.0f / (1.0f + p1 + p2 + p3);
            if (lane < 4) { const int k = lane; const int e = (k == 0) ? sel[0] : (k == 1) ? sel[1] : (k == 2) ? sel[2] : sel[3];
                const float gt = ((k == 0) ? 1.0f : (k == 1) ? p1 : (k == 2) ? p2 : p3) * inv;
                const unsigned pl = __hip_atomic_fetch_add(LC + e, 1u, __ATOMIC_RELAXED, __HIP_MEMORY_SCOPE_WORKGROUP);
                LAS int* pe = PEND + it * 12 + k * 3; pe[0] = e; pe[1] = (int)pl; pe[2] = __float_as_int(gt); }
        }
        for (int repc_ = 0; repc_ < NREP(63); ++repc_) { const int bank_ = (repc_ + 1 < NREP(63)) ? 4096 * 24 : cnt_bank;
        __syncthreads();
        if (tid_ < NE) LC[32 + tid_] = __hip_atomic_fetch_add((unsigned*)(F.ctl + CW_CNT + bank_ + 64 * tid_), LC[tid_], __ATOMIC_RELAXED, __HIP_MEMORY_SCOPE_AGENT);
        __syncthreads();
        for (int it = 0; it < 8; ++it) if (lane < 4) { const int k = lane, mtok = tok0 + F.wave * 8 + it; const LAS int* pe = PEND + it * 12 + k * 3; const int e = pe[0]; const unsigned pos = LC[32 + e] + (unsigned)pe[1];
            tok_e[mtok * 4 + k] = e; tok_pos[mtok * 4 + k] = (int)pos; if (cnt_bank == 0) { list_tok[e * 16384 + pos] = mtok; list_gate[e * 16384 + pos] = __int_as_float(pe[2]); } }
        }
        __syncthreads();
    }
    SEAM(6);
    LAS int* TAB = (LAS int*)(F.lds + TAB_OFF);
    if (IN(8) || IN(9) || IN(10)) {
        const int tid_ = F.wave * 64 + LANE_NOW;
        if (tid_ < NE) TAB[328 + tid_] = (int)__hip_atomic_load((unsigned*)(F.ctl + CW_CNT + 64 * tid_), __ATOMIC_RELAXED, __HIP_MEMORY_SCOPE_AGENT);
        __syncthreads();
        if (F.wave == 0) { const int l_ = LANE_NOW, e_ = l_ & 31;
            const int nt_ = (TAB[328 + e_] + 255) >> 8; int inc_ = nt_;
#pragma unroll
            for (int o_ = 1; o_ < 32; o_ <<= 1) { const int up_ = __shfl_up(inc_, o_, 32); inc_ += (e_ >= o_) ? up_ : 0; }
            const int t0_ = inc_ - nt_;
            if (l_ < 32) { TAB[e_] = t0_; for (int t = 0; t < nt_; ++t) TAB[40 + t0_ + t] = e_; if (e_ == 31) TAB[32] = inc_; } }
        __syncthreads();
        { const int nTl = TAB[32]; const bool live = tid_ < nTl; int isfull = 0;
          if (live) { const int e = TAB[40 + tid_]; isfull = (TAB[328 + e] - (tid_ - TAB[e]) * 256 > 128) ? 1 : 0; }
          const unsigned long long bal = __ballot(live && isfull);
          if (LANE_NOW == 0) TAB[752 + F.wave] = __popcll(bal);
          __syncthreads();
          int before = 0, nF = 0;
#pragma unroll
          for (int w = 0; w < NWAVES; ++w) { const int cw = TAB[752 + w]; nF += cw; if (w < F.wave) before += cw; }
          const int fi = before + __popcll(bal & ((1ull << LANE_NOW) - 1ull)), si = tid_ - fi, nS = nTl - nF;
          if (live) { const int idx = isfull ? fi : si, n = isfull ? nF : nS; int x = 0;
#pragma unroll
              for (int q = 1; q < 8; ++q) if (idx >= q * n / 8) x = q;
              const int f0 = x * nF / 8, f1 = (x + 1) * nF / 8, s0 = x * nS / 8;
              TAB[360 + x * 48 + (isfull ? (fi - f0) : (f1 - f0) + (si - s0))] = tid_; }
          if (tid_ < 8) { const int x = tid_; TAB[744 + x] = ((x + 1) * nF / 8 - x * nF / 8) + ((x + 1) * nS / 8 - x * nS / 8); } }
        __syncthreads();
    }
    if (IN(8)) for (int rep_ = 0; rep_ < NREP(8); ++rep_) {
        const int nT = __builtin_amdgcn_readfirstlane(TAB[32]);
        pg8::MoeOrderG S; S.npn = 8; S.G = F.G; S.c = CG_WORD() & 0xffff; S.rdy = (unsigned*)(F.ctl + CW_RDY); S.tmo = (unsigned*)(F.ctl + CW_BAR) + XB_TMO; S.mode = (NREP(8) == 1) ? 1 : 0; S.nb64 = 2048 * 64; S.ebytes = 2048 * 1024; S.tab = (const LAS int*)TAB; S.tokl = (const LAS int*)(F.lds + TOK_OFF);
        { LAS int* TOK = (LAS int*)(F.lds + TOK_OFF); const int tid_ = F.wave * 64 + LANE_NOW; pg8::Unit u;
          int tk[12];
          int e_l, lt_l, cnt_l; const int ok_l = S.next_v(LANE_NOW < 12 ? LANE_NOW : 0, e_l, lt_l, cnt_l) ? 1 : 0;
#pragma unroll
          for (int i = 0; i < 12; ++i) { const bool ok = __builtin_amdgcn_readlane(ok_l, i) != 0; const int ue = __builtin_amdgcn_readlane(e_l, i), ult = __builtin_amdgcn_readlane(lt_l, i), ucnt = __builtin_amdgcn_readlane(cnt_l, i);
              const int p = ult * 256 + (tid_ & 255); const bool live = ok && p < ucnt; const int v = list_tok[live ? ue * 16384 + p : 0]; tk[i] = live ? v : 0; }
#pragma unroll
          for (int i = 0; i < 12; ++i) if (tid_ < 256) TOK[i * 256 + tid_] = tk[i];
          __syncthreads(); }
        pg8::Gemm g{(const bf16*)((const unsigned char*)args.out + 2048), WGU, M, 2048, D / 2, nullptr, nullptr}; S.pitch = X1P; S.fsc = 0x01010101 * (127 - 7);
        pg8::EpiMoe1 E{(unsigned char*)ACT, F8_ASCALE, args.in[15], args.in[17], rstd_tok, (const LAS int*)(F.lds + TOK_OFF), (LAS float*)(F.lds + EPISTG_OFF)};
        pg8::gemm_phase<pg8::EpiMoe1, pg8::MoeOrderG, true, true>(F.lds + RING_OFF, g, S, E, F.wave);
    }
    if (!grouped || PROBE_DUP >= 0) SEAM(8);
    if (IN(9)) for (int rep_ = 0; rep_ < NREP(9); ++rep_) {
        const int nT = __builtin_amdgcn_readfirstlane(TAB[32]);
        pg8::Gemm g{ACT, WD, MAXT * 256, 1024, FF / 2, nullptr, nullptr}; pg8::MoeOrder S{4, F.G, CG_WORD() & 0xffff, (const LAS int*)TAB}; S.rdy = (unsigned*)(F.ctl + CW_RDY); S.tmo = (unsigned*)(F.ctl + CW_BAR) + XB_TMO; S.mode = (NREP(8) == 1) ? 2 : 0; S.nb64 = 1024 * 64; S.ebytes = 1024 * 1024; S.pkl = (LAS unsigned*)(F.lds + LDSCTL_OFF + 8192); S.fsc = 0x01010101 * (127 - 6);
        pg8::EpiMoe2 E{(unsigned char*)YS, F8_YSCALE, args.in[19], list_gate, (LAS float*)(F.lds + EPISTG_OFF)};
        pg8::gemm_phase<pg8::EpiMoe2, pg8::MoeOrder, true, true>(F.lds + RING_OFF, g, S, E, F.wave);
    }
    SEAM(9);
    if (IN(10)) for (int rep_ = 0; rep_ < NREP(10); ++rep_) {
        float* const OUTP = (rep_ + 1 < NREP(10)) ? (float*)ACT : args.out;
        const float* g_fin = args.in[20];
        unsigned poison = (__hip_atomic_load(F.ctl + CW_TMO, RLX_AGENT) != 0u) || (__hip_atomic_load((gu32*)((unsigned*)(F.ctl + CW_BAR) + XB_TMO), RLX_AGENT) != 0u);
        typedef int i32x4 __attribute__((ext_vector_type(4)));
        i32x4 ne = {0, 0, 0, 0}, np = {0, 0, 0, 0};
        if (gw < M) { ne = *(const i32x4*)(tok_e + gw * 4); np = *(const i32x4*)(tok_pos + gw * 4); }
        for (int m = gw; m < M; m += NGW) {
            const i32x4 ce = ne, cp = np;
            if (m + NGW < M) { ne = *(const i32x4*)(tok_e + (m + NGW) * 4); np = *(const i32x4*)(tok_pos + (m + NGW) * 4); }
            f32x4 v[4];
#pragma unroll
            for (int j = 0; j < 4; ++j) { const unsigned long long xw = __builtin_nontemporal_load((const unsigned long long*)(X1 + (size_t)m * X1P + 4 * LANE_NOW + 256 * j)); const unsigned xl = (unsigned)xw, xh = (unsigned)(xw >> 32); v[j] = (f32x4){pg8::bf_lo(xl), pg8::bf_hi(xl), pg8::bf_lo(xh), pg8::bf_hi(xh)}; }
            f32x4 ys[4] = {{0.f, 0.f, 0.f, 0.f}, {0.f, 0.f, 0.f, 0.f}, {0.f, 0.f, 0.f, 0.f}, {0.f, 0.f, 0.f, 0.f}};
#pragma unroll
            for (int k = 0; k < 4; ++k) { const int e = ce[k], pos = cp[k]; const size_t slot = (size_t)TAB[e] * 256 + pos;
#pragma unroll
                for (int j = 0; j < 4; ++j) { const int w = __builtin_nontemporal_load((const int*)((const unsigned char*)YS + slot * D + 4 * LANE_NOW + 256 * j));
                    const pg8::f32x2 lo = __builtin_amdgcn_cvt_pk_f32_fp8(w, false), hi = __builtin_amdgcn_cvt_pk_f32_fp8(w, true);
                    ys[j] = ys[j] + (f32x4){lo[0], lo[1], hi[0], hi[1]}; } }
#pragma unroll
            for (int j = 0; j < 4; ++j) v[j] = v[j] + ys[j] * (1.0f / F8_YSCALE);
            float s = 0.f;
#pragma unroll
            for (int j = 0; j < 4; ++j) s += (v[j].x * v[j].x + v[j].y * v[j].y) + (v[j].z * v[j].z + v[j].w * v[j].w);
            const float rstd = 1.f / sqrtf(wave_sum(s) * (1.f / D) + EPS);
#pragma unroll
            for (int j = 0; j < 4; ++j) { const f32x4 gg = *(const f32x4*)(g_fin + 4 * LANE_NOW + 256 * j); f32x4 o = v[j] * rstd * gg;
                if (poison) { const float q = __builtin_nanf(""); o = (f32x4){q, q, q, q}; }
                __builtin_nontemporal_store(o, (f32x4*)(OUTP + (size_t)m * D + 4 * LANE_NOW + 256 * j)); }
        }
    }
#undef IN
#undef SEAM
}

#ifndef MK_ONE_LAUNCH
#define MK_ONE_LAUNCH 1
#endif
constexpr int N_PHASES = 11;
extern "C" void kernel_launch(void* const* d_in, const int* in_sizes, int n_in, void* d_out, int out_size, void* d_ws, size_t ws_size, hipStream_t stream) {
    static int grid = 0;
    if (grid == 0) {
        if (n_in != 21 || in_sizes[0] != M * D || out_size != M * D || ws_size < WS_END) { fprintf(stderr, "kernel_launch: unexpected shapes: n_in %d in0 %d out %d ws %zu (need %zu); nothing launched\n", n_in, n_in > 0 ? in_sizes[0] : -1, out_size, ws_size, (size_t)WS_END); grid = -1; return; }
        int dev = 0, cus = 0, per_cu = 0;
        if (hipGetDevice(&dev) != hipSuccess || hipDeviceGetAttribute(&cus, hipDeviceAttributeMultiprocessorCount, dev) != hipSuccess) { grid = -1; return; }
        if (hipFuncSetAttribute((const void*)mk_fwd, hipFuncAttributeMaxDynamicSharedMemorySize, LDS_BYTES) != hipSuccess) { fprintf(stderr, "kernel_launch: hipFuncSetAttribute failed\n"); grid = -1; return; }
        if (hipOccupancyMaxActiveBlocksPerMultiprocessor(&per_cu, (const void*)mk_fwd, NWAVES * 64, LDS_BYTES) != hipSuccess || per_cu < 1) { fprintf(stderr, "kernel_launch: occupancy query says %d blocks per CU\n", per_cu); (void)hipGetLastError(); grid = -1; return; }
        grid = cus;
        if (grid != 256) fprintf(stderr, "kernel_launch: note: %d CUs\n", grid);
    }
    if (grid < 0) return;
    if (hipMemsetAsync((char*)d_ws + WS_CTL, 0, CTL_ZERO_BYTES, stream) != hipSuccess) return;
    Args a{};
    for (int i = 0; i < 21; ++i) a.in[i] = (const float*)d_in[i];
    a.out = (float*)d_out; a.ws = (unsigned char*)d_ws;
#if MK_ONE_LAUNCH
    a.ph_lo = 0; a.ph_hi = N_PHASES;
    hipLaunchKernelGGL(mk_fwd, dim3(grid), dim3(NWAVES * 64), LDS_BYTES, stream, a);
#else
    for (int p = 0; p < N_PHASES; ++p) { a.ph_lo = p; a.ph_hi = p + 1; hipLaunchKernelGGL(mk_fwd, dim3(grid), dim3(NWAVES * 64), LDS_BYTES, stream, a); }
#endif
}
```

```cpp
#include <hip/hip_runtime.h>
#include <cstdio>
#include <cstdint>
__device__ __forceinline__ int lane_id_now() { int l; asm volatile("v_mbcnt_lo_u32_b32 %0, -1, 0\n\tv_mbcnt_hi_u32_b32 %0, -1, %0" : "=v"(l)); return l; }
namespace pg8 {
#define PG8_LAS __attribute__((address_space(3)))
typedef unsigned short bf16_t;
typedef short bf16x8 __attribute__((ext_vector_type(8)));
typedef float f32x4 __attribute__((ext_vector_type(4)));
typedef unsigned u32x4 __attribute__((ext_vector_type(4)));
constexpr int BM = 256, BK = 64, HALF = 128, HTB = HALF * BK * 2  , STAGE_BYTES = 8 * HTB, NXCD = 8, WGM = 8;

__host__ __device__ __forceinline__ int lds_byte(int r, int c) { const int st = (r >> 4) * 2 + (c >> 5), rr = r & 15, cc = c & 31, ob = rr * 64 + cc * 2; return st * 1024 + (ob ^ (((ob >> 9) & 1) << 5)); }
__host__ __device__ __forceinline__ void stage_rc(int b, int& R, int& C) { const int st = b / 1024, sb = b % 1024, swz = sb ^ (((sb >> 9) & 1) << 5); R = (st >> 1) * 16 + swz / 64; C = (st & 1) * 32 + (swz % 64) / 2; }
__host__ __device__ __forceinline__ int perm32(int rho) { const int n = rho >> 4, i = rho & 15; return 8 * (i >> 2) + 4 * n + (i & 3); }

struct Unit { int pm, pn, pb, e, lt, cnt, full, ui; };
struct Gemm { const bf16_t* A; const bf16_t* Bt; int M, N, K; const bf16_t* A2; const bf16_t* Bt2; };

struct StaticOrder {
    int nM, nN, nwg, G, c;
    __host__ __device__ __forceinline__ void init(int M, int N, int G_, int c_) { nM = M / BM; nN = N / BM; nwg = nM * nN; G = G_; c = c_; }
    __host__ __device__ __forceinline__ bool next(int i, Unit& u) const {
        const long L = (long)i * G + c; if (L >= nwg) return false;
        int wgid = (int)L; { const int q = nwg / NXCD, r = nwg % NXCD, xcd = wgid % NXCD, off = wgid / NXCD; wgid = (xcd < r ? xcd * (q + 1) : r * (q + 1) + (xcd - r) * q) + off; }
        const int nig = WGM * nN, gid = wgid / nig, fm = gid * WGM, gsz = (nM - fm) < WGM ? (nM - fm) : WGM;
        u.pm = fm + ((wgid % nig) % gsz); u.pn = (wgid % nig) / gsz; u.pb = u.pn; u.e = 0; u.lt = 0; u.cnt = 0; u.full = 1; u.ui = i; return true;
    }
    static constexpr bool DUAL = false, GATHER = false, HALFSKIP = false, FP8 = false, BCH = false; static constexpr int fsc = 0, nb64 = 0, ebytes = 0;
    __device__ __forceinline__ void a_ready(const Unit&) const {}
    __device__ __forceinline__ void done(const Unit&) const {}
};

__device__ __forceinline__ unsigned cvt_pk_bf16(float lo, float hi) { unsigned r; asm volatile("v_cvt_pk_bf16_f32 %0, %1, %2" : "=v"(r) : "v"(lo), "v"(hi)); return r; }
__device__ __forceinline__ u32x4 pack8(const f32x4 a, const f32x4 b) { u32x4 w; w.x = cvt_pk_bf16(a[0], a[1]); w.y = cvt_pk_bf16(a[2], a[3]); w.z = cvt_pk_bf16(b[0], b[1]); w.w = cvt_pk_bf16(b[2], b[3]); return w; }
__device__ __forceinline__ float bf_lo(unsigned w) { return __uint_as_float(w << 16); }
__device__ __forceinline__ float bf_hi(unsigned w) { return __uint_as_float(w & 0xffff0000u); }
__device__ __forceinline__ void unpack8(const u32x4 w, f32x4& a, f32x4& b) { a = (f32x4){bf_lo(w.x), bf_hi(w.x), bf_lo(w.y), bf_hi(w.y)}; b = (f32x4){bf_lo(w.z), bf_hi(w.z), bf_lo(w.w), bf_hi(w.w)}; }
__device__ __forceinline__ float sigmoidf_(float x) { return __builtin_amdgcn_rcpf(1.0f + __expf(-x)); }
__device__ __forceinline__ f32x4 sig4(const f32x4 v) { return (f32x4){sigmoidf_(v[0]), sigmoidf_(v[1]), sigmoidf_(v[2]), sigmoidf_(v[3])}; }

struct EpiPlain {
    static constexpr bool PERM = true, AFTER_DRAIN = false, PREFETCH = false; struct Pref {};
    bf16_t* O; int ldc;
    __device__ __forceinline__ void operator()(const f32x4 (&acc)[2][2][4][2], const Unit& u, int wr, int wc, int fr, int fq) const {
        const int row0 = u.pm * BM + wr * 64 + fr, col0 = u.pn * BM + wc * 32 + 8 * fq;
#pragma unroll
        for (int ai = 0; ai < 2; ++ai)
#pragma unroll
            for (int m = 0; m < 4; ++m) { bf16_t* rowp = O + (size_t)(row0 + ai * HALF + m * 16) * ldc + col0;
#pragma unroll
                for (int bj = 0; bj < 2; ++bj) *(u32x4*)(rowp + bj * HALF) = pack8(acc[ai][bj][m][0], acc[ai][bj][m][1]); }
    }
};

struct EpiInProj {
    static constexpr bool PERM = true, AFTER_DRAIN = false, PREFETCH = false; struct Pref {};
    bf16_t* P; const float* rope; float qscale;
    __device__ __forceinline__ void operator()(const f32x4 (&acc)[2][2][4][2], const Unit& u, int wr, int wc, int fr, int fq) const {
        const int row0 = u.pm * BM + wr * 64 + fr;
        if (u.pn < 4) {
            const float qs = (u.pn < 2) ? qscale : 1.0f;
            const int colbase = u.pn * BM + wc * 64 + 8 * fq;
#pragma unroll
            for (int ai = 0; ai < 2; ++ai)
#pragma unroll
                for (int m = 0; m < 4; ++m) { const int row = row0 + ai * HALF + m * 16, pos = row & 4095;
                    const float* cp = rope + pos * 32 + 8 * fq; const float* sp = cp + 4096 * 32;
                    const f32x4 c0 = *(const f32x4*)cp, c1 = *(const f32x4*)(cp + 4), s0 = *(const f32x4*)sp, s1 = *(const f32x4*)(sp + 4);
                    const f32x4 a0 = acc[ai][0][m][0], a1 = acc[ai][0][m][1], b0 = acc[ai][1][m][0], b1 = acc[ai][1][m][1];
                    const f32x4 y10 = (a0 * c0 - b0 * s0) * qs, y11 = (a1 * c1 - b1 * s1) * qs, y20 = (b0 * c0 + a0 * s0) * qs, y21 = (b1 * c1 + a1 * s1) * qs;
                    bf16_t* rowp = P + (size_t)row * 5120 + colbase;
                    *(u32x4*)(rowp) = pack8(y10, y11); *(u32x4*)(rowp + 32) = pack8(y20, y21); }
        } else {
            const int col0 = u.pn * BM + wc * 32 + 8 * fq; const bool gate = u.pn >= 12; const float sc = (u.pn == 6 || u.pn == 7) ? 0.125f * 1.4426950408889634f : 1.0f;
            if (gate) {
#pragma unroll
                for (int ai = 0; ai < 2; ++ai)
#pragma unroll
                    for (int m = 0; m < 4; ++m) { unsigned char* rowb = (unsigned char*)P + (size_t)(row0 + ai * HALF + m * 16) * 10240 + 6144 + (col0 - 3072);
#pragma unroll
                        for (int bj = 0; bj < 2; ++bj) { const f32x4 v0 = sig4(acc[ai][bj][m][0]) * 255.0f + 0.5f, v1 = sig4(acc[ai][bj][m][1]) * 255.0f + 0.5f;
                            const unsigned lo = (unsigned)v0[0] | ((unsigned)v0[1] << 8) | ((unsigned)v0[2] << 16) | ((unsigned)v0[3] << 24), hi = (unsigned)v1[0] | ((unsigned)v1[1] << 8) | ((unsigned)v1[2] << 16) | ((unsigned)v1[3] << 24);
                            *(unsigned long long*)(rowb + bj * HALF) = (unsigned long long)lo | ((unsigned long long)hi << 32); } }
            } else {
#pragma unroll
            for (int ai = 0; ai < 2; ++ai)
#pragma unroll
                for (int m = 0; m < 4; ++m) { bf16_t* rowp = P + (size_t)(row0 + ai * HALF + m * 16) * 5120 + col0;
#pragma unroll
                    for (int bj = 0; bj < 2; ++bj) { const f32x4 v0 = acc[ai][bj][m][0] * sc, v1 = acc[ai][bj][m][1] * sc;
                        *(u32x4*)(rowp + bj * HALF) = pack8(v0, v1); } }
            }
        }
    }
};

template <int SECOND> struct EpiMix {
    static constexpr bool PERM = true, AFTER_DRAIN = false, PREFETCH = true;
    struct Pref { unsigned long long g[4][2]; };
    const bf16_t* P; bf16_t* MX;
    __device__ __forceinline__ void prefetch(Pref& pf, const Unit& u, int wr, int wc, int fr, int fq) const {
        const int row0 = u.pm * BM + wr * 64 + fr, col0 = u.pn * BM + wc * 32 + 8 * fq;
#pragma unroll
        for (int m = 0; m < 4; ++m)
#pragma unroll
            for (int bj = 0; bj < 2; ++bj) pf.g[m][bj] = *(const unsigned long long*)((const unsigned char*)P + (size_t)(row0 + m * 16) * 10240 + 6144 + (SECOND ? 1024 : 0) + col0 + bj * HALF);
    }
    __device__ __forceinline__ void operator()(const f32x4 (&acc)[2][2][4][2], const Unit& u, int wr, int wc, int fr, int fq, const Pref& pf) const {
        const int row0 = u.pm * BM + wr * 64 + fr, col0 = u.pn * BM + wc * 32 + 8 * fq;
        unsigned long long g1[4][2];
#pragma unroll
        for (int m = 0; m < 4; ++m)
#pragma unroll
            for (int bj = 0; bj < 2; ++bj) g1[m][bj] = *(const unsigned long long*)((const unsigned char*)P + (size_t)(row0 + HALF + m * 16) * 10240 + 6144 + (SECOND ? 1024 : 0) + col0 + bj * HALF);
#pragma unroll
        for (int ai = 0; ai < 2; ++ai)
#pragma unroll
            for (int m = 0; m < 4; ++m) { const size_t row = (size_t)(row0 + ai * HALF + m * 16);
#pragma unroll
                for (int bj = 0; bj < 2; ++bj) { const int c = col0 + bj * HALF;
                    const unsigned long long gq = ai ? g1[m][bj] : pf.g[m][bj]; const unsigned gl = (unsigned)gq, gh = (unsigned)(gq >> 32);
                    const f32x4 g0 = (f32x4){(float)(gl & 255u), (float)((gl >> 8) & 255u), (float)((gl >> 16) & 255u), (float)(gl >> 24)} * (1.0f / 255.0f);
                    const f32x4 g1 = (f32x4){(float)(gh & 255u), (float)((gh >> 8) & 255u), (float)((gh >> 16) & 255u), (float)(gh >> 24)} * (1.0f / 255.0f);
                    f32x4 v0 = acc[ai][bj][m][0] * g0, v1 = acc[ai][bj][m][1] * g1;
                    if (SECOND) { const u32x4 ow = *(const u32x4*)(MX + row * 1024 + c); f32x4 o0, o1; unpack8(ow, o0, o1); v0 = v0 + o0; v1 = v1 + o1; }
                    *(u32x4*)(MX + row * 1024 + c) = pack8(v0, v1); } }
    }
};

struct EpiResid {
    static constexpr bool PERM = false, AFTER_DRAIN = false, PREFETCH = false; struct Pref {};
    const float* X; float* O; int ldc;
    __device__ __forceinline__ void operator()(const f32x4 (&acc)[2][2][4][2], const Unit& u, int wr, int wc, int fr, int fq) const {
        const int row0 = u.pm * BM + wr * 64 + fr, col0 = u.pn * BM + wc * 32 + 4 * fq;
#pragma unroll
        for (int ai = 0; ai < 2; ++ai)
#pragma unroll
            for (int m = 0; m < 4; ++m) { const size_t off = (size_t)(row0 + ai * HALF + m * 16) * ldc + col0;
#pragma unroll
                for (int bj = 0; bj < 2; ++bj)
#pragma unroll
                    for (int n = 0; n < 2; ++n) { const f32x4 xv = *(const f32x4*)(X + off + bj * HALF + n * 16); *(f32x4*)(O + off + bj * HALF + n * 16) = xv + acc[ai][bj][m][n]; } }
    }
};

typedef float f32x2 __attribute__((ext_vector_type(2)));
__device__ __forceinline__ unsigned long long pack8_f8(f32x4 a, f32x4 b, float s) {
    float v[8] = {a[0] * s, a[1] * s, a[2] * s, a[3] * s, b[0] * s, b[1] * s, b[2] * s, b[3] * s};
#pragma unroll
    for (int i = 0; i < 8; ++i) v[i] = __builtin_amdgcn_fmed3f(v[i], -448.0f, 448.0f);
    int lo = 0, hi = 0;
    lo = __builtin_amdgcn_cvt_pk_fp8_f32(v[0], v[1], lo, false); lo = __builtin_amdgcn_cvt_pk_fp8_f32(v[2], v[3], lo, true);
    hi = __builtin_amdgcn_cvt_pk_fp8_f32(v[4], v[5], hi, false); hi = __builtin_amdgcn_cvt_pk_fp8_f32(v[6], v[7], hi, true);
    return (unsigned long long)(unsigned)lo | ((unsigned long long)(unsigned)hi << 32);
}
struct EpiResidBf {
    static constexpr bool PERM = true, AFTER_DRAIN = false, PREFETCH = false; struct Pref {};
    const float* X; bf16_t* O; int ldx, ldo; unsigned char* O8; int ld8; float s8;
    __device__ __forceinline__ void operator()(const f32x4 (&acc)[2][2][4][2], const Unit& u, int wr, int wc, int fr, int fq) const {
        const int row0 = u.pm * BM + wr * 64 + fr, col0 = u.pn * BM + wc * 32 + 8 * fq;
#pragma unroll
        for (int ai = 0; ai < 2; ++ai)
#pragma unroll
            for (int m = 0; m < 4; ++m) { const size_t row = (size_t)(row0 + ai * HALF + m * 16);
#pragma unroll
                for (int bj = 0; bj < 2; ++bj) { const float* xp = X + row * ldx + col0 + bj * HALF; const f32x4 x0 = *(const f32x4*)xp, x1v = *(const f32x4*)(xp + 4);
                    const f32x4 y0 = x0 + acc[ai][bj][m][0], y1 = x1v + acc[ai][bj][m][1];
                    *(u32x4*)(O + row * ldo + col0 + bj * HALF) = pack8(y0, y1);
                    *(unsigned long long*)(O8 + row * ld8 + col0 + bj * HALF) = pack8_f8(y0, y1, s8); } }
    }
};

struct EpiMoe1 {
    static constexpr bool PERM = true, AFTER_DRAIN = false, PREFETCH = false; struct Pref {};
    static constexpr bool STAGE = true;
    unsigned char* ACT; float sact; const float* bg; const float* bu; const float* rstd; const PG8_LAS int* tokl; PG8_LAS float* stg;
    __device__ __forceinline__ void stage(const Unit& u, int wid, int lane) const {
        PG8_LAS float* sb = stg + (u.ui & 1) * 512; const float* src;
        if (wid < 4) src = rstd + tokl[u.ui * 256 + wid * 64 + lane];
        else src = ((wid < 6) ? bg : bu) + u.e * 1024 + u.pn * HALF + (wid & 1) * 64 + lane;
        __builtin_amdgcn_global_load_lds((const unsigned*)src, (PG8_LAS unsigned*)(sb + wid * 64), 4, 0, 0);
    }
    __device__ __forceinline__ void operator()(const f32x4 (&acc)[2][2][4][2], const Unit& u, int wr, int wc, int fr, int fq) const {
        int fr_ = fr, fq_ = fq; asm volatile("" : "+v"(fr_), "+v"(fq_) : "v"(acc[0][0][0][0]));
        const int lrow0 = wr * 64 + fr_, f0 = u.pn * HALF + wc * 32 + 8 * fq_;
        const PG8_LAS float* sb = stg + (u.ui & 1) * 512; const int cl = wc * 32 + 8 * fq_;
        const f32x4 bg0 = *(const PG8_LAS f32x4*)(sb + 256 + cl), bg1 = *(const PG8_LAS f32x4*)(sb + 256 + cl + 4);
        const f32x4 bu0 = *(const PG8_LAS f32x4*)(sb + 384 + cl), bu1 = *(const PG8_LAS f32x4*)(sb + 384 + cl + 4);
#pragma unroll
        for (int ai = 0; ai < 2; ++ai)
#pragma unroll
            for (int m = 0; m < 4; ++m) { int w8[2] = {0, 0}; const int lr = lrow0 + ai * HALF + m * 16; const float rs = sb[lr]; const f32x2 rs2 = {rs, rs};
#pragma unroll
                for (int n = 0; n < 2; ++n) { const f32x4 ag = acc[ai][0][m][n], au = acc[ai][1][m][n], bgn = n ? bg1 : bg0, bun = n ? bu1 : bu0;
#pragma unroll
                    for (int h = 0; h < 2; ++h) {
                        const f32x2 gv = __builtin_elementwise_fma((f32x2){ag[2 * h], ag[2 * h + 1]}, rs2, (f32x2){bgn[2 * h], bgn[2 * h + 1]});
                        const f32x2 uv = __builtin_elementwise_fma((f32x2){au[2 * h], au[2 * h + 1]}, rs2, (f32x2){bun[2 * h], bun[2 * h + 1]});
                        const f32x2 g = {fminf(gv[0], 7.0f), fminf(gv[1], 7.0f)};
                        const f32x2 uu = {__builtin_amdgcn_fmed3f(uv[0], -7.0f, 7.0f), __builtin_amdgcn_fmed3f(uv[1], -7.0f, 7.0f)};
                        const f32x2 t = g * (f32x2){-1.702f * 1.4426950408889634f, -1.702f * 1.4426950408889634f};
                        const f32x2 den = (f32x2){__builtin_amdgcn_exp2f(t[0]), __builtin_amdgcn_exp2f(t[1])} + (f32x2){1.0f, 1.0f};
                        const f32x2 gs = g * (f32x2){__builtin_amdgcn_rcpf(den[0]), __builtin_amdgcn_rcpf(den[1])};
                        const f32x2 r = __builtin_elementwise_fma(uu, (f32x2){sact, sact}, (f32x2){sact, sact}) * gs;
                        w8[n] = h ? __builtin_amdgcn_cvt_pk_fp8_f32(r[0], r[1], w8[n], true) : __builtin_amdgcn_cvt_pk_fp8_f32(r[0], r[1], w8[n], false); } }
                *(unsigned long long*)(ACT + ((size_t)u.pm * BM + lr) * 1024 + f0) = (unsigned long long)(unsigned)w8[0] | ((unsigned long long)(unsigned)w8[1] << 32); }
    }
};
struct EpiMoe2 {
    static constexpr bool PERM = true, AFTER_DRAIN = false, PREFETCH = false; struct Pref {};
    static constexpr bool STAGE = true;
    unsigned char* Y; float sy; const float* bd; const float* lg; PG8_LAS float* stg;
    __device__ __forceinline__ void stage(const Unit& u, int wid, int lane) const {
        PG8_LAS float* sb = stg + (u.ui & 1) * 512; const float* src;
        if (wid < 4) { const int p = u.lt * 256 + wid * 64 + lane; src = lg + u.e * 16384 + (p < u.cnt ? p : 0); }
        else src = bd + u.e * 1024 + u.pn * BM + (wid - 4) * 64 + lane;
        __builtin_amdgcn_global_load_lds((const unsigned*)src, (PG8_LAS unsigned*)(sb + wid * 64), 4, 0, 0);
    }
    __device__ __forceinline__ void operator()(const f32x4 (&acc)[2][2][4][2], const Unit& u, int wr, int wc, int fr, int fq) const {
        int fr_ = fr, fq_ = fq; asm volatile("" : "+v"(fr_), "+v"(fq_) : "v"(acc[0][0][0][0]));
        const int lrow0 = wr * 64 + fr_, col0 = u.pn * BM + wc * 32 + 8 * fq_;
        const PG8_LAS float* sb = stg + (u.ui & 1) * 512; f32x4 bv[2][2];
#pragma unroll
        for (int bj = 0; bj < 2; ++bj)
#pragma unroll
            for (int n = 0; n < 2; ++n) bv[bj][n] = *(const PG8_LAS f32x4*)(sb + 256 + wc * 32 + 8 * fq_ + bj * HALF + 4 * n);
#pragma unroll
        for (int ai = 0; ai < 2; ++ai)
#pragma unroll
            for (int m = 0; m < 4; ++m) { const int lr = lrow0 + ai * HALF + m * 16, p = u.lt * 256 + lr; const float g = (p < u.cnt) ? sb[lr] * sy : 0.f; const size_t row = (size_t)u.pm * BM + lr;
#pragma unroll
                for (int bj = 0; bj < 2; ++bj) *(unsigned long long*)(Y + row * 1024 + col0 + bj * HALF) = pack8_f8((acc[ai][bj][m][0] + bv[bj][0]) * g, (acc[ai][bj][m][1] + bv[bj][1]) * g, 1.0f); }
    }
};
struct MoeOrder {
    static constexpr bool DUAL = false, GATHER = false, HALFSKIP = false, FP8 = true, BCH = true;
    int npn, G, c; const PG8_LAS int* tab; int fsc = 0x7F7F7F7F; unsigned* rdy = nullptr; unsigned* tmo = nullptr; int mode = 0; PG8_LAS unsigned* pkl = nullptr; int nb64 = 0, ebytes = 0;
    __device__ __forceinline__ bool next(int i, Unit& u) const {
        const int x = c & 7, cu_ = (mode == 2) ? (G >> 3) - 1 - (c >> 3) : (c >> 3), slot = i * (G >> 3) + cu_, j = slot / npn, pn = slot - j * npn;
        if (j >= __builtin_amdgcn_readfirstlane(tab[744 + x])) return false;
        const int t = __builtin_amdgcn_readfirstlane(tab[360 + x * 48 + j]), e = __builtin_amdgcn_readfirstlane(tab[40 + t]);
        u.pm = t; u.pn = pn; u.e = e; u.pb = e * npn + pn; u.lt = t - __builtin_amdgcn_readfirstlane(tab[e]); u.cnt = __builtin_amdgcn_readfirstlane(tab[328 + e]);
        u.full = (u.cnt - u.lt * 256 > 128) ? 1 : 0; u.ui = i; return true;
    }
    __device__ __forceinline__ bool next_v(int i, int& e, int& lt, int& cnt) const {
        const int x = c & 7, cu_ = (mode == 2) ? (G >> 3) - 1 - (c >> 3) : (c >> 3), slot = i * (G >> 3) + cu_, j = slot / npn;
        e = 0; lt = 0; cnt = 0;
        if (j >= tab[744 + x]) return false;
        const int t = tab[360 + x * 48 + j]; e = tab[40 + t]; lt = t - tab[e]; cnt = tab[328 + e]; return true;
    }
    __device__ __forceinline__ void a_ready(const Unit& u) const {
        if (mode != 2) return;
        unsigned sp = 0u;
        while ((unsigned)__builtin_amdgcn_readfirstlane((int)__hip_atomic_load(rdy + 16 * u.pm, __ATOMIC_RELAXED, __HIP_MEMORY_SCOPE_AGENT)) < 64u) {
            __builtin_amdgcn_s_sleep(1);
            if ((++sp & 255u) == 0u) { if (__hip_atomic_load(tmo, __ATOMIC_RELAXED, __HIP_MEMORY_SCOPE_AGENT) != 0u) break; if (sp > (1u << 18)) { __hip_atomic_fetch_add(tmo, 1u, __ATOMIC_RELAXED, __HIP_MEMORY_SCOPE_AGENT); break; } } }
        asm volatile("" ::: "memory");
    }
    static constexpr bool PEEK = true;
    __device__ __forceinline__ void peek(const Unit& u, int wid) const { if (mode == 2) __builtin_amdgcn_global_load_lds((const unsigned*)(rdy + 16 * u.pm), (PG8_LAS unsigned*)(pkl + wid * 64), 4, 0, 16); }
    __device__ __forceinline__ void a_ready_pk(const Unit& u, int wid) const {
        if (mode != 2) return;
        if ((unsigned)__builtin_amdgcn_readfirstlane((int)pkl[wid * 64]) >= 64u) return;
        a_ready(u);
    }
    __device__ __forceinline__ void done(const Unit& u) const {
        if (mode != 1) return;
        asm volatile("s_waitcnt vmcnt(0)" ::: "memory");
        if (__builtin_amdgcn_mbcnt_hi(~0u, __builtin_amdgcn_mbcnt_lo(~0u, 0u)) == 0u) __hip_atomic_fetch_add(rdy + 16 * u.pm, 1u, __ATOMIC_RELAXED, __HIP_MEMORY_SCOPE_AGENT);
    }
};
struct MoeOrderG : MoeOrder {
    static constexpr bool GATHER = true;
    const PG8_LAS int* tokl; int pitch;
    __device__ __forceinline__ int row_token(int ui, int r) const { return tokl[ui * 256 + r]; }
};
struct DupOrder {
    static constexpr bool DUAL = false, GATHER = false, HALFSKIP = false, FP8 = false, BCH = false; static constexpr int fsc = 0, nb64 = 0, ebytes = 0;
    StaticOrder S; int n, reps;
    __device__ __forceinline__ bool next(int i, Unit& u) const { if (i >= n * reps) return false; return S.next(i % n, u); }
    __device__ __forceinline__ void a_ready(const Unit&) const {}
    __device__ __forceinline__ void done(const Unit&) const {}
};
struct DualOrder {
    static constexpr bool DUAL = true, GATHER = false, HALFSKIP = false, FP8 = false, BCH = false; static constexpr int fsc = 0, nb64 = 0, ebytes = 0;
    StaticOrder S; int reps;
    __device__ __forceinline__ bool next(int i, Unit& u) const { if (i >= 2 * reps) return false; if (!S.next(0, u)) return false; u.e = i & 1; return true; }
    __device__ __forceinline__ void a_ready(const Unit&) const {}
    __device__ __forceinline__ void done(const Unit&) const {}
};
typedef int pg8_i32x4 __attribute__((ext_vector_type(4)));
typedef int pg8_i32x8 __attribute__((ext_vector_type(8)));
__device__ __forceinline__ pg8_i32x8 pg8_cat8(bf16x8 a, bf16x8 b) { const pg8_i32x4 x = __builtin_bit_cast(pg8_i32x4, a), y = __builtin_bit_cast(pg8_i32x4, b); return __builtin_shufflevector(x, y, 0, 1, 2, 3, 4, 5, 6, 7); }
template <class S, class = void> struct sched_has_peek { static constexpr bool value = false; };
template <class S> struct sched_has_peek<S, decltype((void)S::PEEK)> { static constexpr bool value = S::PEEK; };
template <class E, class = void> struct epi_has_stage { static constexpr bool value = false; };
template <class E> struct epi_has_stage<E, decltype((void)E::STAGE)> { static constexpr bool value = E::STAGE; };
template <class Epi, class Sched, bool ALIGN_EPI = false, bool SP2 = false>
__device__ __forceinline__ void gemm_phase(PG8_LAS unsigned char* lds, const Gemm g, const Sched& S, const Epi& E, int wave_) {
    const int wid = wave_, lane = lane_id_now(), tid = wid * 64 + lane, wr = wid >> 2, wc = wid & 3, fr = lane & 15, fq = lane >> 4;
    const int K = g.K; int nt = K / BK; asm volatile("" : "+s"(nt));
    unsigned voffA[2], voffB[2];
#pragma unroll
    for (int i = 0; i < 2; ++i) { int R, C; stage_rc(tid * 16 + i * 8192, R, C); const int Rb = Epi::PERM ? ((R & ~31) + perm32(R & 31)) : R;
        voffA[i] = (unsigned)(R * K + C) * 2u; voffB[i] = Sched::BCH ? (unsigned)((C >> 5) * S.nb64 + Rb * 64 + ((2 * C) & 63)) : (unsigned)(Rb * K + C) * 2u; }
    int gR[2] = {0, 0}, gC[2] = {0, 0}; unsigned cvo[2][2] = {{0u, 0u}, {0u, 0u}};
    if constexpr (Sched::GATHER) { static_assert(SP2, "GATHER is written for the SP2 loop");
#pragma unroll
        for (int i = 0; i < 2; ++i) stage_rc(tid * 16 + i * 8192, gR[i], gC[i]); }
#define PG8_GVO(dst, ui_) do { _Pragma("unroll") for (int h_ = 0; h_ < 2; ++h_) _Pragma("unroll") for (int i_ = 0; i_ < 2; ++i_) dst[h_][i_] = (unsigned)(S.row_token(ui_, h_ * HALF + gR[i_]) * S.pitch + gC[i_]) * 2u; } while (0)
#define PG8_STAGE_A(bufoff, base, half, v0, v1) do { if constexpr (Sched::GATHER) { const unsigned vv_[2] = {v0, v1}; PG8_STAGE(bufoff, base, vv_); } else { PG8_STAGE(bufoff, (base) + (half) * hstep, voffA); } } while (0)
    const size_t kstep = (size_t)(BK * 2);
    const size_t kstepB = Sched::BCH ? (size_t)2 * S.nb64 : (size_t)(BK * 2), hstepB = Sched::BCH ? (size_t)HALF * 64 : (size_t)HALF * K * 2;
    const size_t hstep = (size_t)HALF * K * 2;
    const size_t tstep = 2 * hstep;
    const unsigned ldsw = (unsigned)wid * 1024u;
    const int aoff = lds_byte(wr * 64 + fr, fq * 8), boff = lds_byte(wc * 32 + fr, fq * 8);
#define PG8_SA(b, h) (((b) * 2 + (h)) * HTB)
#define PG8_SB(b, h) ((4 + (b) * 2 + (h)) * HTB)
#define PG8_STAGE(bufoff, gbase, voff) do { _Pragma("unroll") for (int _i = 0; _i < 2; ++_i) { unsigned vo_ = (voff)[_i]; const char* gb_ = (const char*)(gbase); if constexpr (Sched::FP8) asm volatile("" : "+v"(vo_), "+s"(gb_)); \
        __builtin_amdgcn_global_load_lds((const unsigned*)(gb_ + vo_), (PG8_LAS unsigned*)(lds + (bufoff) + ldsw + _i * 8192), 16, 0, 0); } } while (0)
#define PG8_LDA(dst, b, h) do { _Pragma("unroll") for (int m = 0; m < 4; ++m) _Pragma("unroll") for (int k = 0; k < 2; ++k) dst[m][k] = *(const PG8_LAS bf16x8*)(lds + PG8_SA(b, h) + aoff + m * 2048 + k * 1024); } while (0)
#define PG8_LDB(dst, b, h) do { _Pragma("unroll") for (int n = 0; n < 2; ++n) _Pragma("unroll") for (int k = 0; k < 2; ++k) dst[n][k] = *(const PG8_LAS bf16x8*)(lds + PG8_SB(b, h) + boff + n * 2048 + k * 1024); } while (0)
#define PG8_MMA(ai, bj, At, Bt) do { __builtin_amdgcn_s_setprio(1); _Pragma("unroll") for (int m = 0; m < 4; ++m) _Pragma("unroll") for (int n = 0; n < 2; ++n) { if constexpr (Sched::FP8) { \
        acc[ai][bj][m][n] = __builtin_amdgcn_mfma_scale_f32_16x16x128_f8f6f4(pg8_cat8(Bt[n][0], Bt[n][1]), pg8_cat8(At[m][0], At[m][1]), acc[ai][bj][m][n], 0, 0, 0, S.fsc, 0, S.fsc); } else { _Pragma("unroll") for (int k = 0; k < 2; ++k) \
        acc[ai][bj][m][n] = __builtin_amdgcn_mfma_f32_16x16x32_bf16(Bt[n][k], At[m][k], acc[ai][bj][m][n], 0, 0, 0); } } __builtin_amdgcn_s_setprio(0); } while (0)
#define PG8_WAIT_V(n) asm volatile("s_waitcnt vmcnt(" #n ")" ::: "memory")
#define PG8_WAIT_L(n) asm volatile("s_waitcnt lgkmcnt(" #n ")" ::: "memory")
#define PG8_BAR __builtin_amdgcn_s_barrier()
#define PG8_SCHED __builtin_amdgcn_sched_barrier(0)
    Unit cur, nxt; int ui = 0;
    if (!S.next(0, cur)) return;
    f32x4 acc[2][2][4][2];
#pragma unroll
    for (int a = 0; a < 2; ++a)
#pragma unroll
        for (int b = 0; b < 2; ++b)
#pragma unroll
            for (int m = 0; m < 4; ++m)
#pragma unroll
                for (int n = 0; n < 2; ++n) acc[a][b][m][n] = (f32x4){0.f, 0.f, 0.f, 0.f};
    bf16x8 At[4][2], B0[2][2], B1[2][2];
    const char* cA = (const char*)((Sched::DUAL && cur.e) ? g.A2 : g.A) + (Sched::GATHER ? (size_t)0 : (size_t)cur.pm * tstep);
    if constexpr (Sched::GATHER) PG8_GVO(cvo, 0);
    const char* cB = (const char*)((Sched::DUAL && cur.e) ? g.Bt2 : g.Bt) + (Sched::BCH ? (size_t)cur.e * S.ebytes + (size_t)cur.pn * (2 * hstepB) : (size_t)cur.pb * tstep);
    if constexpr (epi_has_stage<Epi>::value) E.stage(cur, wid, lane_id_now());
    typename Epi::Pref pf_{}; if constexpr (Epi::PREFETCH) E.prefetch(pf_, cur, wr, wc, fr, fq);
    S.a_ready(cur);
    if constexpr (SP2) {
        PG8_STAGE(PG8_SB(0, 0), cB, voffB); PG8_STAGE(PG8_SB(0, 1), cB + hstepB, voffB); PG8_STAGE_A(PG8_SA(0, 0), cA, 0, cvo[0][0], cvo[0][1]); PG8_STAGE_A(PG8_SA(0, 1), cA, 1, cvo[1][0], cvo[1][1]);
        if (wr == 1) PG8_BAR;
        PG8_WAIT_V(2); PG8_BAR;
        PG8_STAGE(PG8_SB(1, 0), cB + kstepB, voffB); PG8_STAGE_A(PG8_SA(1, 0), cA + kstep, 0, cvo[0][0], cvo[0][1]); PG8_STAGE(PG8_SB(1, 1), cB + hstepB + kstepB, voffB);
        PG8_WAIT_V(6); PG8_BAR;
    } else {
        PG8_STAGE(PG8_SB(0, 0), cB, voffB); PG8_STAGE(PG8_SA(0, 0), cA, voffA); PG8_STAGE(PG8_SB(0, 1), cB + hstepB, voffB); PG8_STAGE(PG8_SA(0, 1), cA + hstep, voffA);
        if (wr == 1) PG8_BAR;
        PG8_WAIT_V(4); PG8_BAR;
        PG8_STAGE(PG8_SB(1, 0), cB + kstepB, voffB); PG8_STAGE(PG8_SA(1, 0), cA + kstep, voffA); PG8_STAGE(PG8_SB(1, 1), cB + hstepB + kstepB, voffB);
        PG8_WAIT_V(6); PG8_BAR;
    }
    for (;;) {
        const bool has_next = S.next(ui + 1, nxt);
        if constexpr (sched_has_peek<Sched>::value) { if (has_next) S.peek(nxt, wid); }
        const char* nA = has_next ? (const char*)((Sched::DUAL && nxt.e) ? g.A2 : g.A) + (Sched::GATHER ? (size_t)0 : (size_t)nxt.pm * tstep) : cA; const char* nB = has_next ? (const char*)((Sched::DUAL && nxt.e) ? g.Bt2 : g.Bt) + (Sched::BCH ? (size_t)nxt.e * S.ebytes + (size_t)nxt.pn * (2 * hstepB) : (size_t)nxt.pb * tstep) : cB;
        for (int t = 0; t < nt; t += 2) {
            const bool last = (t == nt - 2);
            const char* a1 = cA + (size_t)(t + 1) * kstep;
            const char* a2 = last ? nA : cA + (size_t)(t + 2) * kstep; const char* b2 = last ? nB : cB + (size_t)(t + 2) * kstepB;
            const char* a3 = a2 + kstep; const char* b3 = b2 + kstepB;
            if (last && has_next) { if constexpr (sched_has_peek<Sched>::value) S.a_ready_pk(nxt, wid); else S.a_ready(nxt); }
            if constexpr (SP2) {
            PG8_LDB(B0, 0, 0); PG8_LDB(B1, 0, 1); PG8_SCHED; PG8_LDA(At, 0, 0); PG8_STAGE_A(PG8_SA(1, 1), a1, 1, cvo[1][0], cvo[1][1]); if constexpr (Sched::GATHER) { if (last && has_next) PG8_GVO(cvo, ui + 1); }
            PG8_WAIT_V(8); PG8_WAIT_L(0); PG8_BAR; PG8_MMA(0, 0, At, B0); PG8_MMA(0, 1, At, B1); PG8_BAR; PG8_SCHED;
            if (!Sched::HALFSKIP || cur.full) PG8_LDA(At, 0, 1); PG8_STAGE(PG8_SB(0, 0), b2, voffB); PG8_STAGE(PG8_SB(0, 1), b2 + hstepB, voffB); PG8_STAGE_A(PG8_SA(0, 0), a2, 0, cvo[0][0], cvo[0][1]);
            PG8_WAIT_V(8); PG8_WAIT_L(0); PG8_BAR; if (!Sched::HALFSKIP || cur.full) { PG8_MMA(1, 0, At, B0); PG8_MMA(1, 1, At, B1); } PG8_BAR; PG8_SCHED;
            PG8_LDB(B0, 1, 0); PG8_LDB(B1, 1, 1); PG8_SCHED; PG8_LDA(At, 1, 0); PG8_STAGE_A(PG8_SA(0, 1), a2, 1, cvo[1][0], cvo[1][1]);
            PG8_WAIT_V(8); PG8_WAIT_L(0); PG8_BAR; PG8_MMA(0, 0, At, B0); PG8_MMA(0, 1, At, B1); PG8_BAR; PG8_SCHED;
            if (!Sched::HALFSKIP || cur.full) PG8_LDA(At, 1, 1); PG8_STAGE(PG8_SB(1, 0), b3, voffB); PG8_STAGE(PG8_SB(1, 1), b3 + hstepB, voffB); PG8_STAGE_A(PG8_SA(1, 0), a3, 0, cvo[0][0], cvo[0][1]);
            PG8_WAIT_V(8); PG8_WAIT_L(0); PG8_BAR; if (!Sched::HALFSKIP || cur.full) { PG8_MMA(1, 0, At, B0); PG8_MMA(1, 1, At, B1); } PG8_BAR; PG8_SCHED;
            } else {
            PG8_LDB(B0, 0, 0); PG8_SCHED; PG8_LDA(At, 0, 0); PG8_STAGE(PG8_SA(1, 1), a1 + hstep, voffA);
            PG8_WAIT_L(8); PG8_BAR; PG8_WAIT_L(0); PG8_MMA(0, 0, At, B0); PG8_BAR; PG8_SCHED;
            PG8_LDB(B1, 0, 1); PG8_STAGE(PG8_SB(0, 0), b2, voffB);
            PG8_BAR; PG8_WAIT_L(0); PG8_MMA(0, 1, At, B1); PG8_BAR;
            PG8_LDA(At, 0, 1); PG8_STAGE(PG8_SA(0, 0), a2, voffA);
            PG8_BAR; PG8_WAIT_L(0); PG8_MMA(1, 0, At, B0); PG8_BAR; PG8_SCHED;
            PG8_STAGE(PG8_SB(0, 1), b2 + hstepB, voffB);
            PG8_WAIT_V(6); PG8_BAR; PG8_MMA(1, 1, At, B1); PG8_BAR;
            PG8_LDB(B0, 1, 0); PG8_SCHED; PG8_LDA(At, 1, 0); PG8_STAGE(PG8_SA(0, 1), a2 + hstep, voffA);
            PG8_WAIT_L(8); PG8_BAR; PG8_WAIT_L(0); PG8_MMA(0, 0, At, B0); PG8_BAR; PG8_SCHED;
            PG8_LDB(B1, 1, 1); PG8_STAGE(PG8_SB(1, 0), b3, voffB);
            PG8_BAR; PG8_WAIT_L(0); PG8_MMA(0, 1, At, B1); PG8_BAR;
            PG8_LDA(At, 1, 1); PG8_STAGE(PG8_SA(1, 0), a3, voffA);
            PG8_BAR; PG8_WAIT_L(0); PG8_MMA(1, 0, At, B0); PG8_BAR; PG8_SCHED;
            PG8_STAGE(PG8_SB(1, 1), b3 + hstepB, voffB);
            PG8_WAIT_V(6); PG8_BAR; PG8_MMA(1, 1, At, B1); PG8_BAR;
            }
        }
        if constexpr (ALIGN_EPI) { if (wr == 0) PG8_BAR; }
        if constexpr (!Epi::AFTER_DRAIN) { if constexpr (Epi::PREFETCH) E(acc, cur, wr, wc, fr, fq, pf_); else E(acc, cur, wr, wc, fr, fq); S.done(cur); }
        if (!has_next) break;
#pragma unroll
        for (int a = 0; a < 2; ++a)
#pragma unroll
            for (int b = 0; b < 2; ++b)
#pragma unroll
                for (int m = 0; m < 4; ++m)
#pragma unroll
                    for (int n = 0; n < 2; ++n) acc[a][b][m][n] = (f32x4){0.f, 0.f, 0.f, 0.f};
        cur = nxt; cA = nA; cB = nB; ++ui;
        if constexpr (epi_has_stage<Epi>::value) E.stage(cur, wid, lane_id_now());
        if constexpr (ALIGN_EPI) { if (wr == 1) PG8_BAR; }
    }
    PG8_WAIT_V(0);
    if constexpr (!ALIGN_EPI) { if (wr == 0) PG8_BAR; }
    PG8_BAR;
    if constexpr (Epi::AFTER_DRAIN) { E.fused(acc, cur, wr, wc, fr, fq, lds, wid, lane); S.done(cur); }
#undef PG8_SA
#undef PG8_SB
#undef PG8_STAGE
#undef PG8_STAGE_A
#undef PG8_GVO
#undef PG8_LDA
#undef PG8_LDB
#undef PG8_MMA
#undef PG8_WAIT_V
#undef PG8_WAIT_L
#undef PG8_BAR
#undef PG8_SCHED
}
}

#ifndef PG8_SP2
#define PG8_SP2 true
#endif
#ifndef PG8_ALIGN
#define PG8_ALIGN true
#endif
#include <hip/hip_bf16.h>
#include <cmath>
namespace attn_body {
using bf16=__hip_bfloat16;
using bf16x8=__attribute__((ext_vector_type(8)))short;
using s16x4=__attribute__((ext_vector_type(4)))short;
using f32x16=__attribute__((ext_vector_type(16)))float;
using u32x4=__attribute__((ext_vector_type(4)))unsigned;
constexpr int BATCH=4,NHEAD=16,SEQ=4096,D=64,DM=NHEAD*D;
constexpr int NW=8,QBLK=32,QB=QBLK*NW,KVBLK=64,NQB=SEQ/QB;
constexpr int ATTN_PITCH=DM, ATTN_UNIT_ROWS=QB;
__device__ __forceinline__ int crow(int r,int hi){return (r&3)+8*(r>>2)+4*hi;}
#define SBAR() __builtin_amdgcn_sched_barrier(0)
__device__ __forceinline__ void cmask(f32x16&p0,f32x16&p1,int jb,int qrel,int hi){
  const float NEG=-INFINITY; int kb=64*jb+4*hi;
  #pragma unroll
  for(int r=0;r<16;++r){int kv=kb+(r&3)+8*(r>>2); if(kv>qrel)p0[r]=NEG; if(kv+32>qrel)p1[r]=NEG;}
}

constexpr int NSLOT=3, SLOTB=8192;
constexpr int LDS_K=0, LDS_V=NSLOT*SLOTB, LDS_WS=2*NSLOT*SLOTB, LDS_OST=LDS_WS+NW*64*4, LDS_BYTES=LDS_OST+NW*4096;
constexpr float C2=0.125f*1.4426950408889634f;
__device__ __forceinline__ void glds16(const void*gsrc,unsigned lds_dst){unsigned keep;
  asm volatile("s_mov_b32 %0, m0\n\ts_mov_b32 m0, %2\n\ts_nop 0\n\tglobal_load_lds_dwordx4 %1, off\n\ts_mov_b32 m0, %0":"=&s"(keep):"v"(gsrc),"s"(lds_dst):"memory");}
__device__ __forceinline__ float max3f(float a,float b,float c){float r;asm("v_max3_f32 %0, %1, %2, %3":"=v"(r):"v"(a),"v"(b),"v"(c));return r;}
__device__ __forceinline__ float max2f(float a,float b){float r;asm("v_max_f32_e32 %0, %1, %2":"=v"(r):"v"(a),"v"(b));return r;}
__device__ __forceinline__ float fadd_s(float a,float b){float r;asm("v_add_f32_e32 %0, %1, %2":"=v"(r):"v"(a),"v"(b));return r;}
__device__ __forceinline__ float fsub_s(float a,float b){float r;asm("v_sub_f32_e32 %0, %1, %2":"=v"(r):"v"(a),"v"(b));return r;}
typedef float f32x2_t __attribute__((ext_vector_type(2))); typedef __bf16 bf16x2_t __attribute__((ext_vector_type(2)));
__device__ __forceinline__ unsigned cvtpk_s(float lo,float hi){f32x2_t v={lo,hi};bf16x2_t b=__builtin_convertvector(v,bf16x2_t);return __builtin_bit_cast(unsigned,b);}
#define WAIT_BAR(N) asm volatile("s_waitcnt vmcnt(" #N ") lgkmcnt(0)\n\ts_barrier":::"memory")

__device__ __forceinline__ void qkt(f32x16&p0,f32x16&p1,const char*Kslot,const bf16x8*qr,const f32x16&negm,int r32,int hi){
  const char*kb=Kslot+hi*1024+r32*16;
  #pragma unroll
  for(int d0=0;d0<4;++d0){
    const bf16x8 b0=*reinterpret_cast<const bf16x8*>(kb+d0*2048);
    const bf16x8 b1=*reinterpret_cast<const bf16x8*>(kb+d0*2048+512);
    if(d0==0){p0=__builtin_amdgcn_mfma_f32_32x32x16_bf16(b0,qr[0],negm,0,0,0);p1=__builtin_amdgcn_mfma_f32_32x32x16_bf16(b1,qr[0],negm,0,0,0);}
    else{p0=__builtin_amdgcn_mfma_f32_32x32x16_bf16(b0,qr[d0],p0,0,0,0);p1=__builtin_amdgcn_mfma_f32_32x32x16_bf16(b1,qr[d0],p1,0,0,0);}}
}
typedef __attribute__((address_space(3))) const char* lds_cptr;
typedef short v4i16_t __attribute__((ext_vector_type(4)));
__device__ __forceinline__ void kload8(bf16x8*kf,lds_cptr kp){
  kf[0]=*(const __attribute__((address_space(3))) bf16x8*)(kp);      kf[1]=*(const __attribute__((address_space(3))) bf16x8*)(kp+512);
  kf[2]=*(const __attribute__((address_space(3))) bf16x8*)(kp+2048); kf[3]=*(const __attribute__((address_space(3))) bf16x8*)(kp+2560);
  kf[4]=*(const __attribute__((address_space(3))) bf16x8*)(kp+4096); kf[5]=*(const __attribute__((address_space(3))) bf16x8*)(kp+4608);
  kf[6]=*(const __attribute__((address_space(3))) bf16x8*)(kp+6144); kf[7]=*(const __attribute__((address_space(3))) bf16x8*)(kp+6656);
}
__device__ __forceinline__ void kload2(bf16x8*kf,lds_cptr kp,int j){ kf[2*j]=*(const __attribute__((address_space(3))) bf16x8*)(kp+j*2048); kf[2*j+1]=*(const __attribute__((address_space(3))) bf16x8*)(kp+j*2048+512); }
__device__ __forceinline__ s16x4 vtr(lds_cptr p){ return __builtin_bit_cast(s16x4,__builtin_amdgcn_ds_read_tr16_b64_v4i16((__attribute__((address_space(3))) v4i16_t*)p)); }
__device__ __forceinline__ float rowmax(const f32x16&p0,const f32x16&p1){
  float a=max3f(p0[0],p0[1],p1[0]),b=max3f(p0[2],p0[3],p1[1]);a=max3f(a,p1[2],p1[3]);
  #pragma unroll
  for(int r=4;r<16;r+=4){a=max3f(a,p0[r],p0[r+1]);b=max3f(b,p0[r+2],p0[r+3]);a=max3f(a,p1[r],p1[r+1]);b=max3f(b,p1[r+2],p1[r+3]);}
  const float m=max2f(a,b);
  auto rr=__builtin_amdgcn_permlane32_swap(__float_as_uint(m),__float_as_uint(m),false,false);
  return max2f(__uint_as_float(rr[0]),__uint_as_float(rr[1]));
}
__device__ __forceinline__ void pv(f32x16*o,int vb,bf16x8 pa0,bf16x8 pa1,bf16x8 pa2,bf16x8 pa3){
  #pragma unroll
  for(int d0=0;d0<2;++d0){s16x4 lo[4],hi[4];
    #pragma unroll
    for(int ks=0;ks<4;++ks){
      asm volatile("ds_read_b64_tr_b16 %0,%1 offset:%c2":"=&v"(lo[ks]):"v"(vb),"i"(d0*4096+ks*1024):"memory");
      asm volatile("ds_read_b64_tr_b16 %0,%1 offset:%c2":"=&v"(hi[ks]):"v"(vb),"i"(d0*4096+ks*1024+512):"memory");}
    asm volatile("s_waitcnt lgkmcnt(0)":::"memory");SBAR();
    #define PK(k) (bf16x8){lo[k][0],lo[k][1],lo[k][2],lo[k][3],hi[k][0],hi[k][1],hi[k][2],hi[k][3]}
    o[d0]=__builtin_amdgcn_mfma_f32_32x32x16_bf16(pa0,PK(0),o[d0],0,0,0);
    o[d0]=__builtin_amdgcn_mfma_f32_32x32x16_bf16(pa1,PK(1),o[d0],0,0,0);
    o[d0]=__builtin_amdgcn_mfma_f32_32x32x16_bf16(pa2,PK(2),o[d0],0,0,0);
    o[d0]=__builtin_amdgcn_mfma_f32_32x32x16_bf16(pa3,PK(3),o[d0],0,0,0);
    #undef PK
  }
}

#ifndef ATTN_STORE16
#define ATTN_STORE16(p,v) (*(u32x4*)(p)=(v))
#endif
template<int THRL,int QP,int KP,int VP,int OP> __device__ __forceinline__ void attn_unit(int wave_,int b,int qb,const bf16*Q,const bf16*__restrict__ K,const bf16*__restrict__ V,bf16*O,char*shm){
  int lane_=lane_id_now(); asm volatile("":"+v"(lane_));
  const int wid=wave_,lane=lane_,tid=wid*64+lane,r32=lane&31,hi=lane>>5;
  const long rowbase=(long)b*SEQ; const int q0=qb*QB;
  const bf16*Qw=Q+(rowbase+q0+wid*QBLK)*QP;
  const bf16*Kh=K+rowbase*KP,*Vh=V+rowbase*VP;
  const unsigned lds0=(unsigned)(uintptr_t)shm;
  float*wsf=(float*)(shm+LDS_WS)+wid*64;
  const bf16*ksrc=Kh+(long)lane*KP+wid*8;
  const bf16*vsrc=Vh+(long)(16*(wid&3)+(lane>>2))*VP+(wid>>2)*32+(lane&3)*8;
  const unsigned kdst=lds0+LDS_K+wid*1024, vdst=lds0+LDS_V+wid*1024;
  #define DMA_K(t,slot) glds16(ksrc+(long)(t)*KVBLK*KP,(unsigned)__builtin_amdgcn_readfirstlane(kdst+(slot)))
  #define DMA_V(t,slot) glds16(vsrc+(long)(t)*KVBLK*VP,(unsigned)__builtin_amdgcn_readfirstlane(vdst+(slot)))
  const int vb0=(int)(lds0+LDS_V)+((lane>>4)&1)*32+(lane&3)*8+(4*hi+((lane&15)>>2))*64;
  const char*Kbase=shm+LDS_K; bf16x8 kf[8];
  const lds_cptr shm3=(lds_cptr)shm; const lds_cptr kp0=shm3+LDS_K+hi*1024+r32*16; const lds_cptr vp0=shm3+LDS_V+((lane>>4)&1)*32+(lane&3)*8+(4*hi+((lane&15)>>2))*64;
  const int NT=(q0+QB)/KVBLK;
  DMA_K(0,0);DMA_V(0,0);DMA_K(1,SLOTB);
  bf16x8 qr[4];
  #pragma unroll
  for(int d0=0;d0<4;++d0)qr[d0]=*reinterpret_cast<const bf16x8*>(&Qw[(long)r32*QP+d0*16+hi*8]);
  float mhat=0.f,l_reg=0.f;f32x16 o[2];o[0]=f32x16{};o[1]=f32x16{};f32x16 negm=f32x16{};asm volatile("":"+v"(negm));
  const int qrel=wid*QBLK+r32;
  #define CMASK(P0,P1,t) do{int jb_=(t)-(NT-4); if(jb_>=0)cmask(P0,P1,jb_,qrel,hi);}while(0)
  bool resc=false;
  #define START(P0,P1) do{ const float rm=rowmax(P0,P1); resc=false; \
    { const float dl=rm; mhat=fadd_s(mhat,dl); \
      _Pragma("unroll") for(int r=0;r<16;++r){P0[r]=fsub_s(P0[r],dl);P1[r]=fsub_s(P1[r],dl);} \
      _Pragma("unroll") for(int r=0;r<16;++r)negm[r]=-mhat; asm volatile("":"+v"(negm)); } \
    _Pragma("unroll") for(int r=0;r<16;++r)P0[r]=__builtin_amdgcn_exp2f(P0[r]); }while(0)
  #define RESC() do{ if(resc){ asm volatile("s_waitcnt lgkmcnt(0)":::"memory"); \
      _Pragma("unroll") for(int d_=0;d_<2;++d_) _Pragma("unroll") for(int r=0;r<16;++r)o[d_][r]*=wsf[crow(r,hi)]; } }while(0)
  f32x16 pA0,pA1,pB0,pB1;
  int sl_prev=0,sl_cur=0,sl_next=SLOTB;
  #define ROT() do{sl_prev=sl_cur;sl_cur=sl_next;sl_next=(sl_next==(NSLOT-1)*SLOTB)?0:sl_next+SLOTB;}while(0)
  DMA_K(2,2*SLOTB);
  WAIT_BAR(3);
  qkt(pA0,pA1,Kbase,qr,negm,r32,hi);asm volatile("s_nop 15\n\ts_nop 7":"+v"(pA0),"+v"(pA1));CMASK(pA0,pA1,0);
  START(pA0,pA1);
  _Pragma("unroll") for(int r=0;r<16;++r)pA1[r]=__builtin_amdgcn_exp2f(pA1[r]);
  WAIT_BAR(0);
  DMA_K(3,0);DMA_V(1,SLOTB);
  ROT();
  kload8(kf,kp0+sl_cur);
  WAIT_BAR(2);
  s16x4 vlo[8],vhi[8]; u32x4 pw0,pw1,pw2,pw3;
  #define PKW(P,B) cvtpk_s(P[B],P[B+1])
  #define PAF(k) __builtin_bit_cast(bf16x8,pw##k)
  #define VFR(i) (bf16x8){vlo[i][0],vlo[i][1],vlo[i][2],vlo[i][3],vhi[i][0],vhi[i][1],vhi[i][2],vhi[i][3]}
  #define PIN(x) asm volatile("":"+v"(x))
  #define MX3(a,b,c) __builtin_fmaxf(__builtin_fmaxf((a),(b)),(c))
  #define GAPA(MF,A0,A1,A2,A3,W0,W1,PW) do{ MF; sacc+=A0; sacc+=A1; sacc+=A2; sacc+=A3; PIN(sacc); W0; W1; PIN(PW); SBAR(); }while(0)
  #define EX(v) __builtin_amdgcn_exp2f(v)
  #define GAPB(MF,X,B) do{ MF; X[B]=EX(X[B]); X[B+1]=EX(X[B+1]); X[B+2]=EX(X[B+2]); X[B+3]=EX(X[B+3]); PIN(X); SBAR(); }while(0)
  #define VRD(i) do{ vlo[i]=vtr(vp_+(((i)>>2)*4096+((i)&3)*1024)); vhi[i]=vtr(vp_+(((i)>>2)*4096+((i)&3)*1024+512)); }while(0)
  #define KRD(G,j) do{ if(G){ kload2(kf,kp0+sl_next,j); SBAR(); } }while(0)
  #define STEP(C0,C1,P0,P1,t,GK,GV,GL) do{ SBAR(); \
    const lds_cptr vp_=vp0+sl_prev; \
    VRD(0); SBAR(); float sacc=(P0[0]+P0[1]); \
    GAPA(C0=__builtin_amdgcn_mfma_f32_32x32x16_bf16(kf[0],qr[0],negm,0,0,0), P0[2],P0[3],P0[4],P0[5],     pw0[0]=PKW(P0,0), pw0[1]=PKW(P0,2), pw0); \
    VRD(4); SBAR(); GAPA(C1=__builtin_amdgcn_mfma_f32_32x32x16_bf16(kf[1],qr[0],negm,0,0,0), P0[6],P0[7],P0[8],P0[9],     pw0[2]=PKW(P0,4), pw0[3]=PKW(P0,6), pw0); \
    VRD(1); SBAR(); GAPA(C0=__builtin_amdgcn_mfma_f32_32x32x16_bf16(kf[2],qr[1],C0,0,0,0),   P0[10],P0[11],P0[12],P0[13], pw1[0]=PKW(P0,8), pw1[1]=PKW(P0,10), pw1); \
    VRD(5); SBAR(); GAPA(C1=__builtin_amdgcn_mfma_f32_32x32x16_bf16(kf[3],qr[1],C1,0,0,0),   P0[14],P0[15],P1[0],P1[1],   pw1[2]=PKW(P0,12),pw1[3]=PKW(P0,14), pw1); \
    VRD(2); SBAR(); GAPA(C0=__builtin_amdgcn_mfma_f32_32x32x16_bf16(kf[4],qr[2],C0,0,0,0),   P1[2],P1[3],P1[4],P1[5],     pw2[0]=PKW(P1,0), pw2[1]=PKW(P1,2), pw2); \
    VRD(6); SBAR(); GAPA(C1=__builtin_amdgcn_mfma_f32_32x32x16_bf16(kf[5],qr[2],C1,0,0,0),   P1[6],P1[7],P1[8],P1[9],     pw2[2]=PKW(P1,4), pw2[3]=PKW(P1,6), pw2); \
    VRD(3); SBAR(); GAPA(C0=__builtin_amdgcn_mfma_f32_32x32x16_bf16(kf[6],qr[3],C0,0,0,0),   P1[10],P1[11],P1[12],P1[13], pw3[0]=PKW(P1,8), pw3[1]=PKW(P1,10), pw3); \
    VRD(7); SBAR(); GAPA(C1=__builtin_amdgcn_mfma_f32_32x32x16_bf16(kf[7],qr[3],C1,0,0,0),   P1[14],P1[15],0.f,0.f,       pw3[2]=PKW(P1,12),pw3[3]=PKW(P1,14), pw3); \
    l_reg+=sacc; \
    if(GK){DMA_K((t)+3,sl_cur);} if(GV){DMA_V((t)+1,sl_next);} \
    CMASK(C0,C1,t); \
    { float a=MX3(C0[0],C0[1],C1[0]),b=MX3(C0[2],C0[3],C1[1]); a=MX3(a,C1[2],C1[3]); \
      _Pragma("unroll") for(int r=4;r<16;r+=4){a=MX3(a,C0[r],C0[r+1]);b=MX3(b,C0[r+2],C0[r+3]);a=MX3(a,C1[r],C1[r+1]);b=MX3(b,C1[r+2],C1[r+3]);} \
      float rm=__builtin_fmaxf(a,b); { auto rr=__builtin_amdgcn_permlane32_swap(__float_as_uint(rm),__float_as_uint(rm),false,false); rm=__builtin_fmaxf(__uint_as_float(rr[0]),__uint_as_float(rr[1])); } \
      resc=false; \
      if(__builtin_expect(__any(rm>(float)THRL),0)){ const float dl=__builtin_fmaxf(rm,0.f); mhat+=dl; \
        _Pragma("unroll") for(int r=0;r<16;++r){C0[r]-=dl;C1[r]-=dl;} \
        _Pragma("unroll") for(int r=0;r<16;++r)negm[r]=-mhat; asm volatile("":"+v"(negm)); \
        const float f=__builtin_amdgcn_exp2f(-dl); l_reg*=f; if(hi==0)wsf[r32]=f; resc=true; } } \
    SBAR(); \
    GAPB(o[0]=__builtin_amdgcn_mfma_f32_32x32x16_bf16(PAF(0),VFR(0),o[0],0,0,0), C0,0); \
    GAPB(o[1]=__builtin_amdgcn_mfma_f32_32x32x16_bf16(PAF(0),VFR(4),o[1],0,0,0), C0,4); \
    KRD(GL,0); GAPB(o[0]=__builtin_amdgcn_mfma_f32_32x32x16_bf16(PAF(1),VFR(1),o[0],0,0,0), C0,8); \
    KRD(GL,1); GAPB(o[1]=__builtin_amdgcn_mfma_f32_32x32x16_bf16(PAF(1),VFR(5),o[1],0,0,0), C0,12); \
    KRD(GL,2); GAPB(o[0]=__builtin_amdgcn_mfma_f32_32x32x16_bf16(PAF(2),VFR(2),o[0],0,0,0), C1,0); \
    KRD(GL,3); GAPB(o[1]=__builtin_amdgcn_mfma_f32_32x32x16_bf16(PAF(2),VFR(6),o[1],0,0,0), C1,4); \
    GAPB(o[0]=__builtin_amdgcn_mfma_f32_32x32x16_bf16(PAF(3),VFR(3),o[0],0,0,0), C1,8); \
    GAPB(o[1]=__builtin_amdgcn_mfma_f32_32x32x16_bf16(PAF(3),VFR(7),o[1],0,0,0), C1,12); \
    }while(0)
  int t=1;
  #undef CMASK
  #define CMASK(P0,P1,t) do{}while(0)
  for(;t+5<NT;t+=2){
    STEP(pB0,pB1,pA0,pA1,t,true,true,true);     WAIT_BAR(2); RESC(); ROT();
    STEP(pA0,pA1,pB0,pB1,t+1,true,true,true);   WAIT_BAR(2); RESC(); ROT();
  }
  #undef CMASK
  int hi_b=hi,qrel_b=qrel; asm volatile("":"+v"(hi_b),"+v"(qrel_b));
  #define CMASK(P0,P1,t) do{int jb_=(t)-(NT-4); if(jb_>=0)cmask(P0,P1,jb_,qrel_b,hi_b);}while(0)
  #define ENDW(tt) do{ if((tt)+3<NT){WAIT_BAR(2);} else if((tt)+2<NT){WAIT_BAR(1);} else {WAIT_BAR(0);} }while(0)
  for(;t+1<NT;t+=2){
    STEP(pB0,pB1,pA0,pA1,t,(t+3<NT),(t+1<NT),(t+1<NT));       ENDW(t);   RESC(); ROT();
    STEP(pA0,pA1,pB0,pB1,t+1,(t+4<NT),(t+2<NT),(t+2<NT));     ENDW(t+1); RESC(); ROT();
  }
  STEP(pB0,pB1,pA0,pA1,NT-1,false,false,false); RESC();
  { float sacc=pB0[0]+pB0[1]; _Pragma("unroll") for(int r=2;r<16;++r)sacc+=pB0[r]; _Pragma("unroll") for(int r=0;r<16;++r)sacc+=pB1[r]; l_reg+=sacc;
    pw0=(u32x4){PKW(pB0,0),PKW(pB0,2),PKW(pB0,4),PKW(pB0,6)};pw1=(u32x4){PKW(pB0,8),PKW(pB0,10),PKW(pB0,12),PKW(pB0,14)};pw2=(u32x4){PKW(pB1,0),PKW(pB1,2),PKW(pB1,4),PKW(pB1,6)};pw3=(u32x4){PKW(pB1,8),PKW(pB1,10),PKW(pB1,12),PKW(pB1,14)};
    SBAR(); pv(o,vb0+sl_cur,PAF(0),PAF(1),PAF(2),PAF(3)); }
  #undef PKW
  #undef PAF
  #undef VFR
  #undef PIN
  #undef MX3
  #undef GAPA
  #undef GAPB
  #undef EX
  #undef VRD
  #undef KRD
  #undef STEP
  #undef ENDW
  {auto rr=__builtin_amdgcn_permlane32_swap(__float_as_uint(l_reg),__float_as_uint(l_reg),false,false);l_reg=__uint_as_float(rr[0])+__uint_as_float(rr[1]);}
  if(hi==0)wsf[32+r32]=l_reg;asm volatile("s_waitcnt lgkmcnt(0)":::"memory");
  float rli[16];
  #pragma unroll
  for(int r=0;r<16;++r)rli[r]=__builtin_amdgcn_rcpf(wsf[32+crow(r,hi)]);
  bf16*Ow=O+(rowbase+q0+wid*QBLK)*OP;
  { bf16*stg=(bf16*)(shm+LDS_OST)+wid*2048;
    #pragma unroll
    for(int r=0;r<16;++r){const int orow=crow(r,hi);
      #pragma unroll
      for(int d0=0;d0<2;++d0)stg[orow*64+d0*32+r32]=__float2bfloat16(o[d0][r]*rli[r]);}
    asm volatile("s_waitcnt lgkmcnt(0)":::"memory");
    #pragma unroll
    for(int i=0;i<4;++i){const int row=i*8+(lane>>3),ch=lane&7; const u32x4 v=*(const u32x4*)(stg+row*64+ch*8); ATTN_STORE16(Ow+(long)row*OP+ch*8,v);} }
  asm volatile("s_waitcnt lgkmcnt(0)\n\ts_barrier":::"memory");
  #undef DMA_K
  #undef DMA_V
  #undef CMASK
  #undef START
  #undef RESC
  #undef ROT
}
template<int THRL,int QP,int KP,int VP,int OP> __device__ __forceinline__ void attn_unit2(int wave_,int b,int qb,const bf16*Q,const bf16*__restrict__ K,const bf16*__restrict__ V,bf16*O,char*shm){
  int lane_=lane_id_now(); asm volatile("":"+v"(lane_));
  const int wid=wave_,lane=lane_,tid=wid*64+lane,r32=lane&31,hi=lane>>5;
  const long rowbase=(long)b*SEQ; const int q0=qb*QB;
  const bf16*Qw=Q+(rowbase+q0+wid*QBLK)*QP;
  const bf16*Kh=K+rowbase*KP,*Vh=V+rowbase*VP;
  const unsigned lds0=(unsigned)(uintptr_t)shm;
  constexpr int LDS2_V2=2*NSLOT*SLOTB, LDS2_WS=3*NSLOT*SLOTB, LDS2_OST=LDS2_WS+NW*64*4, V2OFF=LDS2_V2-LDS_V;
  float*wsf=(float*)(shm+LDS2_WS)+wid*64;
  const bf16*ksrc=Kh+(long)lane*KP+wid*8;
  const bf16*vsrc=Vh+(long)(16*(wid&3)+(lane>>2))*VP+(wid>>2)*32+(lane&3)*8;
  const unsigned kdst=lds0+LDS_K+wid*1024, vdst=lds0+LDS_V+wid*1024, vdst2=lds0+LDS2_V2+wid*1024;
  #define DMA_K(t,slot) glds16(ksrc+(long)(t)*KVBLK*KP,(unsigned)__builtin_amdgcn_readfirstlane(kdst+(slot)))
  #define DMA_V(t,slot) do{ glds16(vsrc+(long)(t)*KVBLK*VP,(unsigned)__builtin_amdgcn_readfirstlane(vdst+(slot))); glds16(vsrc+64+(long)(t)*KVBLK*VP,(unsigned)__builtin_amdgcn_readfirstlane(vdst2+(slot))); }while(0)
  const int vb0=(int)(lds0+LDS_V)+((lane>>4)&1)*32+(lane&3)*8+(4*hi+((lane&15)>>2))*64;
  const char*Kbase=shm+LDS_K; bf16x8 kf[8];
  const lds_cptr shm3=(lds_cptr)shm; const lds_cptr kp0=shm3+LDS_K+hi*1024+r32*16; const lds_cptr vp0=shm3+LDS_V+((lane>>4)&1)*32+(lane&3)*8+(4*hi+((lane&15)>>2))*64;
  const int NT=(q0+QB)/KVBLK;
  DMA_K(0,0);DMA_V(0,0);DMA_K(1,SLOTB);
  bf16x8 qr[4];
  #pragma unroll
  for(int d0=0;d0<4;++d0)qr[d0]=*reinterpret_cast<const bf16x8*>(&Qw[(long)r32*QP+d0*16+hi*8]);
  float mhat=0.f,l_reg=0.f;f32x16 o[4];o[0]=f32x16{};o[1]=f32x16{};o[2]=f32x16{};o[3]=f32x16{};const f32x16 negm=f32x16{};
  const int qrel=wid*QBLK+r32;
  #define CMASK(P0,P1,t) do{int jb_=(t)-(NT-4); if(jb_>=0)cmask(P0,P1,jb_,qrel,hi);}while(0)
  bool resc=false;
  #define START(P0,P1) do{ const float rm=rowmax(P0,P1); resc=false; \
    { const float dl=rm; mhat=fadd_s(mhat,dl); \
      _Pragma("unroll") for(int r=0;r<16;++r){P0[r]=fsub_s(P0[r],dl);P1[r]=fsub_s(P1[r],dl);} \
      } \
    _Pragma("unroll") for(int r=0;r<16;++r)P0[r]=__builtin_amdgcn_exp2f(P0[r]); }while(0)
  #define RESC() do{ if(resc){ asm volatile("s_waitcnt lgkmcnt(0)":::"memory"); \
      _Pragma("unroll") for(int d_=0;d_<4;++d_) _Pragma("unroll") for(int r=0;r<16;++r)o[d_][r]*=wsf[crow(r,hi)]; } }while(0)
  f32x16 pA0,pA1,pB0,pB1;
  int sl_prev=0,sl_cur=0,sl_next=SLOTB;
  #define ROT() do{sl_prev=sl_cur;sl_cur=sl_next;sl_next=(sl_next==(NSLOT-1)*SLOTB)?0:sl_next+SLOTB;}while(0)
  DMA_K(2,2*SLOTB);
  WAIT_BAR(4);
  qkt(pA0,pA1,Kbase,qr,negm,r32,hi);asm volatile("s_nop 15\n\ts_nop 7":"+v"(pA0),"+v"(pA1));CMASK(pA0,pA1,0);
  START(pA0,pA1);
  _Pragma("unroll") for(int r=0;r<16;++r)pA1[r]=__builtin_amdgcn_exp2f(pA1[r]);
  WAIT_BAR(0);
  DMA_K(3,0);DMA_V(1,SLOTB);
  ROT();
  kload8(kf,kp0+sl_cur);
  WAIT_BAR(3);
  s16x4 vlo[4],vhi[4]; u32x4 pw0,pw1,pw2,pw3;
  #define PKW(P,B) cvtpk_s(P[B],P[B+1])
  #define PAF(k) __builtin_bit_cast(bf16x8,pw##k)
  #define VFR(i) (bf16x8){vlo[i][0],vlo[i][1],vlo[i][2],vlo[i][3],vhi[i][0],vhi[i][1],vhi[i][2],vhi[i][3]}
  #define PIN(x) asm volatile("":"+v"(x))
  #define MX3(a,b,c) __builtin_fmaxf(__builtin_fmaxf((a),(b)),(c))
  #define GAPA(MF,A0,A1,A2,A3,W0,W1,PW) do{ MF; sacc+=A0; sacc+=A1; sacc+=A2; sacc+=A3; PIN(sacc); W0; W1; PIN(PW); SBAR(); }while(0)
  #define EX(v) __builtin_amdgcn_exp2f(v)
  #define GAPB(MF,X,B) do{ MF; X[B]=EX(X[B]); X[B+1]=EX(X[B+1]); X[B+2]=EX(X[B+2]); X[B+3]=EX(X[B+3]); PIN(X); SBAR(); }while(0)
  #define VRD(i) do{ vlo[i]=vtr(vp_+(((i)>>2)*4096+((i)&3)*1024)); vhi[i]=vtr(vp_+(((i)>>2)*4096+((i)&3)*1024+512)); }while(0)
  #define VLD(S,i,OFF) do{ vlo[S]=vtr(vp_+(OFF)+(((i)>>2)*4096+((i)&3)*1024)); vhi[S]=vtr(vp_+(OFF)+(((i)>>2)*4096+((i)&3)*1024+512)); }while(0)
  #define GAPB3(MF,X,B,LD) do{ MF; LD; X[B]=EX(X[B]); X[B+1]=EX(X[B+1]); X[B+2]=EX(X[B+2]); X[B+3]=EX(X[B+3]); PIN(X); SBAR(); }while(0)
  #define KRD(G,j) do{ if(G){ kload2(kf,kp0+sl_next,j); SBAR(); } }while(0)
  #define STEP(C0,C1,P0,P1,t,GK,GV,GL) do{ SBAR(); \
    const lds_cptr vp_=vp0+sl_prev; \
    VLD(0,0,0); SBAR(); float sacc=(P0[0]+P0[1]); \
    GAPA(C0=__builtin_amdgcn_mfma_f32_32x32x16_bf16(kf[0],qr[0],C0,0,0,0), P0[2],P0[3],P0[4],P0[5],     pw0[0]=PKW(P0,0), pw0[1]=PKW(P0,2), pw0); \
    VLD(1,4,0); SBAR(); GAPA(C1=__builtin_amdgcn_mfma_f32_32x32x16_bf16(kf[1],qr[0],C1,0,0,0), P0[6],P0[7],P0[8],P0[9],     pw0[2]=PKW(P0,4), pw0[3]=PKW(P0,6), pw0); \
    VLD(2,1,0); SBAR(); GAPA(C0=__builtin_amdgcn_mfma_f32_32x32x16_bf16(kf[2],qr[1],C0,0,0,0),   P0[10],P0[11],P0[12],P0[13], pw1[0]=PKW(P0,8), pw1[1]=PKW(P0,10), pw1); \
    VLD(3,5,0); SBAR(); GAPA(C1=__builtin_amdgcn_mfma_f32_32x32x16_bf16(kf[3],qr[1],C1,0,0,0),   P0[14],P0[15],P1[0],P1[1],   pw1[2]=PKW(P0,12),pw1[3]=PKW(P0,14), pw1); \
    GAPA(C0=__builtin_amdgcn_mfma_f32_32x32x16_bf16(kf[4],qr[2],C0,0,0,0),   P1[2],P1[3],P1[4],P1[5],     pw2[0]=PKW(P1,0), pw2[1]=PKW(P1,2), pw2); \
    GAPA(C1=__builtin_amdgcn_mfma_f32_32x32x16_bf16(kf[5],qr[2],C1,0,0,0),   P1[6],P1[7],P1[8],P1[9],     pw2[2]=PKW(P1,4), pw2[3]=PKW(P1,6), pw2); \
    GAPA(C0=__builtin_amdgcn_mfma_f32_32x32x16_bf16(kf[6],qr[3],C0,0,0,0),   P1[10],P1[11],P1[12],P1[13], pw3[0]=PKW(P1,8), pw3[1]=PKW(P1,10), pw3); \
    GAPA(C1=__builtin_amdgcn_mfma_f32_32x32x16_bf16(kf[7],qr[3],C1,0,0,0),   P1[14],P1[15],0.f,0.f,       pw3[2]=PKW(P1,12),pw3[3]=PKW(P1,14), pw3); \
    l_reg+=sacc; \
    if(GK){DMA_K((t)+3,sl_cur);} if(GV){DMA_V((t)+1,sl_next);} \
    CMASK(C0,C1,t); \
    { float a=MX3(C0[0],C0[1],C1[0]),b=MX3(C0[2],C0[3],C1[1]); a=MX3(a,C1[2],C1[3]); \
      _Pragma("unroll") for(int r=4;r<16;r+=4){a=MX3(a,C0[r],C0[r+1]);b=MX3(b,C0[r+2],C0[r+3]);a=MX3(a,C1[r],C1[r+1]);b=MX3(b,C1[r+2],C1[r+3]);} \
      float rm=__builtin_fmaxf(a,b); { auto rr=__builtin_amdgcn_permlane32_swap(__float_as_uint(rm),__float_as_uint(rm),false,false); rm=__builtin_fmaxf(__uint_as_float(rr[0]),__uint_as_float(rr[1])); } \
      resc=false; \
      if(__builtin_expect(__any(rm>(float)THRL),0)){ const float dl=__builtin_fmaxf(rm,0.f); mhat+=dl; \
        _Pragma("unroll") for(int r=0;r<16;++r){C0[r]-=dl;C1[r]-=dl;} \
        \
        const float f=__builtin_amdgcn_exp2f(-dl); l_reg*=f; if(hi==0)wsf[r32]=f; resc=true; } } \
    SBAR(); \
    GAPB3(o[0]=__builtin_amdgcn_mfma_f32_32x32x16_bf16(PAF(0),VFR(0),o[0],0,0,0), C0,0, VLD(0,2,0)); \
    GAPB3(o[1]=__builtin_amdgcn_mfma_f32_32x32x16_bf16(PAF(0),VFR(1),o[1],0,0,0), C0,4, VLD(1,6,0)); \
    KRD(GL,0); GAPB3(o[0]=__builtin_amdgcn_mfma_f32_32x32x16_bf16(PAF(1),VFR(2),o[0],0,0,0), C0,8, VLD(2,3,0)); \
    KRD(GL,1); GAPB3(o[1]=__builtin_amdgcn_mfma_f32_32x32x16_bf16(PAF(1),VFR(3),o[1],0,0,0), C0,12, VLD(3,7,0)); \
    KRD(GL,2); GAPB3(o[0]=__builtin_amdgcn_mfma_f32_32x32x16_bf16(PAF(2),VFR(0),o[0],0,0,0), C1,0, VLD(0,0,V2OFF)); \
    KRD(GL,3); GAPB3(o[1]=__builtin_amdgcn_mfma_f32_32x32x16_bf16(PAF(2),VFR(1),o[1],0,0,0), C1,4, VLD(1,4,V2OFF)); \
    GAPB3(o[0]=__builtin_amdgcn_mfma_f32_32x32x16_bf16(PAF(3),VFR(2),o[0],0,0,0), C1,8, VLD(2,1,V2OFF)); \
    GAPB3(o[1]=__builtin_amdgcn_mfma_f32_32x32x16_bf16(PAF(3),VFR(3),o[1],0,0,0), C1,12, VLD(3,5,V2OFF)); \
    const float nm_=-mhat; \
    o[2]=__builtin_amdgcn_mfma_f32_32x32x16_bf16(PAF(0),VFR(0),o[2],0,0,0); VLD(0,2,V2OFF); P0[0]=nm_;P0[1]=nm_;P0[2]=nm_;P0[3]=nm_; PIN(P0); SBAR(); \
    o[3]=__builtin_amdgcn_mfma_f32_32x32x16_bf16(PAF(0),VFR(1),o[3],0,0,0); VLD(1,6,V2OFF); P0[4]=nm_;P0[5]=nm_;P0[6]=nm_;P0[7]=nm_; PIN(P0); SBAR(); \
    o[2]=__builtin_amdgcn_mfma_f32_32x32x16_bf16(PAF(1),VFR(2),o[2],0,0,0); VLD(2,3,V2OFF); P0[8]=nm_;P0[9]=nm_;P0[10]=nm_;P0[11]=nm_; PIN(P0); SBAR(); \
    o[3]=__builtin_amdgcn_mfma_f32_32x32x16_bf16(PAF(1),VFR(3),o[3],0,0,0); VLD(3,7,V2OFF); P0[12]=nm_;P0[13]=nm_;P0[14]=nm_;P0[15]=nm_; PIN(P0); SBAR(); \
    o[2]=__builtin_amdgcn_mfma_f32_32x32x16_bf16(PAF(2),VFR(0),o[2],0,0,0); P1[0]=nm_;P1[1]=nm_;P1[2]=nm_;P1[3]=nm_; PIN(P1); SBAR(); \
    o[3]=__builtin_amdgcn_mfma_f32_32x32x16_bf16(PAF(2),VFR(1),o[3],0,0,0); P1[4]=nm_;P1[5]=nm_;P1[6]=nm_;P1[7]=nm_; PIN(P1); SBAR(); \
    o[2]=__builtin_amdgcn_mfma_f32_32x32x16_bf16(PAF(3),VFR(2),o[2],0,0,0); P1[8]=nm_;P1[9]=nm_;P1[10]=nm_;P1[11]=nm_; PIN(P1); SBAR(); \
    o[3]=__builtin_amdgcn_mfma_f32_32x32x16_bf16(PAF(3),VFR(3),o[3],0,0,0); P1[12]=nm_;P1[13]=nm_;P1[14]=nm_;P1[15]=nm_; PIN(P1); SBAR(); \
    }while(0)
  _Pragma("unroll") for(int r=0;r<16;++r){pB0[r]=-mhat;pB1[r]=-mhat;}
  int t=1;
  #undef CMASK
  #define CMASK(P0,P1,t) do{}while(0)
  for(;t+5<NT;t+=2){
    STEP(pB0,pB1,pA0,pA1,t,true,true,true);     WAIT_BAR(3); RESC(); ROT();
    STEP(pA0,pA1,pB0,pB1,t+1,true,true,true);   WAIT_BAR(3); RESC(); ROT();
  }
  #undef CMASK
  int hi_b=hi,qrel_b=qrel; asm volatile("":"+v"(hi_b),"+v"(qrel_b));
  #define CMASK(P0,P1,t) do{int jb_=(t)-(NT-4); if(jb_>=0)cmask(P0,P1,jb_,qrel_b,hi_b);}while(0)
  #define ENDW(tt) do{ if((tt)+3<NT){WAIT_BAR(3);} else if((tt)+2<NT){WAIT_BAR(2);} else {WAIT_BAR(0);} }while(0)
  for(;t+1<NT;t+=2){
    STEP(pB0,pB1,pA0,pA1,t,(t+3<NT),(t+1<NT),(t+1<NT));       ENDW(t);   RESC(); ROT();
    STEP(pA0,pA1,pB0,pB1,t+1,(t+4<NT),(t+2<NT),(t+2<NT));     ENDW(t+1); RESC(); ROT();
  }
  STEP(pB0,pB1,pA0,pA1,NT-1,false,false,false); RESC();
  { float sacc=pB0[0]+pB0[1]; _Pragma("unroll") for(int r=2;r<16;++r)sacc+=pB0[r]; _Pragma("unroll") for(int r=0;r<16;++r)sacc+=pB1[r]; l_reg+=sacc;
    pw0=(u32x4){PKW(pB0,0),PKW(pB0,2),PKW(pB0,4),PKW(pB0,6)};pw1=(u32x4){PKW(pB0,8),PKW(pB0,10),PKW(pB0,12),PKW(pB0,14)};pw2=(u32x4){PKW(pB1,0),PKW(pB1,2),PKW(pB1,4),PKW(pB1,6)};pw3=(u32x4){PKW(pB1,8),PKW(pB1,10),PKW(pB1,12),PKW(pB1,14)};
    SBAR(); pv(o,vb0+sl_cur,PAF(0),PAF(1),PAF(2),PAF(3)); pv(o+2,vb0+V2OFF+sl_cur,PAF(0),PAF(1),PAF(2),PAF(3)); }
  #undef PKW
  #undef PAF
  #undef VFR
  #undef PIN
  #undef MX3
  #undef GAPA
  #undef GAPB
  #undef EX
  #undef VRD
  #undef KRD
  #undef VLD
  #undef GAPB3
  #undef STEP
  #undef ENDW
  {auto rr=__builtin_amdgcn_permlane32_swap(__float_as_uint(l_reg),__float_as_uint(l_reg),false,false);l_reg=__uint_as_float(rr[0])+__uint_as_float(rr[1]);}
  if(hi==0)wsf[32+r32]=l_reg;asm volatile("s_waitcnt lgkmcnt(0)":::"memory");
  float rli[16];
  #pragma unroll
  for(int r=0;r<16;++r)rli[r]=__builtin_amdgcn_rcpf(wsf[32+crow(r,hi)]);
  bf16*Ow=O+(rowbase+q0+wid*QBLK)*OP;
  { bf16*stg=(bf16*)(shm+LDS2_OST)+wid*2048;
    #pragma unroll
    for(int hh=0;hh<2;++hh){
      #pragma unroll
      for(int r=0;r<16;++r){const int orow=crow(r,hi);
        #pragma unroll
        for(int d0=0;d0<2;++d0)stg[orow*64+d0*32+r32]=__float2bfloat16(o[2*hh+d0][r]*rli[r]);}
      asm volatile("s_waitcnt lgkmcnt(0)":::"memory");
      #pragma unroll
      for(int i=0;i<4;++i){const int row=i*8+(lane>>3),ch=lane&7; const u32x4 v=*(const u32x4*)(stg+row*64+ch*8); ATTN_STORE16(Ow+(long)row*OP+hh*64+ch*8,v);}
      asm volatile("s_waitcnt lgkmcnt(0)":::"memory"); } }
  asm volatile("s_waitcnt lgkmcnt(0)\n\ts_barrier":::"memory");
  #undef DMA_K
  #undef DMA_V
  #undef CMASK
  #undef START
  #undef RESC
  #undef ROT
}
constexpr int ATTN_LDS_BYTES=LDS_BYTES;
#undef SBAR
#undef WAIT_BAR
}
#define GAS __attribute__((address_space(1)))
#define LAS __attribute__((address_space(3)))
typedef unsigned short bf16;
typedef unsigned v4u __attribute__((ext_vector_type(4)));
typedef float f32x4 __attribute__((ext_vector_type(4)));
typedef short bf16x8 __attribute__((ext_vector_type(8)));
typedef GAS unsigned gu32;
typedef GAS unsigned long long gu64;
#define RLX_AGENT __ATOMIC_RELAXED, __HIP_MEMORY_SCOPE_AGENT
#define LDS_WAIT() asm volatile("s_waitcnt lgkmcnt(0)" ::: "memory")
#define VM_WAIT() asm volatile("s_waitcnt vmcnt(0)" ::: "memory")
__device__ __forceinline__ unsigned long long rt() { return __builtin_amdgcn_s_memrealtime(); }
__device__ __forceinline__ unsigned f2bf(float f) { unsigned u = __builtin_bit_cast(unsigned, f); return (u + 0x7fffu + ((u >> 16) & 1u)) >> 16; }
__device__ __forceinline__ unsigned pk2(float lo, float hi) { return f2bf(lo) | (f2bf(hi) << 16); }

#define XB_TMO      128
#define XB_XCNT(j)  (256  + 64 * (j))
#define XB_XSUB(j)  (1280 + 64 * (j))
#define XB_XGEN(j)  (2304 + 64 * (j))
#define XB_TOP      3328
#define XB_TOPGEN   3392
#define XCD_BAR_WORDS 3456
#define XB_SPIN_CAP (1u << 18)

__device__ __forceinline__ unsigned xb_ld(unsigned* p)              { return __hip_atomic_load(p, __ATOMIC_RELAXED, __HIP_MEMORY_SCOPE_AGENT); }
__device__ __forceinline__ unsigned xb_add(unsigned* p, unsigned v) { return __hip_atomic_fetch_add(p, v, __ATOMIC_RELAXED, __HIP_MEMORY_SCOPE_AGENT); }
__device__ __forceinline__ unsigned xb_xcc_id() { return (unsigned)__builtin_amdgcn_s_getreg((3 << 11) | 20) & 0xFu; }
#define XB_SPIN(cond, bar) do { unsigned _sp = 0; while (cond) { __builtin_amdgcn_s_sleep(1); \
    if ((++_sp & 255u) == 0u) { if (xb_ld(&(bar)[XB_TMO])) break; if (_sp > XB_SPIN_CAP) { atomicAdd(&(bar)[XB_TMO], 1u); break; } } } } while (0)

struct XcdBarrier {
    unsigned* bar; unsigned x;
    volatile LAS unsigned* st;
};

__device__ __forceinline__ XcdBarrier xcd_barrier_post(unsigned* bar, volatile LAS unsigned* st) {
    XcdBarrier b; b.bar = bar; b.x = xb_xcc_id(); b.st = st;
    if (threadIdx.x == 0) { const unsigned r_ = xb_add(&bar[XB_XCNT(b.x)], 1u); st[2] = r_; st[3] = b.x; }
    return b;
}
__device__ __forceinline__ void xcd_barrier_complete(unsigned* bar, unsigned x, unsigned& nloc, unsigned& nx, unsigned& regular) {
    const unsigned G = gridDim.x * gridDim.y * gridDim.z;
    unsigned sum, cnt, mine, sp = 0u;
    for (;;) {
        sum = 0u; cnt = 0u; mine = 0u; regular = 1u;
#pragma unroll
        for (unsigned j = 0; j < 16; ++j) { const unsigned c = xb_ld(&bar[XB_XCNT(j)]); sum += c; cnt += (c > 0u) ? 1u : 0u; mine = (j == x) ? c : mine; regular &= (c == 0u || c == 32u) ? 1u : 0u; }
        if (sum == G) break;
        __builtin_amdgcn_s_sleep(1);
        if ((++sp & 255u) == 0u) { if (xb_ld(&bar[XB_TMO])) break; if (sp > XB_SPIN_CAP) { atomicAdd(&bar[XB_TMO], 1u); break; } }
    }
    nloc = mine > 0u ? mine : 1u; nx = cnt > 0u ? cnt : 1u; regular = (regular != 0u && cnt == 8u && sum == G) ? 1u : 0u;
}

__device__ __forceinline__ void xcd_barrier(const XcdBarrier& b, int wave_) {
    asm volatile("s_waitcnt vmcnt(0)" ::: "memory");
    __syncthreads();
    if (wave_ == 0 && lane_id_now() == 0) {
        unsigned* bar = b.bar;
        __builtin_amdgcn_s_waitcnt(0);
        unsigned nloc = b.st[0], nx = b.st[1];
        if (nloc == 0u) { unsigned reg_; xcd_barrier_complete(bar, b.x, nloc, nx, reg_); b.st[0] = nloc; b.st[1] = nx; b.st[5] = reg_; }
        const unsigned old = xb_add(&bar[XB_XSUB(b.x)], 1u);
        const unsigned gen = old / nloc;
        if (old + 1u == (gen + 1u) * nloc) {
            __builtin_amdgcn_fence(__ATOMIC_RELEASE, "agent");
            asm volatile("s_waitcnt vmcnt(0)" ::: "memory");
            const unsigned og = xb_add(&bar[XB_TOP], 1u);
            const unsigned tg = og / nx;
            if (og + 1u == (tg + 1u) * nx) xb_add(&bar[XB_TOPGEN], 1u);
            else XB_SPIN(xb_ld(&bar[XB_TOPGEN]) == tg, bar);
            __builtin_amdgcn_fence(__ATOMIC_ACQUIRE, "agent");
            xb_add(&bar[XB_XGEN(b.x)], 1u);
            asm volatile("s_waitcnt vmcnt(0)" ::: "memory");
        } else {
            XB_SPIN(xb_ld(&bar[XB_XGEN(b.x)]) == gen, bar);
            __builtin_amdgcn_fence(__ATOMIC_ACQUIRE, "agent");
            asm volatile("s_waitcnt vmcnt(0)" ::: "memory");
        }
    }
    __syncthreads();
}
constexpr int NWAVES = 8;
constexpr int BATCH = 4, T = 4096, D = 1024, M = BATCH * T;
constexpr int NPROJ = 5120;
constexpr int NE = 32, TOPK = 4, FF = 1024;
constexpr int MAXT = (M * TOPK) / 256 + NE;
constexpr float EPS = 1e-5f;
constexpr float F8_XSCALE = 32.0f, F8_WSCALE = 512.0f, F8_ASCALE = 8.0f, F8_YSCALE = 64.0f;
constexpr float LAMBDA_INIT = 0.2f;

constexpr size_t MiB = 1u << 20;
constexpr size_t WS_CTL = 0, CTL_ZERO_BYTES = 128 * 1024;
constexpr size_t WS_ROPE = 1 * MiB;
constexpr size_t WS_ROUTE = 2 * MiB;
constexpr size_t WS_WLG = 3 * MiB;
constexpr size_t WS_WGU = 4 * MiB;
constexpr size_t WS_WD = 132 * MiB;
constexpr size_t WS_WIN = 196 * MiB;
constexpr size_t WS_WDA = 206 * MiB, WS_WSB = 207 * MiB, WS_WO = 208 * MiB;
constexpr size_t WS_A0 = 210 * MiB;
constexpr size_t WS_H = WS_A0;
constexpr size_t WS_P = WS_A0 + 32 * MiB;
constexpr size_t WS_VBT = WS_A0 + 192 * MiB;
constexpr size_t WS_ODA = WS_A0 + 208 * MiB;
constexpr size_t WS_DA = WS_A0 + 240 * MiB;
constexpr size_t WS_SB = WS_A0 + 256 * MiB;
constexpr size_t WS_YS = WS_A0 + 144 * MiB;
constexpr size_t WS_ACT = WS_A0;
constexpr size_t WS_LIST = WS_A0 + 288 * MiB;
constexpr size_t WS_END = WS_A0 + 292 * MiB;
static_assert(WS_SB + 16 * MiB <= WS_END && WS_END <= 512 * MiB, "d_ws map");
constexpr int CW_TMO = 0, CW_CODE = 1;
constexpr int CW_CNT = 1024;
constexpr int CW_BAR = 4096;
constexpr int CW_RANK = 8192;
constexpr int CW_GRP = 9216;
constexpr int CW_XL = 13312;
constexpr int CW_RDY = 14336;
static_assert((CW_RDY + 16 * MAXT) * 4 <= (int)CTL_ZERO_BYTES, "control words");

constexpr int RING_OFF = 0, RING_BYTES = 131072;
constexpr int RT_STRIDE = 36, RT_BYTES = 1024 * RT_STRIDE * 4;
constexpr int LDSCTL_OFF = 147456, MISC_OFF = LDSCTL_OFF + 320, TAB_OFF = LDSCTL_OFF + 1024;
constexpr int JUNK_OFF = RING_BYTES, TOK_OFF = RING_BYTES;
constexpr int EPISTG_OFF = LDSCTL_OFF + 4096;
constexpr int LDS_BYTES = 163840;
static_assert(RT_BYTES <= LDSCTL_OFF && TAB_OFF + 4 * 768 <= LDS_BYTES && TOK_OFF + 16384 <= LDSCTL_OFF, "LDS map");
#define LANE_NOW (lane_id_now())
struct Frame {
    LAS unsigned char* lds;
    volatile LAS unsigned* MISC;
    gu32* ctl;
    int wave;
    int vcu, G;
};
__device__ __forceinline__ float wave_sum(float v) {
#pragma unroll
    for (int o = 1; o < 64; o <<= 1) v += __shfl_xor(v, o);
    return v;
}
__device__ __forceinline__ unsigned cvtpk2(float lo, float hi) { unsigned r; asm volatile("v_cvt_pk_bf16_f32 %0, %1, %2" : "=v"(r) : "v"(lo), "v"(hi)); return r; }
__device__ __forceinline__ void tb_load(float (&tv)[32], const float* W, int ldw, int lane) {
#pragma unroll
    for (int i = 0; i < 32; ++i) tv[i] = __builtin_nontemporal_load(W + (size_t)(2 * i + (lane >> 5)) * ldw + (lane & 31));
}
__device__ __forceinline__ void tb_finish(const float (&tv)[32], bf16* WT, int ldt, const float* gk, LAS float* scr, int lane) {
    if (gk) {
#pragma unroll
        for (int i = 0; i < 32; ++i) scr[(2 * i + (lane >> 5)) * 33 + (lane & 31)] = tv[i] * gk[2 * i + (lane >> 5)];
    } else {
#pragma unroll
        for (int i = 0; i < 32; ++i) scr[(2 * i + (lane >> 5)) * 33 + (lane & 31)] = tv[i];
    }
    LDS_WAIT(); asm volatile("" ::: "memory");
    const int c = lane & 7;
#pragma unroll
    for (int j = 0; j < 4; ++j) { const int n = (lane >> 3) + 8 * j; const LAS float* s = scr + (8 * c) * 33 + n;
        v4u o; o.x = cvtpk2(s[0 * 33], s[1 * 33]); o.y = cvtpk2(s[2 * 33], s[3 * 33]); o.z = cvtpk2(s[4 * 33], s[5 * 33]); o.w = cvtpk2(s[6 * 33], s[7 * 33]);
        __builtin_nontemporal_store(o, (GAS v4u*)(WT + (size_t)n * ldt + 8 * c)); }
    LDS_WAIT(); asm volatile("" ::: "memory");
}
struct XItem { const float* src; int ldw; bf16* dst; int ldt; const float* gk; bf16* dst2; float f8; };
__device__ __forceinline__ void tb_load64(float (&tv)[64], const float* W, int ldw, int lane) {
#pragma unroll
    for (int i = 0; i < 64; ++i) tv[i] = __builtin_nontemporal_load(W + (size_t)i * ldw + lane);
}
__device__ __forceinline__ void tb_finish64(const float (&tv)[64], const XItem& it, LAS float* scr, int lane) {
    if (it.f8 != 0.f) {
#pragma unroll
        for (int i = 0; i < 64; ++i) scr[i * 65 + lane] = __builtin_amdgcn_fmed3f(tv[i] * (it.gk ? it.gk[i] * it.f8 : it.f8), -448.0f, 448.0f);
        LDS_WAIT(); asm volatile("" ::: "memory");
        const int c4 = lane & 3;
#pragma unroll
        for (int j = 0; j < 4; ++j) { const int n = (lane >> 2) + 16 * j; const LAS float* s = scr + (16 * c4) * 65 + n; int w[4];
#pragma unroll
            for (int q = 0; q < 4; ++q) { int t = 0; t = __builtin_amdgcn_cvt_pk_fp8_f32(s[(4 * q) * 65], s[(4 * q + 1) * 65], t, false); t = __builtin_amdgcn_cvt_pk_fp8_f32(s[(4 * q + 2) * 65], s[(4 * q + 3) * 65], t, true); w[q] = t; }
            v4u o; o.x = (unsigned)w[0]; o.y = (unsigned)w[1]; o.z = (unsigned)w[2]; o.w = (unsigned)w[3];
            __builtin_nontemporal_store(o, (GAS v4u*)((unsigned char*)it.dst + (size_t)n * 64 + 16 * c4)); }
        LDS_WAIT(); asm volatile("" ::: "memory");
        return;
    }
    if (it.gk) {
#pragma unroll
        for (int i = 0; i < 64; ++i) scr[i * 65 + lane] = tv[i] * it.gk[i];
    } else {
#pragma unroll
        for (int i = 0; i < 64; ++i) scr[i * 65 + lane] = tv[i];
    }
    LDS_WAIT(); asm volatile("" ::: "memory");
    const int c = lane & 7;
#pragma unroll
    for (int j = 0; j < 8; ++j) { const int n = (lane >> 3) + 8 * j; const LAS float* s = scr + (8 * c) * 65 + n;
        v4u o; o.x = cvtpk2(s[0 * 65], s[1 * 65]); o.y = cvtpk2(s[2 * 65], s[3 * 65]); o.z = cvtpk2(s[4 * 65], s[5 * 65]); o.w = cvtpk2(s[6 * 65], s[7 * 65]);
        bf16* rowp = (j < 4) ? it.dst + (size_t)n * it.ldt : it.dst2 + (size_t)(n - 32) * it.ldt;
        *(GAS v4u*)(rowp + 8 * c) = o; }
    LDS_WAIT(); asm volatile("" ::: "memory");
}
__device__ __forceinline__ void rms_row_to_bf16(int lane, const float* xrow, const float* g, bf16* orow) {
    const GAS f32x4* xr = (const GAS f32x4*)xrow + lane; const GAS f32x4* gr = (const GAS f32x4*)g + lane;
    f32x4 v[4]; float s = 0.f;
#pragma unroll
    for (int j = 0; j < 4; ++j) { v[j] = xr[64 * j]; s += (v[j].x * v[j].x + v[j].y * v[j].y) + (v[j].z * v[j].z + v[j].w * v[j].w); }
    const float rstd = 1.f / sqrtf(wave_sum(s) * (1.f / D) + EPS);
    GAS unsigned long long* o8 = (GAS unsigned long long*)orow + lane;
#pragma unroll
    for (int j = 0; j < 4; ++j) { const f32x4 gg = gr[64 * j]; const f32x4 y = v[j] * rstd * gg;
        o8[64 * j] = (unsigned long long)cvtpk2(y.x, y.y) | ((unsigned long long)cvtpk2(y.z, y.w) << 32); }
}

struct Args { const float* in[21]; float* out; unsigned char* ws; int ph_lo, ph_hi; };
__device__ const float INV_FREQ[32] = {1.000000000e+00f, 7.498942018e-01f, 5.623413324e-01f, 4.216965139e-01f, 3.162277639e-01f, 2.371373922e-01f, 1.778279394e-01f, 1.333521456e-01f, 1.000000015e-01f, 7.498941571e-02f, 5.623412877e-02f, 4.216964915e-02f, 3.162277862e-02f, 2.371373586e-02f, 1.778279431e-02f, 1.333521493e-02f, 9.999999776e-03f, 7.498942316e-03f, 5.623413250e-03f, 4.216964822e-03f, 3.162277862e-03f, 2.371373819e-03f, 1.778279431e-03f, 1.333521446e-03f, 1.000000047e-03f, 7.498941850e-04f, 5.623413017e-04f, 4.216965463e-04f, 3.162277862e-04f, 2.371373848e-04f, 1.778279402e-04f, 1.333521504e-04f};

__device__ __forceinline__ void p0_prologue(Frame& F, const Args& a, unsigned char* ws) {
    LAS float* scr = (LAS float*)(F.lds + RING_OFF + F.wave * 16384);
    const int gw = F.vcu * NWAVES + F.wave, NGW = F.G * NWAVES;
    const float* x = a.in[0]; const float* g_mix = a.in[1]; const float* w_in = a.in[2];
    const float* w_da = a.in[8]; const float* w_sb = a.in[9]; const float* w_o = a.in[10];
    const float* w_gate = a.in[14]; const float* w_up = a.in[16]; const float* w_down = a.in[18]; const float* g_ffn_p = a.in[11];
    bf16* WIN = (bf16*)(ws + WS_WIN); bf16* WDA = (bf16*)(ws + WS_WDA); bf16* WSB = (bf16*)(ws + WS_WSB); bf16* WO = (bf16*)(ws + WS_WO);
    bf16* WGU = (bf16*)(ws + WS_WGU); bf16* WD = (bf16*)(ws + WS_WD);
    constexpr int I_IN = 16 * 80, I_DA = 8 * 16, I_SB = 8 * 16, I_O = 16 * 16, I_EXP = 16 * 16;
    constexpr int NITEMS = I_IN + I_DA + I_SB + I_O + 96 * I_EXP;
    auto item = [&](int it) -> XItem {
        int r = it;
        if (r < I_IN) { const int kb = r / 80, nb = r % 80, n0 = 64 * nb;
            if (n0 < 1024) { const int pn = n0 >> 8, w = n0 & 255, drow = 256 * pn + 32 * (w >> 6);
                return XItem{w_in + (size_t)(64 * kb) * NPROJ + n0, NPROJ, WIN + (size_t)drow * 1024 + 64 * kb, 1024, nullptr, WIN + (size_t)(drow + 128) * 1024 + 64 * kb, 0.f}; }
            return XItem{w_in + (size_t)(64 * kb) * NPROJ + n0, NPROJ, WIN + (size_t)n0 * 1024 + 64 * kb, 1024, nullptr, WIN + (size_t)(n0 + 32) * 1024 + 64 * kb, 0.f}; }
        r -= I_IN;
        if (r < I_DA) { const int kb = r / 16, n0 = 64 * (r % 16); return XItem{w_da + (size_t)(64 * kb) * 1024 + n0, 1024, WDA + (size_t)n0 * 512 + 64 * kb, 512, nullptr, WDA + (size_t)(n0 + 32) * 512 + 64 * kb, 0.f}; }
        r -= I_DA;
        if (r < I_SB) { const int kb = r / 16, n0 = 64 * (r % 16); return XItem{w_sb + (size_t)(64 * kb) * 1024 + n0, 1024, WSB + (size_t)n0 * 512 + 64 * kb, 512, nullptr, WSB + (size_t)(n0 + 32) * 512 + 64 * kb, 0.f}; }
        r -= I_SB;
        if (r < I_O) { const int kb = r / 16, n0 = 64 * (r % 16); return XItem{w_o + (size_t)(64 * kb) * 1024 + n0, 1024, WO + (size_t)n0 * 1024 + 64 * kb, 1024, nullptr, WO + (size_t)(n0 + 32) * 1024 + 64 * kb, 0.f}; }
        r -= I_O;
        const int mat = r / I_EXP, q = r % I_EXP, kb = q / 16, n0 = 64 * (q % 16), e = mat / 3, kind = mat % 3;
        const size_t eoff = (size_t)e * 1024 * 1024;
        if (kind == 2) { unsigned char* d = (unsigned char*)WD + (((size_t)e * 16 + kb) * 1024 + n0) * 64; return XItem{w_down + eoff + (size_t)(64 * kb) * 1024 + n0, 1024, (bf16*)d, 1024, nullptr, (bf16*)d, F8_WSCALE}; }
        unsigned char* d = (unsigned char*)WGU + (((size_t)e * 16 + kb) * 2048 + 256 * (n0 >> 7) + (kind == 1 ? 128 : 0) + (n0 & 127)) * 64;
        return XItem{(kind == 0 ? w_gate : w_up) + eoff + (size_t)(64 * kb) * 1024 + n0, 1024, (bf16*)d, 1024, g_ffn_p + 64 * kb, (bf16*)d, F8_WSCALE};
    };
    { LAS float* scr64 = (LAS float*)(F.lds + F.wave * 16640);
      float tvn[64]; XItem nx = item(gw < NITEMS ? gw : 0);
      if (gw < NITEMS) tb_load64(tvn, nx.src, nx.ldw, LANE_NOW);
      for (int it = gw; it < NITEMS; it += NGW) {
          const XItem cu = nx; float tv[64];
#pragma unroll
          for (int i = 0; i < 64; ++i) tv[i] = tvn[i];
          if (it + NGW < NITEMS) { nx = item(it + NGW); tb_load64(tvn, nx.src, nx.ldw, LANE_NOW); }
          tb_finish64(tv, cu, scr64, LANE_NOW);
      } }
    bf16* H = (bf16*)(ws + WS_H);
    { const int lane_ = LANE_NOW; const GAS f32x4* gr = (const GAS f32x4*)g_mix + lane_; f32x4 gg[4];
#pragma unroll
      for (int j = 0; j < 4; ++j) gg[j] = gr[64 * j];
      for (int mb = gw; mb < M; mb += 8 * NGW) { f32x4 v[8][4];
#pragma unroll
          for (int i = 0; i < 8; ++i) { const int mm = (mb + i * NGW < M) ? mb + i * NGW : mb; const GAS f32x4* xr = (const GAS f32x4*)(x + (size_t)mm * D) + lane_;
#pragma unroll
              for (int j = 0; j < 4; ++j) v[i][j] = __builtin_nontemporal_load(xr + 64 * j); }
#pragma unroll
          for (int i = 0; i < 8; ++i) { const int mrow = mb + i * NGW; if (mrow >= M) break; float s = 0.f;
#pragma unroll
              for (int j = 0; j < 4; ++j) s += (v[i][j].x * v[i][j].x + v[i][j].y * v[i][j].y) + (v[i][j].z * v[i][j].z + v[i][j].w * v[i][j].w);
              const float rstd = 1.f / sqrtf(wave_sum(s) * (1.f / D) + EPS);
              GAS unsigned long long* o8 = (GAS unsigned long long*)(H + (size_t)mrow * D) + lane_;
#pragma unroll
              for (int j = 0; j < 4; ++j) { const f32x4 y = v[i][j] * rstd * gg[j]; o8[64 * j] = (unsigned long long)cvtpk2(y.x, y.y) | ((unsigned long long)cvtpk2(y.z, y.w) << 32); } } } }
    { const float* w_r = a.in[12]; float* WLG = (float*)(ws + WS_WLG);
      for (int idx = gw * 64 + LANE_NOW; idx < 1024 * 32; idx += NGW * 64) { const int k = idx >> 5, e = idx & 31;
          WLG[(size_t)((((k >> 6) * 4 + ((k >> 4) & 3)) * 4 + ((k >> 2) & 3)) * 32 + e) * 4 + (k & 3)] = w_r[idx] * g_ffn_p[k]; } }
    float* rope = (float*)(ws + WS_ROPE);
    for (int idx = gw * 64 + LANE_NOW; idx < 4096 * 32; idx += NGW * 64) { const int pos = idx >> 5, i = idx & 31;
        const float ang = (float)pos * INV_FREQ[i];
        const double rev = (double)ang * 0.15915494309189535; const double fr = rev - __builtin_rint(rev); const float rf = (float)fr;
        rope[idx] = __builtin_amdgcn_cosf(rf); rope[4096 * 32 + idx] = __builtin_amdgcn_sinf(rf); }
}

typedef float f32x16 __attribute__((ext_vector_type(16)));
typedef short s16x4 __attribute__((ext_vector_type(4)));
__device__ __forceinline__ int crow_(int r, int hi) { return (r & 3) + 8 * (r >> 2) + 4 * hi; }
__device__ __forceinline__ void sb_item(int b, int h, int qt, const bf16* P, const bf16* VT, bf16* O, int lane_) {
    int lane = lane_; asm volatile("" : "+v"(lane));
    const int r32 = lane & 31, hi = lane >> 5;
    const int q0 = qt * 32; const size_t tokq = (size_t)b * T + q0 + r32;
    const bf16* Qp = P + tokq * NPROJ + 1536 + h * 64 + hi * 8;
    bf16x8 qf[4];
#pragma unroll
    for (int d0 = 0; d0 < 4; ++d0) qf[d0] = *(const bf16x8*)(Qp + d0 * 16);
    f32x16 o0, o1;
#pragma unroll
    for (int r = 0; r < 16; ++r) { o0[r] = 0.f; o1[r] = 0.f; }
    float R = 0.f;
    const bf16* Kb = P + ((size_t)b * T + r32) * NPROJ + 2048 + h * 64 + hi * 8;
    const bf16* Vb = VT + (size_t)(h * 64 + r32) * M + (size_t)b * T + 4 * hi;
    bf16x8 kfN[4]; s16x4 vlN[2][2], vhN[2][2];
#define SB_LOAD(kt_) do { const int kv0_ = (kt_) * 32; \
        _Pragma("unroll") for (int d0 = 0; d0 < 4; ++d0) kfN[d0] = *(const bf16x8*)(Kb + (size_t)kv0_ * NPROJ + d0 * 16); \
        _Pragma("unroll") for (int s = 0; s < 2; ++s) _Pragma("unroll") for (int d0 = 0; d0 < 2; ++d0) { const bf16* vp = Vb + (size_t)(d0 * 32) * M + kv0_ + 16 * s; vlN[s][d0] = *(const s16x4*)vp; vhN[s][d0] = *(const s16x4*)(vp + 8); } } while (0)
    SB_LOAD(qt);
    for (int kt = qt; kt >= 0; --kt) {
        bf16x8 kf[4]; s16x4 vl[2][2], vh[2][2];
#pragma unroll
        for (int d0 = 0; d0 < 4; ++d0) kf[d0] = kfN[d0];
#pragma unroll
        for (int s = 0; s < 2; ++s)
#pragma unroll
            for (int d0 = 0; d0 < 2; ++d0) { vl[s][d0] = vlN[s][d0]; vh[s][d0] = vhN[s][d0]; }
        if (kt > 0) SB_LOAD(kt - 1);
        f32x16 sc;
#pragma unroll
        for (int r = 0; r < 16; ++r) sc[r] = 0.f;
#pragma unroll
        for (int d0 = 0; d0 < 4; ++d0) sc = __builtin_amdgcn_mfma_f32_32x32x16_bf16(kf[d0], qf[d0], sc, 0, 0, 0);
        const int lim = (kt == qt) ? r32 : 64;
        float c[16];
#pragma unroll
        for (int r = 0; r < 16; ++r) { const float z = sc[r]; const float sp = fmaxf(z, 0.f) + __logf(1.0f + __expf(-fabsf(z))); c[r] = (crow_(r, hi) < lim) ? sp : 0.f; }
        float g[4], gp[4], Tt[4], A[4];
#pragma unroll
        for (int m = 0; m < 4; ++m) { g[m] = (c[4 * m] + c[4 * m + 1]) + (c[4 * m + 2] + c[4 * m + 3]); gp[m] = __shfl_xor(g[m], 32); Tt[m] = g[m] + gp[m]; }
        const float suf3 = 0.f, suf2 = Tt[3], suf1 = suf2 + Tt[2], suf0 = suf1 + Tt[1];
        A[0] = suf0 + (hi ? 0.f : gp[0]); A[1] = suf1 + (hi ? 0.f : gp[1]); A[2] = suf2 + (hi ? 0.f : gp[2]); A[3] = suf3 + (hi ? 0.f : gp[3]);
        float av[16];
#pragma unroll
        for (int m = 0; m < 4; ++m) { float run = R + A[m];
#pragma unroll
            for (int e = 3; e >= 0; --e) { const int r = 4 * m + e; run += c[r]; av[r] = (crow_(r, hi) < lim) ? __expf(sc[r] - run) : 0.f; } }
        R += suf0 + Tt[0];
        const bool sb_done = __all(R > 96.0f);
        v4u pw0, pw1;
        pw0.x = cvtpk2(av[0], av[1]); pw0.y = cvtpk2(av[2], av[3]); pw0.z = cvtpk2(av[4], av[5]); pw0.w = cvtpk2(av[6], av[7]);
        pw1.x = cvtpk2(av[8], av[9]); pw1.y = cvtpk2(av[10], av[11]); pw1.z = cvtpk2(av[12], av[13]); pw1.w = cvtpk2(av[14], av[15]);
        const bf16x8 pf0 = __builtin_bit_cast(bf16x8, pw0), pf1 = __builtin_bit_cast(bf16x8, pw1);
#define VF(s, d0) (bf16x8){vl[s][d0][0], vl[s][d0][1], vl[s][d0][2], vl[s][d0][3], vh[s][d0][0], vh[s][d0][1], vh[s][d0][2], vh[s][d0][3]}
        o0 = __builtin_amdgcn_mfma_f32_32x32x16_bf16(VF(0, 0), pf0, o0, 0, 0, 0);
        o1 = __builtin_amdgcn_mfma_f32_32x32x16_bf16(VF(0, 1), pf0, o1, 0, 0, 0);
        o0 = __builtin_amdgcn_mfma_f32_32x32x16_bf16(VF(1, 0), pf1, o0, 0, 0, 0);
        o1 = __builtin_amdgcn_mfma_f32_32x32x16_bf16(VF(1, 1), pf1, o1, 0, 0, 0);
#undef VF
        if (sb_done) break;
    }
#undef SB_LOAD
    bf16* Op = O + tokq * 512 + h * 64 + 4 * hi;
#pragma unroll
    for (int gi = 0; gi < 4; ++gi) {
        *(unsigned long long*)(Op + 8 * gi) = (unsigned long long)cvtpk2(o0[4 * gi], o0[4 * gi + 1]) | ((unsigned long long)cvtpk2(o0[4 * gi + 2], o0[4 * gi + 3]) << 32);
        *(unsigned long long*)(Op + 32 + 8 * gi) = (unsigned long long)cvtpk2(o1[4 * gi], o1[4 * gi + 1]) | ((unsigned long long)cvtpk2(o1[4 * gi + 2], o1[4 * gi + 3]) << 32);
    }
}


constexpr int SBL_KST = 448 * 16, SBL_V = 8 * SBL_KST, SBL_FLAG = 2 * SBL_V;
__device__ __forceinline__ void sb_unit(int wave, int b, int h, int qblk, const bf16* P, bf16* O, char* shm) {
    int lane = LANE_NOW; asm volatile("" : "+v"(lane));
    const int r32 = lane & 31, hi = lane >> 5;
    const int q0 = qblk * 256; const size_t tokq = (size_t)b * T + q0 + wave * 32 + r32;
    const int nb = (qblk == 0) ? 0 : 6;
    const unsigned lds0 = (unsigned)(uintptr_t)shm;
    typedef __attribute__((address_space(3))) const char* lptr;
    const lptr shm3 = (lptr)shm;
    volatile LAS unsigned* flags = (volatile LAS unsigned*)((LAS unsigned char*)shm3 + SBL_FLAG);
    const bf16* Kh = P + (size_t)b * T * NPROJ + 2048 + h * 64 + wave * 8;
    const bf16* Vh = P + (size_t)b * T * NPROJ + 2560 + h * 64 + (wave >> 2) * 32 + (lane & 3) * 8;
#define SB_DMA(start_, n64_) do { \
        for (int j_ = 0; j_ < (n64_); ++j_) { int rk_ = (start_) + 64 * j_ + lane; rk_ = rk_ < 0 ? 0 : rk_; int rv_ = (start_) + 64 * j_ + 16 * (wave & 3) + (lane >> 2); rv_ = rv_ < 0 ? 0 : rv_; \
            attn_body::glds16(Kh + (size_t)rk_ * NPROJ, (unsigned)__builtin_amdgcn_readfirstlane(lds0 + wave * SBL_KST + j_ * 1024)); \
            attn_body::glds16(Vh + (size_t)rv_ * NPROJ, (unsigned)__builtin_amdgcn_readfirstlane(lds0 + SBL_V + j_ * 8192 + wave * 1024)); } } while (0)
    int start = q0 - 32 * nb;
    SB_DMA(start, 7);
    if (wave == 0 && lane == 0) { flags[0] = 0u; flags[1] = 0u; }
    const bf16* Qp = P + tokq * NPROJ + 1536 + h * 64 + hi * 8;
    bf16x8 qf[4];
#pragma unroll
    for (int d0 = 0; d0 < 4; ++d0) qf[d0] = *(const bf16x8*)(Qp + d0 * 16);
    f32x16 o0, o1;
#pragma unroll
    for (int r = 0; r < 16; ++r) { o0[r] = 0.f; o1[r] = 0.f; }
    float R = 1.0f; bool done = false;
    const lptr kb = shm3 + hi * SBL_KST + r32 * 16;
    const lptr vb = shm3 + SBL_V + (4 * hi + ((lane & 15) >> 2)) * 64 + ((lane >> 4) & 1) * 32 + (lane & 3) * 8;
    for (int c = 0; ; ++c) {
        asm volatile("s_waitcnt vmcnt(0) lgkmcnt(0)\n\ts_barrier" ::: "memory");
        for (int jt = (c == 0) ? nb + wave : 7; jt >= 0 && !done; --jt) {
            if (start + 32 * jt < 0) break;
            bf16x8 kf[4];
#pragma unroll
            for (int d0 = 0; d0 < 4; ++d0) kf[d0] = *(const __attribute__((address_space(3))) bf16x8*)(kb + d0 * (2 * SBL_KST) + jt * 512);
            s16x4 vl[2][2], vh[2][2];
#pragma unroll
            for (int s = 0; s < 2; ++s)
#pragma unroll
                for (int d0 = 0; d0 < 2; ++d0) { const lptr vp = vb + (jt >> 1) * 8192 + d0 * 4096 + ((jt & 1) * 32 + 16 * s) * 64;
                    vl[s][d0] = __builtin_bit_cast(s16x4, __builtin_amdgcn_ds_read_tr16_b64_v4i16((__attribute__((address_space(3))) attn_body::v4i16_t*)vp));
                    vh[s][d0] = __builtin_bit_cast(s16x4, __builtin_amdgcn_ds_read_tr16_b64_v4i16((__attribute__((address_space(3))) attn_body::v4i16_t*)(vp + 512))); }
            f32x16 sc;
#pragma unroll
            for (int r = 0; r < 16; ++r) sc[r] = 0.f;
#pragma unroll
            for (int d0 = 0; d0 < 4; ++d0) sc = __builtin_amdgcn_mfma_f32_32x32x16_bf16(kf[d0], qf[d0], sc, 0, 0, 0);
            const int lim = (c == 0 && jt == nb + wave) ? r32 : 64;
            float cc[16];
#pragma unroll
            for (int r = 0; r < 16; ++r) { const float sg = __builtin_amdgcn_rcpf(1.0f + __builtin_amdgcn_exp2f(sc[r])); cc[r] = (crow_(r, hi) < lim) ? sg : 1.0f; }
            float g[4], gp[4], Tt[4], A[4];
#pragma unroll
            for (int m = 0; m < 4; ++m) { g[m] = (cc[4 * m] * cc[4 * m + 1]) * (cc[4 * m + 2] * cc[4 * m + 3]); gp[m] = __shfl_xor(g[m], 32); Tt[m] = g[m] * gp[m]; }
            const float suf3 = 1.0f, suf2 = Tt[3], suf1 = suf2 * Tt[2], suf0 = suf1 * Tt[1];
            A[0] = suf0 * (hi ? 1.0f : gp[0]); A[1] = suf1 * (hi ? 1.0f : gp[1]); A[2] = suf2 * (hi ? 1.0f : gp[2]); A[3] = suf3 * (hi ? 1.0f : gp[3]);
            float av[16];
#pragma unroll
            for (int m = 0; m < 4; ++m) { float run = R * A[m];
#pragma unroll
                for (int e = 3; e >= 0; --e) { const int r = 4 * m + e; av[r] = (1.0f - cc[r]) * run; run *= cc[r]; } }
            R *= suf0 * Tt[0];
            done = __all(R < 0x1p-40f);
            v4u pw0, pw1;
            pw0.x = cvtpk2(av[0], av[1]); pw0.y = cvtpk2(av[2], av[3]); pw0.z = cvtpk2(av[4], av[5]); pw0.w = cvtpk2(av[6], av[7]);
            pw1.x = cvtpk2(av[8], av[9]); pw1.y = cvtpk2(av[10], av[11]); pw1.z = cvtpk2(av[12], av[13]); pw1.w = cvtpk2(av[14], av[15]);
            const bf16x8 pf0 = __builtin_bit_cast(bf16x8, pw0), pf1 = __builtin_bit_cast(bf16x8, pw1);
#define VF(s, d0) (bf16x8){vl[s][d0][0], vl[s][d0][1], vl[s][d0][2], vl[s][d0][3], vh[s][d0][0], vh[s][d0][1], vh[s][d0][2], vh[s][d0][3]}
            o0 = __builtin_amdgcn_mfma_f32_32x32x16_bf16(VF(0, 0), pf0, o0, 0, 0, 0);
            o1 = __builtin_amdgcn_mfma_f32_32x32x16_bf16(VF(0, 1), pf0, o1, 0, 0, 0);
            o0 = __builtin_amdgcn_mfma_f32_32x32x16_bf16(VF(1, 0), pf1, o0, 0, 0, 0);
            o1 = __builtin_amdgcn_mfma_f32_32x32x16_bf16(VF(1, 1), pf1, o1, 0, 0, 0);
#undef VF
        }
        if (start <= 0) done = true;
        const int fb = c & 1;
        if (!done && lane == 0) flags[fb] = 1u;
        asm volatile("s_waitcnt lgkmcnt(0)\n\ts_barrier" ::: "memory");
        const unsigned want = flags[fb];
        if (wave == 0 && lane == 0) flags[fb ^ 1] = 0u;
        if (__builtin_amdgcn_readfirstlane(want) == 0u) break;
        start -= 256; SB_DMA(start, 4);
    }
    asm volatile("s_waitcnt lgkmcnt(0)\n\ts_barrier" ::: "memory");
#undef SB_DMA
    bf16* Op = O + tokq * 512 + h * 64 + 4 * hi;
#pragma unroll
    for (int gi = 0; gi < 4; ++gi) {
        *(unsigned long long*)(Op + 8 * gi) = (unsigned long long)cvtpk2(o0[4 * gi], o0[4 * gi + 1]) | ((unsigned long long)cvtpk2(o0[4 * gi + 2], o0[4 * gi + 3]) << 32);
        *(unsigned long long*)(Op + 32 + 8 * gi) = (unsigned long long)cvtpk2(o1[4 * gi], o1[4 * gi + 1]) | ((unsigned long long)cvtpk2(o1[4 * gi + 2], o1[4 * gi + 3]) << 32);
    }
}

__device__ __forceinline__ void cnt_barrier(unsigned* word, unsigned target, unsigned* bar, int wave_) {
    asm volatile("s_waitcnt vmcnt(0)" ::: "memory");
    __syncthreads();
    if (wave_ == 0 && lane_id_now() == 0) {
        __builtin_amdgcn_s_waitcnt(0);
        (void)xb_add(word, 1u);
        XB_SPIN(xb_ld(word) < target, bar);
        __builtin_amdgcn_fence(__ATOMIC_ACQUIRE, "agent");
        asm volatile("s_waitcnt vmcnt(0)" ::: "memory");
    }
    __syncthreads();
}
#define CG_WORD() ((int)__builtin_amdgcn_readfirstlane((int)F.MISC[12]))

__global__ void __launch_bounds__(NWAVES * 64, 2) mk_fwd(Args args) {
    extern __shared__ __attribute__((aligned(16))) unsigned char lds[];
    Frame F;
    F.lds = (LAS unsigned char*)lds;
    F.MISC = (volatile LAS unsigned*)(F.lds + MISC_OFF);
    F.wave = __builtin_amdgcn_readfirstlane((int)threadIdx.x >> 6);
    F.G = gridDim.x; { const int bx = blockIdx.x; F.vcu = (F.G % 8 == 0) ? (bx % 8) * (F.G / 8) + bx / 8 : bx; }
    unsigned char* ws = args.ws;
    F.ctl = (gu32*)(ws + WS_CTL);
    for (int u = (F.wave * 64 + LANE_NOW); u < (LDS_BYTES - LDSCTL_OFF) / 4; u += NWAVES * 64) ((LAS unsigned*)(F.lds + LDSCTL_OFF))[u] = 0u;
    __syncthreads();
    const int lo = args.ph_lo, hi_ = args.ph_hi;
    const bool one_launch = (hi_ - lo) > 1;
    XcdBarrier bar; bar.bar = (unsigned*)(F.ctl + CW_BAR); bar.x = 0; bar.st = nullptr;
    if (one_launch) bar = xcd_barrier_post((unsigned*)(F.ctl + CW_BAR), F.MISC + 8);
#ifndef PH_MASK
#define PH_MASK 0xffff
#endif
#define IN(k) ((((PH_MASK) >> (k)) & 1) && lo <= (k) && (k) < hi_)
#ifndef MK_PREFETCH
#define MK_PREFETCH 0
#endif
#ifndef PROBE_DUP
#define PROBE_DUP -1
#endif
#define NREP(k) ((PROBE_DUP == (k)) ? 2 : 1)
#define LSEAM(k, word, target) do { if (IN(k) && IN((k) + 1)) { if (grouped) cnt_barrier((unsigned*)(F.ctl + (word)), (target), (unsigned*)(F.ctl + CW_BAR), F.wave); else xcd_barrier(bar, F.wave); } } while (0)
#define SEAM(k) do { if (IN(k) && IN((k) + 1)) { xcd_barrier(bar, F.wave); if (PROBE_DUP == 20) xcd_barrier(bar, F.wave); } } while (0)
    const int gw = F.vcu * NWAVES + F.wave, NGW = F.G * NWAVES;

    bf16* WIN = (bf16*)(ws + WS_WIN); bf16* WDA = (bf16*)(ws + WS_WDA); bf16* WSB = (bf16*)(ws + WS_WSB); bf16* WO = (bf16*)(ws + WS_WO);
    bf16* WGU = (bf16*)(ws + WS_WGU); bf16* WD = (bf16*)(ws + WS_WD);
    bf16* H = (bf16*)(ws + WS_H); bf16* P = (bf16*)(ws + WS_P); bf16* VBT = (bf16*)(ws + WS_VBT); bf16* ODA = (bf16*)(ws + WS_ODA);
    bf16* DA = (bf16*)(ws + WS_DA); bf16* SBO = (bf16*)(ws + WS_SB); bf16* MX = (bf16*)(ws + WS_H);
    bf16* ACT = (bf16*)(ws + WS_ACT); bf16* YS = (bf16*)(ws + WS_YS);
    float* rope = (float*)(ws + WS_ROPE);
    int* tok_e = (int*)(ws + WS_ROUTE); int* tok_pos = tok_e + M * 4;
    float* rstd_tok = (float*)(ws + WS_ROUTE + 768 * 1024);
    int* list_tok = (int*)(ws + WS_LIST); float* list_gate = (float*)(ws + WS_LIST + 2 * MiB);
    bf16* X1 = (bf16*)args.out; constexpr int X1P = 2 * D;

    if (IN(0)) for (int rep_ = 0; rep_ < NREP(0); ++rep_) { p0_prologue(F, args, ws); }
    SEAM(0);
    if (IN(1)) {
        { pg8::Gemm g{H, WIN, M, NPROJ, D}; pg8::DupOrder S; S.S.init(M, NPROJ, F.G, (int)blockIdx.x); S.n = 5; S.reps = NREP(21);
          pg8::EpiInProj E{P, rope, 0.125f * 1.4426950408889634f};
          pg8::gemm_phase<pg8::EpiInProj, pg8::DupOrder, true, true>(F.lds + RING_OFF, g, S, E, F.wave); }
#ifdef SB_WAVE_FORM
        for (int rep_ = 0; rep_ < NREP(11); ++rep_)
        { pg8::Gemm g{WIN + (size_t)2560 * 1024, H, 512, M, D}; pg8::StaticOrder S; S.init(512, M, F.G, (int)blockIdx.x);
          pg8::EpiPlain E{VBT, M};
          pg8::gemm_phase<pg8::EpiPlain, pg8::StaticOrder, true, true>(F.lds + RING_OFF, g, S, E, F.wave); }
    #endif
    }
    SEAM(1);
    if (IN(2)) {
#ifndef DA_SPLIT_V
        for (int rep_ = 0; rep_ < NREP(2); ++rep_)
        for (int i = 0; i < 2; ++i) {
            const int bh = F.vcu >> 3, s = F.vcu & 7; const int qb = (i == 0) ? s : 15 - s;
            const int b = bh >> 3, hq = bh & 7;
            if (bh < BATCH * 8)
                attn_body::attn_unit2<8, NPROJ, NPROJ, NPROJ, 1024>(F.wave, b, qb, (const attn_body::bf16*)(P + hq * 64), (const attn_body::bf16*)(P + 512 + hq * 64),
                    (const attn_body::bf16*)(P + 1024 + (hq >> 1) * 128), (attn_body::bf16*)(ODA + hq * 128), (char*)lds + RING_OFF);
        }
#else
        for (int rep_ = 0; rep_ < NREP(2); ++rep_)
        for (int i = 0; i < 4; ++i) {
            const int bh = F.vcu >> 2, s = F.vcu & 3; const int qb = (i == 0) ? s : (i == 1) ? 7 - s : (i == 2) ? 8 + s : 15 - s;
            const int b = bh >> 4, vh = bh & 15;
            if (bh < BATCH * 16)
                attn_body::attn_unit<8, NPROJ, NPROJ, NPROJ, 1024>(F.wave, b, qb, (const attn_body::bf16*)(P + (vh >> 1) * 64), (const attn_body::bf16*)(P + 512 + (vh >> 1) * 64),
                    (const attn_body::bf16*)(P + 1024 + (vh >> 2) * 128 + (vh & 1) * 64), (attn_body::bf16*)(ODA + vh * 64), (char*)lds + RING_OFF);
        }
#endif
#ifndef SB_WAVE_FORM
        for (int rep_ = 0; rep_ < NREP(12); ++rep_)
        for (int i = 0; i < 2; ++i) {
            const int bh = F.vcu >> 3, s = F.vcu & 7; const int qblk = (i == 0) ? s : 15 - s;
            if (bh < BATCH * 8) sb_unit(F.wave, bh >> 3, bh & 7, qblk, P, SBO, (char*)lds + RING_OFF);
        }
#else
        for (int rep_ = 0; rep_ < NREP(12); ++rep_)
        for (int w = gw; w < 2048; w += NGW) { const int bh = w >> 6, j = w & 63; sb_item(bh >> 3, bh & 7, j, P, VBT, SBO, LANE_NOW); sb_item(bh >> 3, bh & 7, 127 - j, P, VBT, SBO, LANE_NOW); }
#endif
    }
    SEAM(2);
    { const bool reg_ = one_launch && F.MISC[13] != 0u && F.G == 256 && PROBE_DUP < 0 && F.MISC[10] < 32u && F.MISC[11] < 8u;
      if (F.wave == 0 && LANE_NOW == 0) F.MISC[12] = reg_ ? (0x10000u | (8u * F.MISC[10] + F.MISC[11])) : (unsigned)blockIdx.x;
      __syncthreads(); }
    const bool grouped = (CG_WORD() >> 16) != 0; const int cg = CG_WORD() & 0xffff;
    int gpm, gpn; { pg8::StaticOrder S_; S_.init(M, D, F.G, cg); pg8::Unit u_; S_.next(0, u_); gpm = u_.pm; gpn = u_.pn; }
    if (IN(3)) for (int rep_ = 0; rep_ < NREP(3); ++rep_) {
        const float* lq1 = args.in[3]; const float* lk1 = args.in[4]; const float* lq2 = args.in[5]; const float* lk2 = args.in[6]; const float* sg = args.in[7];
        const float lam = __expf(wave_sum(lq1[LANE_NOW] * lk1[LANE_NOW])) - __expf(wave_sum(lq2[LANE_NOW] * lk2[LANE_NOW])) + LAMBDA_INIT;
        const int l = LANE_NOW, hh = l >> 4, c0 = 8 * (l & 15), half = c0 >> 6, cc = c0 & 63;
        const f32x4 ga = *(const f32x4*)(sg + c0), gb = *(const f32x4*)(sg + c0 + 4);
        const int m_lo = grouped ? gpm * 256 + gpn * 64 + F.wave : gw, m_hi = grouped ? gpm * 256 + gpn * 64 + 64 : M, m_st = grouped ? NWAVES : NGW;
        for (int mb = m_lo; mb < m_hi; mb += 8 * m_st) {
          v4u w0s[8], w1s[8];
#pragma unroll
          for (int i = 0; i < 8; ++i) { const int mm = (mb + i * m_st < m_hi) ? mb + i * m_st : mb;
              w0s[i] = __builtin_nontemporal_load((const v4u*)(ODA + (size_t)mm * 1024 + (4 * hh + half) * 64 + cc)); w1s[i] = __builtin_nontemporal_load((const v4u*)(ODA + (size_t)mm * 1024 + (4 * hh + 2 + half) * 64 + cc)); }
#pragma unroll
          for (int i = 0; i < 8; ++i) { const int m = mb + i * m_st; if (m >= m_hi) break;
            const v4u w0 = w0s[i], w1 = w1s[i];
            f32x4 a0, a1, b0, b1; pg8::unpack8(w0, a0, a1); pg8::unpack8(w1, b0, b1);
            const f32x4 d0 = a0 - b0 * lam, d1 = a1 - b1 * lam;
            float ss = (d0[0] * d0[0] + d0[1] * d0[1]) + (d0[2] * d0[2] + d0[3] * d0[3]) + (d1[0] * d1[0] + d1[1] * d1[1]) + (d1[2] * d1[2] + d1[3] * d1[3]);
            ss += __shfl_xor(ss, 1); ss += __shfl_xor(ss, 2); ss += __shfl_xor(ss, 4); ss += __shfl_xor(ss, 8);
            const float rs = (1.0f - LAMBDA_INIT) / sqrtf(ss * (1.0f / 128.0f) + EPS);
            *(v4u*)(DA + (size_t)m * 512 + hh * 128 + c0) = pg8::pack8(d0 * rs * ga, d1 * rs * gb);
          }
        }
    }
    LSEAM(3, CW_GRP + 64 * gpm, 4u);
    if (IN(4)) {
        { pg8::StaticOrder S0; S0.init(M, D, F.G, cg); pg8::Unit u0;
          if (MK_PREFETCH && S0.next(0, u0)) { const char* gbase = (const char*)(P + (size_t)u0.pm * 256 * NPROJ + 3072 + u0.pn * 256); const int tid_ = F.wave * 64 + LANE_NOW;
#pragma unroll
            for (int i = 0; i < 4; ++i) { const int line = tid_ + 512 * (i & 1), row = line >> 2, seg = line & 3;
                attn_body::glds16(gbase + (size_t)row * (NPROJ * 2) + (i >> 1) * 2048 + seg * 128, (unsigned)__builtin_amdgcn_readfirstlane((unsigned)(uintptr_t)lds + JUNK_OFF + F.wave * 1024)); } } }
        { pg8::Gemm g{DA, WDA, M, D, 512, nullptr, nullptr}; pg8::DupOrder S; S.S.init(M, D, F.G, cg); S.n = 1; S.reps = NREP(24); pg8::EpiMix<0> E{P, MX};
          pg8::gemm_phase<pg8::EpiMix<0>, pg8::DupOrder, true, true>(F.lds + RING_OFF, g, S, E, F.wave); }
        { pg8::Gemm g{SBO, WSB, M, D, 512, nullptr, nullptr}; pg8::DupOrder S; S.S.init(M, D, F.G, cg); S.n = 1; S.reps = NREP(24); pg8::EpiMix<1> E{P, MX};
          pg8::gemm_phase<pg8::EpiMix<1>, pg8::DupOrder, true, true>(F.lds + RING_OFF, g, S, E, F.wave); }
    }
    LSEAM(4, CW_GRP + 64 * gpm, 8u);
    if (IN(5)) for (int rep_ = 0; rep_ < NREP(5); ++rep_) {
        pg8::Gemm g{MX, WO, M, D, D}; pg8::StaticOrder S; S.init(M, D, F.G, cg); pg8::EpiResidBf E{args.in[0], X1, D, X1P, (unsigned char*)args.out + 2048, 4096, F8_XSCALE};
        { pg8::Unit u0;
          if (MK_PREFETCH && S.next(0, u0)) { const char* xbase = (const char*)(args.in[0] + (size_t)u0.pm * 256 * D + u0.pn * 256); const int tid_ = F.wave * 64 + LANE_NOW;
#pragma unroll
            for (int i = 0; i < 4; ++i) { const int line = tid_ + 512 * i, row = line >> 3, seg = line & 7;
                attn_body::glds16(xbase + (size_t)row * (D * 4) + seg * 128, (unsigned)__builtin_amdgcn_readfirstlane((unsigned)(uintptr_t)lds + JUNK_OFF + F.wave * 1024)); } } }
        pg8::gemm_phase<pg8::EpiResidBf, pg8::StaticOrder, true, true>(F.lds + RING_OFF, g, S, E, F.wave);
    }
    LSEAM(5, CW_GRP + 64 * gpm, 12u);
    if (IN(6)) for (int rep_ = 0; rep_ < NREP(6); ++rep_) {
        const int cnt_bank = (rep_ + 1 < NREP(6)) ? 4096 * 16 : 0;
        const float* g_ffn = args.in[11]; const float* w_r = args.in[12]; const float* b_r = args.in[13];
        LAS float* WL = (LAS float*)(F.lds);
        LAS float* LG = (LAS float*)(F.lds + RING_BYTES);
        LAS float* RS = (LAS float*)(F.lds + RING_BYTES + 8192);
        LAS unsigned* LC = (LAS unsigned*)(F.lds + LDSCTL_OFF + 8192);
        LAS int* PEND = (LAS int*)(F.lds + LDSCTL_OFF + 8192 + 512) + F.wave * 128;
        const int tid_ = F.wave * 64 + LANE_NOW, lane = LANE_NOW;
        if (tid_ < 64) LC[tid_] = 0u;
        for (int reps_ = 0; reps_ < NREP(60); ++reps_)
        { const char* wlg = (const char*)(ws + WS_WLG) + F.wave * 1024 + lane * 16; const unsigned wl0 = (unsigned)(uintptr_t)F.lds + (unsigned)F.wave * 1024u;
#pragma unroll
          for (int j = 0; j < 16; ++j) attn_body::glds16(wlg + j * 8192, (unsigned)__builtin_amdgcn_readfirstlane(wl0 + j * 8192u));
          asm volatile("s_waitcnt vmcnt(0)" ::: "memory"); }
        __syncthreads();
        const int tok0 = grouped ? (gpm * 4 + gpn) * 64 : F.vcu * 64;
        for (int repa_ = 0; repa_ < NREP(61); ++repa_)
        {
            const int tg = F.wave >> 1, eh = F.wave & 1, tl = lane & 15, kq = lane >> 4;
            const bf16* xrow = X1 + (size_t)(tok0 + 16 * tg + tl) * X1P + 16 * kq;
            const LAS float* wl = WL + (size_t)(kq * 4 * 32 + 16 * eh + tl) * 4;
            f32x4 acc = {0.f, 0.f, 0.f, 0.f}; float ss = 0.f;
            v4u awa[16][2];
#pragma unroll
            for (int jj = 0; jj < 16; ++jj) { awa[jj][0] = *(const v4u*)(xrow + 64 * jj); awa[jj][1] = *(const v4u*)(xrow + 64 * jj + 8); }
#pragma unroll
            for (int jj = 0; jj < 16; ++jj) { const v4u aw0 = awa[jj][0], aw1 = awa[jj][1];
                float a[16];
                a[0] = pg8::bf_lo(aw0.x); a[1] = pg8::bf_hi(aw0.x); a[2] = pg8::bf_lo(aw0.y); a[3] = pg8::bf_hi(aw0.y); a[4] = pg8::bf_lo(aw0.z); a[5] = pg8::bf_hi(aw0.z); a[6] = pg8::bf_lo(aw0.w); a[7] = pg8::bf_hi(aw0.w);
                a[8] = pg8::bf_lo(aw1.x); a[9] = pg8::bf_hi(aw1.x); a[10] = pg8::bf_lo(aw1.y); a[11] = pg8::bf_hi(aw1.y); a[12] = pg8::bf_lo(aw1.z); a[13] = pg8::bf_hi(aw1.z); a[14] = pg8::bf_lo(aw1.w); a[15] = pg8::bf_hi(aw1.w);
#pragma unroll
                for (int iq = 0; iq < 4; ++iq) { const f32x4 b4 = *(const LAS f32x4*)(wl + (size_t)jj * 2048 + iq * 128);
#pragma unroll
                    for (int i = 0; i < 4; ++i) { ss += a[4 * iq + i] * a[4 * iq + i]; acc = __builtin_amdgcn_mfma_f32_16x16x4f32(a[4 * iq + i], b4[i], acc, 0, 0, 0); } } }
            ss += __shfl_xor(ss, 16); ss += __shfl_xor(ss, 32);
            const float rstd = 1.f / sqrtf(ss * (1.f / D) + EPS);
            if (eh == 0 && kq == 0) rstd_tok[tok0 + 16 * tg + tl] = rstd;
            const float bias = b_r[16 * eh + tl];
#pragma unroll
            for (int r = 0; r < 4; ++r) { const float rs = __shfl(rstd, 4 * kq + r); LG[(16 * tg + 4 * kq + r) * 32 + 16 * eh + tl] = acc[r] * rs + bias; }
        }
        __syncthreads();
        for (int it = 0; it < 8; ++it) { const int tl = F.wave * 8 + it, mtok = tok0 + tl;
            const float cur = LG[tl * 32 + (lane >> 1)];
            int sel[4]; float sv[4];
            for (int rept_ = 0; rept_ < NREP(64); ++rept_)
            { const int eme = lane >> 1; int rank = 0;
#pragma unroll
              for (int j = 0; j < 32; ++j) { const float vj = __int_as_float(__builtin_amdgcn_readlane(__float_as_int(cur), 2 * j)); rank += (vj > cur || (vj == cur && j < eme)) ? 1 : 0; }
#pragma unroll
              for (int k = 0; k < 4; ++k) { const unsigned long long bal = __ballot(rank == k); const int ln = __ffsll((long long)bal) - 1; sel[k] = ln >> 1; sv[k] = __int_as_float(__builtin_amdgcn_readlane(__float_as_int(cur), ln)); } }
            const float p1 = __expf(sv[1] - sv[0]), p2 = __expf(sv[2] - sv[0]), p3 = __expf(sv[3] - sv[0]); const float inv = 1.0f / (1.0f + p1 + p2 + p3);
            if (lane < 4) { const int k = lane; const int e = (k == 0) ? sel[0] : (k == 1) ? sel[1] : (k == 2) ? sel[2] : sel[3];
                const float gt = ((k == 0) ? 1.0f : (k == 1) ? p1 : (k == 2) ? p2 : p3) * inv;
                const unsigned pl = __hip_atomic_fetch_add(LC + e, 1u, __ATOMIC_RELAXED, __HIP_MEMORY_SCOPE_WORKGROUP);
                LAS int* pe = PEND + it * 12 + k * 3; pe[0] = e; pe[1] = (int)pl; pe[2] = __float_as_int(gt); }
        }
        for (int repc_ = 0; repc_ < NREP(63); ++repc_) { const int bank_ = (repc_ + 1 < NREP(63)) ? 4096 * 24 : cnt_bank;
        __syncthreads();
        if (tid_ < NE) LC[32 + tid_] = __hip_atomic_fetch_add((unsigned*)(F.ctl + CW_CNT + bank_ + 64 * tid_), LC[tid_], __ATOMIC_RELAXED, __HIP_MEMORY_SCOPE_AGENT);
        __syncthreads();
        for (int it = 0; it < 8; ++it) if (lane < 4) { const int k = lane, mtok = tok0 + F.wave * 8 + it; const LAS int* pe = PEND + it * 12 + k * 3; const int e = pe[0]; const unsigned pos = LC[32 + e] + (unsigned)pe[1];
            tok_e[mtok * 4 + k] = e; tok_pos[mtok * 4 + k] = (int)pos; if (cnt_bank == 0) { list_tok[e * 16384 + pos] = mtok; list_gate[e * 16384 + pos] = __int_as_float(pe[2]); } }
        }
        __syncthreads();
    }
    SEAM(6);
    LAS int* TAB = (LAS int*)(F.lds + TAB_OFF);
    if (IN(8) || IN(9) || IN(10)) {
        const int tid_ = F.wave * 64 + LANE_NOW;
        if (tid_ < NE) TAB[328 + tid_] = (int)__hip_atomic_load((unsigned*)(F.ctl + CW_CNT + 64 * tid_), __ATOMIC_RELAXED, __HIP_MEMORY_SCOPE_AGENT);
        __syncthreads();
        if (F.wave == 0) { const int l_ = LANE_NOW, e_ = l_ & 31;
            const int nt_ = (TAB[328 + e_] + 255) >> 8; int inc_ = nt_;
#pragma unroll
            for (int o_ = 1; o_ < 32; o_ <<= 1) { const int up_ = __shfl_up(inc_, o_, 32); inc_ += (e_ >= o_) ? up_ : 0; }
            const int t0_ = inc_ - nt_;
            if (l_ < 32) { TAB[e_] = t0_; for (int t = 0; t < nt_; ++t) TAB[40 + t0_ + t] = e_; if (e_ == 31) TAB[32] = inc_; } }
        __syncthreads();
        { const int nTl = TAB[32]; const bool live = tid_ < nTl; int isfull = 0;
          if (live) { const int e = TAB[40 + tid_]; isfull = (TAB[328 + e] - (tid_ - TAB[e]) * 256 > 128) ? 1 : 0; }
          const unsigned long long bal = __ballot(live && isfull);
          if (LANE_NOW == 0) TAB[752 + F.wave] = __popcll(bal);
          __syncthreads();
          int before = 0, nF = 0;
#pragma unroll
          for (int w = 0; w < NWAVES; ++w) { const int cw = TAB[752 + w]; nF += cw; if (w < F.wave) before += cw; }
          const int fi = before + __popcll(bal & ((1ull << LANE_NOW) - 1ull)), si = tid_ - fi, nS = nTl - nF;
          if (live) { const int idx = isfull ? fi : si, n = isfull ? nF : nS; int x = 0;
#pragma unroll
              for (int q = 1; q < 8; ++q) if (idx >= q * n / 8) x = q;
              const int f0 = x * nF / 8, f1 = (x + 1) * nF / 8, s0 = x * nS / 8;
              TAB[360 + x * 48 + (isfull ? (fi - f0) : (f1 - f0) + (si - s0))] = tid_; }
          if (tid_ < 8) { const int x = tid_; TAB[744 + x] = ((x + 1) * nF / 8 - x * nF / 8) + ((x + 1) * nS / 8 - x * nS / 8); } }
        __syncthreads();
    }
    if (IN(8)) for (int rep_ = 0; rep_ < NREP(8); ++rep_) {
        const int nT = __builtin_amdgcn_readfirstlane(TAB[32]);
        pg8::MoeOrderG S; S.npn = 8; S.G = F.G; S.c = CG_WORD() & 0xffff; S.rdy = (unsigned*)(F.ctl + CW_RDY); S.tmo = (unsigned*)(F.ctl + CW_BAR) + XB_TMO; S.mode = (NREP(8) == 1) ? 1 : 0; S.nb64 = 2048 * 64; S.ebytes = 2048 * 1024; S.tab = (const LAS int*)TAB; S.tokl = (const LAS int*)(F.lds + TOK_OFF);
        { LAS int* TOK = (LAS int*)(F.lds + TOK_OFF); const int tid_ = F.wave * 64 + LANE_NOW; pg8::Unit u;
          int tk[12];
          int e_l, lt_l, cnt_l; const int ok_l = S.next_v(LANE_NOW < 12 ? LANE_NOW : 0, e_l, lt_l, cnt_l) ? 1 : 0;
#pragma unroll
          for (int i = 0; i < 12; ++i) { const bool ok = __builtin_amdgcn_readlane(ok_l, i) != 0; const int ue = __builtin_amdgcn_readlane(e_l, i), ult = __builtin_amdgcn_readlane(lt_l, i), ucnt = __builtin_amdgcn_readlane(cnt_l, i);
              const int p = ult * 256 + (tid_ & 255); const bool live = ok && p < ucnt; const int v = list_tok[live ? ue * 16384 + p : 0]; tk[i] = live ? v : 0; }
#pragma unroll
          for (int i = 0; i < 12; ++i) if (tid_ < 256) TOK[i * 256 + tid_] = tk[i];
          __syncthreads(); }
        pg8::Gemm g{(const bf16*)((const unsigned char*)args.out + 2048), WGU, M, 2048, D / 2, nullptr, nullptr}; S.pitch = X1P; S.fsc = 0x01010101 * (127 - 7);
        pg8::EpiMoe1 E{(unsigned char*)ACT, F8_ASCALE, args.in[15], args.in[17], rstd_tok, (const LAS int*)(F.lds + TOK_OFF), (LAS float*)(F.lds + EPISTG_OFF)};
        pg8::gemm_phase<pg8::EpiMoe1, pg8::MoeOrderG, true, true>(F.lds + RING_OFF, g, S, E, F.wave);
    }
    if (!grouped || PROBE_DUP >= 0) SEAM(8);
    if (IN(9)) for (int rep_ = 0; rep_ < NREP(9); ++rep_) {
        const int nT = __builtin_amdgcn_readfirstlane(TAB[32]);
        pg8::Gemm g{ACT, WD, MAXT * 256, 1024, FF / 2, nullptr, nullptr}; pg8::MoeOrder S{4, F.G, CG_WORD() & 0xffff, (const LAS int*)TAB}; S.rdy = (unsigned*)(F.ctl + CW_RDY); S.tmo = (unsigned*)(F.ctl + CW_BAR) + XB_TMO; S.mode = (NREP(8) == 1) ? 2 : 0; S.nb64 = 1024 * 64; S.ebytes = 1024 * 1024; S.pkl = (LAS unsigned*)(F.lds + LDSCTL_OFF + 8192); S.fsc = 0x01010101 * (127 - 6);
        pg8::EpiMoe2 E{(unsigned char*)YS, F8_YSCALE, args.in[19], list_gate, (LAS float*)(F.lds + EPISTG_OFF)};
        pg8::gemm_phase<pg8::EpiMoe2, pg8::MoeOrder, true, true>(F.lds + RING_OFF, g, S, E, F.wave);
    }
    SEAM(9);
    if (IN(10)) for (int rep_ = 0; rep_ < NREP(10); ++rep_) {
        float* const OUTP = (rep_ + 1 < NREP(10)) ? (float*)ACT : args.out;
        const float* g_fin = args.in[20];
        unsigned poison = (__hip_atomic_load(F.ctl + CW_TMO, RLX_AGENT) != 0u) || (__hip_atomic_load((gu32*)((unsigned*)(F.ctl + CW_BAR) + XB_TMO), RLX_AGENT) != 0u);
        typedef int i32x4 __attribute__((ext_vector_type(4)));
        i32x4 ne = {0, 0, 0, 0}, np = {0, 0, 0, 0};
        if (gw < M) { ne = *(const i32x4*)(tok_e + gw * 4); np = *(const i32x4*)(tok_pos + gw * 4); }
        for (int m = gw; m < M; m += NGW) {
            const i32x4 ce = ne, cp = np;
            if (m + NGW < M) { ne = *(const i32x4*)(tok_e + (m + NGW) * 4); np = *(const i32x4*)(tok_pos + (m + NGW) * 4); }
            f32x4 v[4];
#pragma unroll
            for (int j = 0; j < 4; ++j) { const unsigned long long xw = __builtin_nontemporal_load((const unsigned long long*)(X1 + (size_t)m * X1P + 4 * LANE_NOW + 256 * j)); const unsigned xl = (unsigned)xw, xh = (unsigned)(xw >> 32); v[j] = (f32x4){pg8::bf_lo(xl), pg8::bf_hi(xl), pg8::bf_lo(xh), pg8::bf_hi(xh)}; }
            f32x4 ys[4] = {{0.f, 0.f, 0.f, 0.f}, {0.f, 0.f, 0.f, 0.f}, {0.f, 0.f, 0.f, 0.f}, {0.f, 0.f, 0.f, 0.f}};
#pragma unroll
            for (int k = 0; k < 4; ++k) { const int e = ce[k], pos = cp[k]; const size_t slot = (size_t)TAB[e] * 256 + pos;
#pragma unroll
                for (int j = 0; j < 4; ++j) { const int w = __builtin_nontemporal_load((const int*)((const unsigned char*)YS + slot * D + 4 * LANE_NOW + 256 * j));
                    const pg8::f32x2 lo = __builtin_amdgcn_cvt_pk_f32_fp8(w, false), hi = __builtin_amdgcn_cvt_pk_f32_fp8(w, true);
                    ys[j] = ys[j] + (f32x4){lo[0], lo[1], hi[0], hi[1]}; } }
#pragma unroll
            for (int j = 0; j < 4; ++j) v[j] = v[j] + ys[j] * (1.0f / F8_YSCALE);
            float s = 0.f;
#pragma unroll
            for (int j = 0; j < 4; ++j) s += (v[j].x * v[j].x + v[j].y * v[j].y) + (v[j].z * v[j].z + v[j].w * v[j].w);
            const float rstd = 1.f / sqrtf(wave_sum(s) * (1.f / D) + EPS);
#pragma unroll
            for (int j = 0; j < 4; ++j) { const f32x4 gg = *(const f32x4*)(g_fin + 4 * LANE_NOW + 256 * j); f32x4 o = v[j] * rstd * gg;
                if (poison) { const float q = __builtin_nanf(""); o = (f32x4){q, q, q, q}; }
                __builtin_nontemporal_store(o, (f32x4*)(OUTP + (size_t)m * D + 4 * LANE_NOW + 256 * j)); }
        }
    }
#undef IN
#undef SEAM
}

#ifndef MK_ONE_LAUNCH
#define MK_ONE_LAUNCH 1
#endif
constexpr int N_PHASES = 11;
extern "C" void kernel_launch(void* const* d_in, const int* in_sizes, int n_in, void* d_out, int out_size, void* d_ws, size_t ws_size, hipStream_t stream) {
    static int grid = 0;
    if (grid == 0) {
        if (n_in != 21 || in_sizes[0] != M * D || out_size != M * D || ws_size < WS_END) { fprintf(stderr, "kernel_launch: unexpected shapes: n_in %d in0 %d out %d ws %zu (need %zu); nothing launched\n", n_in, n_in > 0 ? in_sizes[0] : -1, out_size, ws_size, (size_t)WS_END); grid = -1; return; }
        int dev = 0, cus = 0, per_cu = 0;
        if (hipGetDevice(&dev) != hipSuccess || hipDeviceGetAttribute(&cus, hipDeviceAttributeMultiprocessorCount, dev) != hipSuccess) { grid = -1; return; }
        if (hipFuncSetAttribute((const void*)mk_fwd, hipFuncAttributeMaxDynamicSharedMemorySize, LDS_BYTES) != hipSuccess) { fprintf(stderr, "kernel_launch: hipFuncSetAttribute failed\n"); grid = -1; return; }
        if (hipOccupancyMaxActiveBlocksPerMultiprocessor(&per_cu, (const void*)mk_fwd, NWAVES * 64, LDS_BYTES) != hipSuccess || per_cu < 1) { fprintf(stderr, "kernel_launch: occupancy query says %d blocks per CU\n", per_cu); (void)hipGetLastError(); grid = -1; return; }
        grid = cus;
        if (grid != 256) fprintf(stderr, "kernel_launch: note: %d CUs\n", grid);
    }
    if (grid < 0) return;
    if (hipMemsetAsync((char*)d_ws + WS_CTL, 0, CTL_ZERO_BYTES, stream) != hipSuccess) return;
    Args a{};
    for (int i = 0; i < 21; ++i) a.in[i] = (const float*)d_in[i];
    a.out = (float*)d_out; a.ws = (unsigned char*)d_ws;
#if MK_ONE_LAUNCH
    a.ph_lo = 0; a.ph_hi = N_PHASES;
    hipLaunchKernelGGL(mk_fwd, dim3(grid), dim3(NWAVES * 64), LDS_BYTES, stream, a);
#else
    for (int p = 0; p < N_PHASES; ++p) { a.ph_lo = p; a.ph_hi = p + 1; hipLaunchKernelGGL(mk_fwd, dim3(grid), dim3(NWAVES * 64), LDS_BYTES, stream, a); }
#endif
}
```

```cpp
#include <hip/hip_runtime.h>
#include <cstdio>
#include <cstdint>
__device__ __forceinline__ int lane_id_now() { int l; asm volatile("v_mbcnt_lo_u32_b32 %0, -1, 0\n\tv_mbcnt_hi_u32_b32 %0, -1, %0" : "=v"(l)); return l; }
namespace pg8 {
#define PG8_LAS __attribute__((address_space(3)))
typedef unsigned short bf16_t;
typedef short bf16x8 __attribute__((ext_vector_type(8)));
typedef float f32x4 __attribute__((ext_vector_type(4)));
typedef unsigned u32x4 __attribute__((ext_vector_type(4)));
constexpr int BM = 256, BK = 64, HALF = 128, HTB = HALF * BK * 2  , STAGE_BYTES = 8 * HTB, NXCD = 8, WGM = 8;

__host__ __device__ __forceinline__ int lds_byte(int r, int c) { const int st = (r >> 4) * 2 + (c >> 5), rr = r & 15, cc = c & 31, ob = rr * 64 + cc * 2; return st * 1024 + (ob ^ (((ob >> 9) & 1) << 5)); }
__host__ __device__ __forceinline__ void stage_rc(int b, int& R, int& C) { const int st = b / 1024, sb = b % 1024, swz = sb ^ (((sb >> 9) & 1) << 5); R = (st >> 1) * 16 + swz / 64; C = (st & 1) * 32 + (swz % 64) / 2; }
__host__ __device__ __forceinline__ int perm32(int rho) { const int n = rho >> 4, i = rho & 15; return 8 * (i >> 2) + 4 * n + (i & 3); }

struct Unit { int pm, pn, pb, e, lt, cnt, full, ui; };
struct Gemm { const bf16_t* A; const bf16_t* Bt; int M, N, K; const bf16_t* A2; const bf16_t* Bt2; };

struct StaticOrder {
    int nM, nN, nwg, G, c;
    __host__ __device__ __forceinline__ void init(int M, int N, int G_, int c_) { nM = M / BM; nN = N / BM; nwg = nM * nN; G = G_; c = c_; }
    __host__ __device__ __forceinline__ bool next(int i, Unit& u) const {
        const long L = (long)i * G + c; if (L >= nwg) return false;
        int wgid = (int)L; { const int q = nwg / NXCD, r = nwg % NXCD, xcd = wgid % NXCD, off = wgid / NXCD; wgid = (xcd < r ? xcd * (q + 1) : r * (q + 1) + (xcd - r) * q) + off; }
        const int nig = WGM * nN, gid = wgid / nig, fm = gid * WGM, gsz = (nM - fm) < WGM ? (nM - fm) : WGM;
        u.pm = fm + ((wgid % nig) % gsz); u.pn = (wgid % nig) / gsz; u.pb = u.pn; u.e = 0; u.lt = 0; u.cnt = 0; u.full = 1; u.ui = i; return true;
    }
    static constexpr bool DUAL = false, GATHER = false, HALFSKIP = false, FP8 = false, BCH = false; static constexpr int fsc = 0, nb64 = 0, ebytes = 0;
    __device__ __forceinline__ void a_ready(const Unit&) const {}
    __device__ __forceinline__ void done(const Unit&) const {}
};

__device__ __forceinline__ unsigned cvt_pk_bf16(float lo, float hi) { unsigned r; asm volatile("v_cvt_pk_bf16_f32 %0, %1, %2" : "=v"(r) : "v"(lo), "v"(hi)); return r; }
__device__ __forceinline__ u32x4 pack8(const f32x4 a, const f32x4 b) { u32x4 w; w.x = cvt_pk_bf16(a[0], a[1]); w.y = cvt_pk_bf16(a[2], a[3]); w.z = cvt_pk_bf16(b[0], b[1]); w.w = cvt_pk_bf16(b[2], b[3]); return w; }
__device__ __forceinline__ float bf_lo(unsigned w) { return __uint_as_float(w << 16); }
__device__ __forceinline__ float bf_hi(unsigned w) { return __uint_as_float(w & 0xffff0000u); }
__device__ __forceinline__ void unpack8(const u32x4 w, f32x4& a, f32x4& b) { a = (f32x4){bf_lo(w.x), bf_hi(w.x), bf_lo(w.y), bf_hi(w.y)}; b = (f32x4){bf_lo(w.z), bf_hi(w.z), bf_lo(w.w), bf_hi(w.w)}; }
__device__ __forceinline__ float sigmoidf_(float x) { return __builtin_amdgcn_rcpf(1.0f + __expf(-x)); }
__device__ __forceinline__ f32x4 sig4(const f32x4 v) { return (f32x4){sigmoidf_(v[0]), sigmoidf_(v[1]), sigmoidf_(v[2]), sigmoidf_(v[3])}; }

struct EpiPlain {
    static constexpr bool PERM = true, AFTER_DRAIN = false, PREFETCH = false; struct Pref {};
    bf16_t* O; int ldc;
    __device__ __forceinline__ void operator()(const f32x4 (&acc)[2][2][4][2], const Unit& u, int wr, int wc, int fr, int fq) const {
        const int row0 = u.pm * BM + wr * 64 + fr, col0 = u.pn * BM + wc * 32 + 8 * fq;
#pragma unroll
        for (int ai = 0; ai < 2; ++ai)
#pragma unroll
            for (int m = 0; m < 4; ++m) { bf16_t* rowp = O + (size_t)(row0 + ai * HALF + m * 16) * ldc + col0;
#pragma unroll
                for (int bj = 0; bj < 2; ++bj) *(u32x4*)(rowp + bj * HALF) = pack8(acc[ai][bj][m][0], acc[ai][bj][m][1]); }
    }
};

struct EpiInProj {
    static constexpr bool PERM = true, AFTER_DRAIN = false, PREFETCH = false; struct Pref {};
    bf16_t* P; const float* rope; float qscale;
    __device__ __forceinline__ void operator()(const f32x4 (&acc)[2][2][4][2], const Unit& u, int wr, int wc, int fr, int fq) const {
        const int row0 = u.pm * BM + wr * 64 + fr;
        if (u.pn < 4) {
            const float qs = (u.pn < 2) ? qscale : 1.0f;
            const int colbase = u.pn * BM + wc * 64 + 8 * fq;
#pragma unroll
            for (int ai = 0; ai < 2; ++ai)
#pragma unroll
                for (int m = 0; m < 4; ++m) { const int row = row0 + ai * HALF + m * 16, pos = row & 4095;
                    const float* cp = rope + pos * 32 + 8 * fq; const float* sp = cp + 4096 * 32;
                    const f32x4 c0 = *(const f32x4*)cp, c1 = *(const f32x4*)(cp + 4), s0 = *(const f32x4*)sp, s1 = *(const f32x4*)(sp + 4);
                    const f32x4 a0 = acc[ai][0][m][0], a1 = acc[ai][0][m][1], b0 = acc[ai][1][m][0], b1 = acc[ai][1][m][1];
                    const f32x4 y10 = (a0 * c0 - b0 * s0) * qs, y11 = (a1 * c1 - b1 * s1) * qs, y20 = (b0 * c0 + a0 * s0) * qs, y21 = (b1 * c1 + a1 * s1) * qs;
                    bf16_t* rowp = P + (size_t)row * 5120 + colbase;
                    *(u32x4*)(rowp) = pack8(y10, y11); *(u32x4*)(rowp + 32) = pack8(y20, y21); }
        } else {
            const int col0 = u.pn * BM + wc * 32 + 8 * fq; const bool gate = u.pn >= 12; const float sc = (u.pn == 6 || u.pn == 7) ? 0.125f * 1.4426950408889634f : 1.0f;
            if (gate) {
#pragma unroll
                for (int ai = 0; ai < 2; ++ai)
#pragma unroll
                    for (int m = 0; m < 4; ++m) { unsigned char* rowb = (unsigned char*)P + (size_t)(row0 + ai * HALF + m * 16) * 10240 + 6144 + (col0 - 3072);
#pragma unroll
                        for (int bj = 0; bj < 2; ++bj) { const f32x4 v0 = sig4(acc[ai][bj][m][0]) * 255.0f + 0.5f, v1 = sig4(acc[ai][bj][m][1]) * 255.0f + 0.5f;
                            const unsigned lo = (unsigned)v0[0] | ((unsigned)v0[1] << 8) | ((unsigned)v0[2] << 16) | ((unsigned)v0[3] << 24), hi = (unsigned)v1[0] | ((unsigned)v1[1] << 8) | ((unsigned)v1[2] << 16) | ((unsigned)v1[3] << 24);
                            *(unsigned long long*)(rowb + bj * HALF) = (unsigned long long)lo | ((unsigned long long)hi << 32); } }
            } else {
#pragma unroll
            for (int ai = 0; ai < 2; ++ai)
#pragma unroll
                for (int m = 0; m < 4; ++m) { bf16_t* rowp = P + (size_t)(row0 + ai * HALF + m * 16) * 5120 + col0;
#pragma unroll
                    for (int bj = 0; bj < 2; ++bj) { const f32x4 v0 = acc[ai][bj][m][0] * sc, v1 = acc[ai][bj][m][1] * sc;
                        *(u32x4*)(rowp + bj * HALF) = pack8(v0, v1); } }
            }
        }
    }
};

template <int SECOND> struct EpiMix {
    static constexpr bool PERM = true, AFTER_DRAIN = false, PREFETCH = true;
    struct Pref { unsigned long long g[4][2]; };
    const bf16_t* P; bf16_t* MX;
    __device__ __forceinline__ void prefetch(Pref& pf, const Unit& u, int wr, int wc, int fr, int fq) const {
        const int row0 = u.pm * BM + wr * 64 + fr, col0 = u.pn * BM + wc * 32 + 8 * fq;
#pragma unroll
        for (int m = 0; m < 4; ++m)
#pragma unroll
            for (int bj = 0; bj < 2; ++bj) pf.g[m][bj] = *(const unsigned long long*)((const unsigned char*)P + (size_t)(row0 + m * 16) * 10240 + 6144 + (SECOND ? 1024 : 0) + col0 + bj * HALF);
    }
    __device__ __forceinline__ void operator()(const f32x4 (&acc)[2][2][4][2], const Unit& u, int wr, int wc, int fr, int fq, const Pref& pf) const {
        const int row0 = u.pm * BM + wr * 64 + fr, col0 = u.pn * BM + wc * 32 + 8 * fq;
        unsigned long long g1[4][2];
#pragma unroll
        for (int m = 0; m < 4; ++m)
#pragma unroll
            for (int bj = 0; bj < 2; ++bj) g1[m][bj] = *(const unsigned long long*)((const unsigned char*)P + (size_t)(row0 + HALF + m * 16) * 10240 + 6144 + (SECOND ? 1024 : 0) + col0 + bj * HALF);
#pragma unroll
        for (int ai = 0; ai < 2; ++ai)
#pragma unroll
            for (int m = 0; m < 4; ++m) { const size_t row = (size_t)(row0 + ai * HALF + m * 16);
#pragma unroll
                for (int bj = 0; bj < 2; ++bj) { const int c = col0 + bj * HALF;
                    const unsigned long long gq = ai ? g1[m][bj] : pf.g[m][bj]; const unsigned gl = (unsigned)gq, gh = (unsigned)(gq >> 32);
                    const f32x4 g0 = (f32x4){(float)(gl & 255u), (float)((gl >> 8) & 255u), (float)((gl >> 16) & 255u), (float)(gl >> 24)} * (1.0f / 255.0f);
                    const f32x4 g1 = (f32x4){(float)(gh & 255u), (float)((gh >> 8) & 255u), (float)((gh >> 16) & 255u), (float)(gh >> 24)} * (1.0f / 255.0f);
                    f32x4 v0 = acc[ai][bj][m][0] * g0, v1 = acc[ai][bj][m][1] * g1;
                    if (SECOND) { const u32x4 ow = *(const u32x4*)(MX + row * 1024 + c); f32x4 o0, o1; unpack8(ow, o0, o1); v0 = v0 + o0; v1 = v1 + o1; }
                    *(u32x4*)(MX + row * 1024 + c) = pack8(v0, v1); } }
    }
};

struct EpiResid {
    static constexpr bool PERM = false, AFTER_DRAIN = false, PREFETCH = false; struct Pref {};
    const float* X; float* O; int ldc;
    __device__ __forceinline__ void operator()(const f32x4 (&acc)[2][2][4][2], const Unit& u, int wr, int wc, int fr, int fq) const {
        const int row0 = u.pm * BM + wr * 64 + fr, col0 = u.pn * BM + wc * 32 + 4 * fq;
#pragma unroll
        for (int ai = 0; ai < 2; ++ai)
#pragma unroll
            for (int m = 0; m < 4; ++m) { const size_t off = (size_t)(row0 + ai * HALF + m * 16) * ldc + col0;
#pragma unroll
                for (int bj = 0; bj < 2; ++bj)
#pragma unroll
                    for (int n = 0; n < 2; ++n) { const f32x4 xv = *(const f32x4*)(X + off + bj * HALF + n * 16); *(f32x4*)(O + off + bj * HALF + n * 16) = xv + acc[ai][bj][m][n]; } }
    }
};

typedef float f32x2 __attribute__((ext_vector_type(2)));
__device__ __forceinline__ unsigned long long pack8_f8(f32x4 a, f32x4 b, float s) {
    float v[8] = {a[0] * s, a[1] * s, a[2] * s, a[3] * s, b[0] * s, b[1] * s, b[2] * s, b[3] * s};
#pragma unroll
    for (int i = 0; i < 8; ++i) v[i] = __builtin_amdgcn_fmed3f(v[i], -448.0f, 448.0f);
    int lo = 0, hi = 0;
    lo = __builtin_amdgcn_cvt_pk_fp8_f32(v[0], v[1], lo, false); lo = __builtin_amdgcn_cvt_pk_fp8_f32(v[2], v[3], lo, true);
    hi = __builtin_amdgcn_cvt_pk_fp8_f32(v[4], v[5], hi, false); hi = __builtin_amdgcn_cvt_pk_fp8_f32(v[6], v[7], hi, true);
    return (unsigned long long)(unsigned)lo | ((unsigned long long)(unsigned)hi << 32);
}
struct EpiResidBf {
    static constexpr bool PERM = true, AFTER_DRAIN = false, PREFETCH = false; struct Pref {};
    const float* X; bf16_t* O; int ldx, ldo; unsigned char* O8; int ld8; float s8;
    __device__ __forceinline__ void operator()(const f32x4 (&acc)[2][2][4][2], const Unit& u, int wr, int wc, int fr, int fq) const {
        const int row0 = u.pm * BM + wr * 64 + fr, col0 = u.pn * BM + wc * 32 + 8 * fq;
#pragma unroll
        for (int ai = 0; ai < 2; ++ai)
#pragma unroll
            for (int m = 0; m < 4; ++m) { const size_t row = (size_t)(row0 + ai * HALF + m * 16);
#pragma unroll
                for (int bj = 0; bj < 2; ++bj) { const float* xp = X + row * ldx + col0 + bj * HALF; const f32x4 x0 = *(const f32x4*)xp, x1v = *(const f32x4*)(xp + 4);
                    const f32x4 y0 = x0 + acc[ai][bj][m][0], y1 = x1v + acc[ai][bj][m][1];
                    *(u32x4*)(O + row * ldo + col0 + bj * HALF) = pack8(y0, y1);
                    *(unsigned long long*)(O8 + row * ld8 + col0 + bj * HALF) = pack8_f8(y0, y1, s8); } }
    }
};

struct EpiMoe1 {
    static constexpr bool PERM = true, AFTER_DRAIN = false, PREFETCH = false; struct Pref {};
    static constexpr bool STAGE = true;
    unsigned char* ACT; float sact; const float* bg; const float* bu; const float* rstd; const PG8_LAS int* tokl; PG8_LAS float* stg;
    __device__ __forceinline__ void stage(const Unit& u, int wid, int lane) const {
        PG8_LAS float* sb = stg + (u.ui & 1) * 512; const float* src;
        if (wid < 4) src = rstd + tokl[u.ui * 256 + wid * 64 + lane];
        else src = ((wid < 6) ? bg : bu) + u.e * 1024 + u.pn * HALF + (wid & 1) * 64 + lane;
        __builtin_amdgcn_global_load_lds((const unsigned*)src, (PG8_LAS unsigned*)(sb + wid * 64), 4, 0, 0);
    }
    __device__ __forceinline__ void operator()(const f32x4 (&acc)[2][2][4][2], const Unit& u, int wr, int wc, int fr, int fq) const {
        int fr_ = fr, fq_ = fq; asm volatile("" : "+v"(fr_), "+v"(fq_) : "v"(acc[0][0][0][0]));
        const int lrow0 = wr * 64 + fr_, f0 = u.pn * HALF + wc * 32 + 8 * fq_;
        const PG8_LAS float* sb = stg + (u.ui & 1) * 512; const int cl = wc * 32 + 8 * fq_;
        const f32x4 bg0 = *(const PG8_LAS f32x4*)(sb + 256 + cl), bg1 = *(const PG8_LAS f32x4*)(sb + 256 + cl + 4);
        const f32x4 bu0 = *(const PG8_LAS f32x4*)(sb + 384 + cl), bu1 = *(const PG8_LAS f32x4*)(sb + 384 + cl + 4);
#pragma unroll
        for (int ai = 0; ai < 2; ++ai)
#pragma unroll
            for (int m = 0; m < 4; ++m) { int w8[2] = {0, 0}; const int lr = lrow0 + ai * HALF + m * 16; const float rs = sb[lr]; const f32x2 rs2 = {rs, rs};
#pragma unroll
                for (int n = 0; n < 2; ++n) { const f32x4 ag = acc[ai][0][m][n], au = acc[ai][1][m][n], bgn = n ? bg1 : bg0, bun = n ? bu1 : bu0;
#pragma unroll
                    for (int h = 0; h < 2; ++h) {
                        const f32x2 gv = __builtin_elementwise_fma((f32x2){ag[2 * h], ag[2 * h + 1]}, rs2, (f32x2){bgn[2 * h], bgn[2 * h + 1]});
                        const f32x2 uv = __builtin_elementwise_fma((f32x2){au[2 * h], au[2 * h + 1]}, rs2, (f32x2){bun[2 * h], bun[2 * h + 1]});
                        const f32x2 g = {fminf(gv[0], 7.0f), fminf(gv[1], 7.0f)};
                        const f32x2 uu = {__builtin_amdgcn_fmed3f(uv[0], -7.0f, 7.0f), __builtin_amdgcn_fmed3f(uv[1], -7.0f, 7.0f)};
                        const f32x2 t = g * (f32x2){-1.702f * 1.4426950408889634f, -1.702f * 1.4426950408889634f};
                        const f32x2 den = (f32x2){__builtin_amdgcn_exp2f(t[0]), __builtin_amdgcn_exp2f(t[1])} + (f32x2){1.0f, 1.0f};
                        const f32x2 gs = g * (f32x2){__builtin_amdgcn_rcpf(den[0]), __builtin_amdgcn_rcpf(den[1])};
                        const f32x2 r = __builtin_elementwise_fma(uu, (f32x2){sact, sact}, (f32x2){sact, sact}) * gs;
                        w8[n] = h ? __builtin_amdgcn_cvt_pk_fp8_f32(r[0], r[1], w8[n], true) : __builtin_amdgcn_cvt_pk_fp8_f32(r[0], r[1], w8[n], false); } }
                *(unsigned long long*)(ACT + ((size_t)u.pm * BM + lr) * 1024 + f0) = (unsigned long long)(unsigned)w8[0] | ((unsigned long long)(unsigned)w8[1] << 32); }
    }
};
struct EpiMoe2 {
    static constexpr bool PERM = true, AFTER_DRAIN = false, PREFETCH = false; struct Pref {};
    static constexpr bool STAGE = true;
    unsigned char* Y; float sy; const float* bd; const float* lg; PG8_LAS float* stg;
    __device__ __forceinline__ void stage(const Unit& u, int wid, int lane) const {
        PG8_LAS float* sb = stg + (u.ui & 1) * 512; const float* src;
        if (wid < 4) { const int p = u.lt * 256 + wid * 64 + lane; src = lg + u.e * 16384 + (p < u.cnt ? p : 0); }
        else src = bd + u.e * 1024 + u.pn * BM + (wid - 4) * 64 + lane;
        __builtin_amdgcn_global_load_lds((const unsigned*)src, (PG8_LAS unsigned*)(sb + wid * 64), 4, 0, 0);
    }
    __device__ __forceinline__ void operator()(const f32x4 (&acc)[2][2][4][2], const Unit& u, int wr, int wc, int fr, int fq) const {
        int fr_ = fr, fq_ = fq; asm volatile("" : "+v"(fr_), "+v"(fq_) : "v"(acc[0][0][0][0]));
        const int lrow0 = wr * 64 + fr_, col0 = u.pn * BM + wc * 32 + 8 * fq_;
        const PG8_LAS float* sb = stg + (u.ui & 1) * 512; f32x4 bv[2][2];
#pragma unroll
        for (int bj = 0; bj < 2; ++bj)
#pragma unroll
            for (int n = 0; n < 2; ++n) bv[bj][n] = *(const PG8_LAS f32x4*)(sb + 256 + wc * 32 + 8 * fq_ + bj * HALF + 4 * n);
#pragma unroll
        for (int ai = 0; ai < 2; ++ai)
#pragma unroll
            for (int m = 0; m < 4; ++m) { const int lr = lrow0 + ai * HALF + m * 16, p = u.lt * 256 + lr; const float g = (p < u.cnt) ? sb[lr] * sy : 0.f; const size_t row = (size_t)u.pm * BM + lr;
#pragma unroll
                for (int bj = 0; bj < 2; ++bj) *(unsigned long long*)(Y + row * 1024 + col0 + bj * HALF) = pack8_f8((acc[ai][bj][m][0] + bv[bj][0]) * g, (acc[ai][bj][m][1] + bv[bj][1]) * g, 1.0f); }
    }
};
struct MoeOrder {
    static constexpr bool DUAL = false, GATHER = false, HALFSKIP = false, FP8 = true, BCH = true;
    int npn, G, c; const PG8_LAS int* tab; int fsc = 0x7F7F7F7F; unsigned* rdy = nullptr; unsigned* tmo = nullptr; int mode = 0; PG8_LAS unsigned* pkl = nullptr; int nb64 = 0, ebytes = 0;
    __device__ __forceinline__ bool next(int i, Unit& u) const {
        const int x = c & 7, cu_ = (mode == 2) ? (G >> 3) - 1 - (c >> 3) : (c >> 3), slot = i * (G >> 3) + cu_, j = slot / npn, pn = slot - j * npn;
        if (j >= __builtin_amdgcn_readfirstlane(tab[744 + x])) return false;
        const int t = __builtin_amdgcn_readfirstlane(tab[360 + x * 48 + j]), e = __builtin_amdgcn_readfirstlane(tab[40 + t]);
        u.pm = t; u.pn = pn; u.e = e; u.pb = e * npn + pn; u.lt = t - __builtin_amdgcn_readfirstlane(tab[e]); u.cnt = __builtin_amdgcn_readfirstlane(tab[328 + e]);
        u.full = (u.cnt - u.lt * 256 > 128) ? 1 : 0; u.ui = i; return true;
    }
    __device__ __forceinline__ bool next_v(int i, int& e, int& lt, int& cnt) const {
        const int x = c & 7, cu_ = (mode == 2) ? (G >> 3) - 1 - (c >> 3) : (c >> 3), slot = i * (G >> 3) + cu_, j = slot / npn;
        e = 0; lt = 0; cnt = 0;
        if (j >= tab[744 + x]) return false;
        const int t = tab[360 + x * 48 + j]; e = tab[40 + t]; lt = t - tab[e]; cnt = tab[328 + e]; return true;
    }
    __device__ __forceinline__ void a_ready(const Unit& u) const {
        if (mode != 2) return;
        unsigned sp = 0u;
        while ((unsigned)__builtin_amdgcn_readfirstlane((int)__hip_atomic_load(rdy + 16 * u.pm, __ATOMIC_RELAXED, __HIP_MEMORY_SCOPE_AGENT)) < 64u) {
            __builtin_amdgcn_s_sleep(1);
            if ((++sp & 255u) == 0u) { if (__hip_atomic_load(tmo, __ATOMIC_RELAXED, __HIP_MEMORY_SCOPE_AGENT) != 0u) break; if (sp > (1u << 18)) { __hip_atomic_fetch_add(tmo, 1u, __ATOMIC_RELAXED, __HIP_MEMORY_SCOPE_AGENT); break; } } }
        asm volatile("" ::: "memory");
    }
    static constexpr bool PEEK = true;
    __device__ __forceinline__ void peek(const Unit& u, int wid) const { if (mode == 2) __builtin_amdgcn_global_load_lds((const unsigned*)(rdy + 16 * u.pm), (PG8_LAS unsigned*)(pkl + wid * 64), 4, 0, 16); }
    __device__ __forceinline__ void a_ready_pk(const Unit& u, int wid) const {
        if (mode != 2) return;
        if ((unsigned)__builtin_amdgcn_readfirstlane((int)pkl[wid * 64]) >= 64u) return;
        a_ready(u);
    }
    __device__ __forceinline__ void done(const Unit& u) const {
        if (mode != 1) return;
        asm volatile("s_waitcnt vmcnt(0)" ::: "memory");
        if (__builtin_amdgcn_mbcnt_hi(~0u, __builtin_amdgcn_mbcnt_lo(~0u, 0u)) == 0u) __hip_atomic_fetch_add(rdy + 16 * u.pm, 1u, __ATOMIC_RELAXED, __HIP_MEMORY_SCOPE_AGENT);
    }
};
struct MoeOrderG : MoeOrder {
    static constexpr bool GATHER = true;
    const PG8_LAS int* tokl; int pitch;
    __device__ __forceinline__ int row_token(int ui, int r) const { return tokl[ui * 256 + r]; }
};
struct DupOrder {
    static constexpr bool DUAL = false, GATHER = false, HALFSKIP = false, FP8 = false, BCH = false; static constexpr int fsc = 0, nb64 = 0, ebytes = 0;
    StaticOrder S; int n, reps;
    __device__ __forceinline__ bool next(int i, Unit& u) const { if (i >= n * reps) return false; return S.next(i % n, u); }
    __device__ __forceinline__ void a_ready(const Unit&) const {}
    __device__ __forceinline__ void done(const Unit&) const {}
};
struct DualOrder {
    static constexpr bool DUAL = true, GATHER = false, HALFSKIP = false, FP8 = false, BCH = false; static constexpr int fsc = 0, nb64 = 0, ebytes = 0;
    StaticOrder S; int reps;
    __device__ __forceinline__ bool next(int i, Unit& u) const { if (i >= 2 * reps) return false; if (!S.next(0, u)) return false; u.e = i & 1; return true; }
    __device__ __forceinline__ void a_ready(const Unit&) const {}
    __device__ __forceinline__ void done(const Unit&) const {}
};
typedef int pg8_i32x4 __attribute__((ext_vector_type(4)));
typedef int pg8_i32x8 __attribute__((ext_vector_type(8)));
__device__ __forceinline__ pg8_i32x8 pg8_cat8(bf16x8 a, bf16x8 b) { const pg8_i32x4 x = __builtin_bit_cast(pg8_i32x4, a), y = __builtin_bit_cast(pg8_i32x4, b); return __builtin_shufflevector(x, y, 0, 1, 2, 3, 4, 5, 6, 7); }
template <class S, class = void> struct sched_has_peek { static constexpr bool value = false; };
template <class S> struct sched_has_peek<S, decltype((void)S::PEEK)> { static constexpr bool value = S::PEEK; };
template <class E, class = void> struct epi_has_stage { static constexpr bool value = false; };
template <class E> struct epi_has_stage<E, decltype((void)E::STAGE)> { static constexpr bool value = E::STAGE; };
template <class Epi, class Sched, bool ALIGN_EPI = false, bool SP2 = false>
__device__ __forceinline__ void gemm_phase(PG8_LAS unsigned char* lds, const Gemm g, const Sched& S, const Epi& E, int wave_) {
    const int wid = wave_, lane = lane_id_now(), tid = wid * 64 + lane, wr = wid >> 2, wc = wid & 3, fr = lane & 15, fq = lane >> 4;
    const int K = g.K; int nt = K / BK; asm volatile("" : "+s"(nt));
    unsigned voffA[2], voffB[2];
#pragma unroll
    for (int i = 0; i < 2; ++i) { int R, C; stage_rc(tid * 16 + i * 8192, R, C); const int Rb = Epi::PERM ? ((R & ~31) + perm32(R & 31)) : R;
        voffA[i] = (unsigned)(R * K + C) * 2u; voffB[i] = Sched::BCH ? (unsigned)((C >> 5) * S.nb64 + Rb * 64 + ((2 * C) & 63)) : (unsigned)(Rb * K + C) * 2u; }
    int gR[2] = {0, 0}, gC[2] = {0, 0}; unsigned cvo[2][2] = {{0u, 0u}, {0u, 0u}};
    if constexpr (Sched::GATHER) { static_assert(SP2, "GATHER is written for the SP2 loop");
#pragma unroll
        for (int i = 0; i < 2; ++i) stage_rc(tid * 16 + i * 8192, gR[i], gC[i]); }
#define PG8_GVO(dst, ui_) do { _Pragma("unroll") for (int h_ = 0; h_ < 2; ++h_) _Pragma("unroll") for (int i_ = 0; i_ < 2; ++i_) dst[h_][i_] = (unsigned)(S.row_token(ui_, h_ * HALF + gR[i_]) * S.pitch + gC[i_]) * 2u; } while (0)
#define PG8_STAGE_A(bufoff, base, half, v0, v1) do { if constexpr (Sched::GATHER) { const unsigned vv_[2] = {v0, v1}; PG8_STAGE(bufoff, base, vv_); } else { PG8_STAGE(bufoff, (base) + (half) * hstep, voffA); } } while (0)
    const size_t kstep = (size_t)(BK * 2);
    const size_t kstepB = Sched::BCH ? (size_t)2 * S.nb64 : (size_t)(BK * 2), hstepB = Sched::BCH ? (size_t)HALF * 64 : (size_t)HALF * K * 2;
    const size_t hstep = (size_t)HALF * K * 2;
    const size_t tstep = 2 * hstep;
    const unsigned ldsw = (unsigned)wid * 1024u;
    const int aoff = lds_byte(wr * 64 + fr, fq * 8), boff = lds_byte(wc * 32 + fr, fq * 8);
#define PG8_SA(b, h) (((b) * 2 + (h)) * HTB)
#define PG8_SB(b, h) ((4 + (b) * 2 + (h)) * HTB)
#define PG8_STAGE(bufoff, gbase, voff) do { _Pragma("unroll") for (int _i = 0; _i < 2; ++_i) { unsigned vo_ = (voff)[_i]; const char* gb_ = (const char*)(gbase); if constexpr (Sched::FP8) asm volatile("" : "+v"(vo_), "+s"(gb_)); \
        __builtin_amdgcn_global_load_lds((const unsigned*)(gb_ + vo_), (PG8_LAS unsigned*)(lds + (bufoff) + ldsw + _i * 8192), 16, 0, 0); } } while (0)
#define PG8_LDA(dst, b, h) do { _Pragma("unroll") for (int m = 0; m < 4; ++m) _Pragma("unroll") for (int k = 0; k < 2; ++k) dst[m][k] = *(const PG8_LAS bf16x8*)(lds + PG8_SA(b, h) + aoff + m * 2048 + k * 1024); } while (0)
#define PG8_LDB(dst, b, h) do { _Pragma("unroll") for (int n = 0; n < 2; ++n) _Pragma("unroll") for (int k = 0; k < 2; ++k) dst[n][k] = *(const PG8_LAS bf16x8*)(lds + PG8_SB(b, h) + boff + n * 2048 + k * 1024); } while (0)
#define PG8_MMA(ai, bj, At, Bt) do { __builtin_amdgcn_s_setprio(1); _Pragma("unroll") for (int m = 0; m < 4; ++m) _Pragma("unroll") for (int n = 0; n < 2; ++n) { if constexpr (Sched::FP8) { \
        acc[ai][bj][m][n] = __builtin_amdgcn_mfma_scale_f32_16x16x128_f8f6f4(pg8_cat8(Bt[n][0], Bt[n][1]), pg8_cat8(At[m][0], At[m][1]), acc[ai][bj][m][n], 0, 0, 0, S.fsc, 0, S.fsc); } else { _Pragma("unroll") for (int k = 0; k < 2; ++k) \
        acc[ai][bj][m][n] = __builtin_amdgcn_mfma_f32_16x16x32_bf16(Bt[n][k], At[m][k], acc[ai][bj][m][n], 0, 0, 0); } } __builtin_amdgcn_s_setprio(0); } while (0)
#define PG8_WAIT_V(n) asm volatile("s_waitcnt vmcnt(" #n ")" ::: "memory")
#define PG8_WAIT_L(n) asm volatile("s_waitcnt lgkmcnt(" #n ")" ::: "memory")
#define PG8_BAR __builtin_amdgcn_s_barrier()
#define PG8_SCHED __builtin_amdgcn_sched_barrier(0)
    Unit cur, nxt; int ui = 0;
    if (!S.next(0, cur)) return;
    f32x4 acc[2][2][4][2];
#pragma unroll
    for (int a = 0; a < 2; ++a)
#pragma unroll
        for (int b = 0; b < 2; ++b)
#pragma unroll
            for (int m = 0; m < 4; ++m)
#pragma unroll
                for (int n = 0; n < 2; ++n) acc[a][b][m][n] = (f32x4){0.f, 0.f, 0.f, 0.f};
    bf16x8 At[4][2], B0[2][2], B1[2][2];
    const char* cA = (const char*)((Sched::DUAL && cur.e) ? g.A2 : g.A) + (Sched::GATHER ? (size_t)0 : (size_t)cur.pm * tstep);
    if constexpr (Sched::GATHER) PG8_GVO(cvo, 0);
    const char* cB = (const char*)((Sched::DUAL && cur.e) ? g.Bt2 : g.Bt) + (Sched::BCH ? (size_t)cur.e * S.ebytes + (size_t)cur.pn * (2 * hstepB) : (size_t)cur.pb * tstep);
    if constexpr (epi_has_stage<Epi>::value) E.stage(cur, wid, lane_id_now());
    typename Epi::Pref pf_{}; if constexpr (Epi::PREFETCH) E.prefetch(pf_, cur, wr, wc, fr, fq);
    S.a_ready(cur);
    if constexpr (SP2) {
        PG8_STAGE(PG8_SB(0, 0), cB, voffB); PG8_STAGE(PG8_SB(0, 1), cB + hstepB, voffB); PG8_STAGE_A(PG8_SA(0, 0), cA, 0, cvo[0][0], cvo[0][1]); PG8_STAGE_A(PG8_SA(0, 1), cA, 1, cvo[1][0], cvo[1][1]);
        if (wr == 1) PG8_BAR;
        PG8_WAIT_V(2); PG8_BAR;
        PG8_STAGE(PG8_SB(1, 0), cB + kstepB, voffB); PG8_STAGE_A(PG8_SA(1, 0), cA + kstep, 0, cvo[0][0], cvo[0][1]); PG8_STAGE(PG8_SB(1, 1), cB + hstepB + kstepB, voffB);
        PG8_WAIT_V(6); PG8_BAR;
    } else {
        PG8_STAGE(PG8_SB(0, 0), cB, voffB); PG8_STAGE(PG8_SA(0, 0), cA, voffA); PG8_STAGE(PG8_SB(0, 1), cB + hstepB, voffB); PG8_STAGE(PG8_SA(0, 1), cA + hstep, voffA);
        if (wr == 1) PG8_BAR;
        PG8_WAIT_V(4); PG8_BAR;
        PG8_STAGE(PG8_SB(1, 0), cB + kstepB, voffB); PG8_STAGE(PG8_SA(1, 0), cA + kstep, voffA); PG8_STAGE(PG8_SB(1, 1), cB + hstepB + kstepB, voffB);
        PG8_WAIT_V(6); PG8_BAR;
    }
    for (;;) {
        const bool has_next = S.next(ui + 1, nxt);
        if constexpr (sched_has_peek<Sched>::value) { if (has_next) S.peek(nxt, wid); }
        const char* nA = has_next ? (const char*)((Sched::DUAL && nxt.e) ? g.A2 : g.A) + (Sched::GATHER ? (size_t)0 : (size_t)nxt.pm * tstep) : cA; const char* nB = has_next ? (const char*)((Sched::DUAL && nxt.e) ? g.Bt2 : g.Bt) + (Sched::BCH ? (size_t)nxt.e * S.ebytes + (size_t)nxt.pn * (2 * hstepB) : (size_t)nxt.pb * tstep) : cB;
        for (int t = 0; t < nt; t += 2) {
            const bool last = (t == nt - 2);
            const char* a1 = cA + (size_t)(t + 1) * kstep;
            const char* a2 = last ? nA : cA + (size_t)(t + 2) * kstep; const char* b2 = last ? nB : cB + (size_t)(t + 2) * kstepB;
            const char* a3 = a2 + kstep; const char* b3 = b2 + kstepB;
            if (last && has_next) { if constexpr (sched_has_peek<Sched>::value) S.a_ready_pk(nxt, wid); else S.a_ready(nxt); }
            if constexpr (SP2) {
            PG8_LDB(B0, 0, 0); PG8_LDB(B1, 0, 1); PG8_SCHED; PG8_LDA(At, 0, 0); PG8_STAGE_A(PG8_SA(1, 1), a1, 1, cvo[1][0], cvo[1][1]); if constexpr (Sched::GATHER) { if (last && has_next) PG8_GVO(cvo, ui + 1); }
            PG8_WAIT_V(8); PG8_WAIT_L(0); PG8_BAR; PG8_MMA(0, 0, At, B0); PG8_MMA(0, 1, At, B1); PG8_BAR; PG8_SCHED;
            if (!Sched::HALFSKIP || cur.full) PG8_LDA(At, 0, 1); PG8_STAGE(PG8_SB(0, 0), b2, voffB); PG8_STAGE(PG8_SB(0, 1), b2 + hstepB, voffB); PG8_STAGE_A(PG8_SA(0, 0), a2, 0, cvo[0][0], cvo[0][1]);
            PG8_WAIT_V(8); PG8_WAIT_L(0); PG8_BAR; if (!Sched::HALFSKIP || cur.full) { PG8_MMA(1, 0, At, B0); PG8_MMA(1, 1, At, B1); } PG8_BAR; PG8_SCHED;
            PG8_LDB(B0, 1, 0); PG8_LDB(B1, 1, 1); PG8_SCHED; PG8_LDA(At, 1, 0); PG8_STAGE_A(PG8_SA(0, 1), a2, 1, cvo[1][0], cvo[1][1]);
            PG8_WAIT_V(8); PG8_WAIT_L(0); PG8_BAR; PG8_MMA(0, 0, At, B0); PG8_MMA(0, 1, At, B1); PG8_BAR; PG8_SCHED;
            if (!Sched::HALFSKIP || cur.full) PG8_LDA(At, 1, 1); PG8_STAGE(PG8_SB(1, 0), b3, voffB); PG8_STAGE(PG8_SB(1, 1), b3 + hstepB, voffB); PG8_STAGE_A(PG8_SA(1, 0), a3, 0, cvo[0][0], cvo[0][1]);
            PG8_WAIT_V(8); PG8_WAIT_L(0); PG8_BAR; if (!Sched::HALFSKIP || cur.full) { PG8_MMA(1, 0, At, B0); PG8_MMA(1, 1, At, B1); } PG8_BAR; PG8_SCHED;
            } else {
            PG8_LDB(B0, 0, 0); PG8_SCHED; PG8_LDA(At, 0, 0); PG8_STAGE(PG8_SA(1, 1), a1 + hstep, voffA);
            PG8_WAIT_L(8); PG8_BAR; PG8_WAIT_L(0); PG8_MMA(0, 0, At, B0); PG8_BAR; PG8_SCHED;
            PG8_LDB(B1, 0, 1); PG8_STAGE(PG8_SB(0, 0), b2, voffB);
            PG8_BAR; PG8_WAIT_L(0); PG8_MMA(0, 1, At, B1); PG8_BAR;
            PG8_LDA(At, 0, 1); PG8_STAGE(PG8_SA(0, 0), a2, voffA);
            PG8_BAR; PG8_WAIT_L(0); PG8_MMA(1, 0, At, B0); PG8_BAR; PG8_SCHED;
            PG8_STAGE(PG8_SB(0, 1), b2 + hstepB, voffB);
            PG8_WAIT_V(6); PG8_BAR; PG8_MMA(1, 1, At, B1); PG8_BAR;
            PG8_LDB(B0, 1, 0); PG8_SCHED; PG8_LDA(At, 1, 0); PG8_STAGE(PG8_SA(0, 1), a2 + hstep, voffA);
            PG8_WAIT_L(8); PG8_BAR; PG8_WAIT_L(0); PG8_MMA(0, 0, At, B0); PG8_BAR; PG8_SCHED;
            PG8_LDB(B1, 1, 1); PG8_STAGE(PG8_SB(1, 0), b3, voffB);
            PG8_BAR; PG8_WAIT_L(0); PG8_MMA(0, 1, At, B1); PG8_BAR;
            PG8_LDA(At, 1, 1); PG8_STAGE(PG8_SA(1, 0), a3, voffA);
            PG8_BAR; PG8_WAIT_L(0); PG8_MMA(1, 0, At, B0); PG8_BAR; PG8_SCHED;
            PG8_STAGE(PG8_SB(1, 1), b3 + hstepB, voffB);
            PG8_WAIT_V(6); PG8_BAR; PG8_MMA(1, 1, At, B1); PG8_BAR;
            }
        }
        if constexpr (ALIGN_EPI) { if (wr == 0) PG8_BAR; }
        if constexpr (!Epi::AFTER_DRAIN) { if constexpr (Epi::PREFETCH) E(acc, cur, wr, wc, fr, fq, pf_); else E(acc, cur, wr, wc, fr, fq); S.done(cur); }
        if (!has_next) break;
#pragma unroll
        for (int a = 0; a < 2; ++a)
#pragma unroll
            for (int b = 0; b < 2; ++b)
#pragma unroll
                for (int m = 0; m < 4; ++m)
#pragma unroll
                    for (int n = 0; n < 2; ++n) acc[a][b][m][n] = (f32x4){0.f, 0.f, 0.f, 0.f};
        cur = nxt; cA = nA; cB = nB; ++ui;
        if constexpr (epi_has_stage<Epi>::value) E.stage(cur, wid, lane_id_now());
        if constexpr (ALIGN_EPI) { if (wr == 1) PG8_BAR; }
    }
    PG8_WAIT_V(0);
    if constexpr (!ALIGN_EPI) { if (wr == 0) PG8_BAR; }
    PG8_BAR;
    if constexpr (Epi::AFTER_DRAIN) { E.fused(acc, cur, wr, wc, fr, fq, lds, wid, lane); S.done(cur); }
#undef PG8_SA
#undef PG8_SB
#undef PG8_STAGE
#undef PG8_STAGE_A
#undef PG8_GVO
#undef PG8_LDA
#undef PG8_LDB
#undef PG8_MMA
#undef PG8_WAIT_V
#undef PG8_WAIT_L
#undef PG8_BAR
#undef PG8_SCHED
}
}

#ifndef PG8_SP2
#define PG8_SP2 true
#endif
#ifndef PG8_ALIGN
#define PG8_ALIGN true
#endif
#include <hip/hip_bf16.h>
#include <cmath>
namespace attn_body {
using bf16=__hip_bfloat16;
using bf16x8=__attribute__((ext_vector_type(8)))short;
using s16x4=__attribute__((ext_vector_type(4)))short;
using f32x16=__attribute__((ext_vector_type(16)))float;
using u32x4=__attribute__((ext_vector_type(4)))unsigned;
constexpr int BATCH=4,NHEAD=16,SEQ=4096,D=64,DM=NHEAD*D;
constexpr int NW=8,QBLK=32,QB=QBLK*NW,KVBLK=64,NQB=SEQ/QB;
constexpr int ATTN_PITCH=DM, ATTN_UNIT_ROWS=QB;
__device__ __forceinline__ int crow(int r,int hi){return (r&3)+8*(r>>2)+4*hi;}
#define SBAR() __builtin_amdgcn_sched_barrier(0)
__device__ __forceinline__ void cmask(f32x16&p0,f32x16&p1,int jb,int qrel,int hi){
  const float NEG=-INFINITY; int kb=64*jb+4*hi;
  #pragma unroll
  for(int r=0;r<16;++r){int kv=kb+(r&3)+8*(r>>2); if(kv>qrel)p0[r]=NEG; if(kv+32>qrel)p1[r]=NEG;}
}

constexpr int NSLOT=3, SLOTB=8192;
constexpr int LDS_K=0, LDS_V=NSLOT*SLOTB, LDS_WS=2*NSLOT*SLOTB, LDS_OST=LDS_WS+NW*64*4, LDS_BYTES=LDS_OST+NW*4096;
constexpr float C2=0.125f*1.4426950408889634f;
__device__ __forceinline__ void glds16(const void*gsrc,unsigned lds_dst){unsigned keep;
  asm volatile("s_mov_b32 %0, m0\n\ts_mov_b32 m0, %2\n\ts_nop 0\n\tglobal_load_lds_dwordx4 %1, off\n\ts_mov_b32 m0, %0":"=&s"(keep):"v"(gsrc),"s"(lds_dst):"memory");}
__device__ __forceinline__ float max3f(float a,float b,float c){float r;asm("v_max3_f32 %0, %1, %2, %3":"=v"(r):"v"(a),"v"(b),"v"(c));return r;}
__device__ __forceinline__ float max2f(float a,float b){float r;asm("v_max_f32_e32 %0, %1, %2":"=v"(r):"v"(a),"v"(b));return r;}
__device__ __forceinline__ float fadd_s(float a,float b){float r;asm("v_add_f32_e32 %0, %1, %2":"=v"(r):"v"(a),"v"(b));return r;}
__device__ __forceinline__ float fsub_s(float a,float b){float r;asm("v_sub_f32_e32 %0, %1, %2":"=v"(r):"v"(a),"v"(b));return r;}
typedef float f32x2_t __attribute__((ext_vector_type(2))); typedef __bf16 bf16x2_t __attribute__((ext_vector_type(2)));
__device__ __forceinline__ unsigned cvtpk_s(float lo,float hi){f32x2_t v={lo,hi};bf16x2_t b=__builtin_convertvector(v,bf16x2_t);return __builtin_bit_cast(unsigned,b);}
#define WAIT_BAR(N) asm volatile("s_waitcnt vmcnt(" #N ") lgkmcnt(0)\n\ts_barrier":::"memory")

__device__ __forceinline__ void qkt(f32x16&p0,f32x16&p1,const char*Kslot,const bf16x8*qr,const f32x16&negm,int r32,int hi){
  const char*kb=Kslot+hi*1024+r32*16;
  #pragma unroll
  for(int d0=0;d0<4;++d0){
    const bf16x8 b0=*reinterpret_cast<const bf16x8*>(kb+d0*2048);
    const bf16x8 b1=*reinterpret_cast<const bf16x8*>(kb+d0*2048+512);
    if(d0==0){p0=__builtin_amdgcn_mfma_f32_32x32x16_bf16(b0,qr[0],negm,0,0,0);p1=__builtin_amdgcn_mfma_f32_32x32x16_bf16(b1,qr[0],negm,0,0,0);}
    else{p0=__builtin_amdgcn_mfma_f32_32x32x16_bf16(b0,qr[d0],p0,0,0,0);p1=__builtin_amdgcn_mfma_f32_32x32x16_bf16(b1,qr[d0],p1,0,0,0);}}
}
typedef __attribute__((address_space(3))) const char* lds_cptr;
typedef short v4i16_t __attribute__((ext_vector_type(4)));
__device__ __forceinline__ void kload8(bf16x8*kf,lds_cptr kp){
  kf[0]=*(const __attribute__((address_space(3))) bf16x8*)(kp);      kf[1]=*(const __attribute__((address_space(3))) bf16x8*)(kp+512);
  kf[2]=*(const __attribute__((address_space(3))) bf16x8*)(kp+2048); kf[3]=*(const __attribute__((address_space(3))) bf16x8*)(kp+2560);
  kf[4]=*(const __attribute__((address_space(3))) bf16x8*)(kp+4096); kf[5]=*(const __attribute__((address_space(3))) bf16x8*)(kp+4608);
  kf[6]=*(const __attribute__((address_space(3))) bf16x8*)(kp+6144); kf[7]=*(const __attribute__((address_space(3))) bf16x8*)(kp+6656);
}
__device__ __forceinline__ void kload2(bf16x8*kf,lds_cptr kp,int j){ kf[2*j]=*(const __attribute__((address_space(3))) bf16x8*)(kp+j*2048); kf[2*j+1]=*(const __attribute__((address_space(3))) bf16x8*)(kp+j*2048+512); }
__device__ __forceinline__ s16x4 vtr(lds_cptr p){ return __builtin_bit_cast(s16x4,__builtin_amdgcn_ds_read_tr16_b64_v4i16((__attribute__((address_space(3))) v4i16_t*)p)); }
__device__ __forceinline__ float rowmax(const f32x16&p0,const f32x16&p1){
  float a=max3f(p0[0],p0[1],p1[0]),b=max3f(p0[2],p0[3],p1[1]);a=max3f(a,p1[2],p1[3]);
  #pragma unroll
  for(int r=4;r<16;r+=4){a=max3f(a,p0[r],p0[r+1]);b=max3f(b,p0[r+2],p0[r+3]);a=max3f(a,p1[r],p1[r+1]);b=max3f(b,p1[r+2],p1[r+3]);}
  const float m=max2f(a,b);
  auto rr=__builtin_amdgcn_permlane32_swap(__float_as_uint(m),__float_as_uint(m),false,false);
  return max2f(__uint_as_float(rr[0]),__uint_as_float(rr[1]));
}
__device__ __forceinline__ void pv(f32x16*o,int vb,bf16x8 pa0,bf16x8 pa1,bf16x8 pa2,bf16x8 pa3){
  #pragma unroll
  for(int d0=0;d0<2;++d0){s16x4 lo[4],hi[4];
    #pragma unroll
    for(int ks=0;ks<4;++ks){
      asm volatile("ds_read_b64_tr_b16 %0,%1 offset:%c2":"=&v"(lo[ks]):"v"(vb),"i"(d0*4096+ks*1024):"memory");
      asm volatile("ds_read_b64_tr_b16 %0,%1 offset:%c2":"=&v"(hi[ks]):"v"(vb),"i"(d0*4096+ks*1024+512):"memory");}
    asm volatile("s_waitcnt lgkmcnt(0)":::"memory");SBAR();
    #define PK(k) (bf16x8){lo[k][0],lo[k][1],lo[k][2],lo[k][3],hi[k][0],hi[k][1],hi[k][2],hi[k][3]}
    o[d0]=__builtin_amdgcn_mfma_f32_32x32x16_bf16(pa0,PK(0),o[d0],0,0,0);
    o[d0]=__builtin_amdgcn_mfma_f32_32x32x16_bf16(pa1,PK(1),o[d0],0,0,0);
    o[d0]=__builtin_amdgcn_mfma_f32_32x32x16_bf16(pa2,PK(2),o[d0],0,0,0);
    o[d0]=__builtin_amdgcn_mfma_f32_32x32x16_bf16(pa3,PK(3),o[d0],0,0,0);
    #undef PK
  }
}

#ifndef ATTN_STORE16
#define ATTN_STORE16(p,v) (*(u32x4*)(p)=(v))
#endif
template<int THRL,int QP,int KP,int VP,int OP> __device__ __forceinline__ void attn_unit(int wave_,int b,int qb,const bf16*Q,const bf16*__restrict__ K,const bf16*__restrict__ V,bf16*O,char*shm){
  int lane_=lane_id_now(); asm volatile("":"+v"(lane_));
  const int wid=wave_,lane=lane_,tid=wid*64+lane,r32=lane&31,hi=lane>>5;
  const long rowbase=(long)b*SEQ; const int q0=qb*QB;
  const bf16*Qw=Q+(rowbase+q0+wid*QBLK)*QP;
  const bf16*Kh=K+rowbase*KP,*Vh=V+rowbase*VP;
  const unsigned lds0=(unsigned)(uintptr_t)shm;
  float*wsf=(float*)(shm+LDS_WS)+wid*64;
  const bf16*ksrc=Kh+(long)lane*KP+wid*8;
  const bf16*vsrc=Vh+(long)(16*(wid&3)+(lane>>2))*VP+(wid>>2)*32+(lane&3)*8;
  const unsigned kdst=lds0+LDS_K+wid*1024, vdst=lds0+LDS_V+wid*1024;
  #define DMA_K(t,slot) glds16(ksrc+(long)(t)*KVBLK*KP,(unsigned)__builtin_amdgcn_readfirstlane(kdst+(slot)))
  #define DMA_V(t,slot) glds16(vsrc+(long)(t)*KVBLK*VP,(unsigned)__builtin_amdgcn_readfirstlane(vdst+(slot)))
  const int vb0=(int)(lds0+LDS_V)+((lane>>4)&1)*32+(lane&3)*8+(4*hi+((lane&15)>>2))*64;
  const char*Kbase=shm+LDS_K; bf16x8 kf[8];
  const lds_cptr shm3=(lds_cptr)shm; const lds_cptr kp0=shm3+LDS_K+hi*1024+r32*16; const lds_cptr vp0=shm3+LDS_V+((lane>>4)&1)*32+(lane&3)*8+(4*hi+((lane&15)>>2))*64;
  const int NT=(q0+QB)/KVBLK;
  DMA_K(0,0);DMA_V(0,0);DMA_K(1,SLOTB);
  bf16x8 qr[4];
  #pragma unroll
  for(int d0=0;d0<4;++d0)qr[d0]=*reinterpret_cast<const bf16x8*>(&Qw[(long)r32*QP+d0*16+hi*8]);
  float mhat=0.f,l_reg=0.f;f32x16 o[2];o[0]=f32x16{};o[1]=f32x16{};f32x16 negm=f32x16{};asm volatile("":"+v"(negm));
  const int qrel=wid*QBLK+r32;
  #define CMASK(P0,P1,t) do{int jb_=(t)-(NT-4); if(jb_>=0)cmask(P0,P1,jb_,qrel,hi);}while(0)
  bool resc=false;
  #define START(P0,P1) do{ const float rm=rowmax(P0,P1); resc=false; \
    { const float dl=rm; mhat=fadd_s(mhat,dl); \
      _Pragma("unroll") for(int r=0;r<16;++r){P0[r]=fsub_s(P0[r],dl);P1[r]=fsub_s(P1[r],dl);} \
      _Pragma("unroll") for(int r=0;r<16;++r)negm[r]=-mhat; asm volatile("":"+v"(negm)); } \
    _Pragma("unroll") for(int r=0;r<16;++r)P0[r]=__builtin_amdgcn_exp2f(P0[r]); }while(0)
  #define RESC() do{ if(resc){ asm volatile("s_waitcnt lgkmcnt(0)":::"memory"); \
      _Pragma("unroll") for(int d_=0;d_<2;++d_) _Pragma("unroll") for(int r=0;r<16;++r)o[d_][r]*=wsf[crow(r,hi)]; } }while(0)
  f32x16 pA0,pA1,pB0,pB1;
  int sl_prev=0,sl_cur=0,sl_next=SLOTB;
  #define ROT() do{sl_prev=sl_cur;sl_cur=sl_next;sl_next=(sl_next==(NSLOT-1)*SLOTB)?0:sl_next+SLOTB;}while(0)
  DMA_K(2,2*SLOTB);
  WAIT_BAR(3);
  qkt(pA0,pA1,Kbase,qr,negm,r32,hi);asm volatile("s_nop 15\n\ts_nop 7":"+v"(pA0),"+v"(pA1));CMASK(pA0,pA1,0);
  START(pA0,pA1);
  _Pragma("unroll") for(int r=0;r<16;++r)pA1[r]=__builtin_amdgcn_exp2f(pA1[r]);
  WAIT_BAR(0);
  DMA_K(3,0);DMA_V(1,SLOTB);
  ROT();
  kload8(kf,kp0+sl_cur);
  WAIT_BAR(2);
  s16x4 vlo[8],vhi[8]; u32x4 pw0,pw1,pw2,pw3;
  #define PKW(P,B) cvtpk_s(P[B],P[B+1])
  #define PAF(k) __builtin_bit_cast(bf16x8,pw##k)
  #define VFR(i) (bf16x8){vlo[i][0],vlo[i][1],vlo[i][2],vlo[i][3],vhi[i][0],vhi[i][1],vhi[i][2],vhi[i][3]}
  #define PIN(x) asm volatile("":"+v"(x))
  #define MX3(a,b,c) __builtin_fmaxf(__builtin_fmaxf((a),(b)),(c))
  #define GAPA(MF,A0,A1,A2,A3,W0,W1,PW) do{ MF; sacc+=A0; sacc+=A1; sacc+=A2; sacc+=A3; PIN(sacc); W0; W1; PIN(PW); SBAR(); }while(0)
  #define EX(v) __builtin_amdgcn_exp2f(v)
  #define GAPB(MF,X,B) do{ MF; X[B]=EX(X[B]); X[B+1]=EX(X[B+1]); X[B+2]=EX(X[B+2]); X[B+3]=EX(X[B+3]); PIN(X); SBAR(); }while(0)
  #define VRD(i) do{ vlo[i]=vtr(vp_+(((i)>>2)*4096+((i)&3)*1024)); vhi[i]=vtr(vp_+(((i)>>2)*4096+((i)&3)*1024+512)); }while(0)
  #define KRD(G,j) do{ if(G){ kload2(kf,kp0+sl_next,j); SBAR(); } }while(0)
  #define STEP(C0,C1,P0,P1,t,GK,GV,GL) do{ SBAR(); \
    const lds_cptr vp_=vp0+sl_prev; \
    VRD(0); SBAR(); float sacc=(P0[0]+P0[1]); \
    GAPA(C0=__builtin_amdgcn_mfma_f32_32x32x16_bf16(kf[0],qr[0],negm,0,0,0), P0[2],P0[3],P0[4],P0[5],     pw0[0]=PKW(P0,0), pw0[1]=PKW(P0,2), pw0); \
    VRD(4); SBAR(); GAPA(C1=__builtin_amdgcn_mfma_f32_32x32x16_bf16(kf[1],qr[0],negm,0,0,0), P0[6],P0[7],P0[8],P0[9],     pw0[2]=PKW(P0,4), pw0[3]=PKW(P0,6), pw0); \
    VRD(1); SBAR(); GAPA(C0=__builtin_amdgcn_mfma_f32_32x32x16_bf16(kf[2],qr[1],C0,0,0,0),   P0[10],P0[11],P0[12],P0[13], pw1[0]=PKW(P0,8), pw1[1]=PKW(P0,10), pw1); \
    VRD(5); SBAR(); GAPA(C1=__builtin_amdgcn_mfma_f32_32x32x16_bf16(kf[3],qr[1],C1,0,0,0),   P0[14],P0[15],P1[0],P1[1],   pw1[2]=PKW(P0,12),pw1[3]=PKW(P0,14), pw1); \
    VRD(2); SBAR(); GAPA(C0=__builtin_amdgcn_mfma_f32_32x32x16_bf16(kf[4],qr[2],C0,0,0,0),   P1[2],P1[3],P1[4],P1[5],     pw2[0]=PKW(P1,0), pw2[1]=PKW(P1,2), pw2); \
    VRD(6); SBAR(); GAPA(C1=__builtin_amdgcn_mfma_f32_32x32x16_bf16(kf[5],qr[2],C1,0,0,0),   P1[6],P1[7],P1[8],P1[9],     pw2[2]=PKW(P1,4), pw2[3]=PKW(P1,6), pw2); \
    VRD(3); SBAR(); GAPA(C0=__builtin_amdgcn_mfma_f32_32x32x16_bf16(kf[6],qr[3],C0,0,0,0),   P1[10],P1[11],P1[12],P1[13], pw3[0]=PKW(P1,8), pw3[1]=PKW(P1,10), pw3); \
    VRD(7); SBAR(); GAPA(C1=__builtin_amdgcn_mfma_f32_32x32x16_bf16(kf[7],qr[3],C1,0,0,0),   P1[14],P1[15],0.f,0.f,       pw3[2]=PKW(P1,12),pw3[3]=PKW(P1,14), pw3); \
    l_reg+=sacc; \
    if(GK){DMA_K((t)+3,sl_cur);} if(GV){DMA_V((t)+1,sl_next);} \
    CMASK(C0,C1,t); \
    { float a=MX3(C0[0],C0[1],C1[0]),b=MX3(C0[2],C0[3],C1[1]); a=MX3(a,C1[2],C1[3]); \
      _Pragma("unroll") for(int r=4;r<16;r+=4){a=MX3(a,C0[r],C0[r+1]);b=MX3(b,C0[r+2],C0[r+3]);a=MX3(a,C1[r],C1[r+1]);b=MX3(b,C1[r+2],C1[r+3]);} \
      float rm=__builtin_fmaxf(a,b); { auto rr=__builtin_amdgcn_permlane32_swap(__float_as_uint(rm),__float_as_uint(rm),false,false); rm=__builtin_fmaxf(__uint_as_float(rr[0]),__uint_as_float(rr[1])); } \
      resc=false; \
      if(__builtin_expect(__any(rm>(float)THRL),0)){ const float dl=__builtin_fmaxf(rm,0.f); mhat+=dl; \
        _Pragma("unroll") for(int r=0;r<16;++r){C0[r]-=dl;C1[r]-=dl;} \
        _Pragma("unroll") for(int r=0;r<16;++r)negm[r]=-mhat; asm volatile("":"+v"(negm)); \
        const float f=__builtin_amdgcn_exp2f(-dl); l_reg*=f; if(hi==0)wsf[r32]=f; resc=true; } } \
    SBAR(); \
    GAPB(o[0]=__builtin_amdgcn_mfma_f32_32x32x16_bf16(PAF(0),VFR(0),o[0],0,0,0), C0,0); \
    GAPB(o[1]=__builtin_amdgcn_mfma_f32_32x32x16_bf16(PAF(0),VFR(4),o[1],0,0,0), C0,4); \
    KRD(GL,0); GAPB(o[0]=__builtin_amdgcn_mfma_f32_32x32x16_bf16(PAF(1),VFR(1),o[0],0,0,0), C0,8); \
    KRD(GL,1); GAPB(o[1]=__builtin_amdgcn_mfma_f32_32x32x16_bf16(PAF(1),VFR(5),o[1],0,0,0), C0,12); \
    KRD(GL,2); GAPB(o[0]=__builtin_amdgcn_mfma_f32_32x32x16_bf16(PAF(2),VFR(2),o[0],0,0,0), C1,0); \
    KRD(GL,3); GAPB(o[1]=__builtin_amdgcn_mfma_f32_32x32x16_bf16(PAF(2),VFR(6),o[1],0,0,0), C1,4); \
    GAPB(o[0]=__builtin_amdgcn_mfma_f32_32x32x16_bf16(PAF(3),VFR(3),o[0],0,0,0), C1,8); \
    GAPB(o[1]=__builtin_amdgcn_mfma_f32_32x32x16_bf16(PAF(3),VFR(7),o[1],0,0,0), C1,12); \
    }while(0)
  int t=1;
  #undef CMASK
  #define CMASK(P0,P1,t) do{}while(0)
  for(;t+5<NT;t+=2){
    STEP(pB0,pB1,pA0,pA1,t,true,true,true);     WAIT_BAR(2); RESC(); ROT();
    STEP(pA0,pA1,pB0,pB1,t+1,true,true,true);   WAIT_BAR(2); RESC(); ROT();
  }
  #undef CMASK
  int hi_b=hi,qrel_b=qrel; asm volatile("":"+v"(hi_b),"+v"(qrel_b));
  #define CMASK(P0,P1,t) do{int jb_=(t)-(NT-4); if(jb_>=0)cmask(P0,P1,jb_,qrel_b,hi_b);}while(0)
  #define ENDW(tt) do{ if((tt)+3<NT){WAIT_BAR(2);} else if((tt)+2<NT){WAIT_BAR(1);} else {WAIT_BAR(0);} }while(0)
  for(;t+1<NT;t+=2){
    STEP(pB0,pB1,pA0,pA1,t,(t+3<NT),(t+1<NT),(t+1<NT));       ENDW(t);   RESC(); ROT();
    STEP(pA0,pA1,pB0,pB1,t+1,(t+4<NT),(t+2<NT),(t+2<NT));     ENDW(t+1); RESC(); ROT();
  }
  STEP(pB0,pB1,pA0,pA1,NT-1,false,false,false); RESC();
  { float sacc=pB0[0]+pB0[1]; _Pragma("unroll") for(int r=2;r<16;++r)sacc+=pB0[r]; _Pragma("unroll") for(int r=0;r<16;++r)sacc+=pB1[r]; l_reg+=sacc;
    pw0=(u32x4){PKW(pB0,0),PKW(pB0,2),PKW(pB0,4),PKW(pB0,6)};pw1=(u32x4){PKW(pB0,8),PKW(pB0,10),PKW(pB0,12),PKW(pB0,14)};pw2=(u32x4){PKW(pB1,0),PKW(pB1,2),PKW(pB1,4),PKW(pB1,6)};pw3=(u32x4){PKW(pB1,8),PKW(pB1,10),PKW(pB1,12),PKW(pB1,14)};
    SBAR(); pv(o,vb0+sl_cur,PAF(0),PAF(1),PAF(2),PAF(3)); }
  #undef PKW
  #undef PAF
  #undef VFR
  #undef PIN
  #undef MX3
  #undef GAPA
  #undef GAPB
  #undef EX
  #undef VRD
  #undef KRD
  #undef STEP
  #undef ENDW
  {auto rr=__builtin_amdgcn_permlane32_swap(__float_as_uint(l_reg),__float_as_uint(l_reg),false,false);l_reg=__uint_as_float(rr[0])+__uint_as_float(rr[1]);}
  if(hi==0)wsf[32+r32]=l_reg;asm volatile("s_waitcnt lgkmcnt(0)":::"memory");
  float rli[16];
  #pragma unroll
  for(int r=0;r<16;++r)rli[r]=__builtin_amdgcn_rcpf(wsf[32+crow(r,hi)]);
  bf16*Ow=O+(rowbase+q0+wid*QBLK)*OP;
  { bf16*stg=(bf16*)(shm+LDS_OST)+wid*2048;
    #pragma unroll
    for(int r=0;r<16;++r){const int orow=crow(r,hi);
      #pragma unroll
      for(int d0=0;d0<2;++d0)stg[orow*64+d0*32+r32]=__float2bfloat16(o[d0][r]*rli[r]);}
    asm volatile("s_waitcnt lgkmcnt(0)":::"memory");
    #pragma unroll
    for(int i=0;i<4;++i){const int row=i*8+(lane>>3),ch=lane&7; const u32x4 v=*(const u32x4*)(stg+row*64+ch*8); ATTN_STORE16(Ow+(long)row*OP+ch*8,v);} }
  asm volatile("s_waitcnt lgkmcnt(0)\n\ts_barrier":::"memory");
  #undef DMA_K
  #undef DMA_V
  #undef CMASK
  #undef START
  #undef RESC
  #undef ROT
}
template<int THRL,int QP,int KP,int VP,int OP> __device__ __forceinline__ void attn_unit2(int wave_,int b,int qb,const bf16*Q,const bf16*__restrict__ K,const bf16*__restrict__ V,bf16*O,char*shm){
  int lane_=lane_id_now(); asm volatile("":"+v"(lane_));
  const int wid=wave_,lane=lane_,tid=wid*64+lane,r32=lane&31,hi=lane>>5;
  const long rowbase=(long)b*SEQ; const int q0=qb*QB;
  const bf16*Qw=Q+(rowbase+q0+wid*QBLK)*QP;
  const bf16*Kh=K+rowbase*KP,*Vh=V+rowbase*VP;
  const unsigned lds0=(unsigned)(uintptr_t)shm;
  constexpr int LDS2_V2=2*NSLOT*SLOTB, LDS2_WS=3*NSLOT*SLOTB, LDS2_OST=LDS2_WS+NW*64*4, V2OFF=LDS2_V2-LDS_V;
  float*wsf=(float*)(shm+LDS2_WS)+wid*64;
  const bf16*ksrc=Kh+(long)lane*KP+wid*8;
  const bf16*vsrc=Vh+(long)(16*(wid&3)+(lane>>2))*VP+(wid>>2)*32+(lane&3)*8;
  const unsigned kdst=lds0+LDS_K+wid*1024, vdst=lds0+LDS_V+wid*1024, vdst2=lds0+LDS2_V2+wid*1024;
  #define DMA_K(t,slot) glds16(ksrc+(long)(t)*KVBLK*KP,(unsigned)__builtin_amdgcn_readfirstlane(kdst+(slot)))
  #define DMA_V(t,slot) do{ glds16(vsrc+(long)(t)*KVBLK*VP,(unsigned)__builtin_amdgcn_readfirstlane(vdst+(slot))); glds16(vsrc+64+(long)(t)*KVBLK*VP,(unsigned)__builtin_amdgcn_readfirstlane(vdst2+(slot))); }while(0)
  const int vb0=(int)(lds0+LDS_V)+((lane>>4)&1)*32+(lane&3)*8+(4*hi+((lane&15)>>2))*64;
  const char*Kbase=shm+LDS_K; bf16x8 kf[8];
  const lds_cptr shm3=(lds_cptr)shm; const lds_cptr kp0=shm3+LDS_K+hi*1024+r32*16; const lds_cptr vp0=shm3+LDS_V+((lane>>4)&1)*32+(lane&3)*8+(4*hi+((lane&15)>>2))*64;
  const int NT=(q0+QB)/KVBLK;
  DMA_K(0,0);DMA_V(0,0);DMA_K(1,SLOTB);
  bf16x8 qr[4];
  #pragma unroll
  for(int d0=0;d0<4;++d0)qr[d0]=*reinterpret_cast<const bf16x8*>(&Qw[(long)r32*QP+d0*16+hi*8]);
  float mhat=0.f,l_reg=0.f;f32x16 o[4];o[0]=f32x16{};o[1]=f32x16{};o[2]=f32x16{};o[3]=f32x16{};const f32x16 negm=f32x16{};
  const int qrel=wid*QBLK+r32;
  #define CMASK(P0,P1,t) do{int jb_=(t)-(NT-4); if(jb_>=0)cmask(P0,P1,jb_,qrel,hi);}while(0)
  bool resc=false;
  #define START(P0,P1) do{ const float rm=rowmax(P0,P1); resc=false; \
    { const float dl=rm; mhat=fadd_s(mhat,dl); \
      _Pragma("unroll") for(int r=0;r<16;++r){P0[r]=fsub_s(P0[r],dl);P1[r]=fsub_s(P1[r],dl);} \
      } \
    _Pragma("unroll") for(int r=0;r<16;++r)P0[r]=__builtin_amdgcn_exp2f(P0[r]); }while(0)
  #define RESC() do{ if(resc){ asm volatile("s_waitcnt lgkmcnt(0)":::"memory"); \
      _Pragma("unroll") for(int d_=0;d_<4;++d_) _Pragma("unroll") for(int r=0;r<16;++r)o[d_][r]*=wsf[crow(r,hi)]; } }while(0)
  f32x16 pA0,pA1,pB0,pB1;
  int sl_prev=0,sl_cur=0,sl_next=SLOTB;
  #define ROT() do{sl_prev=sl_cur;sl_cur=sl_next;sl_next=(sl_next==(NSLOT-1)*SLOTB)?0:sl_next+SLOTB;}while(0)
  DMA_K(2,2*SLOTB);
  WAIT_BAR(4);
  qkt(pA0,pA1,Kbase,qr,negm,r32,hi);asm volatile("s_nop 15\n\ts_nop 7":"+v"(pA0),"+v"(pA1));CMASK(pA0,pA1,0);
  START(pA0,pA1);
  _Pragma("unroll") for(int r=0;r<16;++r)pA1[r]=__builtin_amdgcn_exp2f(pA1[r]);
  WAIT_BAR(0);
  DMA_K(3,0);DMA_V(1,SLOTB);
  ROT();
  kload8(kf,kp0+sl_cur);
  WAIT_BAR(3);
  s16x4 vlo[4],vhi[4]; u32x4 pw0,pw1,pw2,pw3;
  #define PKW(P,B) cvtpk_s(P[B],P[B+1])
  #define PAF(k) __builtin_bit_cast(bf16x8,pw##k)
  #define VFR(i) (bf16x8){vlo[i][0],vlo[i][1],vlo[i][2],vlo[i][3],vhi[i][0],vhi[i][1],vhi[i][2],vhi[i][3]}
  #define PIN(x) asm volatile("":"+v"(x))
  #define MX3(a,b,c) __builtin_fmaxf(__builtin_fmaxf((a),(b)),(c))
  #define GAPA(MF,A0,A1,A2,A3,W0,W1,PW) do{ MF; sacc+=A0; sacc+=A1; sacc+=A2; sacc+=A3; PIN(sacc); W0; W1; PIN(PW); SBAR(); }while(0)
  #define EX(v) __builtin_amdgcn_exp2f(v)
  #define GAPB(MF,X,B) do{ MF; X[B]=EX(X[B]); X[B+1]=EX(X[B+1]); X[B+2]=EX(X[B+2]); X[B+3]=EX(X[B+3]); PIN(X); SBAR(); }while(0)
  #define VRD(i) do{ vlo[i]=vtr(vp_+(((i)>>2)*4096+((i)&3)*1024)); vhi[i]=vtr(vp_+(((i)>>2)*4096+((i)&3)*1024+512)); }while(0)
  #define VLD(S,i,OFF) do{ vlo[S]=vtr(vp_+(OFF)+(((i)>>2)*4096+((i)&3)*1024)); vhi[S]=vtr(vp_+(OFF)+(((i)>>2)*4096+((i)&3)*1024+512)); }while(0)
  #define GAPB3(MF,X,B,LD) do{ MF; LD; X[B]=EX(X[B]); X[B+1]=EX(X[B+1]); X[B+2]=EX(X[B+2]); X[B+3]=EX(X[B+3]); PIN(X); SBAR(); }while(0)
  #define KRD(G,j) do{ if(G){ kload2(kf,kp0+sl_next,j); SBAR(); } }while(0)
  #define STEP(C0,C1,P0,P1,t,GK,GV,GL) do{ SBAR(); \
    const lds_cptr vp_=vp0+sl_prev; \
    VLD(0,0,0); SBAR(); float sacc=(P0[0]+P0[1]); \
    GAPA(C0=__builtin_amdgcn_mfma_f32_32x32x16_bf16(kf[0],qr[0],C0,0,0,0), P0[2],P0[3],P0[4],P0[5],     pw0[0]=PKW(P0,0), pw0[1]=PKW(P0,2), pw0); \
    VLD(1,4,0); SBAR(); GAPA(C1=__builtin_amdgcn_mfma_f32_32x32x16_bf16(kf[1],qr[0],C1,0,0,0), P0[6],P0[7],P0[8],P0[9],     pw0[2]=PKW(P0,4), pw0[3]=PKW(P0,6), pw0); \
    VLD(2,1,0); SBAR(); GAPA(C0=__builtin_amdgcn_mfma_f32_32x32x16_bf16(kf[2],qr[1],C0,0,0,0),   P0[10],P0[11],P0[12],P0[13], pw1[0]=PKW(P0,8), pw1[1]=PKW(P0,10), pw1); \
    VLD(3,5,0); SBAR(); GAPA(C1=__builtin_amdgcn_mfma_f32_32x32x16_bf16(kf[3],qr[1],C1,0,0,0),   P0[14],P0[15],P1[0],P1[1],   pw1[2]=PKW(P0,12),pw1[3]=PKW(P0,14), pw1); \
    GAPA(C0=__builtin_amdgcn_mfma_f32_32x32x16_bf16(kf[4],qr[2],C0,0,0,0),   P1[2],P1[3],P1[4],P1[5],     pw2[0]=PKW(P1,0), pw2[1]=PKW(P1,2), pw2); \
    GAPA(C1=__builtin_amdgcn_mfma_f32_32x32x16_bf16(kf[5],qr[2],C1,0,0,0),   P1[6],P1[7],P1[8],P1[9],     pw2[2]=PKW(P1,4), pw2[3]=PKW(P1,6), pw2); \
    GAPA(C0=__builtin_amdgcn_mfma_f32_32x32x16_bf16(kf[6],qr[3],C0,0,0,0),   P1[10],P1[11],P1[12],P1[13], pw3[0]=PKW(P1,8), pw3[1]=PKW(P1,10), pw3); \
    GAPA(C1=__builtin_amdgcn_mfma_f32_32x32x16_bf16(kf[7],qr[3],C1,0,0,0),   P1[14],P1[15],0.f,0.f,       pw3[2]=PKW(P1,12),pw3[3]=PKW(P1,14), pw3); \
    l_reg+=sacc; \
    if(GK){DMA_K((t)+3,sl_cur);} if(GV){DMA_V((t)+1,sl_next);} \
    CMASK(C0,C1,t); \
    { float a=MX3(C0[0],C0[1],C1[0]),b=MX3(C0[2],C0[3],C1[1]); a=MX3(a,C1[2],C1[3]); \
      _Pragma("unroll") for(int r=4;r<16;r+=4){a=MX3(a,C0[r],C0[r+1]);b=MX3(b,C0[r+2],C0[r+3]);a=MX3(a,C1[r],C1[r+1]);b=MX3(b,C1[r+2],C1[r+3]);} \
      float rm=__builtin_fmaxf(a,b); { auto rr=__builtin_amdgcn_permlane32_swap(__float_as_uint(rm),__float_as_uint(rm),false,false); rm=__builtin_fmaxf(__uint_as_float(rr[0]),__uint_as_float(rr[1])); } \
      resc=false; \
      if(__builtin_expect(__any(rm>(float)THRL),0)){ const float dl=__builtin_fmaxf(rm,0.f); mhat+=dl; \
        _Pragma("unroll") for(int r=0;r<16;++r){C0[r]-=dl;C1[r]-=dl;} \
        \
        const float f=__builtin_amdgcn_exp2f(-dl); l_reg*=f; if(hi==0)wsf[r32]=f; resc=true; } } \
    SBAR(); \
    GAPB3(o[0]=__builtin_amdgcn_mfma_f32_32x32x16_bf16(PAF(0),VFR(0),o[0],0,0,0), C0,0, VLD(0,2,0)); \
    GAPB3(o[1]=__builtin_amdgcn_mfma_f32_32x32x16_bf16(PAF(0),VFR(1),o[1],0,0,0), C0,4, VLD(1,6,0)); \
    KRD(GL,0); GAPB3(o[0]=__builtin_amdgcn_mfma_f32_32x32x16_bf16(PAF(1),VFR(2),o[0],0,0,0), C0,8, VLD(2,3,0)); \
    KRD(GL,1); GAPB3(o[1]=__builtin_amdgcn_mfma_f32_32x32x16_bf16(PAF(1),VFR(3),o[1],0,0,0), C0,12, VLD(3,7,0)); \
    KRD(GL,2); GAPB3(o[0]=__builtin_amdgcn_mfma_f32_32x32x16_bf16(PAF(2),VFR(0),o[0],0,0,0), C1,0, VLD(0,0,V2OFF)); \
    KRD(GL,3); GAPB3(o[1]=__builtin_amdgcn_mfma_f32_32x32x16_bf16(PAF(2),VFR(1),o[1],0,0,0), C1,4, VLD(1,4,V2OFF)); \
    GAPB3(o[0]=__builtin_amdgcn_mfma_f32_32x32x16_bf16(PAF(3),VFR(2),o[0],0,0,0), C1,8, VLD(2,1,V2OFF)); \
    GAPB3(o[1]=__builtin_amdgcn_mfma_f32_32x32x16_bf16(PAF(3),VFR(3),o[1],0,0,0), C1,12, VLD(3,5,V2OFF)); \
    const float nm_=-mhat; \
    o[2]=__builtin_amdgcn_mfma_f32_32x32x16_bf16(PAF(0),VFR(0),o[2],0,0,0); VLD(0,2,V2OFF); P0[0]=nm_;P0[1]=nm_;P0[2]=nm_;P0[3]=nm_; PIN(P0); SBAR(); \
    o[3]=__builtin_amdgcn_mfma_f32_32x32x16_bf16(PAF(0),VFR(1),o[3],0,0,0); VLD(1,6,V2OFF); P0[4]=nm_;P0[5]=nm_;P0[6]=nm_;P0[7]=nm_; PIN(P0); SBAR(); \
    o[2]=__builtin_amdgcn_mfma_f32_32x32x16_bf16(PAF(1),VFR(2),o[2],0,0,0); VLD(2,3,V2OFF); P0[8]=nm_;P0[9]=nm_;P0[10]=nm_;P0[11]=nm_; PIN(P0); SBAR(); \
    o[3]=__builtin_amdgcn_mfma_f32_32x32x16_bf16(PAF(1),VFR(3),o[3],0,0,0); VLD(3,7,V2OFF); P0[12]=nm_;P0[13]=nm_;P0[14]=nm_;P0[15]=nm_; PIN(P0); SBAR(); \
    o[2]=__builtin_amdgcn_mfma_f32_32x32x16_bf16(PAF(2),VFR(0),o[2],0,0,0); P1[0]=nm_;P1[1]=nm_;P1[2]=nm_;P1[3]=nm_; PIN(P1); SBAR(); \
    o[3]=__builtin_amdgcn_mfma_f32_32x32x16_bf16(PAF(2),VFR(1),o[3],0,0,0); P1[4]=nm_;P1[5]=nm_;P1[6]=nm_;P1[7]=nm_; PIN(P1); SBAR(); \
    o[2]=__builtin_amdgcn_mfma_f32_32x32x16_bf16(PAF(3),VFR(2),o[2],0,0,0); P1[8]=nm_;P1[9]=nm_;P1[10]=nm_;P1[11]=nm_; PIN(P1); SBAR(); \
    o[3]=__builtin_amdgcn_mfma_f32_32x32x16_bf16(PAF(3),VFR(3),o[3],0,0,0); P1[12]=nm_;P1[13]=nm_;P1[14]=nm_;P1[15]=nm_; PIN(P1); SBAR(); \
    }while(0)
  _Pragma("unroll") for(int r=0;r<16;++r){pB0[r]=-mhat;pB1[r]=-mhat;}
  int t=1;
  #undef CMASK
  #define CMASK(P0,P1,t) do{}while(0)
  for(;t+5<NT;t+=2){
    STEP(pB0,pB1,pA0,pA1,t,true,true,true);     WAIT_BAR(3); RESC(); ROT();
    STEP(pA0,pA1,pB0,pB1,t+1,true,true,true);   WAIT_BAR(3); RESC(); ROT();
  }
  #undef CMASK
  int hi_b=hi,qrel_b=qrel; asm volatile("":"+v"(hi_b),"+v"(qrel_b));
  #define CMASK(P0,P1,t) do{int jb_=(t)-(NT-4); if(jb_>=0)cmask(P0,P1,jb_,qrel_b,hi_b);}while(0)
  #define ENDW(tt) do{ if((tt)+3<NT){WAIT_BAR(3);} else if((tt)+2<NT){WAIT_BAR(2);} else {WAIT_BAR(0);} }while(0)
  for(;t+1<NT;t+=2){
    STEP(pB0,pB1,pA0,pA1,t,(t+3<NT),(t+1<NT),(t+1<NT));       ENDW(t);   RESC(); ROT();
    STEP(pA0,pA1,pB0,pB1,t+1,(t+4<NT),(t+2<NT),(t+2<NT));     ENDW(t+1); RESC(); ROT();
  }
  STEP(pB0,pB1,pA0,pA1,NT-1,false,false,false); RESC();
  { float sacc=pB0[0]+pB0[1]; _Pragma("unroll") for(int r=2;r<16;++r)sacc+=pB0[r]; _Pragma("unroll") for(int r=0;r<16;++r)sacc+=pB1[r]; l_reg+=sacc;
    pw0=(u32x4){PKW(pB0,0),PKW(pB0,2),PKW(pB0,4),PKW(pB0,6)};pw1=(u32x4){PKW(pB0,8),PKW(pB0,10),PKW(pB0,12),PKW(pB0,14)};pw2=(u32x4){PKW(pB1,0),PKW(pB1,2),PKW(pB1,4),PKW(pB1,6)};pw3=(u32x4){PKW(pB1,8),PKW(pB1,10),PKW(pB1,12),PKW(pB1,14)};
    SBAR(); pv(o,vb0+sl_cur,PAF(0),PAF(1),PAF(2),PAF(3)); pv(o+2,vb0+V2OFF+sl_cur,PAF(0),PAF(1),PAF(2),PAF(3)); }
  #undef PKW
  #undef PAF
  #undef VFR
  #undef PIN
  #undef MX3
  #undef GAPA
  #undef GAPB
  #undef EX
  #undef VRD
  #undef KRD
  #undef VLD
  #undef GAPB3
  #undef STEP
  #undef ENDW
  {auto rr=__builtin_amdgcn_permlane32_swap(__float_as_uint(l_reg),__float_as_uint(l_reg),false,false);l_reg=__uint_as_float(rr[0])+__uint_as_float(rr[1]);}
  if(hi==0)wsf[32+r32]=l_reg;asm volatile("s_waitcnt lgkmcnt(0)":::"memory");
  float rli[16];
  #pragma unroll
  for(int r=0;r<16;++r)rli[r]=__builtin_amdgcn_rcpf(wsf[32+crow(r,hi)]);
  bf16*Ow=O+(rowbase+q0+wid*QBLK)*OP;
  { bf16*stg=(bf16*)(shm+LDS2_OST)+wid*2048;
    #pragma unroll
    for(int hh=0;hh<2;++hh){
      #pragma unroll
      for(int r=0;r<16;++r){const int orow=crow(r,hi);
        #pragma unroll
        for(int d0=0;d0<2;++d0)stg[orow*64+d0*32+r32]=__float2bfloat16(o[2*hh+d0][r]*rli[r]);}
      asm volatile("s_waitcnt lgkmcnt(0)":::"memory");
      #pragma unroll
      for(int i=0;i<4;++i){const int row=i*8+(lane>>3),ch=lane&7; const u32x4 v=*(const u32x4*)(stg+row*64+ch*8); ATTN_STORE16(Ow+(long)row*OP+hh*64+ch*8,v);}
      asm volatile("s_waitcnt lgkmcnt(0)":::"memory"); } }
  asm volatile("s_waitcnt lgkmcnt(0)\n\ts_barrier":::"memory");
  #undef DMA_K
  #undef DMA_V
  #undef CMASK
  #undef START
  #undef RESC
  #undef ROT
}
constexpr int ATTN_LDS_BYTES=LDS_BYTES;
#undef SBAR
#undef WAIT_BAR
}
#define GAS __attribute__((address_space(1)))
#define LAS __attribute__((address_space(3)))
typedef unsigned short bf16;
typedef unsigned v4u __attribute__((ext_vector_type(4)));
typedef float f32x4 __attribute__((ext_vector_type(4)));
typedef short bf16x8 __attribute__((ext_vector_type(8)));
typedef GAS unsigned gu32;
typedef GAS unsigned long long gu64;
#define RLX_AGENT __ATOMIC_RELAXED, __HIP_MEMORY_SCOPE_AGENT
#define LDS_WAIT() asm volatile("s_waitcnt lgkmcnt(0)" ::: "memory")
#define VM_WAIT() asm volatile("s_waitcnt vmcnt(0)" ::: "memory")
__device__ __forceinline__ unsigned long long rt() { return __builtin_amdgcn_s_memrealtime(); }
__device__ __forceinline__ unsigned f2bf(float f) { unsigned u = __builtin_bit_cast(unsigned, f); return (u + 0x7fffu + ((u >> 16) & 1u)) >> 16; }
__device__ __forceinline__ unsigned pk2(float lo, float hi) { return f2bf(lo) | (f2bf(hi) << 16); }

#define XB_TMO      128
#define XB_XCNT(j)  (256  + 64 * (j))
#define XB_XSUB(j)  (1280 + 64 * (j))
#define XB_XGEN(j)  (2304 + 64 * (j))
#define XB_TOP      3328
#define XB_TOPGEN   3392
#define XCD_BAR_WORDS 3456
#define XB_SPIN_CAP (1u << 18)

__device__ __forceinline__ unsigned xb_ld(unsigned* p)              { return __hip_atomic_load(p, __ATOMIC_RELAXED, __HIP_MEMORY_SCOPE_AGENT); }
__device__ __forceinline__ unsigned xb_add(unsigned* p, unsigned v) { return __hip_atomic_fetch_add(p, v, __ATOMIC_RELAXED, __HIP_MEMORY_SCOPE_AGENT); }
__device__ __forceinline__ unsigned xb_xcc_id() { return (unsigned)__builtin_amdgcn_s_getreg((3 << 11) | 20) & 0xFu; }
#define XB_SPIN(cond, bar) do { unsigned _sp = 0; while (cond) { __builtin_amdgcn_s_sleep(1); \
    if ((++_sp & 255u) == 0u) { if (xb_ld(&(bar)[XB_TMO])) break; if (_sp > XB_SPIN_CAP) { atomicAdd(&(bar)[XB_TMO], 1u); break; } } } } while (0)

struct XcdBarrier {
    unsigned* bar; unsigned x;
    volatile LAS unsigned* st;
};

__device__ __forceinline__ XcdBarrier xcd_barrier_post(unsigned* bar, volatile LAS unsigned* st) {
    XcdBarrier b; b.bar = bar; b.x = xb_xcc_id(); b.st = st;
    if (threadIdx.x == 0) { const unsigned r_ = xb_add(&bar[XB_XCNT(b.x)], 1u); st[2] = r_; st[3] = b.x; }
    return b;
}
__device__ __forceinline__ void xcd_barrier_complete(unsigned* bar, unsigned x, unsigned& nloc, unsigned& nx, unsigned& regular) {
    const unsigned G = gridDim.x * gridDim.y * gridDim.z;
    unsigned sum, cnt, mine, sp = 0u;
    for (;;) {
        sum = 0u; cnt = 0u; mine = 0u; regular = 1u;
#pragma unroll
        for (unsigned j = 0; j < 16; ++j) { const unsigned c = xb_ld(&bar[XB_XCNT(j)]); sum += c; cnt += (c > 0u) ? 1u : 0u; mine = (j == x) ? c : mine; regular &= (c == 0u || c == 32u) ? 1u : 0u; }
        if (sum == G) break;
        __builtin_amdgcn_s_sleep(1);
        if ((++sp & 255u) == 0u) { if (xb_ld(&bar[XB_TMO])) break; if (sp > XB_SPIN_CAP) { atomicAdd(&bar[XB_TMO], 1u); break; } }
    }
    nloc = mine > 0u ? mine : 1u; nx = cnt > 0u ? cnt : 1u; regular = (regular != 0u && cnt == 8u && sum == G) ? 1u : 0u;
}

__device__ __forceinline__ void xcd_barrier(const XcdBarrier& b, int wave_) {
    asm volatile("s_waitcnt vmcnt(0)" ::: "memory");
    __syncthreads();
    if (wave_ == 0 && lane_id_now() == 0) {
        unsigned* bar = b.bar;
        __builtin_amdgcn_s_waitcnt(0);
        unsigned nloc = b.st[0], nx = b.st[1];
        if (nloc == 0u) { unsigned reg_; xcd_barrier_complete(bar, b.x, nloc, nx, reg_); b.st[0] = nloc; b.st[1] = nx; b.st[5] = reg_; }
        const unsigned old = xb_add(&bar[XB_XSUB(b.x)], 1u);
        const unsigned gen = old / nloc;
        if (old + 1u == (gen + 1u) * nloc) {
            __builtin_amdgcn_fence(__ATOMIC_RELEASE, "agent");
            asm volatile("s_waitcnt vmcnt(0)" ::: "memory");
            const unsigned og = xb_add(&bar[XB_TOP], 1u);
            const unsigned tg = og / nx;
            if (og + 1u == (tg + 1u) * nx) xb_add(&bar[XB_TOPGEN], 1u);
            else XB_SPIN(xb_ld(&bar[XB_TOPGEN]) == tg, bar);
            __builtin_amdgcn_fence(__ATOMIC_ACQUIRE, "agent");
            xb_add(&bar[XB_XGEN(b.x)], 1u);
            asm volatile("s_waitcnt vmcnt(0)" ::: "memory");
        } else {
            XB_SPIN(xb_ld(&bar[XB_XGEN(b.x)]) == gen, bar);
            __builtin_amdgcn_fence(__ATOMIC_ACQUIRE, "agent");
            asm volatile("s_waitcnt vmcnt(0)" ::: "memory");
        }
    }
    __syncthreads();
}
constexpr int NWAVES = 8;
constexpr int BATCH = 4, T = 4096, D = 1024, M = BATCH * T;
constexpr int NPROJ = 5120;
constexpr int NE = 32, TOPK = 4, FF = 1024;
constexpr int MAXT = (M * TOPK) / 256 + NE;
constexpr float EPS = 1e-5f;
constexpr float F8_XSCALE = 32.0f, F8_WSCALE = 512.0f, F8_ASCALE = 8.0f, F8_YSCALE = 64.0f;
constexpr float LAMBDA_INIT = 0.2f;

constexpr size_t MiB = 1u << 20;
constexpr size_t WS_CTL = 0, CTL_ZERO_BYTES = 128 * 1024;
constexpr size_t WS_ROPE = 1 * MiB;
constexpr size_t WS_ROUTE = 2 * MiB;
constexpr size_t WS_WLG = 3 * MiB;
constexpr size_t WS_WGU = 4 * MiB;
constexpr size_t WS_WD = 132 * MiB;
constexpr size_t WS_WIN = 196 * MiB;
constexpr size_t WS_WDA = 206 * MiB, WS_WSB = 207 * MiB, WS_WO = 208 * MiB;
constexpr size_t WS_A0 = 210 * MiB;
constexpr size_t WS_H = WS_A0;
constexpr size_t WS_P = WS_A0 + 32 * MiB;
constexpr size_t WS_VBT = WS_A0 + 192 * MiB;
constexpr size_t WS_ODA = WS_A0 + 208 * MiB;
constexpr size_t WS_DA = WS_A0 + 240 * MiB;
constexpr size_t WS_SB = WS_A0 + 256 * MiB;
constexpr size_t WS_YS = WS_A0 + 144 * MiB;
constexpr size_t WS_ACT = WS_A0;
constexpr size_t WS_LIST = WS_A0 + 288 * MiB;
constexpr size_t WS_END = WS_A0 + 292 * MiB;
static_assert(WS_SB + 16 * MiB <= WS_END && WS_END <= 512 * MiB, "d_ws map");
constexpr int CW_TMO = 0, CW_CODE = 1;
constexpr int CW_CNT = 1024;
constexpr int CW_BAR = 4096;
constexpr int CW_RANK = 8192;
constexpr int CW_GRP = 9216;
constexpr int CW_XL = 13312;
constexpr int CW_RDY = 14336;
static_assert((CW_RDY + 16 * MAXT) * 4 <= (int)CTL_ZERO_BYTES, "control words");

constexpr int RING_OFF = 0, RING_BYTES = 131072;
constexpr int RT_STRIDE = 36, RT_BYTES = 1024 * RT_STRIDE * 4;
constexpr int LDSCTL_OFF = 147456, MISC_OFF = LDSCTL_OFF + 320, TAB_OFF = LDSCTL_OFF + 1024;
constexpr int JUNK_OFF = RING_BYTES, TOK_OFF = RING_BYTES;
constexpr int EPISTG_OFF = LDSCTL_OFF + 4096;
constexpr int LDS_BYTES = 163840;
static_assert(RT_BYTES <= LDSCTL_OFF && TAB_OFF + 4 * 768 <= LDS_BYTES && TOK_OFF + 16384 <= LDSCTL_OFF, "LDS map");
#define LANE_NOW (lane_id_now())
struct Frame {
    LAS unsigned char* lds;
    volatile LAS unsigned* MISC;
    gu32* ctl;
    int wave;
    int vcu, G;
};
__device__ __forceinline__ float wave_sum(float v) {
#pragma unroll
    for (int o = 1; o < 64; o <<= 1) v += __shfl_xor(v, o);
    return v;
}
__device__ __forceinline__ unsigned cvtpk2(float lo, float hi) { unsigned r; asm volatile("v_cvt_pk_bf16_f32 %0, %1, %2" : "=v"(r) : "v"(lo), "v"(hi)); return r; }
__device__ __forceinline__ void tb_load(float (&tv)[32], const float* W, int ldw, int lane) {
#pragma unroll
    for (int i = 0; i < 32; ++i) tv[i] = __builtin_nontemporal_load(W + (size_t)(2 * i + (lane >> 5)) * ldw + (lane & 31));
}
__device__ __forceinline__ void tb_finish(const float (&tv)[32], bf16* WT, int ldt, const float* gk, LAS float* scr, int lane) {
    if (gk) {
#pragma unroll
        for (int i = 0; i < 32; ++i) scr[(2 * i + (lane >> 5)) * 33 + (lane & 31)] = tv[i] * gk[2 * i + (lane >> 5)];
    } else {
#pragma unroll
        for (int i = 0; i < 32; ++i) scr[(2 * i + (lane >> 5)) * 33 + (lane & 31)] = tv[i];
    }
    LDS_WAIT(); asm volatile("" ::: "memory");
    const int c = lane & 7;
#pragma unroll
    for (int j = 0; j < 4; ++j) { const int n = (lane >> 3) + 8 * j; const LAS float* s = scr + (8 * c) * 33 + n;
        v4u o; o.x = cvtpk2(s[0 * 33], s[1 * 33]); o.y = cvtpk2(s[2 * 33], s[3 * 33]); o.z = cvtpk2(s[4 * 33], s[5 * 33]); o.w = cvtpk2(s[6 * 33], s[7 * 33]);
        __builtin_nontemporal_store(o, (GAS v4u*)(WT + (size_t)n * ldt + 8 * c)); }
    LDS_WAIT(); asm volatile("" ::: "memory");
}
struct XItem { const float* src; int ldw; bf16* dst; int ldt; const float* gk; bf16* dst2; float f8; };
__device__ __forceinline__ void tb_load64(float (&tv)[64], const float* W, int ldw, int lane) {
#pragma unroll
    for (int i = 0; i < 64; ++i) tv[i] = __builtin_nontemporal_load(W + (size_t)i * ldw + lane);
}
__device__ __forceinline__ void tb_finish64(const float (&tv)[64], const XItem& it, LAS float* scr, int lane) {
    if (it.f8 != 0.f) {
#pragma unroll
        for (int i = 0; i < 64; ++i) scr[i * 65 + lane] = __builtin_amdgcn_fmed3f(tv[i] * (it.gk ? it.gk[i] * it.f8 : it.f8), -448.0f, 448.0f);
        LDS_WAIT(); asm volatile("" ::: "memory");
        const int c4 = lane & 3;
#pragma unroll
        for (int j = 0; j < 4; ++j) { const int n = (lane >> 2) + 16 * j; const LAS float* s = scr + (16 * c4) * 65 + n; int w[4];
#pragma unroll
            for (int q = 0; q < 4; ++q) { int t = 0; t = __builtin_amdgcn_cvt_pk_fp8_f32(s[(4 * q) * 65], s[(4 * q + 1) * 65], t, false); t = __builtin_amdgcn_cvt_pk_fp8_f32(s[(4 * q + 2) * 65], s[(4 * q + 3) * 65], t, true); w[q] = t; }
            v4u o; o.x = (unsigned)w[0]; o.y = (unsigned)w[1]; o.z = (unsigned)w[2]; o.w = (unsigned)w[3];
            __builtin_nontemporal_store(o, (GAS v4u*)((unsigned char*)it.dst + (size_t)n * 64 + 16 * c4)); }
        LDS_WAIT(); asm volatile("" ::: "memory");
        return;
    }
    if (it.gk) {
#pragma unroll
        for (int i = 0; i < 64; ++i) scr[i * 65 + lane] = tv[i] * it.gk[i];
    } else {
#pragma unroll
        for (int i = 0; i < 64; ++i) scr[i * 65 + lane] = tv[i];
    }
    LDS_WAIT(); asm volatile("" ::: "memory");
    const int c = lane & 7;
#pragma unroll
    for (int j = 0; j < 8; ++j) { const int n = (lane >> 3) + 8 * j; const LAS float* s = scr + (8 * c) * 65 + n;
        v4u o; o.x = cvtpk2(s[0 * 65], s[1 * 65]); o.y = cvtpk2(s[2 * 65], s[3 * 65]); o.z = cvtpk2(s[4 * 65], s[5 * 65]); o.w = cvtpk2(s[6 * 65], s[7 * 65]);
        bf16* rowp = (j < 4) ? it.dst + (size_t)n * it.ldt : it.dst2 + (size_t)(n - 32) * it.ldt;
        *(GAS v4u*)(rowp + 8 * c) = o; }
    LDS_WAIT(); asm volatile("" ::: "memory");
}
__device__ __forceinline__ void rms_row_to_bf16(int lane, const float* xrow, const float* g, bf16* orow) {
    const GAS f32x4* xr = (const GAS f32x4*)xrow + lane; const GAS f32x4* gr = (const GAS f32x4*)g + lane;
    f32x4 v[4]; float s = 0.f;
#pragma unroll
    for (int j = 0; j < 4; ++j) { v[j] = xr[64 * j]; s += (v[j].x * v[j].x + v[j].y * v[j].y) + (v[j].z * v[j].z + v[j].w * v[j].w); }
    const float rstd = 1.f / sqrtf(wave_sum(s) * (1.f / D) + EPS);
    GAS unsigned long long* o8 = (GAS unsigned long long*)orow + lane;
#pragma unroll
    for (int j = 0; j < 4; ++j) { const f32x4 gg = gr[64 * j]; const f32x4 y = v[j] * rstd * gg;
        o8[64 * j] = (unsigned long long)cvtpk2(y.x, y.y) | ((unsigned long long)cvtpk2(y.z, y.w) << 32); }
}

struct Args { const float* in[21]; float* out; unsigned char* ws; int ph_lo, ph_hi; };
__device__ const float INV_FREQ[32] = {1.000000000e+00f, 7.498942018e-01f, 5.623413324e-01f, 4.216965139e-01f, 3.162277639e-01f, 2.371373922e-01f, 1.778279394e-01f, 1.333521456e-01f, 1.000000015e-01f, 7.498941571e-02f, 5.623412877e-02f, 4.216964915e-02f, 3.162277862e-02f, 2.371373586e-02f, 1.778279431e-02f, 1.333521493e-02f, 9.999999776e-03f, 7.498942316e-03f, 5.623413250e-03f, 4.216964822e-03f, 3.162277862e-03f, 2.371373819e-03f, 1.778279431e-03f, 1.333521446e-03f, 1.000000047e-03f, 7.498941850e-04f, 5.623413017e-04f, 4.216965463e-04f, 3.162277862e-04f, 2.371373848e-04f, 1.778279402e-04f, 1.333521504e-04f};

__device__ __forceinline__ void p0_prologue(Frame& F, const Args& a, unsigned char* ws) {
    LAS float* scr = (LAS float*)(F.lds + RING_OFF + F.wave * 16384);
    const int gw = F.vcu * NWAVES + F.wave, NGW = F.G * NWAVES;
    const float* x = a.in[0]; const float* g_mix = a.in[1]; const float* w_in = a.in[2];
    const float* w_da = a.in[8]; const float* w_sb = a.in[9]; const float* w_o = a.in[10];
    const float* w_gate = a.in[14]; const float* w_up = a.in[16]; const float* w_down = a.in[18]; const float* g_ffn_p = a.in[11];
    bf16* WIN = (bf16*)(ws + WS_WIN); bf16* WDA = (bf16*)(ws + WS_WDA); bf16* WSB = (bf16*)(ws + WS_WSB); bf16* WO = (bf16*)(ws + WS_WO);
    bf16* WGU = (bf16*)(ws + WS_WGU); bf16* WD = (bf16*)(ws + WS_WD);
    constexpr int I_IN = 16 * 80, I_DA = 8 * 16, I_SB = 8 * 16, I_O = 16 * 16, I_EXP = 16 * 16;
    constexpr int NITEMS = I_IN + I_DA + I_SB + I_O + 96 * I_EXP;
    auto item = [&](int it) -> XItem {
        int r = it;
        if (r < I_IN) { const int kb = r / 80, nb = r % 80, n0 = 64 * nb;
            if (n0 < 1024) { const int pn = n0 >> 8, w = n0 & 255, drow = 256 * pn + 32 * (w >> 6);
                return XItem{w_in + (size_t)(64 * kb) * NPROJ + n0, NPROJ, WIN + (size_t)drow * 1024 + 64 * kb, 1024, nullptr, WIN + (size_t)(drow + 128) * 1024 + 64 * kb, 0.f}; }
            return XItem{w_in + (size_t)(64 * kb) * NPROJ + n0, NPROJ, WIN + (size_t)n0 * 1024 + 64 * kb, 1024, nullptr, WIN + (size_t)(n0 + 32) * 1024 + 64 * kb, 0.f}; }
        r -= I_IN;
        if (r < I_DA) { const int kb = r / 16, n0 = 64 * (r % 16); return XItem{w_da + (size_t)(64 * kb) * 1024 + n0, 1024, WDA + (size_t)n0 * 512 + 64 * kb, 512, nullptr, WDA + (size_t)(n0 + 32) * 512 + 64 * kb, 0.f}; }
        r -= I_DA;
        if (r < I_SB) { const int kb = r / 16, n0 = 64 * (r % 16); return XItem{w_sb + (size_t)(64 * kb) * 1024 + n0, 1024, WSB + (size_t)n0 * 512 + 64 * kb, 512, nullptr, WSB + (size_t)(n0 + 32) * 512 + 64 * kb, 0.f}; }
        r -= I_SB;
        if (r < I_O) { const int kb = r / 16, n0 = 64 * (r % 16); return XItem{w_o + (size_t)(64 * kb) * 1024 + n0, 1024, WO + (size_t)n0 * 1024 + 64 * kb, 1024, nullptr, WO + (size_t)(n0 + 32) * 1024 + 64 * kb, 0.f}; }
        r -= I_O;
        const int mat = r / I_EXP, q = r % I_EXP, kb = q / 16, n0 = 64 * (q % 16), e = mat / 3, kind = mat % 3;
        const size_t eoff = (size_t)e * 1024 * 1024;
        if (kind == 2) { unsigned char* d = (unsigned char*)WD + (((size_t)e * 16 + kb) * 1024 + n0) * 64; return XItem{w_down + eoff + (size_t)(64 * kb) * 1024 + n0, 1024, (bf16*)d, 1024, nullptr, (bf16*)d, F8_WSCALE}; }
        unsigned char* d = (unsigned char*)WGU + (((size_t)e * 16 + kb) * 2048 + 256 * (n0 >> 7) + (kind == 1 ? 128 : 0) + (n0 & 127)) * 64;
        return XItem{(kind == 0 ? w_gate : w_up) + eoff + (size_t)(64 * kb) * 1024 + n0, 1024, (bf16*)d, 1024, g_ffn_p + 64 * kb, (bf16*)d, F8_WSCALE};
    };
    { LAS float* scr64 = (LAS float*)(F.lds + F.wave * 16640);
      float tvn[64]; XItem nx = item(gw < NITEMS ? gw : 0);
      if (gw < NITEMS) tb_load64(tvn, nx.src, nx.ldw, LANE_NOW);
      for (int it = gw; it < NITEMS; it += NGW) {
          const XItem cu = nx; float tv[64];
#pragma unroll
          for (int i = 0; i < 64; ++i) tv[i] = tvn[i];
          if (it + NGW < NITEMS) { nx = item(it + NGW); tb_load64(tvn, nx.src, nx.ldw, LANE_NOW); }
          tb_finish64(tv, cu, scr64, LANE_NOW);
      } }
    bf16* H = (bf16*)(ws + WS_H);
    { const int lane_ = LANE_NOW; const GAS f32x4* gr = (const GAS f32x4*)g_mix + lane_; f32x4 gg[4];
#pragma unroll
      for (int j = 0; j < 4; ++j) gg[j] = gr[64 * j];
      for (int mb = gw; mb < M; mb += 8 * NGW) { f32x4 v[8][4];
#pragma unroll
          for (int i = 0; i < 8; ++i) { const int mm = (mb + i * NGW < M) ? mb + i * NGW : mb; const GAS f32x4* xr = (const GAS f32x4*)(x + (size_t)mm * D) + lane_;
#pragma unroll
              for (int j = 0; j < 4; ++j) v[i][j] = __builtin_nontemporal_load(xr + 64 * j); }
#pragma unroll
          for (int i = 0; i < 8; ++i) { const int mrow = mb + i * NGW; if (mrow >= M) break; float s = 0.f;
#pragma unroll
              for (int j = 0; j < 4; ++j) s += (v[i][j].x * v[i][j].x + v[i][j].y * v[i][j].y) + (v[i][j].z * v[i][j].z + v[i][j].w * v[i][j].w);
              const float rstd = 1.f / sqrtf(wave_sum(s) * (1.f / D) + EPS);
              GAS unsigned long long* o8 = (GAS unsigned long long*)(H + (size_t)mrow * D) + lane_;
#pragma unroll
              for (int j = 0; j < 4; ++j) { const f32x4 y = v[i][j] * rstd * gg[j]; o8[64 * j] = (unsigned long long)cvtpk2(y.x, y.y) | ((unsigned long long)cvtpk2(y.z, y.w) << 32); } } } }
    { const float* w_r = a.in[12]; float* WLG = (float*)(ws + WS_WLG);
      for (int idx = gw * 64 + LANE_NOW; idx < 1024 * 32; idx += NGW * 64) { const int k = idx >> 5, e = idx & 31;
          const float w = w_r[idx] * g_ffn_p[k]; const unsigned hi = f2bf(w), lo = f2bf(w - __uint_as_float(hi << 16));
          unsigned short* d = (unsigned short*)WLG + (size_t)(((((k >> 6) * 2 + ((k >> 3) & 1)) * 2) * 4 + ((k >> 4) & 3)) * 32 + e) * 8 + (k & 7);
          d[0] = (unsigned short)hi; d[4 * 32 * 8] = (unsigned short)lo; } }
    float* rope = (float*)(ws + WS_ROPE);
    for (int idx = gw * 64 + LANE_NOW; idx < 4096 * 32; idx += NGW * 64) { const int pos = idx >> 5, i = idx & 31;
        const float ang = (float)pos * INV_FREQ[i];
        const double rev = (double)ang * 0.15915494309189535; const double fr = rev - __builtin_rint(rev); const float rf = (float)fr;
        rope[idx] = __builtin_amdgcn_cosf(rf); rope[4096 * 32 + idx] = __builtin_amdgcn_sinf(rf); }
}

typedef float f32x16 __attribute__((ext_vector_type(16)));
typedef short s16x4 __attribute__((ext_vector_type(4)));
__device__ __forceinline__ int crow_(int r, int hi) { return (r & 3) + 8 * (r >> 2) + 4 * hi; }
__device__ __forceinline__ void sb_item(int b, int h, int qt, const bf16* P, const bf16* VT, bf16* O, int lane_) {
    int lane = lane_; asm volatile("" : "+v"(lane));
    const int r32 = lane & 31, hi = lane >> 5;
    const int q0 = qt * 32; const size_t tokq = (size_t)b * T + q0 + r32;
    const bf16* Qp = P + tokq * NPROJ + 1536 + h * 64 + hi * 8;
    bf16x8 qf[4];
#pragma unroll
    for (int d0 = 0; d0 < 4; ++d0) qf[d0] = *(const bf16x8*)(Qp + d0 * 16);
    f32x16 o0, o1;
#pragma unroll
    for (int r = 0; r < 16; ++r) { o0[r] = 0.f; o1[r] = 0.f; }
    float R = 0.f;
    const bf16* Kb = P + ((size_t)b * T + r32) * NPROJ + 2048 + h * 64 + hi * 8;
    const bf16* Vb = VT + (size_t)(h * 64 + r32) * M + (size_t)b * T + 4 * hi;
    bf16x8 kfN[4]; s16x4 vlN[2][2], vhN[2][2];
#define SB_LOAD(kt_) do { const int kv0_ = (kt_) * 32; \
        _Pragma("unroll") for (int d0 = 0; d0 < 4; ++d0) kfN[d0] = *(const bf16x8*)(Kb + (size_t)kv0_ * NPROJ + d0 * 16); \
        _Pragma("unroll") for (int s = 0; s < 2; ++s) _Pragma("unroll") for (int d0 = 0; d0 < 2; ++d0) { const bf16* vp = Vb + (size_t)(d0 * 32) * M + kv0_ + 16 * s; vlN[s][d0] = *(const s16x4*)vp; vhN[s][d0] = *(const s16x4*)(vp + 8); } } while (0)
    SB_LOAD(qt);
    for (int kt = qt; kt >= 0; --kt) {
        bf16x8 kf[4]; s16x4 vl[2][2], vh[2][2];
#pragma unroll
        for (int d0 = 0; d0 < 4; ++d0) kf[d0] = kfN[d0];
#pragma unroll
        for (int s = 0; s < 2; ++s)
#pragma unroll
            for (int d0 = 0; d0 < 2; ++d0) { vl[s][d0] = vlN[s][d0]; vh[s][d0] = vhN[s][d0]; }
        if (kt > 0) SB_LOAD(kt - 1);
        f32x16 sc;
#pragma unroll
        for (int r = 0; r < 16; ++r) sc[r] = 0.f;
#pragma unroll
        for (int d0 = 0; d0 < 4; ++d0) sc = __builtin_amdgcn_mfma_f32_32x32x16_bf16(kf[d0], qf[d0], sc, 0, 0, 0);
        const int lim = (kt == qt) ? r32 : 64;
        float c[16];
#pragma unroll
        for (int r = 0; r < 16; ++r) { const float z = sc[r]; const float sp = fmaxf(z, 0.f) + __logf(1.0f + __expf(-fabsf(z))); c[r] = (crow_(r, hi) < lim) ? sp : 0.f; }
        float g[4], gp[4], Tt[4], A[4];
#pragma unroll
        for (int m = 0; m < 4; ++m) { g[m] = (c[4 * m] + c[4 * m + 1]) + (c[4 * m + 2] + c[4 * m + 3]); gp[m] = __shfl_xor(g[m], 32); Tt[m] = g[m] + gp[m]; }
        const float suf3 = 0.f, suf2 = Tt[3], suf1 = suf2 + Tt[2], suf0 = suf1 + Tt[1];
        A[0] = suf0 + (hi ? 0.f : gp[0]); A[1] = suf1 + (hi ? 0.f : gp[1]); A[2] = suf2 + (hi ? 0.f : gp[2]); A[3] = suf3 + (hi ? 0.f : gp[3]);
        float av[16];
#pragma unroll
        for (int m = 0; m < 4; ++m) { float run = R + A[m];
#pragma unroll
            for (int e = 3; e >= 0; --e) { const int r = 4 * m + e; run += c[r]; av[r] = (crow_(r, hi) < lim) ? __expf(sc[r] - run) : 0.f; } }
        R += suf0 + Tt[0];
        const bool sb_done = __all(R > 96.0f);
        v4u pw0, pw1;
        pw0.x = cvtpk2(av[0], av[1]); pw0.y = cvtpk2(av[2], av[3]); pw0.z = cvtpk2(av[4], av[5]); pw0.w = cvtpk2(av[6], av[7]);
        pw1.x = cvtpk2(av[8], av[9]); pw1.y = cvtpk2(av[10], av[11]); pw1.z = cvtpk2(av[12], av[13]); pw1.w = cvtpk2(av[14], av[15]);
        const bf16x8 pf0 = __builtin_bit_cast(bf16x8, pw0), pf1 = __builtin_bit_cast(bf16x8, pw1);
#define VF(s, d0) (bf16x8){vl[s][d0][0], vl[s][d0][1], vl[s][d0][2], vl[s][d0][3], vh[s][d0][0], vh[s][d0][1], vh[s][d0][2], vh[s][d0][3]}
        o0 = __builtin_amdgcn_mfma_f32_32x32x16_bf16(VF(0, 0), pf0, o0, 0, 0, 0);
        o1 = __builtin_amdgcn_mfma_f32_32x32x16_bf16(VF(0, 1), pf0, o1, 0, 0, 0);
        o0 = __builtin_amdgcn_mfma_f32_32x32x16_bf16(VF(1, 0), pf1, o0, 0, 0, 0);
        o1 = __builtin_amdgcn_mfma_f32_32x32x16_bf16(VF(1, 1), pf1, o1, 0, 0, 0);
#undef VF
        if (sb_done) break;
    }
#undef SB_LOAD
    bf16* Op = O + tokq * 512 + h * 64 + 4 * hi;
#pragma unroll
    for (int gi = 0; gi < 4; ++gi) {
        *(unsigned long long*)(Op + 8 * gi) = (unsigned long long)cvtpk2(o0[4 * gi], o0[4 * gi + 1]) | ((unsigned long long)cvtpk2(o0[4 * gi + 2], o0[4 * gi + 3]) << 32);
        *(unsigned long long*)(Op + 32 + 8 * gi) = (unsigned long long)cvtpk2(o1[4 * gi], o1[4 * gi + 1]) | ((unsigned long long)cvtpk2(o1[4 * gi + 2], o1[4 * gi + 3]) << 32);
    }
}


constexpr int SBL_KST = 448 * 16, SBL_V = 8 * SBL_KST, SBL_FLAG = 2 * SBL_V;
__device__ __forceinline__ void sb_unit(int wave, int b, int h, int qblk, const bf16* P, bf16* O, char* shm) {
    int lane = LANE_NOW; asm volatile("" : "+v"(lane));
    const int r32 = lane & 31, hi = lane >> 5;
    const int q0 = qblk * 256; const size_t tokq = (size_t)b * T + q0 + wave * 32 + r32;
    const int nb = (qblk == 0) ? 0 : 6;
    const unsigned lds0 = (unsigned)(uintptr_t)shm;
    typedef __attribute__((address_space(3))) const char* lptr;
    const lptr shm3 = (lptr)shm;
    volatile LAS unsigned* flags = (volatile LAS unsigned*)((LAS unsigned char*)shm3 + SBL_FLAG);
    const bf16* Kh = P + (size_t)b * T * NPROJ + 2048 + h * 64 + wave * 8;
    const bf16* Vh = P + (size_t)b * T * NPROJ + 2560 + h * 64 + (wave >> 2) * 32 + (lane & 3) * 8;
#define SB_DMA(start_, n64_) do { \
        for (int j_ = 0; j_ < (n64_); ++j_) { int rk_ = (start_) + 64 * j_ + lane; rk_ = rk_ < 0 ? 0 : rk_; int rv_ = (start_) + 64 * j_ + 16 * (wave & 3) + (lane >> 2); rv_ = rv_ < 0 ? 0 : rv_; \
            attn_body::glds16(Kh + (size_t)rk_ * NPROJ, (unsigned)__builtin_amdgcn_readfirstlane(lds0 + wave * SBL_KST + j_ * 1024)); \
            attn_body::glds16(Vh + (size_t)rv_ * NPROJ, (unsigned)__builtin_amdgcn_readfirstlane(lds0 + SBL_V + j_ * 8192 + wave * 1024)); } } while (0)
    int start = q0 - 32 * nb;
    SB_DMA(start, 7);
    if (wave == 0 && lane == 0) { flags[0] = 0u; flags[1] = 0u; }
    const bf16* Qp = P + tokq * NPROJ + 1536 + h * 64 + hi * 8;
    bf16x8 qf[4];
#pragma unroll
    for (int d0 = 0; d0 < 4; ++d0) qf[d0] = *(const bf16x8*)(Qp + d0 * 16);
    f32x16 o0, o1;
#pragma unroll
    for (int r = 0; r < 16; ++r) { o0[r] = 0.f; o1[r] = 0.f; }
    float R = 1.0f; bool done = false;
    const lptr kb = shm3 + hi * SBL_KST + r32 * 16;
    const lptr vb = shm3 + SBL_V + (4 * hi + ((lane & 15) >> 2)) * 64 + ((lane >> 4) & 1) * 32 + (lane & 3) * 8;
    for (int c = 0; ; ++c) {
        asm volatile("s_waitcnt vmcnt(0) lgkmcnt(0)\n\ts_barrier" ::: "memory");
        for (int jt = (c == 0) ? nb + wave : 7; jt >= 0 && !done; --jt) {
            if (start + 32 * jt < 0) break;
            bf16x8 kf[4];
#pragma unroll
            for (int d0 = 0; d0 < 4; ++d0) kf[d0] = *(const __attribute__((address_space(3))) bf16x8*)(kb + d0 * (2 * SBL_KST) + jt * 512);
            s16x4 vl[2][2], vh[2][2];
#pragma unroll
            for (int s = 0; s < 2; ++s)
#pragma unroll
                for (int d0 = 0; d0 < 2; ++d0) { const lptr vp = vb + (jt >> 1) * 8192 + d0 * 4096 + ((jt & 1) * 32 + 16 * s) * 64;
                    vl[s][d0] = __builtin_bit_cast(s16x4, __builtin_amdgcn_ds_read_tr16_b64_v4i16((__attribute__((address_space(3))) attn_body::v4i16_t*)vp));
                    vh[s][d0] = __builtin_bit_cast(s16x4, __builtin_amdgcn_ds_read_tr16_b64_v4i16((__attribute__((address_space(3))) attn_body::v4i16_t*)(vp + 512))); }
            f32x16 sc;
#pragma unroll
            for (int r = 0; r < 16; ++r) sc[r] = 0.f;
#pragma unroll
            for (int d0 = 0; d0 < 4; ++d0) sc = __builtin_amdgcn_mfma_f32_32x32x16_bf16(kf[d0], qf[d0], sc, 0, 0, 0);
            const int lim = (c == 0 && jt == nb + wave) ? r32 : 64;
            float cc[16];
#pragma unroll
            for (int r = 0; r < 16; ++r) { const float sg = __builtin_amdgcn_rcpf(1.0f + __builtin_amdgcn_exp2f(sc[r])); cc[r] = (crow_(r, hi) < lim) ? sg : 1.0f; }
            float g[4], gp[4], Tt[4], A[4];
#pragma unroll
            for (int m = 0; m < 4; ++m) { g[m] = (cc[4 * m] * cc[4 * m + 1]) * (cc[4 * m + 2] * cc[4 * m + 3]); gp[m] = __shfl_xor(g[m], 32); Tt[m] = g[m] * gp[m]; }
            const float suf3 = 1.0f, suf2 = Tt[3], suf1 = suf2 * Tt[2], suf0 = suf1 * Tt[1];
            A[0] = suf0 * (hi ? 1.0f : gp[0]); A[1] = suf1 * (hi ? 1.0f : gp[1]); A[2] = suf2 * (hi ? 1.0f : gp[2]); A[3] = suf3 * (hi ? 1.0f : gp[3]);
            float av[16];
#pragma unroll
            for (int m = 0; m < 4; ++m) { float run = R * A[m];
#pragma unroll
                for (int e = 3; e >= 0; --e) { const int r = 4 * m + e; av[r] = (1.0f - cc[r]) * run; run *= cc[r]; } }
            R *= suf0 * Tt[0];
            done = __all(R < 0x1p-40f);
            v4u pw0, pw1;
            pw0.x = cvtpk2(av[0], av[1]); pw0.y = cvtpk2(av[2], av[3]); pw0.z = cvtpk2(av[4], av[5]); pw0.w = cvtpk2(av[6], av[7]);
            pw1.x = cvtpk2(av[8], av[9]); pw1.y = cvtpk2(av[10], av[11]); pw1.z = cvtpk2(av[12], av[13]); pw1.w = cvtpk2(av[14], av[15]);
            const bf16x8 pf0 = __builtin_bit_cast(bf16x8, pw0), pf1 = __builtin_bit_cast(bf16x8, pw1);
#define VF(s, d0) (bf16x8){vl[s][d0][0], vl[s][d0][1], vl[s][d0][2], vl[s][d0][3], vh[s][d0][0], vh[s][d0][1], vh[s][d0][2], vh[s][d0][3]}
            o0 = __builtin_amdgcn_mfma_f32_32x32x16_bf16(VF(0, 0), pf0, o0, 0, 0, 0);
            o1 = __builtin_amdgcn_mfma_f32_32x32x16_bf16(VF(0, 1), pf0, o1, 0, 0, 0);
            o0 = __builtin_amdgcn_mfma_f32_32x32x16_bf16(VF(1, 0), pf1, o0, 0, 0, 0);
            o1 = __builtin_amdgcn_mfma_f32_32x32x16_bf16(VF(1, 1), pf1, o1, 0, 0, 0);
#undef VF
        }
        if (start <= 0) done = true;
        const int fb = c & 1;
        if (!done && lane == 0) flags[fb] = 1u;
        asm volatile("s_waitcnt lgkmcnt(0)\n\ts_barrier" ::: "memory");
        const unsigned want = flags[fb];
        if (wave == 0 && lane == 0) flags[fb ^ 1] = 0u;
        if (__builtin_amdgcn_readfirstlane(want) == 0u) break;
        start -= 256; SB_DMA(start, 4);
    }
    asm volatile("s_waitcnt lgkmcnt(0)\n\ts_barrier" ::: "memory");
#undef SB_DMA
    bf16* Op = O + tokq * 512 + h * 64 + 4 * hi;
#pragma unroll
    for (int gi = 0; gi < 4; ++gi) {
        *(unsigned long long*)(Op + 8 * gi) = (unsigned long long)cvtpk2(o0[4 * gi], o0[4 * gi + 1]) | ((unsigned long long)cvtpk2(o0[4 * gi + 2], o0[4 * gi + 3]) << 32);
        *(unsigned long long*)(Op + 32 + 8 * gi) = (unsigned long long)cvtpk2(o1[4 * gi], o1[4 * gi + 1]) | ((unsigned long long)cvtpk2(o1[4 * gi + 2], o1[4 * gi + 3]) << 32);
    }
}

__device__ __forceinline__ void cnt_barrier(unsigned* word, unsigned target, unsigned* bar, int wave_) {
    asm volatile("s_waitcnt vmcnt(0)" ::: "memory");
    __syncthreads();
    if (wave_ == 0 && lane_id_now() == 0) {
        __builtin_amdgcn_s_waitcnt(0);
        (void)xb_add(word, 1u);
        XB_SPIN(xb_ld(word) < target, bar);
        __builtin_amdgcn_fence(__ATOMIC_ACQUIRE, "agent");
        asm volatile("s_waitcnt vmcnt(0)" ::: "memory");
    }
    __syncthreads();
}
#define CG_WORD() ((int)__builtin_amdgcn_readfirstlane((int)F.MISC[12]))

__global__ void __launch_bounds__(NWAVES * 64, 2) mk_fwd(Args args) {
    extern __shared__ __attribute__((aligned(16))) unsigned char lds[];
    Frame F;
    F.lds = (LAS unsigned char*)lds;
    F.MISC = (volatile LAS unsigned*)(F.lds + MISC_OFF);
    F.wave = __builtin_amdgcn_readfirstlane((int)threadIdx.x >> 6);
    F.G = gridDim.x; { const int bx = blockIdx.x; F.vcu = (F.G % 8 == 0) ? (bx % 8) * (F.G / 8) + bx / 8 : bx; }
    unsigned char* ws = args.ws;
    F.ctl = (gu32*)(ws + WS_CTL);
    for (int u = (F.wave * 64 + LANE_NOW); u < (LDS_BYTES - LDSCTL_OFF) / 4; u += NWAVES * 64) ((LAS unsigned*)(F.lds + LDSCTL_OFF))[u] = 0u;
    __syncthreads();
    const int lo = args.ph_lo, hi_ = args.ph_hi;
    const bool one_launch = (hi_ - lo) > 1;
    XcdBarrier bar; bar.bar = (unsigned*)(F.ctl + CW_BAR); bar.x = 0; bar.st = nullptr;
    if (one_launch) bar = xcd_barrier_post((unsigned*)(F.ctl + CW_BAR), F.MISC + 8);
#ifndef PH_MASK
#define PH_MASK 0xffff
#endif
#define IN(k) ((((PH_MASK) >> (k)) & 1) && lo <= (k) && (k) < hi_)
#ifndef MK_PREFETCH
#define MK_PREFETCH 0
#endif
#ifndef PROBE_DUP
#define PROBE_DUP -1
#endif
#define NREP(k) ((PROBE_DUP == (k)) ? 2 : 1)
#define LSEAM(k, word, target) do { if (IN(k) && IN((k) + 1)) { if (grouped) cnt_barrier((unsigned*)(F.ctl + (word)), (target), (unsigned*)(F.ctl + CW_BAR), F.wave); else xcd_barrier(bar, F.wave); } } while (0)
#define SEAM(k) do { if (IN(k) && IN((k) + 1)) { xcd_barrier(bar, F.wave); if (PROBE_DUP == 20) xcd_barrier(bar, F.wave); } } while (0)
    const int gw = F.vcu * NWAVES + F.wave, NGW = F.G * NWAVES;

    bf16* WIN = (bf16*)(ws + WS_WIN); bf16* WDA = (bf16*)(ws + WS_WDA); bf16* WSB = (bf16*)(ws + WS_WSB); bf16* WO = (bf16*)(ws + WS_WO);
    bf16* WGU = (bf16*)(ws + WS_WGU); bf16* WD = (bf16*)(ws + WS_WD);
    bf16* H = (bf16*)(ws + WS_H); bf16* P = (bf16*)(ws + WS_P); bf16* VBT = (bf16*)(ws + WS_VBT); bf16* ODA = (bf16*)(ws + WS_ODA);
    bf16* DA = (bf16*)(ws + WS_DA); bf16* SBO = (bf16*)(ws + WS_SB); bf16* MX = (bf16*)(ws + WS_H);
    bf16* ACT = (bf16*)(ws + WS_ACT); bf16* YS = (bf16*)(ws + WS_YS);
    float* rope = (float*)(ws + WS_ROPE);
    int* tok_e = (int*)(ws + WS_ROUTE); int* tok_pos = tok_e + M * 4;
    float* rstd_tok = (float*)(ws + WS_ROUTE + 768 * 1024);
    int* list_tok = (int*)(ws + WS_LIST); float* list_gate = (float*)(ws + WS_LIST + 2 * MiB);
    bf16* X1 = (bf16*)args.out; constexpr int X1P = 2 * D;

    if (IN(0)) for (int rep_ = 0; rep_ < NREP(0); ++rep_) { p0_prologue(F, args, ws); }
    SEAM(0);
    if (IN(1)) {
        { pg8::Gemm g{H, WIN, M, NPROJ, D}; pg8::DupOrder S; S.S.init(M, NPROJ, F.G, (int)blockIdx.x); S.n = 5; S.reps = NREP(21);
          pg8::EpiInProj E{P, rope, 0.125f * 1.4426950408889634f};
          pg8::gemm_phase<pg8::EpiInProj, pg8::DupOrder, true, true>(F.lds + RING_OFF, g, S, E, F.wave); }
#ifdef SB_WAVE_FORM
        for (int rep_ = 0; rep_ < NREP(11); ++rep_)
        { pg8::Gemm g{WIN + (size_t)2560 * 1024, H, 512, M, D}; pg8::StaticOrder S; S.init(512, M, F.G, (int)blockIdx.x);
          pg8::EpiPlain E{VBT, M};
          pg8::gemm_phase<pg8::EpiPlain, pg8::StaticOrder, true, true>(F.lds + RING_OFF, g, S, E, F.wave); }
    #endif
    }
    SEAM(1);
    if (IN(2)) {
#ifndef DA_SPLIT_V
        for (int rep_ = 0; rep_ < NREP(2); ++rep_)
        for (int i = 0; i < 2; ++i) {
            const int bh = F.vcu >> 3, s = F.vcu & 7; const int qb = (i == 0) ? s : 15 - s;
            const int b = bh >> 3, hq = bh & 7;
            if (bh < BATCH * 8)
                attn_body::attn_unit2<8, NPROJ, NPROJ, NPROJ, 1024>(F.wave, b, qb, (const attn_body::bf16*)(P + hq * 64), (const attn_body::bf16*)(P + 512 + hq * 64),
                    (const attn_body::bf16*)(P + 1024 + (hq >> 1) * 128), (attn_body::bf16*)(ODA + hq * 128), (char*)lds + RING_OFF);
        }
#else
        for (int rep_ = 0; rep_ < NREP(2); ++rep_)
        for (int i = 0; i < 4; ++i) {
            const int bh = F.vcu >> 2, s = F.vcu & 3; const int qb = (i == 0) ? s : (i == 1) ? 7 - s : (i == 2) ? 8 + s : 15 - s;
            const int b = bh >> 4, vh = bh & 15;
            if (bh < BATCH * 16)
                attn_body::attn_unit<8, NPROJ, NPROJ, NPROJ, 1024>(F.wave, b, qb, (const attn_body::bf16*)(P + (vh >> 1) * 64), (const attn_body::bf16*)(P + 512 + (vh >> 1) * 64),
                    (const attn_body::bf16*)(P + 1024 + (vh >> 2) * 128 + (vh & 1) * 64), (attn_body::bf16*)(ODA + vh * 64), (char*)lds + RING_OFF);
        }
#endif
#ifndef SB_WAVE_FORM
        for (int rep_ = 0; rep_ < NREP(12); ++rep_)
        for (int i = 0; i < 2; ++i) {
            const int bh = F.vcu >> 3, s = F.vcu & 7; const int qblk = (i == 0) ? s : 15 - s;
            if (bh < BATCH * 8) sb_unit(F.wave, bh >> 3, bh & 7, qblk, P, SBO, (char*)lds + RING_OFF);
        }
#else
        for (int rep_ = 0; rep_ < NREP(12); ++rep_)
        for (int w = gw; w < 2048; w += NGW) { const int bh = w >> 6, j = w & 63; sb_item(bh >> 3, bh & 7, j, P, VBT, SBO, LANE_NOW); sb_item(bh >> 3, bh & 7, 127 - j, P, VBT, SBO, LANE_NOW); }
#endif
    }
    SEAM(2);
    { const bool reg_ = one_launch && F.MISC[13] != 0u && F.G == 256 && PROBE_DUP < 0 && F.MISC[10] < 32u && F.MISC[11] < 8u;
      if (F.wave == 0 && LANE_NOW == 0) F.MISC[12] = reg_ ? (0x10000u | (8u * F.MISC[10] + F.MISC[11])) : (unsigned)blockIdx.x;
      __syncthreads(); }
    const bool grouped = (CG_WORD() >> 16) != 0; const int cg = CG_WORD() & 0xffff;
    int gpm, gpn; { pg8::StaticOrder S_; S_.init(M, D, F.G, cg); pg8::Unit u_; S_.next(0, u_); gpm = u_.pm; gpn = u_.pn; }
    if (IN(3)) for (int rep_ = 0; rep_ < NREP(3); ++rep_) {
        const float* lq1 = args.in[3]; const float* lk1 = args.in[4]; const float* lq2 = args.in[5]; const float* lk2 = args.in[6]; const float* sg = args.in[7];
        const float lam = __expf(wave_sum(lq1[LANE_NOW] * lk1[LANE_NOW])) - __expf(wave_sum(lq2[LANE_NOW] * lk2[LANE_NOW])) + LAMBDA_INIT;
        const int l = LANE_NOW, hh = l >> 4, c0 = 8 * (l & 15), half = c0 >> 6, cc = c0 & 63;
        const f32x4 ga = *(const f32x4*)(sg + c0), gb = *(const f32x4*)(sg + c0 + 4);
        const int m_lo = grouped ? gpm * 256 + gpn * 64 + F.wave : gw, m_hi = grouped ? gpm * 256 + gpn * 64 + 64 : M, m_st = grouped ? NWAVES : NGW;
        for (int mb = m_lo; mb < m_hi; mb += 8 * m_st) {
          v4u w0s[8], w1s[8];
#pragma unroll
          for (int i = 0; i < 8; ++i) { const int mm = (mb + i * m_st < m_hi) ? mb + i * m_st : mb;
              w0s[i] = __builtin_nontemporal_load((const v4u*)(ODA + (size_t)mm * 1024 + (4 * hh + half) * 64 + cc)); w1s[i] = __builtin_nontemporal_load((const v4u*)(ODA + (size_t)mm * 1024 + (4 * hh + 2 + half) * 64 + cc)); }
#pragma unroll
          for (int i = 0; i < 8; ++i) { const int m = mb + i * m_st; if (m >= m_hi) break;
            const v4u w0 = w0s[i], w1 = w1s[i];
            f32x4 a0, a1, b0, b1; pg8::unpack8(w0, a0, a1); pg8::unpack8(w1, b0, b1);
            const f32x4 d0 = a0 - b0 * lam, d1 = a1 - b1 * lam;
            float ss = (d0[0] * d0[0] + d0[1] * d0[1]) + (d0[2] * d0[2] + d0[3] * d0[3]) + (d1[0] * d1[0] + d1[1] * d1[1]) + (d1[2] * d1[2] + d1[3] * d1[3]);
            ss += __shfl_xor(ss, 1); ss += __shfl_xor(ss, 2); ss += __shfl_xor(ss, 4); ss += __shfl_xor(ss, 8);
            const float rs = (1.0f - LAMBDA_INIT) / sqrtf(ss * (1.0f / 128.0f) + EPS);
            *(v4u*)(DA + (size_t)m * 512 + hh * 128 + c0) = pg8::pack8(d0 * rs * ga, d1 * rs * gb);
          }
        }
    }
    LSEAM(3, CW_GRP + 64 * gpm, 4u);
    if (IN(4)) {
        { pg8::StaticOrder S0; S0.init(M, D, F.G, cg); pg8::Unit u0;
          if (MK_PREFETCH && S0.next(0, u0)) { const char* gbase = (const char*)(P + (size_t)u0.pm * 256 * NPROJ + 3072 + u0.pn * 256); const int tid_ = F.wave * 64 + LANE_NOW;
#pragma unroll
            for (int i = 0; i < 4; ++i) { const int line = tid_ + 512 * (i & 1), row = line >> 2, seg = line & 3;
                attn_body::glds16(gbase + (size_t)row * (NPROJ * 2) + (i >> 1) * 2048 + seg * 128, (unsigned)__builtin_amdgcn_readfirstlane((unsigned)(uintptr_t)lds + JUNK_OFF + F.wave * 1024)); } } }
        { pg8::Gemm g{DA, WDA, M, D, 512, nullptr, nullptr}; pg8::DupOrder S; S.S.init(M, D, F.G, cg); S.n = 1; S.reps = NREP(24); pg8::EpiMix<0> E{P, MX};
          pg8::gemm_phase<pg8::EpiMix<0>, pg8::DupOrder, true, true>(F.lds + RING_OFF, g, S, E, F.wave); }
        { pg8::Gemm g{SBO, WSB, M, D, 512, nullptr, nullptr}; pg8::DupOrder S; S.S.init(M, D, F.G, cg); S.n = 1; S.reps = NREP(24); pg8::EpiMix<1> E{P, MX};
          pg8::gemm_phase<pg8::EpiMix<1>, pg8::DupOrder, true, true>(F.lds + RING_OFF, g, S, E, F.wave); }
    }
    LSEAM(4, CW_GRP + 64 * gpm, 8u);
    if (IN(5)) for (int rep_ = 0; rep_ < NREP(5); ++rep_) {
        pg8::Gemm g{MX, WO, M, D, D}; pg8::StaticOrder S; S.init(M, D, F.G, cg); pg8::EpiResidBf E{args.in[0], X1, D, X1P, (unsigned char*)args.out + 2048, 4096, F8_XSCALE};
        { pg8::Unit u0;
          if (MK_PREFETCH && S.next(0, u0)) { const char* xbase = (const char*)(args.in[0] + (size_t)u0.pm * 256 * D + u0.pn * 256); const int tid_ = F.wave * 64 + LANE_NOW;
#pragma unroll
            for (int i = 0; i < 4; ++i) { const int line = tid_ + 512 * i, row = line >> 3, seg = line & 7;
                attn_body::glds16(xbase + (size_t)row * (D * 4) + seg * 128, (unsigned)__builtin_amdgcn_readfirstlane((unsigned)(uintptr_t)lds + JUNK_OFF + F.wave * 1024)); } } }
        pg8::gemm_phase<pg8::EpiResidBf, pg8::StaticOrder, true, true>(F.lds + RING_OFF, g, S, E, F.wave);
    }
    LSEAM(5, CW_GRP + 64 * gpm, 12u);
    if (IN(6)) for (int rep_ = 0; rep_ < NREP(6); ++rep_) {
        const int cnt_bank = (rep_ + 1 < NREP(6)) ? 4096 * 16 : 0;
        const float* g_ffn = args.in[11]; const float* w_r = args.in[12]; const float* b_r = args.in[13];
        LAS float* WL = (LAS float*)(F.lds);
        LAS float* LG = (LAS float*)(F.lds + RING_BYTES);
        LAS float* RS = (LAS float*)(F.lds + RING_BYTES + 8192);
        LAS unsigned* LC = (LAS unsigned*)(F.lds + LDSCTL_OFF + 8192);
        LAS int* PEND = (LAS int*)(F.lds + LDSCTL_OFF + 8192 + 512) + F.wave * 128;
        const int tid_ = F.wave * 64 + LANE_NOW, lane = LANE_NOW;
        if (tid_ < 64) LC[tid_] = 0u;
        for (int reps_ = 0; reps_ < NREP(60); ++reps_)
        { const char* wlg = (const char*)(ws + WS_WLG) + F.wave * 1024 + lane * 16; const unsigned wl0 = (unsigned)(uintptr_t)F.lds + (unsigned)F.wave * 1024u;
#pragma unroll
          for (int j = 0; j < 16; ++j) attn_body::glds16(wlg + j * 8192, (unsigned)__builtin_amdgcn_readfirstlane(wl0 + j * 8192u));
          asm volatile("s_waitcnt vmcnt(0)" ::: "memory"); }
        __syncthreads();
        const int tok0 = grouped ? (gpm * 4 + gpn) * 64 : F.vcu * 64;
        for (int repa_ = 0; repa_ < NREP(61); ++repa_)
        {
            const int tg = F.wave >> 1, eh = F.wave & 1, tl = lane & 15, kq = lane >> 4;
            const bf16* xrow = X1 + (size_t)(tok0 + 16 * tg + tl) * X1P + 16 * kq;
            const LAS unsigned char* wlb = (const LAS unsigned char*)WL + (size_t)(kq * 32 + 16 * eh + tl) * 16;
            f32x4 acc = {0.f, 0.f, 0.f, 0.f}; float ss = 0.f;
            v4u awa[16][2];
#pragma unroll
            for (int jj = 0; jj < 16; ++jj) { awa[jj][0] = *(const v4u*)(xrow + 64 * jj); awa[jj][1] = *(const v4u*)(xrow + 64 * jj + 8); }
#pragma unroll
            for (int jj = 0; jj < 16; ++jj) {
#pragma unroll
                for (int p = 0; p < 2; ++p) { const v4u aw = awa[jj][p];
                    const float a0 = pg8::bf_lo(aw.x), a1 = pg8::bf_hi(aw.x), a2 = pg8::bf_lo(aw.y), a3 = pg8::bf_hi(aw.y), a4 = pg8::bf_lo(aw.z), a5 = pg8::bf_hi(aw.z), a6 = pg8::bf_lo(aw.w), a7 = pg8::bf_hi(aw.w);
                    ss += (a0 * a0 + a1 * a1) + (a2 * a2 + a3 * a3) + (a4 * a4 + a5 * a5) + (a6 * a6 + a7 * a7);
                    const bf16x8 af = __builtin_bit_cast(bf16x8, aw);
                    const bf16x8 bh = *(const LAS bf16x8*)(wlb + (size_t)((jj * 2 + p) * 2 + 0) * 2048), bl = *(const LAS bf16x8*)(wlb + (size_t)((jj * 2 + p) * 2 + 1) * 2048);
                    acc = __builtin_amdgcn_mfma_f32_16x16x32_bf16(af, bh, acc, 0, 0, 0); acc = __builtin_amdgcn_mfma_f32_16x16x32_bf16(af, bl, acc, 0, 0, 0); } }
            ss += __shfl_xor(ss, 16); ss += __shfl_xor(ss, 32);
            const float rstd = 1.f / sqrtf(ss * (1.f / D) + EPS);
            if (eh == 0 && kq == 0) rstd_tok[tok0 + 16 * tg + tl] = rstd;
            const float bias = b_r[16 * eh + tl];
#pragma unroll
            for (int r = 0; r < 4; ++r) { const float rs = __shfl(rstd, 4 * kq + r); LG[(16 * tg + 4 * kq + r) * 32 + 16 * eh + tl] = acc[r] * rs + bias; }
        }
        __syncthreads();
        for (int it = 0; it < 8; ++it) { const int tl = F.wave * 8 + it, mtok = tok0 + tl;
            const float cur = LG[tl * 32 + (lane >> 1)];
            int sel[4]; float sv[4];
            for (int rept_ = 0; rept_ < NREP(64); ++rept_)
            { const int eme = lane >> 1; int rank = 0;
#pragma unroll
              for (int j = 0; j < 32; ++j) { const float vj = __int_as_float(__builtin_amdgcn_readlane(__float_as_int(cur), 2 * j)); rank += (vj > cur || (vj == cur && j < eme)) ? 1 : 0; }
#pragma unroll
              for (int k = 0; k < 4; ++k) { const unsigned long long bal = __ballot(rank == k); const int ln = __ffsll((long long)bal) - 1; sel[k] = ln >> 1; sv[k] = __int_as_float(__builtin_amdgcn_readlane(__float_as_int(cur), ln)); } }
            const float p1 = __expf(sv[1] - sv[0]), p2 = __expf(sv[2] - sv[0]), p3 = __expf(sv[3] - sv[0]); const float inv = 1.0f / (1.0f + p1 + p2 + p3);
            if (lane < 4) { const int k = lane; const int e = (k == 0) ? sel[0] : (k == 1) ? sel[1] : (k == 2) ? sel[2] : sel[3];
                const float gt = ((k == 0) ? 1.0f : (k == 1) ? p1 : (k == 2) ? p2 : p3) * inv;
                const unsigned pl = __hip_atomic_fetch_add(LC + e, 1u, __ATOMIC_RELAXED, __HIP_MEMORY_SCOPE_WORKGROUP);
                LAS int* pe = PEND + it * 12 + k * 3; pe[0] = e; pe[1] = (int)pl; pe[2] = __float_as_int(gt); }
        }
        for (int repc_ = 0; repc_ < NREP(63); ++repc_) { const int bank_ = (repc_ + 1 < NREP(63)) ? 4096 * 24 : cnt_bank;
        __syncthreads();
        if (tid_ < NE) LC[32 + tid_] = __hip_atomic_fetch_add((unsigned*)(F.ctl + CW_CNT + bank_ + 64 * tid_), LC[tid_], __ATOMIC_RELAXED, __HIP_MEMORY_SCOPE_AGENT);
        __syncthreads();
        for (int it = 0; it < 8; ++it) if (lane < 4) { const int k = lane, mtok = tok0 + F.wave * 8 + it; const LAS int* pe = PEND + it * 12 + k * 3; const int e = pe[0]; const unsigned pos = LC[32 + e] + (unsigned)pe[1];
            tok_e[mtok * 4 + k] = e; tok_pos[mtok * 4 + k] = (int)pos; if (cnt_bank == 0) { list_tok[e * 16384 + pos] = mtok; list_gate[e * 16384 + pos] = __int_as_float(pe[2]); } }
        }
        __syncthreads();
    }
    SEAM(6);
    LAS int* TAB = (LAS int*)(F.lds + TAB_OFF);
    if (IN(8) || IN(9) || IN(10)) {
        const int tid_ = F.wave * 64 + LANE_NOW;
        if (tid_ < NE) TAB[328 + tid_] = (int)__hip_atomic_load((unsigned*)(F.ctl + CW_CNT + 64 * tid_), __ATOMIC_RELAXED, __HIP_MEMORY_SCOPE_AGENT);
        __syncthreads();
        if (F.wave == 0) { const int l_ = LANE_NOW, e_ = l_ & 31;
            const int nt_ = (TAB[328 + e_] + 255) >> 8; int inc_ = nt_;
#pragma unroll
            for (int o_ = 1; o_ < 32; o_ <<= 1) { const int up_ = __shfl_up(inc_, o_, 32); inc_ += (e_ >= o_) ? up_ : 0; }
            const int t0_ = inc_ - nt_;
            if (l_ < 32) { TAB[e_] = t0_; for (int t = 0; t < nt_; ++t) TAB[40 + t0_ + t] = e_; if (e_ == 31) TAB[32] = inc_; } }
        __syncthreads();
        { const int nTl = TAB[32]; const bool live = tid_ < nTl; int isfull = 0;
          if (live) { const int e = TAB[40 + tid_]; isfull = (TAB[328 + e] - (tid_ - TAB[e]) * 256 > 128) ? 1 : 0; }
          const unsigned long long bal = __ballot(live && isfull);
          if (LANE_NOW == 0) TAB[752 + F.wave] = __popcll(bal);
          __syncthreads();
          int before = 0, nF = 0;
#pragma unroll
          for (int w = 0; w < NWAVES; ++w) { const int cw = TAB[752 + w]; nF += cw; if (w < F.wave) before += cw; }
          const int fi = before + __popcll(bal & ((1ull << LANE_NOW) - 1ull)), si = tid_ - fi, nS = nTl - nF;
          if (live) { const int idx = isfull ? fi : si, n = isfull ? nF : nS; int x = 0;
#pragma unroll
              for (int q = 1; q < 8; ++q) if (idx >= q * n / 8) x = q;
              const int f0 = x * nF / 8, f1 = (x + 1) * nF / 8, s0 = x * nS / 8;
              TAB[360 + x * 48 + (isfull ? (fi - f0) : (f1 - f0) + (si - s0))] = tid_; }
          if (tid_ < 8) { const int x = tid_; TAB[744 + x] = ((x + 1) * nF / 8 - x * nF / 8) + ((x + 1) * nS / 8 - x * nS / 8); } }
        __syncthreads();
    }
    if (IN(8)) for (int rep_ = 0; rep_ < NREP(8); ++rep_) {
        const int nT = __builtin_amdgcn_readfirstlane(TAB[32]);
        pg8::MoeOrderG S; S.npn = 8; S.G = F.G; S.c = CG_WORD() & 0xffff; S.rdy = (unsigned*)(F.ctl + CW_RDY); S.tmo = (unsigned*)(F.ctl + CW_BAR) + XB_TMO; S.mode = (NREP(8) == 1) ? 1 : 0; S.nb64 = 2048 * 64; S.ebytes = 2048 * 1024; S.tab = (const LAS int*)TAB; S.tokl = (const LAS int*)(F.lds + TOK_OFF);
        { LAS int* TOK = (LAS int*)(F.lds + TOK_OFF); const int tid_ = F.wave * 64 + LANE_NOW; pg8::Unit u;
          int tk[12];
          int e_l, lt_l, cnt_l; const int ok_l = S.next_v(LANE_NOW < 12 ? LANE_NOW : 0, e_l, lt_l, cnt_l) ? 1 : 0;
#pragma unroll
          for (int i = 0; i < 12; ++i) { const bool ok = __builtin_amdgcn_readlane(ok_l, i) != 0; const int ue = __builtin_amdgcn_readlane(e_l, i), ult = __builtin_amdgcn_readlane(lt_l, i), ucnt = __builtin_amdgcn_readlane(cnt_l, i);
              const int p = ult * 256 + (tid_ & 255); const bool live = ok && p < ucnt; const int v = list_tok[live ? ue * 16384 + p : 0]; tk[i] = live ? v : 0; }
#pragma unroll
          for (int i = 0; i < 12; ++i) if (tid_ < 256) TOK[i * 256 + tid_] = tk[i];
          __syncthreads(); }
        pg8::Gemm g{(const bf16*)((const unsigned char*)args.out + 2048), WGU, M, 2048, D / 2, nullptr, nullptr}; S.pitch = X1P; S.fsc = 0x01010101 * (127 - 7);
        pg8::EpiMoe1 E{(unsigned char*)ACT, F8_ASCALE, args.in[15], args.in[17], rstd_tok, (const LAS int*)(F.lds + TOK_OFF), (LAS float*)(F.lds + EPISTG_OFF)};
        pg8::gemm_phase<pg8::EpiMoe1, pg8::MoeOrderG, true, true>(F.lds + RING_OFF, g, S, E, F.wave);
    }
    if (!grouped || PROBE_DUP >= 0) SEAM(8);
    if (IN(9)) for (int rep_ = 0; rep_ < NREP(9); ++rep_) {
        const int nT = __builtin_amdgcn_readfirstlane(TAB[32]);
        pg8::Gemm g{ACT, WD, MAXT * 256, 1024, FF / 2, nullptr, nullptr}; pg8::MoeOrder S{4, F.G, CG_WORD() & 0xffff, (const LAS int*)TAB}; S.rdy = (unsigned*)(F.ctl + CW_RDY); S.tmo = (unsigned*)(F.ctl + CW_BAR) + XB_TMO; S.mode = (NREP(8) == 1) ? 2 : 0; S.nb64 = 1024 * 64; S.ebytes = 1024 * 1024; S.pkl = (LAS unsigned*)(F.lds + LDSCTL_OFF + 8192); S.fsc = 0x01010101 * (127 - 6);
        pg8::EpiMoe2 E{(unsigned char*)YS, F8_YSCALE, args.in[19], list_gate, (LAS float*)(F.lds + EPISTG_OFF)};
        pg8::gemm_phase<pg8::EpiMoe2, pg8::MoeOrder, true, true>(F.lds + RING_OFF, g, S, E, F.wave);
    }
    SEAM(9);
    if (IN(10)) for (int rep_ = 0; rep_ < NREP(10); ++rep_) {
        float* const OUTP = (rep_ + 1 < NREP(10)) ? (float*)ACT : args.out;
        const float* g_fin = args.in[20];
        unsigned poison = (__hip_atomic_load(F.ctl + CW_TMO, RLX_AGENT) != 0u) || (__hip_atomic_load((gu32*)((unsigned*)(F.ctl + CW_BAR) + XB_TMO), RLX_AGENT) != 0u);
        typedef int i32x4 __attribute__((ext_vector_type(4)));
        i32x4 ne = {0, 0, 0, 0}, np = {0, 0, 0, 0};
        if (gw < M) { ne = *(const i32x4*)(tok_e + gw * 4); np = *(const i32x4*)(tok_pos + gw * 4); }
        for (int m = gw; m < M; m += NGW) {
            const i32x4 ce = ne, cp = np;
            if (m + NGW < M) { ne = *(const i32x4*)(tok_e + (m + NGW) * 4); np = *(const i32x4*)(tok_pos + (m + NGW) * 4); }
            f32x4 v[4];
#pragma unroll
            for (int j = 0; j < 4; ++j) { const unsigned long long xw = __builtin_nontemporal_load((const unsigned long long*)(X1 + (size_t)m * X1P + 4 * LANE_NOW + 256 * j)); const unsigned xl = (unsigned)xw, xh = (unsigned)(xw >> 32); v[j] = (f32x4){pg8::bf_lo(xl), pg8::bf_hi(xl), pg8::bf_lo(xh), pg8::bf_hi(xh)}; }
            f32x4 ys[4] = {{0.f, 0.f, 0.f, 0.f}, {0.f, 0.f, 0.f, 0.f}, {0.f, 0.f, 0.f, 0.f}, {0.f, 0.f, 0.f, 0.f}};
#pragma unroll
            for (int k = 0; k < 4; ++k) { const int e = ce[k], pos = cp[k]; const size_t slot = (size_t)TAB[e] * 256 + pos;
#pragma unroll
                for (int j = 0; j < 4; ++j) { const int w = __builtin_nontemporal_load((const int*)((const unsigned char*)YS + slot * D + 4 * LANE_NOW + 256 * j));
                    const pg8::f32x2 lo = __builtin_amdgcn_cvt_pk_f32_fp8(w, false), hi = __builtin_amdgcn_cvt_pk_f32_fp8(w, true);
                    ys[j] = ys[j] + (f32x4){lo[0], lo[1], hi[0], hi[1]}; } }
#pragma unroll
            for (int j = 0; j < 4; ++j) v[j] = v[j] + ys[j] * (1.0f / F8_YSCALE);
            float s = 0.f;
#pragma unroll
            for (int j = 0; j < 4; ++j) s += (v[j].x * v[j].x + v[j].y * v[j].y) + (v[j].z * v[j].z + v[j].w * v[j].w);
            const float rstd = 1.f / sqrtf(wave_sum(s) * (1.f / D) + EPS);
#pragma unroll
            for (int j = 0; j < 4; ++j) { const f32x4 gg = *(const f32x4*)(g_fin + 4 * LANE_NOW + 256 * j); f32x4 o = v[j] * rstd * gg;
                if (poison) { const float q = __builtin_nanf(""); o = (f32x4){q, q, q, q}; }
                __builtin_nontemporal_store(o, (f32x4*)(OUTP + (size_t)m * D + 4 * LANE_NOW + 256 * j)); }
        }
    }
#undef IN
#undef SEAM
}

#ifndef MK_ONE_LAUNCH
#define MK_ONE_LAUNCH 1
#endif
constexpr int N_PHASES = 11;
extern "C" void kernel_launch(void* const* d_in, const int* in_sizes, int n_in, void* d_out, int out_size, void* d_ws, size_t ws_size, hipStream_t stream) {
    static int grid = 0;
    if (grid == 0) {
        if (n_in != 21 || in_sizes[0] != M * D || out_size != M * D || ws_size < WS_END) { fprintf(stderr, "kernel_launch: unexpected shapes: n_in %d in0 %d out %d ws %zu (need %zu); nothing launched\n", n_in, n_in > 0 ? in_sizes[0] : -1, out_size, ws_size, (size_t)WS_END); grid = -1; return; }
        int dev = 0, cus = 0, per_cu = 0;
        if (hipGetDevice(&dev) != hipSuccess || hipDeviceGetAttribute(&cus, hipDeviceAttributeMultiprocessorCount, dev) != hipSuccess) { grid = -1; return; }
        if (hipFuncSetAttribute((const void*)mk_fwd, hipFuncAttributeMaxDynamicSharedMemorySize, LDS_BYTES) != hipSuccess) { fprintf(stderr, "kernel_launch: hipFuncSetAttribute failed\n"); grid = -1; return; }
        if (hipOccupancyMaxActiveBlocksPerMultiprocessor(&per_cu, (const void*)mk_fwd, NWAVES * 64, LDS_BYTES) != hipSuccess || per_cu < 1) { fprintf(stderr, "kernel_launch: occupancy query says %d blocks per CU\n", per_cu); (void)hipGetLastError(); grid = -1; return; }
        grid = cus;
        if (grid != 256) fprintf(stderr, "kernel_launch: note: %d CUs\n", grid);
    }
    if (grid < 0) return;
    if (hipMemsetAsync((char*)d_ws + WS_CTL, 0, CTL_ZERO_BYTES, stream) != hipSuccess) return;
    Args a{};
    for (int i = 0; i < 21; ++i) a.in[i] = (const float*)d_in[i];
    a.out = (float*)d_out; a.ws = (unsigned char*)d_ws;
#if MK_ONE_LAUNCH
    a.ph_lo = 0; a.ph_hi = N_PHASES;
    hipLaunchKernelGGL(mk_fwd, dim3(grid), dim3(NWAVES * 64), LDS_BYTES, stream, a);
#else
    for (int p = 0; p < N_PHASES; ++p) { a.ph_lo = p; a.ph_hi = p + 1; hipLaunchKernelGGL(mk_fwd, dim3(grid), dim3(NWAVES * 64), LDS_BYTES, stream, a); }
#endif
}
```

```cpp
#include <hip/hip_runtime.h>
#include <cstdio>
#include <cstdint>
__device__ __forceinline__ int lane_id_now() { int l; asm volatile("v_mbcnt_lo_u32_b32 %0, -1, 0\n\tv_mbcnt_hi_u32_b32 %0, -1, %0" : "=v"(l)); return l; }
namespace pg8 {
#define PG8_LAS __attribute__((address_space(3)))
typedef unsigned short bf16_t;
typedef short bf16x8 __attribute__((ext_vector_type(8)));
typedef float f32x4 __attribute__((ext_vector_type(4)));
typedef unsigned u32x4 __attribute__((ext_vector_type(4)));
constexpr int BM = 256, BK = 64, HALF = 128, HTB = HALF * BK * 2  , STAGE_BYTES = 8 * HTB, NXCD = 8, WGM = 8;

__host__ __device__ __forceinline__ int lds_byte(int r, int c) { const int st = (r >> 4) * 2 + (c >> 5), rr = r & 15, cc = c & 31, ob = rr * 64 + cc * 2; return st * 1024 + (ob ^ (((ob >> 9) & 1) << 5)); }
__host__ __device__ __forceinline__ void stage_rc(int b, int& R, int& C) { const int st = b / 1024, sb = b % 1024, swz = sb ^ (((sb >> 9) & 1) << 5); R = (st >> 1) * 16 + swz / 64; C = (st & 1) * 32 + (swz % 64) / 2; }
__host__ __device__ __forceinline__ int perm32(int rho) { const int n = rho >> 4, i = rho & 15; return 8 * (i >> 2) + 4 * n + (i & 3); }

struct Unit { int pm, pn, pb, e, lt, cnt, full, ui; };
struct Gemm { const bf16_t* A; const bf16_t* Bt; int M, N, K; const bf16_t* A2; const bf16_t* Bt2; };

struct StaticOrder {
    int nM, nN, nwg, G, c;
    __host__ __device__ __forceinline__ void init(int M, int N, int G_, int c_) { nM = M / BM; nN = N / BM; nwg = nM * nN; G = G_; c = c_; }
    __host__ __device__ __forceinline__ bool next(int i, Unit& u) const {
        const long L = (long)i * G + c; if (L >= nwg) return false;
        int wgid = (int)L; { const int q = nwg / NXCD, r = nwg % NXCD, xcd = wgid % NXCD, off = wgid / NXCD; wgid = (xcd < r ? xcd * (q + 1) : r * (q + 1) + (xcd - r) * q) + off; }
        const int nig = WGM * nN, gid = wgid / nig, fm = gid * WGM, gsz = (nM - fm) < WGM ? (nM - fm) : WGM;
        u.pm = fm + ((wgid % nig) % gsz); u.pn = (wgid % nig) / gsz; u.pb = u.pn; u.e = 0; u.lt = 0; u.cnt = 0; u.full = 1; u.ui = i; return true;
    }
    static constexpr bool DUAL = false, GATHER = false, HALFSKIP = false, FP8 = false, BCH = false; static constexpr int fsc = 0, nb64 = 0, ebytes = 0;
    __device__ __forceinline__ void a_ready(const Unit&) const {}
    __device__ __forceinline__ void done(const Unit&) const {}
};

__device__ __forceinline__ unsigned cvt_pk_bf16(float lo, float hi) { unsigned r; asm volatile("v_cvt_pk_bf16_f32 %0, %1, %2" : "=v"(r) : "v"(lo), "v"(hi)); return r; }
__device__ __forceinline__ u32x4 pack8(const f32x4 a, const f32x4 b) { u32x4 w; w.x = cvt_pk_bf16(a[0], a[1]); w.y = cvt_pk_bf16(a[2], a[3]); w.z = cvt_pk_bf16(b[0], b[1]); w.w = cvt_pk_bf16(b[2], b[3]); return w; }
__device__ __forceinline__ float bf_lo(unsigned w) { return __uint_as_float(w << 16); }
__device__ __forceinline__ float bf_hi(unsigned w) { return __uint_as_float(w & 0xffff0000u); }
__device__ __forceinline__ void unpack8(const u32x4 w, f32x4& a, f32x4& b) { a = (f32x4){bf_lo(w.x), bf_hi(w.x), bf_lo(w.y), bf_hi(w.y)}; b = (f32x4){bf_lo(w.z), bf_hi(w.z), bf_lo(w.w), bf_hi(w.w)}; }
__device__ __forceinline__ float sigmoidf_(float x) { return __builtin_amdgcn_rcpf(1.0f + __expf(-x)); }
__device__ __forceinline__ f32x4 sig4(const f32x4 v) { return (f32x4){sigmoidf_(v[0]), sigmoidf_(v[1]), sigmoidf_(v[2]), sigmoidf_(v[3])}; }

struct EpiPlain {
    static constexpr bool PERM = true, AFTER_DRAIN = false, PREFETCH = false; struct Pref {};
    bf16_t* O; int ldc;
    __device__ __forceinline__ void operator()(const f32x4 (&acc)[2][2][4][2], const Unit& u, int wr, int wc, int fr, int fq) const {
        const int row0 = u.pm * BM + wr * 64 + fr, col0 = u.pn * BM + wc * 32 + 8 * fq;
#pragma unroll
        for (int ai = 0; ai < 2; ++ai)
#pragma unroll
            for (int m = 0; m < 4; ++m) { bf16_t* rowp = O + (size_t)(row0 + ai * HALF + m * 16) * ldc + col0;
#pragma unroll
                for (int bj = 0; bj < 2; ++bj) *(u32x4*)(rowp + bj * HALF) = pack8(acc[ai][bj][m][0], acc[ai][bj][m][1]); }
    }
};

struct EpiInProj {
    static constexpr bool PERM = true, AFTER_DRAIN = false, PREFETCH = false; struct Pref {};
    bf16_t* P; const float* rope; float qscale;
    __device__ __forceinline__ void operator()(const f32x4 (&acc)[2][2][4][2], const Unit& u, int wr, int wc, int fr, int fq) const {
        const int row0 = u.pm * BM + wr * 64 + fr;
        if (u.pn < 4) {
            const float qs = (u.pn < 2) ? qscale : 1.0f;
            const int colbase = u.pn * BM + wc * 64 + 8 * fq;
#pragma unroll
            for (int ai = 0; ai < 2; ++ai)
#pragma unroll
                for (int m = 0; m < 4; ++m) { const int row = row0 + ai * HALF + m * 16, pos = row & 4095;
                    const float* cp = rope + pos * 32 + 8 * fq; const float* sp = cp + 4096 * 32;
                    const f32x4 c0 = *(const f32x4*)cp, c1 = *(const f32x4*)(cp + 4), s0 = *(const f32x4*)sp, s1 = *(const f32x4*)(sp + 4);
                    const f32x4 a0 = acc[ai][0][m][0], a1 = acc[ai][0][m][1], b0 = acc[ai][1][m][0], b1 = acc[ai][1][m][1];
                    const f32x4 y10 = (a0 * c0 - b0 * s0) * qs, y11 = (a1 * c1 - b1 * s1) * qs, y20 = (b0 * c0 + a0 * s0) * qs, y21 = (b1 * c1 + a1 * s1) * qs;
                    bf16_t* rowp = P + (size_t)row * 5120 + colbase;
                    *(u32x4*)(rowp) = pack8(y10, y11); *(u32x4*)(rowp + 32) = pack8(y20, y21); }
        } else {
            const int col0 = u.pn * BM + wc * 32 + 8 * fq; const bool gate = u.pn >= 12; const float sc = (u.pn == 6 || u.pn == 7) ? 0.125f * 1.4426950408889634f : 1.0f;
            if (gate) {
#pragma unroll
                for (int ai = 0; ai < 2; ++ai)
#pragma unroll
                    for (int m = 0; m < 4; ++m) { unsigned char* rowb = (unsigned char*)P + (size_t)(row0 + ai * HALF + m * 16) * 10240 + 6144 + (col0 - 3072);
#pragma unroll
                        for (int bj = 0; bj < 2; ++bj) { const f32x4 v0 = sig4(acc[ai][bj][m][0]) * 255.0f + 0.5f, v1 = sig4(acc[ai][bj][m][1]) * 255.0f + 0.5f;
                            const unsigned lo = (unsigned)v0[0] | ((unsigned)v0[1] << 8) | ((unsigned)v0[2] << 16) | ((unsigned)v0[3] << 24), hi = (unsigned)v1[0] | ((unsigned)v1[1] << 8) | ((unsigned)v1[2] << 16) | ((unsigned)v1[3] << 24);
                            *(unsigned long long*)(rowb + bj * HALF) = (unsigned long long)lo | ((unsigned long long)hi << 32); } }
            } else {
#pragma unroll
            for (int ai = 0; ai < 2; ++ai)
#pragma unroll
                for (int m = 0; m < 4; ++m) { bf16_t* rowp = P + (size_t)(row0 + ai * HALF + m * 16) * 5120 + col0;
#pragma unroll
                    for (int bj = 0; bj < 2; ++bj) { const f32x4 v0 = acc[ai][bj][m][0] * sc, v1 = acc[ai][bj][m][1] * sc;
                        *(u32x4*)(rowp + bj * HALF) = pack8(v0, v1); } }
            }
        }
    }
};

__device__ __forceinline__ unsigned long long pack8_f8(f32x4 a, f32x4 b, float s);
template <int SECOND> struct EpiMix {
    static constexpr bool PERM = true, AFTER_DRAIN = false, PREFETCH = false;
    struct Pref { unsigned long long g[4][2]; };
    const bf16_t* P; bf16_t* MX; unsigned char* MX8;
    __device__ __forceinline__ void prefetch(Pref& pf, const Unit& u, int wr, int wc, int fr, int fq) const {
        const int row0 = u.pm * BM + wr * 64 + fr, col0 = u.pn * BM + wc * 32 + 8 * fq;
#pragma unroll
        for (int m = 0; m < 4; ++m)
#pragma unroll
            for (int bj = 0; bj < 2; ++bj) pf.g[m][bj] = *(const unsigned long long*)((const unsigned char*)P + (size_t)(row0 + m * 16) * 10240 + 6144 + (SECOND ? 1024 : 0) + col0 + bj * HALF);
    }
    __device__ __forceinline__ void operator()(const f32x4 (&acc)[2][2][4][2], const Unit& u, int wr_, int wc_, int fr_, int fq_) const {
        int wr = wr_, wc = wc_, fr = fr_, fq = fq_; asm volatile("" : "+v"(fr), "+v"(fq) : "v"(acc[0][0][0][0]));
        const int row0 = u.pm * BM + wr * 64 + fr, col0 = u.pn * BM + wc * 32 + 8 * fq;
        Pref pf; prefetch(pf, u, wr, wc, fr, fq);
        unsigned long long g1[4][2];
#pragma unroll
        for (int m = 0; m < 4; ++m)
#pragma unroll
            for (int bj = 0; bj < 2; ++bj) g1[m][bj] = *(const unsigned long long*)((const unsigned char*)P + (size_t)(row0 + HALF + m * 16) * 10240 + 6144 + (SECOND ? 1024 : 0) + col0 + bj * HALF);
#pragma unroll
        for (int ai = 0; ai < 2; ++ai)
#pragma unroll
            for (int m = 0; m < 4; ++m) { const size_t row = (size_t)(row0 + ai * HALF + m * 16);
#pragma unroll
                for (int bj = 0; bj < 2; ++bj) { const int c = col0 + bj * HALF;
                    const unsigned long long gq = ai ? g1[m][bj] : pf.g[m][bj]; const unsigned gl = (unsigned)gq, gh = (unsigned)(gq >> 32);
                    const f32x4 g0 = (f32x4){(float)(gl & 255u), (float)((gl >> 8) & 255u), (float)((gl >> 16) & 255u), (float)(gl >> 24)} * (1.0f / 255.0f);
                    const f32x4 g1 = (f32x4){(float)(gh & 255u), (float)((gh >> 8) & 255u), (float)((gh >> 16) & 255u), (float)(gh >> 24)} * (1.0f / 255.0f);
                    f32x4 v0 = acc[ai][bj][m][0] * g0, v1 = acc[ai][bj][m][1] * g1;
                    u32x4* part = (u32x4*)MX + ((size_t)(u.pm * 4 + u.pn) * 16 + (ai * 4 + m) * 2 + bj) * 512 + threadIdx.x;
                    if (SECOND) { const u32x4 ow = *part; f32x4 o0, o1; unpack8(ow, o0, o1); v0 = v0 + o0; v1 = v1 + o1; }
                    if (SECOND) *(unsigned long long*)(MX8 + row * 1024 + c) = pack8_f8(v0, v1, 32.0f); else *part = pack8(v0, v1); } }
    }
};

struct EpiMixDual {
    static constexpr bool PERM = true, AFTER_DRAIN = false, PREFETCH = false, CARRY = true; struct Pref {};
    const bf16_t* P; bf16_t* MX; unsigned char* MX8;
    __device__ __forceinline__ bool carry(const Unit& u) const { return u.e == 0; }
    static __device__ __forceinline__ void bytes8(unsigned long long q, f32x4& lo, f32x4& hi) { const unsigned gl = (unsigned)q, gh = (unsigned)(q >> 32);
        lo = (f32x4){(float)(gl & 255u), (float)((gl >> 8) & 255u), (float)((gl >> 16) & 255u), (float)(gl >> 24)}; hi = (f32x4){(float)(gh & 255u), (float)((gh >> 8) & 255u), (float)((gh >> 16) & 255u), (float)(gh >> 24)}; }
    static __device__ __forceinline__ f32x4 max1(f32x4 v) { return (f32x4){fmaxf(v[0], 1.0f), fmaxf(v[1], 1.0f), fmaxf(v[2], 1.0f), fmaxf(v[3], 1.0f)}; }
    static __device__ __forceinline__ f32x4 rcp4(f32x4 v) { return (f32x4){__builtin_amdgcn_rcpf(v[0]), __builtin_amdgcn_rcpf(v[1]), __builtin_amdgcn_rcpf(v[2]), __builtin_amdgcn_rcpf(v[3])}; }
    __device__ __forceinline__ void operator()(f32x4 (&acc)[2][2][4][2], const Unit& u, int wr_, int wc_, int fr_, int fq_) const {
        int wr = wr_, wc = wc_, fr = fr_, fq = fq_; asm volatile("" : "+v"(fr), "+v"(fq) : "v"(acc[0][0][0][0]));
        const int row0 = u.pm * BM + wr * 64 + fr, col0 = u.pn * BM + wc * 32 + 8 * fq;
        const unsigned char* gp = (const unsigned char*)P + (size_t)row0 * 10240 + 6144 + col0;
        if (u.e == 0) {
#pragma unroll
            for (int ai = 0; ai < 2; ++ai) { unsigned long long ga[4][2], gb[4][2];
#pragma unroll
                for (int m = 0; m < 4; ++m)
#pragma unroll
                    for (int bj = 0; bj < 2; ++bj) { const unsigned char* q = gp + (size_t)(ai * HALF + m * 16) * 10240 + bj * HALF; ga[m][bj] = *(const unsigned long long*)q; gb[m][bj] = *(const unsigned long long*)(q + 1024); }
#pragma unroll
                for (int m = 0; m < 4; ++m)
#pragma unroll
                    for (int bj = 0; bj < 2; ++bj) { f32x4 a0, a1, b0, b1; bytes8(ga[m][bj], a0, a1); bytes8(gb[m][bj], b0, b1);
                        acc[ai][bj][m][0] = acc[ai][bj][m][0] * (a0 * rcp4(max1(b0))); acc[ai][bj][m][1] = acc[ai][bj][m][1] * (a1 * rcp4(max1(b1))); } }
        } else {
            unsigned long long gball[2][4][2];
#pragma unroll
            for (int ai = 0; ai < 2; ++ai)
#pragma unroll
                for (int m = 0; m < 4; ++m)
#pragma unroll
                    for (int bj = 0; bj < 2; ++bj) gball[ai][m][bj] = *(const unsigned long long*)(gp + (size_t)(ai * HALF + m * 16) * 10240 + bj * HALF + 1024);
#pragma unroll
            for (int ai = 0; ai < 2; ++ai) {
#pragma unroll
                for (int m = 0; m < 4; ++m) { const size_t row = (size_t)(row0 + ai * HALF + m * 16);
#pragma unroll
                    for (int bj = 0; bj < 2; ++bj) { f32x4 b0, b1; bytes8(gball[ai][m][bj], b0, b1);
                        *(unsigned long long*)(MX8 + row * 1024 + col0 + bj * HALF) = pack8_f8(acc[ai][bj][m][0] * max1(b0), acc[ai][bj][m][1] * max1(b1), 32.0f / 255.0f); } } }
        }
    }
};

struct EpiResid {
    static constexpr bool PERM = false, AFTER_DRAIN = false, PREFETCH = false; struct Pref {};
    const float* X; float* O; int ldc;
    __device__ __forceinline__ void operator()(const f32x4 (&acc)[2][2][4][2], const Unit& u, int wr, int wc, int fr, int fq) const {
        const int row0 = u.pm * BM + wr * 64 + fr, col0 = u.pn * BM + wc * 32 + 4 * fq;
#pragma unroll
        for (int ai = 0; ai < 2; ++ai)
#pragma unroll
            for (int m = 0; m < 4; ++m) { const size_t off = (size_t)(row0 + ai * HALF + m * 16) * ldc + col0;
#pragma unroll
                for (int bj = 0; bj < 2; ++bj)
#pragma unroll
                    for (int n = 0; n < 2; ++n) { const f32x4 xv = *(const f32x4*)(X + off + bj * HALF + n * 16); *(f32x4*)(O + off + bj * HALF + n * 16) = xv + acc[ai][bj][m][n]; } }
    }
};

typedef float f32x2 __attribute__((ext_vector_type(2)));
__device__ __forceinline__ unsigned long long pack8_f8(f32x4 a, f32x4 b, float s) {
    float v[8] = {a[0] * s, a[1] * s, a[2] * s, a[3] * s, b[0] * s, b[1] * s, b[2] * s, b[3] * s};
#pragma unroll
    for (int i = 0; i < 8; ++i) v[i] = __builtin_amdgcn_fmed3f(v[i], -448.0f, 448.0f);
    int lo = 0, hi = 0;
    lo = __builtin_amdgcn_cvt_pk_fp8_f32(v[0], v[1], lo, false); lo = __builtin_amdgcn_cvt_pk_fp8_f32(v[2], v[3], lo, true);
    hi = __builtin_amdgcn_cvt_pk_fp8_f32(v[4], v[5], hi, false); hi = __builtin_amdgcn_cvt_pk_fp8_f32(v[6], v[7], hi, true);
    return (unsigned long long)(unsigned)lo | ((unsigned long long)(unsigned)hi << 32);
}
struct EpiResidBf {
    static constexpr bool PERM = true, AFTER_DRAIN = false, PREFETCH = false; struct Pref {};
    const float* X; bf16_t* O; int ldx, ldo; unsigned char* O8; int ld8; float s8; const bf16_t* Hh; const float* G; const float* RI;
    __device__ __forceinline__ void operator()(const f32x4 (&acc)[2][2][4][2], const Unit& u, int wr, int wc, int fr, int fq) const {
        const int row0 = u.pm * BM + wr * 64 + fr, col0 = u.pn * BM + wc * 32 + 8 * fq;
        f32x4 gi[2][2];
#pragma unroll
        for (int bj = 0; bj < 2; ++bj) { const float* gp = G + col0 + bj * HALF; const f32x4 a = *(const f32x4*)gp, b = *(const f32x4*)(gp + 4);
            gi[bj][0] = (f32x4){__builtin_amdgcn_rcpf(a[0]), __builtin_amdgcn_rcpf(a[1]), __builtin_amdgcn_rcpf(a[2]), __builtin_amdgcn_rcpf(a[3])};
            gi[bj][1] = (f32x4){__builtin_amdgcn_rcpf(b[0]), __builtin_amdgcn_rcpf(b[1]), __builtin_amdgcn_rcpf(b[2]), __builtin_amdgcn_rcpf(b[3])}; }
#pragma unroll
        for (int ai = 0; ai < 2; ++ai) { u32x4 hs[4][2]; float ris[4];
#pragma unroll
            for (int m = 0; m < 4; ++m) { const size_t row = (size_t)(row0 + ai * HALF + m * 16); ris[m] = RI[row];
#pragma unroll
                for (int bj = 0; bj < 2; ++bj) hs[m][bj] = *(const u32x4*)(Hh + row * 1024 + col0 + bj * HALF); }
#pragma unroll
            for (int m = 0; m < 4; ++m) { const size_t row = (size_t)(row0 + ai * HALF + m * 16); const float ri = ris[m];
#pragma unroll
                for (int bj = 0; bj < 2; ++bj) { f32x4 h0, h1; unpack8(hs[m][bj], h0, h1);
                    const f32x4 y0 = h0 * gi[bj][0] * ri + acc[ai][bj][m][0], y1 = h1 * gi[bj][1] * ri + acc[ai][bj][m][1];
                    *(u32x4*)(O + row * ldo + col0 + bj * HALF) = pack8(y0, y1);
                    *(unsigned long long*)(O8 + row * ld8 + col0 + bj * HALF) = pack8_f8(y0, y1, s8); } } }
    }
};

struct EpiMoe1 {
    static constexpr bool PERM = true, AFTER_DRAIN = false, PREFETCH = false; struct Pref {};
    static constexpr bool STAGE = true;
    unsigned char* ACT; float sact; const float* bg; const float* bu; const float* rstd; const PG8_LAS int* tokl; PG8_LAS float* stg;
    __device__ __forceinline__ void stage(const Unit& u, int wid, int lane) const {
        PG8_LAS float* sb = stg + (u.ui & 1) * 512; const float* src;
        if (wid < 4) src = rstd + tokl[u.ui * 256 + wid * 64 + lane];
        else src = ((wid < 6) ? bg : bu) + u.e * 1024 + u.pn * HALF + (wid & 1) * 64 + lane;
        __builtin_amdgcn_global_load_lds((const unsigned*)src, (PG8_LAS unsigned*)(sb + wid * 64), 4, 0, 0);
    }
    __device__ __forceinline__ void operator()(const f32x4 (&acc)[2][2][4][2], const Unit& u, int wr, int wc, int fr, int fq) const {
        int fr_ = fr, fq_ = fq; asm volatile("" : "+v"(fr_), "+v"(fq_) : "v"(acc[0][0][0][0]));
        const int lrow0 = wr * 64 + fr_, f0 = u.pn * HALF + wc * 32 + 8 * fq_;
        const PG8_LAS float* sb = stg + (u.ui & 1) * 512; const int cl = wc * 32 + 8 * fq_;
        const f32x4 bg0 = *(const PG8_LAS f32x4*)(sb + 256 + cl), bg1 = *(const PG8_LAS f32x4*)(sb + 256 + cl + 4);
        const f32x4 bu0 = *(const PG8_LAS f32x4*)(sb + 384 + cl), bu1 = *(const PG8_LAS f32x4*)(sb + 384 + cl + 4);
#pragma unroll
        for (int ai = 0; ai < 2; ++ai)
#pragma unroll
            for (int m = 0; m < 4; ++m) { int w8[2] = {0, 0}; const int lr = lrow0 + ai * HALF + m * 16; const float rs = sb[lr]; const f32x2 rs2 = {rs, rs};
#pragma unroll
                for (int n = 0; n < 2; ++n) { const f32x4 ag = acc[ai][0][m][n], au = acc[ai][1][m][n], bgn = n ? bg1 : bg0, bun = n ? bu1 : bu0;
#pragma unroll
                    for (int h = 0; h < 2; ++h) {
                        const f32x2 gv = __builtin_elementwise_fma((f32x2){ag[2 * h], ag[2 * h + 1]}, rs2, (f32x2){bgn[2 * h], bgn[2 * h + 1]});
                        const f32x2 uv = __builtin_elementwise_fma((f32x2){au[2 * h], au[2 * h + 1]}, rs2, (f32x2){bun[2 * h], bun[2 * h + 1]});
                        const f32x2 g = {fminf(gv[0], 7.0f), fminf(gv[1], 7.0f)};
                        const f32x2 uu = {__builtin_amdgcn_fmed3f(uv[0], -7.0f, 7.0f), __builtin_amdgcn_fmed3f(uv[1], -7.0f, 7.0f)};
                        const f32x2 t = g * (f32x2){-1.702f * 1.4426950408889634f, -1.702f * 1.4426950408889634f};
                        const f32x2 den = (f32x2){__builtin_amdgcn_exp2f(t[0]), __builtin_amdgcn_exp2f(t[1])} + (f32x2){1.0f, 1.0f};
                        const f32x2 gs = g * (f32x2){__builtin_amdgcn_rcpf(den[0]), __builtin_amdgcn_rcpf(den[1])};
                        const f32x2 r = __builtin_elementwise_fma(uu, (f32x2){sact, sact}, (f32x2){sact, sact}) * gs;
                        w8[n] = h ? __builtin_amdgcn_cvt_pk_fp8_f32(r[0], r[1], w8[n], true) : __builtin_amdgcn_cvt_pk_fp8_f32(r[0], r[1], w8[n], false); } }
                *(unsigned long long*)(ACT + ((size_t)u.pm * BM + lr) * 1024 + f0) = (unsigned long long)(unsigned)w8[0] | ((unsigned long long)(unsigned)w8[1] << 32); }
    }
};
struct EpiMoe2 {
    static constexpr bool PERM = true, AFTER_DRAIN = false, PREFETCH = false; struct Pref {};
    static constexpr bool STAGE = true;
    unsigned char* Y; float sy; const float* bd; const float* lg; PG8_LAS float* stg;
    __device__ __forceinline__ void stage(const Unit& u, int wid, int lane) const {
        PG8_LAS float* sb = stg + (u.ui & 1) * 512; const float* src;
        if (wid < 4) { const int p = u.lt * 256 + wid * 64 + lane; src = lg + u.e * 16384 + (p < u.cnt ? p : 0); }
        else src = bd + u.e * 1024 + u.pn * BM + (wid - 4) * 64 + lane;
        __builtin_amdgcn_global_load_lds((const unsigned*)src, (PG8_LAS unsigned*)(sb + wid * 64), 4, 0, 0);
    }
    __device__ __forceinline__ void operator()(const f32x4 (&acc)[2][2][4][2], const Unit& u, int wr, int wc, int fr, int fq) const {
        int fr_ = fr, fq_ = fq; asm volatile("" : "+v"(fr_), "+v"(fq_) : "v"(acc[0][0][0][0]));
        const int lrow0 = wr * 64 + fr_, col0 = u.pn * BM + wc * 32 + 8 * fq_;
        const PG8_LAS float* sb = stg + (u.ui & 1) * 512; f32x4 bv[2][2];
#pragma unroll
        for (int bj = 0; bj < 2; ++bj)
#pragma unroll
            for (int n = 0; n < 2; ++n) bv[bj][n] = *(const PG8_LAS f32x4*)(sb + 256 + wc * 32 + 8 * fq_ + bj * HALF + 4 * n);
#pragma unroll
        for (int ai = 0; ai < 2; ++ai)
#pragma unroll
            for (int m = 0; m < 4; ++m) { const int lr = lrow0 + ai * HALF + m * 16, p = u.lt * 256 + lr; const float g = (p < u.cnt) ? sb[lr] * sy : 0.f; const size_t row = (size_t)u.pm * BM + lr;
#pragma unroll
                for (int bj = 0; bj < 2; ++bj) *(unsigned long long*)(Y + row * 1024 + col0 + bj * HALF) = pack8_f8((acc[ai][bj][m][0] + bv[bj][0]) * g, (acc[ai][bj][m][1] + bv[bj][1]) * g, 1.0f); }
    }
};
struct MoeOrder {
    static constexpr bool DUAL = false, GATHER = false, HALFSKIP = false, FP8 = true, BCH = true;
    int npn, G, c; const PG8_LAS int* tab; int fsc = 0x7F7F7F7F; unsigned* rdy = nullptr; unsigned* tmo = nullptr; int mode = 0; PG8_LAS unsigned* pkl = nullptr; int nb64 = 0, ebytes = 0;
    __device__ __forceinline__ bool next(int i, Unit& u) const {
        const int x = c & 7, cu_ = (mode == 2) ? (G >> 3) - 1 - (c >> 3) : (c >> 3), slot = i * (G >> 3) + cu_, j = slot / npn, pn = slot - j * npn;
        if (j >= __builtin_amdgcn_readfirstlane(tab[744 + x])) return false;
        const int t = __builtin_amdgcn_readfirstlane(tab[360 + x * 48 + j]), e = __builtin_amdgcn_readfirstlane(tab[40 + t]);
        u.pm = t; u.pn = pn; u.e = e; u.pb = e * npn + pn; u.lt = t - __builtin_amdgcn_readfirstlane(tab[e]); u.cnt = __builtin_amdgcn_readfirstlane(tab[328 + e]);
        u.full = (u.cnt - u.lt * 256 > 128) ? 1 : 0; u.ui = i; return true;
    }
    __device__ __forceinline__ bool next_v(int i, int& e, int& lt, int& cnt) const {
        const int x = c & 7, cu_ = (mode == 2) ? (G >> 3) - 1 - (c >> 3) : (c >> 3), slot = i * (G >> 3) + cu_, j = slot / npn;
        e = 0; lt = 0; cnt = 0;
        if (j >= tab[744 + x]) return false;
        const int t = tab[360 + x * 48 + j]; e = tab[40 + t]; lt = t - tab[e]; cnt = tab[328 + e]; return true;
    }
    __device__ __forceinline__ void a_ready(const Unit& u) const {
        if (mode != 2) return;
        unsigned sp = 0u;
        while ((unsigned)__builtin_amdgcn_readfirstlane((int)__hip_atomic_load(rdy + 16 * u.pm, __ATOMIC_RELAXED, __HIP_MEMORY_SCOPE_AGENT)) < 64u) {
            __builtin_amdgcn_s_sleep(1);
            if ((++sp & 255u) == 0u) { if (__hip_atomic_load(tmo, __ATOMIC_RELAXED, __HIP_MEMORY_SCOPE_AGENT) != 0u) break; if (sp > (1u << 18)) { __hip_atomic_fetch_add(tmo, 1u, __ATOMIC_RELAXED, __HIP_MEMORY_SCOPE_AGENT); break; } } }
        asm volatile("" ::: "memory");
    }
    static constexpr bool PEEK = true;
    __device__ __forceinline__ void peek(const Unit& u, int wid) const { if (mode == 2) __builtin_amdgcn_global_load_lds((const unsigned*)(rdy + 16 * u.pm), (PG8_LAS unsigned*)(pkl + wid * 64), 4, 0, 16); }
    __device__ __forceinline__ void a_ready_pk(const Unit& u, int wid) const {
        if (mode != 2) return;
        if ((unsigned)__builtin_amdgcn_readfirstlane((int)pkl[wid * 64]) >= 64u) return;
        a_ready(u);
    }
    __device__ __forceinline__ void done(const Unit& u) const {
        if (mode != 1) return;
        asm volatile("s_waitcnt vmcnt(0)" ::: "memory");
        if (__builtin_amdgcn_mbcnt_hi(~0u, __builtin_amdgcn_mbcnt_lo(~0u, 0u)) == 0u) __hip_atomic_fetch_add(rdy + 16 * u.pm, 1u, __ATOMIC_RELAXED, __HIP_MEMORY_SCOPE_AGENT);
    }
};
struct MoeOrderG : MoeOrder {
    static constexpr bool GATHER = true;
    const PG8_LAS int* tokl; int pitch;
    __device__ __forceinline__ int row_token(int ui, int r) const { return tokl[ui * 256 + r]; }
};
struct DupOrder {
    static constexpr bool DUAL = false, GATHER = false, HALFSKIP = false, FP8 = false, BCH = false; static constexpr int fsc = 0, nb64 = 0, ebytes = 0;
    StaticOrder S; int n, reps;
    __device__ __forceinline__ bool next(int i, Unit& u) const { if (i >= n * reps) return false; return S.next(i % n, u); }
    __device__ __forceinline__ void a_ready(const Unit&) const {}
    __device__ __forceinline__ void done(const Unit&) const {}
};
__device__ __forceinline__ void seam_wait(unsigned* sw, unsigned st, unsigned* tmo) {
    unsigned sp = 0u;
    while ((unsigned)__builtin_amdgcn_readfirstlane((int)__hip_atomic_load(sw, __ATOMIC_RELAXED, __HIP_MEMORY_SCOPE_AGENT)) < st) {
        __builtin_amdgcn_s_sleep(1);
        if ((++sp & 255u) == 0u) { if (__hip_atomic_load(tmo, __ATOMIC_RELAXED, __HIP_MEMORY_SCOPE_AGENT) != 0u) break; if (sp > (1u << 18)) { __hip_atomic_fetch_add(tmo, 1u, __ATOMIC_RELAXED, __HIP_MEMORY_SCOPE_AGENT); break; } } }
    asm volatile("" ::: "memory");
}
struct StaticOrderF8 : StaticOrder { static constexpr bool FP8 = true; int fsc = 0x7F7F7F7F; unsigned* sw = nullptr; unsigned st = 0u; unsigned* tmo = nullptr;
    __device__ __forceinline__ void a_ready(const Unit& u) const { if (sw != nullptr && u.ui == 0) seam_wait(sw, st, tmo); } };
struct DupOrderF8 : DupOrder { static constexpr bool FP8 = true; int fsc = 0x7F7F7F7F; };
struct DualOrderF8;
struct DualOrder {
    static constexpr bool DUAL = true, GATHER = false, HALFSKIP = false, FP8 = false, BCH = false; static constexpr int fsc = 0, nb64 = 0, ebytes = 0;
    StaticOrder S; int reps;
    __device__ __forceinline__ bool next(int i, Unit& u) const { if (i >= 2 * reps) return false; if (!S.next(0, u)) return false; u.e = i & 1; return true; }
    __device__ __forceinline__ void a_ready(const Unit&) const {}
    __device__ __forceinline__ void done(const Unit&) const {}
};
struct DualOrderF8 : DualOrder { static constexpr bool FP8 = true; int fsc = 0x7F7F7F7F; unsigned* sw = nullptr; unsigned st = 0u; unsigned* tmo = nullptr;
    __device__ __forceinline__ void a_ready(const Unit& u) const { if (sw != nullptr && u.e == 0) seam_wait(sw, st, tmo); } };
typedef int pg8_i32x4 __attribute__((ext_vector_type(4)));
typedef int pg8_i32x8 __attribute__((ext_vector_type(8)));
__device__ __forceinline__ pg8_i32x8 pg8_cat8(bf16x8 a, bf16x8 b) { const pg8_i32x4 x = __builtin_bit_cast(pg8_i32x4, a), y = __builtin_bit_cast(pg8_i32x4, b); return __builtin_shufflevector(x, y, 0, 1, 2, 3, 4, 5, 6, 7); }
template <class S, class = void> struct sched_has_peek { static constexpr bool value = false; };
template <class S> struct sched_has_peek<S, decltype((void)S::PEEK)> { static constexpr bool value = S::PEEK; };
template <class E, class = void> struct epi_has_stage { static constexpr bool value = false; };
template <class E> struct epi_has_stage<E, decltype((void)E::STAGE)> { static constexpr bool value = E::STAGE; };
template <class E, class = void> struct epi_has_carry { static constexpr bool value = false; };
template <class E> struct epi_has_carry<E, decltype((void)E::CARRY)> { static constexpr bool value = E::CARRY; };
template <class Epi, class Sched, bool ALIGN_EPI = false, bool SP2 = false>
__device__ __forceinline__ void gemm_phase(PG8_LAS unsigned char* lds, const Gemm g, const Sched& S, const Epi& E, int wave_) {
    const int wid = wave_, lane = lane_id_now(), tid = wid * 64 + lane, wr = wid >> 2, wc = wid & 3, fr = lane & 15, fq = lane >> 4;
    const int K = g.K; int nt = K / BK; asm volatile("" : "+s"(nt));
    unsigned voffA[2], voffB[2];
#pragma unroll
    for (int i = 0; i < 2; ++i) { int R, C; stage_rc(tid * 16 + i * 8192, R, C); const int Rb = Epi::PERM ? ((R & ~31) + perm32(R & 31)) : R;
        voffA[i] = (unsigned)(R * K + C) * 2u; voffB[i] = Sched::BCH ? (unsigned)((C >> 5) * S.nb64 + Rb * 64 + ((2 * C) & 63)) : (unsigned)(Rb * K + C) * 2u; }
    int gR[2] = {0, 0}, gC[2] = {0, 0}; unsigned cvo[2][2] = {{0u, 0u}, {0u, 0u}};
    if constexpr (Sched::GATHER) { static_assert(SP2, "GATHER is written for the SP2 loop");
#pragma unroll
        for (int i = 0; i < 2; ++i) stage_rc(tid * 16 + i * 8192, gR[i], gC[i]); }
#define PG8_GVO(dst, ui_) do { _Pragma("unroll") for (int h_ = 0; h_ < 2; ++h_) _Pragma("unroll") for (int i_ = 0; i_ < 2; ++i_) dst[h_][i_] = (unsigned)(S.row_token(ui_, h_ * HALF + gR[i_]) * S.pitch + gC[i_]) * 2u; } while (0)
#define PG8_STAGE_A(bufoff, base, half, v0, v1) do { if constexpr (Sched::GATHER) { const unsigned vv_[2] = {v0, v1}; PG8_STAGE(bufoff, base, vv_); } else { PG8_STAGE(bufoff, (base) + (half) * hstep, voffA); } } while (0)
    const size_t kstep = (size_t)(BK * 2);
    const size_t kstepB = Sched::BCH ? (size_t)2 * S.nb64 : (size_t)(BK * 2), hstepB = Sched::BCH ? (size_t)HALF * 64 : (size_t)HALF * K * 2;
    const size_t hstep = (size_t)HALF * K * 2;
    const size_t tstep = 2 * hstep;
    const unsigned ldsw = (unsigned)wid * 1024u;
    const int aoff = lds_byte(wr * 64 + fr, fq * 8), boff = lds_byte(wc * 32 + fr, fq * 8);
#define PG8_SA(b, h) (((b) * 2 + (h)) * HTB)
#define PG8_SB(b, h) ((4 + (b) * 2 + (h)) * HTB)
#define PG8_STAGE(bufoff, gbase, voff) do { _Pragma("unroll") for (int _i = 0; _i < 2; ++_i) { unsigned vo_ = (voff)[_i]; const char* gb_ = (const char*)(gbase); if constexpr (Sched::FP8) asm volatile("" : "+v"(vo_), "+s"(gb_)); \
        __builtin_amdgcn_global_load_lds((const unsigned*)(gb_ + vo_), (PG8_LAS unsigned*)(lds + (bufoff) + ldsw + _i * 8192), 16, 0, 0); } } while (0)
#define PG8_LDA(dst, b, h) do { _Pragma("unroll") for (int m = 0; m < 4; ++m) _Pragma("unroll") for (int k = 0; k < 2; ++k) dst[m][k] = *(const PG8_LAS bf16x8*)(lds + PG8_SA(b, h) + aoff + m * 2048 + k * 1024); } while (0)
#define PG8_LDB(dst, b, h) do { _Pragma("unroll") for (int n = 0; n < 2; ++n) _Pragma("unroll") for (int k = 0; k < 2; ++k) dst[n][k] = *(const PG8_LAS bf16x8*)(lds + PG8_SB(b, h) + boff + n * 2048 + k * 1024); } while (0)
#define PG8_MMA(ai, bj, At, Bt) do { __builtin_amdgcn_s_setprio(1); _Pragma("unroll") for (int m = 0; m < 4; ++m) _Pragma("unroll") for (int n = 0; n < 2; ++n) { if constexpr (Sched::FP8) { \
        acc[ai][bj][m][n] = __builtin_amdgcn_mfma_scale_f32_16x16x128_f8f6f4(pg8_cat8(Bt[n][0], Bt[n][1]), pg8_cat8(At[m][0], At[m][1]), acc[ai][bj][m][n], 0, 0, 0, S.fsc, 0, S.fsc); } else { _Pragma("unroll") for (int k = 0; k < 2; ++k) \
        acc[ai][bj][m][n] = __builtin_amdgcn_mfma_f32_16x16x32_bf16(Bt[n][k], At[m][k], acc[ai][bj][m][n], 0, 0, 0); } } __builtin_amdgcn_s_setprio(0); } while (0)
#define PG8_WAIT_V(n) asm volatile("s_waitcnt vmcnt(" #n ")" ::: "memory")
#define PG8_WAIT_L(n) asm volatile("s_waitcnt lgkmcnt(" #n ")" ::: "memory")
#define PG8_BAR __builtin_amdgcn_s_barrier()
#define PG8_SCHED __builtin_amdgcn_sched_barrier(0)
    Unit cur, nxt; int ui = 0;
    if (!S.next(0, cur)) return;
    f32x4 acc[2][2][4][2];
#pragma unroll
    for (int a = 0; a < 2; ++a)
#pragma unroll
        for (int b = 0; b < 2; ++b)
#pragma unroll
            for (int m = 0; m < 4; ++m)
#pragma unroll
                for (int n = 0; n < 2; ++n) acc[a][b][m][n] = (f32x4){0.f, 0.f, 0.f, 0.f};
    bf16x8 At[4][2], B0[2][2], B1[2][2];
    const char* cA = (const char*)((Sched::DUAL && cur.e) ? g.A2 : g.A) + (Sched::GATHER ? (size_t)0 : (size_t)cur.pm * tstep);
    if constexpr (Sched::GATHER) PG8_GVO(cvo, 0);
    const char* cB = (const char*)((Sched::DUAL && cur.e) ? g.Bt2 : g.Bt) + (Sched::BCH ? (size_t)cur.e * S.ebytes + (size_t)cur.pn * (2 * hstepB) : (size_t)cur.pb * tstep);
    if constexpr (epi_has_stage<Epi>::value) E.stage(cur, wid, lane_id_now());
    typename Epi::Pref pf_{}; if constexpr (Epi::PREFETCH) E.prefetch(pf_, cur, wr, wc, fr, fq);
    if constexpr (SP2) {
        PG8_STAGE(PG8_SB(0, 0), cB, voffB); PG8_STAGE(PG8_SB(0, 1), cB + hstepB, voffB); S.a_ready(cur); PG8_STAGE_A(PG8_SA(0, 0), cA, 0, cvo[0][0], cvo[0][1]); PG8_STAGE_A(PG8_SA(0, 1), cA, 1, cvo[1][0], cvo[1][1]);
        if (wr == 1) PG8_BAR;
        PG8_WAIT_V(2); PG8_BAR;
        PG8_STAGE(PG8_SB(1, 0), cB + kstepB, voffB); PG8_STAGE_A(PG8_SA(1, 0), cA + kstep, 0, cvo[0][0], cvo[0][1]); PG8_STAGE(PG8_SB(1, 1), cB + hstepB + kstepB, voffB);
        PG8_WAIT_V(6); PG8_BAR;
    } else {
        S.a_ready(cur);
        PG8_STAGE(PG8_SB(0, 0), cB, voffB); PG8_STAGE(PG8_SA(0, 0), cA, voffA); PG8_STAGE(PG8_SB(0, 1), cB + hstepB, voffB); PG8_STAGE(PG8_SA(0, 1), cA + hstep, voffA);
        if (wr == 1) PG8_BAR;
        PG8_WAIT_V(4); PG8_BAR;
        PG8_STAGE(PG8_SB(1, 0), cB + kstepB, voffB); PG8_STAGE(PG8_SA(1, 0), cA + kstep, voffA); PG8_STAGE(PG8_SB(1, 1), cB + hstepB + kstepB, voffB);
        PG8_WAIT_V(6); PG8_BAR;
    }
    for (;;) {
        const bool has_next = S.next(ui + 1, nxt);
        if constexpr (sched_has_peek<Sched>::value) { if (has_next) S.peek(nxt, wid); }
        const char* nA = has_next ? (const char*)((Sched::DUAL && nxt.e) ? g.A2 : g.A) + (Sched::GATHER ? (size_t)0 : (size_t)nxt.pm * tstep) : cA; const char* nB = has_next ? (const char*)((Sched::DUAL && nxt.e) ? g.Bt2 : g.Bt) + (Sched::BCH ? (size_t)nxt.e * S.ebytes + (size_t)nxt.pn * (2 * hstepB) : (size_t)nxt.pb * tstep) : cB;
        for (int t = 0; t < nt; t += 2) {
            const bool last = (t == nt - 2);
            const char* a1 = cA + (size_t)(t + 1) * kstep;
            const char* a2 = last ? nA : cA + (size_t)(t + 2) * kstep; const char* b2 = last ? nB : cB + (size_t)(t + 2) * kstepB;
            const char* a3 = a2 + kstep; const char* b3 = b2 + kstepB;
            if (last && has_next) { if constexpr (sched_has_peek<Sched>::value) S.a_ready_pk(nxt, wid); else S.a_ready(nxt); }
            if constexpr (SP2) {
            PG8_LDB(B0, 0, 0); PG8_LDB(B1, 0, 1); PG8_SCHED; PG8_LDA(At, 0, 0); PG8_STAGE_A(PG8_SA(1, 1), a1, 1, cvo[1][0], cvo[1][1]); if constexpr (Sched::GATHER) { if (last && has_next) PG8_GVO(cvo, ui + 1); }
            PG8_WAIT_V(8); PG8_WAIT_L(0); PG8_BAR; PG8_MMA(0, 0, At, B0); PG8_MMA(0, 1, At, B1); PG8_BAR; PG8_SCHED;
            if (!Sched::HALFSKIP || cur.full) PG8_LDA(At, 0, 1); PG8_STAGE(PG8_SB(0, 0), b2, voffB); PG8_STAGE(PG8_SB(0, 1), b2 + hstepB, voffB); PG8_STAGE_A(PG8_SA(0, 0), a2, 0, cvo[0][0], cvo[0][1]);
            PG8_WAIT_V(8); PG8_WAIT_L(0); PG8_BAR; if (!Sched::HALFSKIP || cur.full) { PG8_MMA(1, 0, At, B0); PG8_MMA(1, 1, At, B1); } PG8_BAR; PG8_SCHED;
            PG8_LDB(B0, 1, 0); PG8_LDB(B1, 1, 1); PG8_SCHED; PG8_LDA(At, 1, 0); PG8_STAGE_A(PG8_SA(0, 1), a2, 1, cvo[1][0], cvo[1][1]);
            PG8_WAIT_V(8); PG8_WAIT_L(0); PG8_BAR; PG8_MMA(0, 0, At, B0); PG8_MMA(0, 1, At, B1); PG8_BAR; PG8_SCHED;
            if (!Sched::HALFSKIP || cur.full) PG8_LDA(At, 1, 1); PG8_STAGE(PG8_SB(1, 0), b3, voffB); PG8_STAGE(PG8_SB(1, 1), b3 + hstepB, voffB); PG8_STAGE_A(PG8_SA(1, 0), a3, 0, cvo[0][0], cvo[0][1]);
            PG8_WAIT_V(8); PG8_WAIT_L(0); PG8_BAR; if (!Sched::HALFSKIP || cur.full) { PG8_MMA(1, 0, At, B0); PG8_MMA(1, 1, At, B1); } PG8_BAR; PG8_SCHED;
            } else {
            PG8_LDB(B0, 0, 0); PG8_SCHED; PG8_LDA(At, 0, 0); PG8_STAGE(PG8_SA(1, 1), a1 + hstep, voffA);
            PG8_WAIT_L(8); PG8_BAR; PG8_WAIT_L(0); PG8_MMA(0, 0, At, B0); PG8_BAR; PG8_SCHED;
            PG8_LDB(B1, 0, 1); PG8_STAGE(PG8_SB(0, 0), b2, voffB);
            PG8_BAR; PG8_WAIT_L(0); PG8_MMA(0, 1, At, B1); PG8_BAR;
            PG8_LDA(At, 0, 1); PG8_STAGE(PG8_SA(0, 0), a2, voffA);
            PG8_BAR; PG8_WAIT_L(0); PG8_MMA(1, 0, At, B0); PG8_BAR; PG8_SCHED;
            PG8_STAGE(PG8_SB(0, 1), b2 + hstepB, voffB);
            PG8_WAIT_V(6); PG8_BAR; PG8_MMA(1, 1, At, B1); PG8_BAR;
            PG8_LDB(B0, 1, 0); PG8_SCHED; PG8_LDA(At, 1, 0); PG8_STAGE(PG8_SA(0, 1), a2 + hstep, voffA);
            PG8_WAIT_L(8); PG8_BAR; PG8_WAIT_L(0); PG8_MMA(0, 0, At, B0); PG8_BAR; PG8_SCHED;
            PG8_LDB(B1, 1, 1); PG8_STAGE(PG8_SB(1, 0), b3, voffB);
            PG8_BAR; PG8_WAIT_L(0); PG8_MMA(0, 1, At, B1); PG8_BAR;
            PG8_LDA(At, 1, 1); PG8_STAGE(PG8_SA(1, 0), a3, voffA);
            PG8_BAR; PG8_WAIT_L(0); PG8_MMA(1, 0, At, B0); PG8_BAR; PG8_SCHED;
            PG8_STAGE(PG8_SB(1, 1), b3 + hstepB, voffB);
            PG8_WAIT_V(6); PG8_BAR; PG8_MMA(1, 1, At, B1); PG8_BAR;
            }
        }
        if constexpr (ALIGN_EPI) { if (wr == 0) PG8_BAR; }
        if constexpr (!Epi::AFTER_DRAIN) { if constexpr (Epi::PREFETCH) E(acc, cur, wr, wc, fr, fq, pf_); else E(acc, cur, wr, wc, fr, fq); S.done(cur); }
        if (!has_next) break;
        bool keep_ = false; if constexpr (epi_has_carry<Epi>::value) keep_ = E.carry(cur);
        if (!keep_) {
#pragma unroll
        for (int a = 0; a < 2; ++a)
#pragma unroll
            for (int b = 0; b < 2; ++b)
#pragma unroll
                for (int m = 0; m < 4; ++m)
#pragma unroll
                    for (int n = 0; n < 2; ++n) acc[a][b][m][n] = (f32x4){0.f, 0.f, 0.f, 0.f};
        }
        cur = nxt; cA = nA; cB = nB; ++ui;
        if constexpr (epi_has_stage<Epi>::value) E.stage(cur, wid, lane_id_now());
        if constexpr (ALIGN_EPI) { if (wr == 1) PG8_BAR; }
    }
    PG8_WAIT_V(0);
    if constexpr (!ALIGN_EPI) { if (wr == 0) PG8_BAR; }
    PG8_BAR;
    if constexpr (Epi::AFTER_DRAIN) { E.fused(acc, cur, wr, wc, fr, fq, lds, wid, lane); S.done(cur); }
#undef PG8_SA
#undef PG8_SB
#undef PG8_STAGE
#undef PG8_STAGE_A
#undef PG8_GVO
#undef PG8_LDA
#undef PG8_LDB
#undef PG8_MMA
#undef PG8_WAIT_V
#undef PG8_WAIT_L
#undef PG8_BAR
#undef PG8_SCHED
}
}

#ifndef PG8_SP2
#define PG8_SP2 true
#endif
#ifndef PG8_ALIGN
#define PG8_ALIGN true
#endif
#include <hip/hip_bf16.h>
#include <cmath>
namespace attn_body {
using bf16=__hip_bfloat16;
using bf16x8=__attribute__((ext_vector_type(8)))short;
using s16x4=__attribute__((ext_vector_type(4)))short;
using f32x16=__attribute__((ext_vector_type(16)))float;
using u32x4=__attribute__((ext_vector_type(4)))unsigned;
constexpr int BATCH=4,NHEAD=16,SEQ=4096,D=64,DM=NHEAD*D;
constexpr int NW=8,QBLK=32,QB=QBLK*NW,KVBLK=64,NQB=SEQ/QB;
constexpr int ATTN_PITCH=DM, ATTN_UNIT_ROWS=QB;
__device__ __forceinline__ int crow(int r,int hi){return (r&3)+8*(r>>2)+4*hi;}
#define SBAR() __builtin_amdgcn_sched_barrier(0)
__device__ __forceinline__ void cmask(f32x16&p0,f32x16&p1,int jb,int qrel,int hi){
  const float NEG=-INFINITY; int kb=64*jb+4*hi;
  #pragma unroll
  for(int r=0;r<16;++r){int kv=kb+(r&3)+8*(r>>2); if(kv>qrel)p0[r]=NEG; if(kv+32>qrel)p1[r]=NEG;}
}

constexpr int NSLOT=3, SLOTB=8192;
constexpr int LDS_K=0, LDS_V=NSLOT*SLOTB, LDS_WS=2*NSLOT*SLOTB, LDS_OST=LDS_WS+NW*64*4, LDS_BYTES=LDS_OST+NW*4096;
constexpr float C2=0.125f*1.4426950408889634f;
__device__ __forceinline__ void glds16(const void*gsrc,unsigned lds_dst){unsigned keep;
  asm volatile("s_mov_b32 %0, m0\n\ts_mov_b32 m0, %2\n\ts_nop 0\n\tglobal_load_lds_dwordx4 %1, off\n\ts_mov_b32 m0, %0":"=&s"(keep):"v"(gsrc),"s"(lds_dst):"memory");}
__device__ __forceinline__ float max3f(float a,float b,float c){float r;asm("v_max3_f32 %0, %1, %2, %3":"=v"(r):"v"(a),"v"(b),"v"(c));return r;}
__device__ __forceinline__ float max2f(float a,float b){float r;asm("v_max_f32_e32 %0, %1, %2":"=v"(r):"v"(a),"v"(b));return r;}
__device__ __forceinline__ float fadd_s(float a,float b){float r;asm("v_add_f32_e32 %0, %1, %2":"=v"(r):"v"(a),"v"(b));return r;}
__device__ __forceinline__ float fsub_s(float a,float b){float r;asm("v_sub_f32_e32 %0, %1, %2":"=v"(r):"v"(a),"v"(b));return r;}
typedef float f32x2_t __attribute__((ext_vector_type(2))); typedef __bf16 bf16x2_t __attribute__((ext_vector_type(2)));
__device__ __forceinline__ unsigned cvtpk_s(float lo,float hi){f32x2_t v={lo,hi};bf16x2_t b=__builtin_convertvector(v,bf16x2_t);return __builtin_bit_cast(unsigned,b);}
#define WAIT_BAR(N) asm volatile("s_waitcnt vmcnt(" #N ") lgkmcnt(0)\n\ts_barrier":::"memory")

__device__ __forceinline__ void qkt(f32x16&p0,f32x16&p1,const char*Kslot,const bf16x8*qr,const f32x16&negm,int r32,int hi){
  const char*kb=Kslot+hi*1024+r32*16;
  #pragma unroll
  for(int d0=0;d0<4;++d0){
    const bf16x8 b0=*reinterpret_cast<const bf16x8*>(kb+d0*2048);
    const bf16x8 b1=*reinterpret_cast<const bf16x8*>(kb+d0*2048+512);
    if(d0==0){p0=__builtin_amdgcn_mfma_f32_32x32x16_bf16(b0,qr[0],negm,0,0,0);p1=__builtin_amdgcn_mfma_f32_32x32x16_bf16(b1,qr[0],negm,0,0,0);}
    else{p0=__builtin_amdgcn_mfma_f32_32x32x16_bf16(b0,qr[d0],p0,0,0,0);p1=__builtin_amdgcn_mfma_f32_32x32x16_bf16(b1,qr[d0],p1,0,0,0);}}
}
typedef __attribute__((address_space(3))) const char* lds_cptr;
typedef short v4i16_t __attribute__((ext_vector_type(4)));
__device__ __forceinline__ void kload8(bf16x8*kf,lds_cptr kp){
  kf[0]=*(const __attribute__((address_space(3))) bf16x8*)(kp);      kf[1]=*(const __attribute__((address_space(3))) bf16x8*)(kp+512);
  kf[2]=*(const __attribute__((address_space(3))) bf16x8*)(kp+2048); kf[3]=*(const __attribute__((address_space(3))) bf16x8*)(kp+2560);
  kf[4]=*(const __attribute__((address_space(3))) bf16x8*)(kp+4096); kf[5]=*(const __attribute__((address_space(3))) bf16x8*)(kp+4608);
  kf[6]=*(const __attribute__((address_space(3))) bf16x8*)(kp+6144); kf[7]=*(const __attribute__((address_space(3))) bf16x8*)(kp+6656);
}
__device__ __forceinline__ void kload2(bf16x8*kf,lds_cptr kp,int j){ kf[2*j]=*(const __attribute__((address_space(3))) bf16x8*)(kp+j*2048); kf[2*j+1]=*(const __attribute__((address_space(3))) bf16x8*)(kp+j*2048+512); }
__device__ __forceinline__ s16x4 vtr(lds_cptr p){ return __builtin_bit_cast(s16x4,__builtin_amdgcn_ds_read_tr16_b64_v4i16((__attribute__((address_space(3))) v4i16_t*)p)); }
__device__ __forceinline__ float rowmax(const f32x16&p0,const f32x16&p1){
  float a=max3f(p0[0],p0[1],p1[0]),b=max3f(p0[2],p0[3],p1[1]);a=max3f(a,p1[2],p1[3]);
  #pragma unroll
  for(int r=4;r<16;r+=4){a=max3f(a,p0[r],p0[r+1]);b=max3f(b,p0[r+2],p0[r+3]);a=max3f(a,p1[r],p1[r+1]);b=max3f(b,p1[r+2],p1[r+3]);}
  const float m=max2f(a,b);
  auto rr=__builtin_amdgcn_permlane32_swap(__float_as_uint(m),__float_as_uint(m),false,false);
  return max2f(__uint_as_float(rr[0]),__uint_as_float(rr[1]));
}
__device__ __forceinline__ void pv(f32x16*o,int vb,bf16x8 pa0,bf16x8 pa1,bf16x8 pa2,bf16x8 pa3){
  #pragma unroll
  for(int d0=0;d0<2;++d0){s16x4 lo[4],hi[4];
    #pragma unroll
    for(int ks=0;ks<4;++ks){
      asm volatile("ds_read_b64_tr_b16 %0,%1 offset:%c2":"=&v"(lo[ks]):"v"(vb),"i"(d0*4096+ks*1024):"memory");
      asm volatile("ds_read_b64_tr_b16 %0,%1 offset:%c2":"=&v"(hi[ks]):"v"(vb),"i"(d0*4096+ks*1024+512):"memory");}
    asm volatile("s_waitcnt lgkmcnt(0)":::"memory");SBAR();
    #define PK(k) (bf16x8){lo[k][0],lo[k][1],lo[k][2],lo[k][3],hi[k][0],hi[k][1],hi[k][2],hi[k][3]}
    o[d0]=__builtin_amdgcn_mfma_f32_32x32x16_bf16(pa0,PK(0),o[d0],0,0,0);
    o[d0]=__builtin_amdgcn_mfma_f32_32x32x16_bf16(pa1,PK(1),o[d0],0,0,0);
    o[d0]=__builtin_amdgcn_mfma_f32_32x32x16_bf16(pa2,PK(2),o[d0],0,0,0);
    o[d0]=__builtin_amdgcn_mfma_f32_32x32x16_bf16(pa3,PK(3),o[d0],0,0,0);
    #undef PK
  }
}

#ifndef ATTN_STORE16
#define ATTN_STORE16(p,v) (*(u32x4*)(p)=(v))
#endif
template<int THRL,int QP,int KP,int VP,int OP> __device__ __forceinline__ void attn_unit(int wave_,int b,int qb,const bf16*Q,const bf16*__restrict__ K,const bf16*__restrict__ V,bf16*O,char*shm){
  int lane_=lane_id_now(); asm volatile("":"+v"(lane_));
  const int wid=wave_,lane=lane_,tid=wid*64+lane,r32=lane&31,hi=lane>>5;
  const long rowbase=(long)b*SEQ; const int q0=qb*QB;
  const bf16*Qw=Q+(rowbase+q0+wid*QBLK)*QP;
  const bf16*Kh=K+rowbase*KP,*Vh=V+rowbase*VP;
  const unsigned lds0=(unsigned)(uintptr_t)shm;
  float*wsf=(float*)(shm+LDS_WS)+wid*64;
  const bf16*ksrc=Kh+(long)lane*KP+wid*8;
  const bf16*vsrc=Vh+(long)(16*(wid&3)+(lane>>2))*VP+(wid>>2)*32+(lane&3)*8;
  const unsigned kdst=lds0+LDS_K+wid*1024, vdst=lds0+LDS_V+wid*1024;
  #define DMA_K(t,slot) glds16(ksrc+(long)(t)*KVBLK*KP,(unsigned)__builtin_amdgcn_readfirstlane(kdst+(slot)))
  #define DMA_V(t,slot) glds16(vsrc+(long)(t)*KVBLK*VP,(unsigned)__builtin_amdgcn_readfirstlane(vdst+(slot)))
  const int vb0=(int)(lds0+LDS_V)+((lane>>4)&1)*32+(lane&3)*8+(4*hi+((lane&15)>>2))*64;
  const char*Kbase=shm+LDS_K; bf16x8 kf[8];
  const lds_cptr shm3=(lds_cptr)shm; const lds_cptr kp0=shm3+LDS_K+hi*1024+r32*16; const lds_cptr vp0=shm3+LDS_V+((lane>>4)&1)*32+(lane&3)*8+(4*hi+((lane&15)>>2))*64;
  const int NT=(q0+QB)/KVBLK;
  DMA_K(0,0);DMA_V(0,0);DMA_K(1,SLOTB);
  bf16x8 qr[4];
  #pragma unroll
  for(int d0=0;d0<4;++d0)qr[d0]=*reinterpret_cast<const bf16x8*>(&Qw[(long)r32*QP+d0*16+hi*8]);
  float mhat=0.f,l_reg=0.f;f32x16 o[2];o[0]=f32x16{};o[1]=f32x16{};f32x16 negm=f32x16{};asm volatile("":"+v"(negm));
  const int qrel=wid*QBLK+r32;
  #define CMASK(P0,P1,t) do{int jb_=(t)-(NT-4); if(jb_>=0)cmask(P0,P1,jb_,qrel,hi);}while(0)
  bool resc=false;
  #define START(P0,P1) do{ const float rm=rowmax(P0,P1); resc=false; \
    { const float dl=rm; mhat=fadd_s(mhat,dl); \
      _Pragma("unroll") for(int r=0;r<16;++r){P0[r]=fsub_s(P0[r],dl);P1[r]=fsub_s(P1[r],dl);} \
      _Pragma("unroll") for(int r=0;r<16;++r)negm[r]=-mhat; asm volatile("":"+v"(negm)); } \
    _Pragma("unroll") for(int r=0;r<16;++r)P0[r]=__builtin_amdgcn_exp2f(P0[r]); }while(0)
  #define RESC() do{ if(resc){ asm volatile("s_waitcnt lgkmcnt(0)":::"memory"); \
      _Pragma("unroll") for(int d_=0;d_<2;++d_) _Pragma("unroll") for(int r=0;r<16;++r)o[d_][r]*=wsf[crow(r,hi)]; } }while(0)
  f32x16 pA0,pA1,pB0,pB1;
  int sl_prev=0,sl_cur=0,sl_next=SLOTB;
  #define ROT() do{sl_prev=sl_cur;sl_cur=sl_next;sl_next=(sl_next==(NSLOT-1)*SLOTB)?0:sl_next+SLOTB;}while(0)
  DMA_K(2,2*SLOTB);
  WAIT_BAR(3);
  qkt(pA0,pA1,Kbase,qr,negm,r32,hi);asm volatile("s_nop 15\n\ts_nop 7":"+v"(pA0),"+v"(pA1));CMASK(pA0,pA1,0);
  START(pA0,pA1);
  _Pragma("unroll") for(int r=0;r<16;++r)pA1[r]=__builtin_amdgcn_exp2f(pA1[r]);
  WAIT_BAR(0);
  DMA_K(3,0);DMA_V(1,SLOTB);
  ROT();
  kload8(kf,kp0+sl_cur);
  WAIT_BAR(2);
  s16x4 vlo[8],vhi[8]; u32x4 pw0,pw1,pw2,pw3;
  #define PKW(P,B) cvtpk_s(P[B],P[B+1])
  #define PAF(k) __builtin_bit_cast(bf16x8,pw##k)
  #define VFR(i) (bf16x8){vlo[i][0],vlo[i][1],vlo[i][2],vlo[i][3],vhi[i][0],vhi[i][1],vhi[i][2],vhi[i][3]}
  #define PIN(x) asm volatile("":"+v"(x))
  #define MX3(a,b,c) __builtin_fmaxf(__builtin_fmaxf((a),(b)),(c))
  #define GAPA(MF,A0,A1,A2,A3,W0,W1,PW) do{ MF; sacc+=A0; sacc+=A1; sacc+=A2; sacc+=A3; PIN(sacc); W0; W1; PIN(PW); SBAR(); }while(0)
  #define EX(v) __builtin_amdgcn_exp2f(v)
  #define GAPB(MF,X,B) do{ MF; X[B]=EX(X[B]); X[B+1]=EX(X[B+1]); X[B+2]=EX(X[B+2]); X[B+3]=EX(X[B+3]); PIN(X); SBAR(); }while(0)
  #define VRD(i) do{ vlo[i]=vtr(vp_+(((i)>>2)*4096+((i)&3)*1024)); vhi[i]=vtr(vp_+(((i)>>2)*4096+((i)&3)*1024+512)); }while(0)
  #define KRD(G,j) do{ if(G){ kload2(kf,kp0+sl_next,j); SBAR(); } }while(0)
  #define STEP(C0,C1,P0,P1,t,GK,GV,GL) do{ SBAR(); \
    const lds_cptr vp_=vp0+sl_prev; \
    VRD(0); SBAR(); float sacc=(P0[0]+P0[1]); \
    GAPA(C0=__builtin_amdgcn_mfma_f32_32x32x16_bf16(kf[0],qr[0],negm,0,0,0), P0[2],P0[3],P0[4],P0[5],     pw0[0]=PKW(P0,0), pw0[1]=PKW(P0,2), pw0); \
    VRD(4); SBAR(); GAPA(C1=__builtin_amdgcn_mfma_f32_32x32x16_bf16(kf[1],qr[0],negm,0,0,0), P0[6],P0[7],P0[8],P0[9],     pw0[2]=PKW(P0,4), pw0[3]=PKW(P0,6), pw0); \
    VRD(1); SBAR(); GAPA(C0=__builtin_amdgcn_mfma_f32_32x32x16_bf16(kf[2],qr[1],C0,0,0,0),   P0[10],P0[11],P0[12],P0[13], pw1[0]=PKW(P0,8), pw1[1]=PKW(P0,10), pw1); \
    VRD(5); SBAR(); GAPA(C1=__builtin_amdgcn_mfma_f32_32x32x16_bf16(kf[3],qr[1],C1,0,0,0),   P0[14],P0[15],P1[0],P1[1],   pw1[2]=PKW(P0,12),pw1[3]=PKW(P0,14), pw1); \
    VRD(2); SBAR(); GAPA(C0=__builtin_amdgcn_mfma_f32_32x32x16_bf16(kf[4],qr[2],C0,0,0,0),   P1[2],P1[3],P1[4],P1[5],     pw2[0]=PKW(P1,0), pw2[1]=PKW(P1,2), pw2); \
    VRD(6); SBAR(); GAPA(C1=__builtin_amdgcn_mfma_f32_32x32x16_bf16(kf[5],qr[2],C1,0,0,0),   P1[6],P1[7],P1[8],P1[9],     pw2[2]=PKW(P1,4), pw2[3]=PKW(P1,6), pw2); \
    VRD(3); SBAR(); GAPA(C0=__builtin_amdgcn_mfma_f32_32x32x16_bf16(kf[6],qr[3],C0,0,0,0),   P1[10],P1[11],P1[12],P1[13], pw3[0]=PKW(P1,8), pw3[1]=PKW(P1,10), pw3); \
    VRD(7); SBAR(); GAPA(C1=__builtin_amdgcn_mfma_f32_32x32x16_bf16(kf[7],qr[3],C1,0,0,0),   P1[14],P1[15],0.f,0.f,       pw3[2]=PKW(P1,12),pw3[3]=PKW(P1,14), pw3); \
    l_reg+=sacc; \
    if(GK){DMA_K((t)+3,sl_cur);} if(GV){DMA_V((t)+1,sl_next);} \
    CMASK(C0,C1,t); \
    { float a=MX3(C0[0],C0[1],C1[0]),b=MX3(C0[2],C0[3],C1[1]); a=MX3(a,C1[2],C1[3]); \
      _Pragma("unroll") for(int r=4;r<16;r+=4){a=MX3(a,C0[r],C0[r+1]);b=MX3(b,C0[r+2],C0[r+3]);a=MX3(a,C1[r],C1[r+1]);b=MX3(b,C1[r+2],C1[r+3]);} \
      float rm=__builtin_fmaxf(a,b); { auto rr=__builtin_amdgcn_permlane32_swap(__float_as_uint(rm),__float_as_uint(rm),false,false); rm=__builtin_fmaxf(__uint_as_float(rr[0]),__uint_as_float(rr[1])); } \
      resc=false; \
      if(__builtin_expect(__any(rm>(float)THRL),0)){ const float dl=__builtin_fmaxf(rm,0.f); mhat+=dl; \
        _Pragma("unroll") for(int r=0;r<16;++r){C0[r]-=dl;C1[r]-=dl;} \
        _Pragma("unroll") for(int r=0;r<16;++r)negm[r]=-mhat; asm volatile("":"+v"(negm)); \
        const float f=__builtin_amdgcn_exp2f(-dl); l_reg*=f; if(hi==0)wsf[r32]=f; resc=true; } } \
    SBAR(); \
    GAPB(o[0]=__builtin_amdgcn_mfma_f32_32x32x16_bf16(PAF(0),VFR(0),o[0],0,0,0), C0,0); \
    GAPB(o[1]=__builtin_amdgcn_mfma_f32_32x32x16_bf16(PAF(0),VFR(4),o[1],0,0,0), C0,4); \
    KRD(GL,0); GAPB(o[0]=__builtin_amdgcn_mfma_f32_32x32x16_bf16(PAF(1),VFR(1),o[0],0,0,0), C0,8); \
    KRD(GL,1); GAPB(o[1]=__builtin_amdgcn_mfma_f32_32x32x16_bf16(PAF(1),VFR(5),o[1],0,0,0), C0,12); \
    KRD(GL,2); GAPB(o[0]=__builtin_amdgcn_mfma_f32_32x32x16_bf16(PAF(2),VFR(2),o[0],0,0,0), C1,0); \
    KRD(GL,3); GAPB(o[1]=__builtin_amdgcn_mfma_f32_32x32x16_bf16(PAF(2),VFR(6),o[1],0,0,0), C1,4); \
    GAPB(o[0]=__builtin_amdgcn_mfma_f32_32x32x16_bf16(PAF(3),VFR(3),o[0],0,0,0), C1,8); \
    GAPB(o[1]=__builtin_amdgcn_mfma_f32_32x32x16_bf16(PAF(3),VFR(7),o[1],0,0,0), C1,12); \
    }while(0)
  int t=1;
  #undef CMASK
  #define CMASK(P0,P1,t) do{}while(0)
  for(;t+5<NT;t+=2){
    STEP(pB0,pB1,pA0,pA1,t,true,true,true);     WAIT_BAR(2); RESC(); ROT();
    STEP(pA0,pA1,pB0,pB1,t+1,true,true,true);   WAIT_BAR(2); RESC(); ROT();
  }
  #undef CMASK
  int hi_b=hi,qrel_b=qrel; asm volatile("":"+v"(hi_b),"+v"(qrel_b));
  #define CMASK(P0,P1,t) do{int jb_=(t)-(NT-4); if(jb_>=0)cmask(P0,P1,jb_,qrel_b,hi_b);}while(0)
  #define ENDW(tt) do{ if((tt)+3<NT){WAIT_BAR(2);} else if((tt)+2<NT){WAIT_BAR(1);} else {WAIT_BAR(0);} }while(0)
  for(;t+1<NT;t+=2){
    STEP(pB0,pB1,pA0,pA1,t,(t+3<NT),(t+1<NT),(t+1<NT));       ENDW(t);   RESC(); ROT();
    STEP(pA0,pA1,pB0,pB1,t+1,(t+4<NT),(t+2<NT),(t+2<NT));     ENDW(t+1); RESC(); ROT();
  }
  STEP(pB0,pB1,pA0,pA1,NT-1,false,false,false); RESC();
  { float sacc=pB0[0]+pB0[1]; _Pragma("unroll") for(int r=2;r<16;++r)sacc+=pB0[r]; _Pragma("unroll") for(int r=0;r<16;++r)sacc+=pB1[r]; l_reg+=sacc;
    pw0=(u32x4){PKW(pB0,0),PKW(pB0,2),PKW(pB0,4),PKW(pB0,6)};pw1=(u32x4){PKW(pB0,8),PKW(pB0,10),PKW(pB0,12),PKW(pB0,14)};pw2=(u32x4){PKW(pB1,0),PKW(pB1,2),PKW(pB1,4),PKW(pB1,6)};pw3=(u32x4){PKW(pB1,8),PKW(pB1,10),PKW(pB1,12),PKW(pB1,14)};
    SBAR(); pv(o,vb0+sl_cur,PAF(0),PAF(1),PAF(2),PAF(3)); }
  #undef PKW
  #undef PAF
  #undef VFR
  #undef PIN
  #undef MX3
  #undef GAPA
  #undef GAPB
  #undef EX
  #undef VRD
  #undef KRD
  #undef STEP
  #undef ENDW
  {auto rr=__builtin_amdgcn_permlane32_swap(__float_as_uint(l_reg),__float_as_uint(l_reg),false,false);l_reg=__uint_as_float(rr[0])+__uint_as_float(rr[1]);}
  if(hi==0)wsf[32+r32]=l_reg;asm volatile("s_waitcnt lgkmcnt(0)":::"memory");
  float rli[16];
  #pragma unroll
  for(int r=0;r<16;++r)rli[r]=__builtin_amdgcn_rcpf(wsf[32+crow(r,hi)]);
  bf16*Ow=O+(rowbase+q0+wid*QBLK)*OP;
  { bf16*stg=(bf16*)(shm+LDS_OST)+wid*2048;
    #pragma unroll
    for(int r=0;r<16;++r){const int orow=crow(r,hi);
      #pragma unroll
      for(int d0=0;d0<2;++d0)stg[orow*64+d0*32+r32]=__float2bfloat16(o[d0][r]*rli[r]);}
    asm volatile("s_waitcnt lgkmcnt(0)":::"memory");
    #pragma unroll
    for(int i=0;i<4;++i){const int row=i*8+(lane>>3),ch=lane&7; const u32x4 v=*(const u32x4*)(stg+row*64+ch*8); ATTN_STORE16(Ow+(long)row*OP+ch*8,v);} }
  asm volatile("s_waitcnt lgkmcnt(0)\n\ts_barrier":::"memory");
  #undef DMA_K
  #undef DMA_V
  #undef CMASK
  #undef START
  #undef RESC
  #undef ROT
}
template<int THRL,int QP,int KP,int VP,int OP> __device__ __forceinline__ void attn_unit2(int wave_,int b,int qb,const bf16*Q,const bf16*__restrict__ K,const bf16*__restrict__ V,bf16*O,char*shm){
  int lane_=lane_id_now(); asm volatile("":"+v"(lane_));
  const int wid=wave_,lane=lane_,tid=wid*64+lane,r32=lane&31,hi=lane>>5;
  const long rowbase=(long)b*SEQ; const int q0=qb*QB;
  const bf16*Qw=Q+(rowbase+q0+wid*QBLK)*QP;
  const bf16*Kh=K+rowbase*KP,*Vh=V+rowbase*VP;
  const unsigned lds0=(unsigned)(uintptr_t)shm;
  constexpr int LDS2_V2=2*NSLOT*SLOTB, LDS2_WS=3*NSLOT*SLOTB, LDS2_OST=LDS2_WS+NW*64*4, V2OFF=LDS2_V2-LDS_V;
  float*wsf=(float*)(shm+LDS2_WS)+wid*64;
  const bf16*ksrc=Kh+(long)lane*KP+wid*8;
  const bf16*vsrc=Vh+(long)(16*(wid&3)+(lane>>2))*VP+(wid>>2)*32+(lane&3)*8;
  const unsigned kdst=lds0+LDS_K+wid*1024, vdst=lds0+LDS_V+wid*1024, vdst2=lds0+LDS2_V2+wid*1024;
  #define DMA_K(t,slot) glds16(ksrc+(long)(t)*KVBLK*KP,(unsigned)__builtin_amdgcn_readfirstlane(kdst+(slot)))
  #define DMA_V(t,slot) do{ glds16(vsrc+(long)(t)*KVBLK*VP,(unsigned)__builtin_amdgcn_readfirstlane(vdst+(slot))); glds16(vsrc+64+(long)(t)*KVBLK*VP,(unsigned)__builtin_amdgcn_readfirstlane(vdst2+(slot))); }while(0)
  const int vb0=(int)(lds0+LDS_V)+((lane>>4)&1)*32+(lane&3)*8+(4*hi+((lane&15)>>2))*64;
  const char*Kbase=shm+LDS_K; bf16x8 kf[8];
  const lds_cptr shm3=(lds_cptr)shm; const lds_cptr kp0=shm3+LDS_K+hi*1024+r32*16; const lds_cptr vp0=shm3+LDS_V+((lane>>4)&1)*32+(lane&3)*8+(4*hi+((lane&15)>>2))*64;
  const int NT=(q0+QB)/KVBLK;
  DMA_K(0,0);DMA_V(0,0);DMA_K(1,SLOTB);
  bf16x8 qr[4];
  #pragma unroll
  for(int d0=0;d0<4;++d0)qr[d0]=*reinterpret_cast<const bf16x8*>(&Qw[(long)r32*QP+d0*16+hi*8]);
  float mhat=0.f,l_reg=0.f;f32x16 o[4];o[0]=f32x16{};o[1]=f32x16{};o[2]=f32x16{};o[3]=f32x16{};const f32x16 negm=f32x16{};
  const int qrel=wid*QBLK+r32;
  #define CMASK(P0,P1,t) do{int jb_=(t)-(NT-4); if(jb_>=0)cmask(P0,P1,jb_,qrel,hi);}while(0)
  bool resc=false;
  #define START(P0,P1) do{ const float rm=rowmax(P0,P1); resc=false; \
    { const float dl=rm; mhat=fadd_s(mhat,dl); \
      _Pragma("unroll") for(int r=0;r<16;++r){P0[r]=fsub_s(P0[r],dl);P1[r]=fsub_s(P1[r],dl);} \
      } \
    _Pragma("unroll") for(int r=0;r<16;++r)P0[r]=__builtin_amdgcn_exp2f(P0[r]); }while(0)
  #define RESC() do{ if(resc){ asm volatile("s_waitcnt lgkmcnt(0)":::"memory"); \
      _Pragma("unroll") for(int d_=0;d_<4;++d_) _Pragma("unroll") for(int r=0;r<16;++r)o[d_][r]*=wsf[crow(r,hi)]; } }while(0)
  f32x16 pA0,pA1,pB0,pB1;
  int sl_prev=0,sl_cur=0,sl_next=SLOTB;
  #define ROT() do{sl_prev=sl_cur;sl_cur=sl_next;sl_next=(sl_next==(NSLOT-1)*SLOTB)?0:sl_next+SLOTB;}while(0)
  DMA_K(2,2*SLOTB);
  WAIT_BAR(4);
  qkt(pA0,pA1,Kbase,qr,negm,r32,hi);asm volatile("s_nop 15\n\ts_nop 7":"+v"(pA0),"+v"(pA1));CMASK(pA0,pA1,0);
  START(pA0,pA1);
  _Pragma("unroll") for(int r=0;r<16;++r)pA1[r]=__builtin_amdgcn_exp2f(pA1[r]);
  WAIT_BAR(0);
  DMA_K(3,0);DMA_V(1,SLOTB);
  ROT();
  kload8(kf,kp0+sl_cur);
  WAIT_BAR(3);
  s16x4 vlo[4],vhi[4]; u32x4 pw0,pw1,pw2,pw3;
  #define PKW(P,B) cvtpk_s(P[B],P[B+1])
  #define PAF(k) __builtin_bit_cast(bf16x8,pw##k)
  #define VFR(i) (bf16x8){vlo[i][0],vlo[i][1],vlo[i][2],vlo[i][3],vhi[i][0],vhi[i][1],vhi[i][2],vhi[i][3]}
  #define PIN(x) asm volatile("":"+v"(x))
  #define MX3(a,b,c) __builtin_fmaxf(__builtin_fmaxf((a),(b)),(c))
  #define GAPA(MF,A0,A1,A2,A3,W0,W1,PW) do{ MF; sacc+=A0; sacc+=A1; sacc+=A2; sacc+=A3; PIN(sacc); W0; W1; PIN(PW); SBAR(); }while(0)
  #define EX(v) __builtin_amdgcn_exp2f(v)
  #define GAPB(MF,X,B) do{ MF; X[B]=EX(X[B]); X[B+1]=EX(X[B+1]); X[B+2]=EX(X[B+2]); X[B+3]=EX(X[B+3]); PIN(X); SBAR(); }while(0)
  #define VRD(i) do{ vlo[i]=vtr(vp_+(((i)>>2)*4096+((i)&3)*1024)); vhi[i]=vtr(vp_+(((i)>>2)*4096+((i)&3)*1024+512)); }while(0)
  #define VLD(S,i,OFF) do{ vlo[S]=vtr(vp_+(OFF)+(((i)>>2)*4096+((i)&3)*1024)); vhi[S]=vtr(vp_+(OFF)+(((i)>>2)*4096+((i)&3)*1024+512)); }while(0)
  #define GAPB3(MF,X,B,LD) do{ MF; LD; X[B]=EX(X[B]); X[B+1]=EX(X[B+1]); X[B+2]=EX(X[B+2]); X[B+3]=EX(X[B+3]); PIN(X); SBAR(); }while(0)
  #define KRD(G,j) do{ if(G){ kload2(kf,kp0+sl_next,j); SBAR(); } }while(0)
  #define STEP(C0,C1,P0,P1,t,GK,GV,GL) do{ SBAR(); \
    const lds_cptr vp_=vp0+sl_prev; \
    VLD(0,0,0); SBAR(); float sacc=(P0[0]+P0[1]); \
    GAPA(C0=__builtin_amdgcn_mfma_f32_32x32x16_bf16(kf[0],qr[0],C0,0,0,0), P0[2],P0[3],P0[4],P0[5],     pw0[0]=PKW(P0,0), pw0[1]=PKW(P0,2), pw0); \
    VLD(1,4,0); SBAR(); GAPA(C1=__builtin_amdgcn_mfma_f32_32x32x16_bf16(kf[1],qr[0],C1,0,0,0), P0[6],P0[7],P0[8],P0[9],     pw0[2]=PKW(P0,4), pw0[3]=PKW(P0,6), pw0); \
    VLD(2,1,0); SBAR(); GAPA(C0=__builtin_amdgcn_mfma_f32_32x32x16_bf16(kf[2],qr[1],C0,0,0,0),   P0[10],P0[11],P0[12],P0[13], pw1[0]=PKW(P0,8), pw1[1]=PKW(P0,10), pw1); \
    VLD(3,5,0); SBAR(); GAPA(C1=__builtin_amdgcn_mfma_f32_32x32x16_bf16(kf[3],qr[1],C1,0,0,0),   P0[14],P0[15],P1[0],P1[1],   pw1[2]=PKW(P0,12),pw1[3]=PKW(P0,14), pw1); \
    GAPA(C0=__builtin_amdgcn_mfma_f32_32x32x16_bf16(kf[4],qr[2],C0,0,0,0),   P1[2],P1[3],P1[4],P1[5],     pw2[0]=PKW(P1,0), pw2[1]=PKW(P1,2), pw2); \
    GAPA(C1=__builtin_amdgcn_mfma_f32_32x32x16_bf16(kf[5],qr[2],C1,0,0,0),   P1[6],P1[7],P1[8],P1[9],     pw2[2]=PKW(P1,4), pw2[3]=PKW(P1,6), pw2); \
    GAPA(C0=__builtin_amdgcn_mfma_f32_32x32x16_bf16(kf[6],qr[3],C0,0,0,0),   P1[10],P1[11],P1[12],P1[13], pw3[0]=PKW(P1,8), pw3[1]=PKW(P1,10), pw3); \
    GAPA(C1=__builtin_amdgcn_mfma_f32_32x32x16_bf16(kf[7],qr[3],C1,0,0,0),   P1[14],P1[15],0.f,0.f,       pw3[2]=PKW(P1,12),pw3[3]=PKW(P1,14), pw3); \
    l_reg+=sacc; \
    if(GK){DMA_K((t)+3,sl_cur);} if(GV){DMA_V((t)+1,sl_next);} \
    CMASK(C0,C1,t); \
    { float a=MX3(C0[0],C0[1],C1[0]),b=MX3(C0[2],C0[3],C1[1]); a=MX3(a,C1[2],C1[3]); \
      _Pragma("unroll") for(int r=4;r<16;r+=4){a=MX3(a,C0[r],C0[r+1]);b=MX3(b,C0[r+2],C0[r+3]);a=MX3(a,C1[r],C1[r+1]);b=MX3(b,C1[r+2],C1[r+3]);} \
      float rm=__builtin_fmaxf(a,b); { auto rr=__builtin_amdgcn_permlane32_swap(__float_as_uint(rm),__float_as_uint(rm),false,false); rm=__builtin_fmaxf(__uint_as_float(rr[0]),__uint_as_float(rr[1])); } \
      resc=false; \
      if(__builtin_expect(__any(rm>(float)THRL),0)){ const float dl=__builtin_fmaxf(rm,0.f); mhat+=dl; \
        _Pragma("unroll") for(int r=0;r<16;++r){C0[r]-=dl;C1[r]-=dl;} \
        \
        const float f=__builtin_amdgcn_exp2f(-dl); l_reg*=f; if(hi==0)wsf[r32]=f; resc=true; } } \
    SBAR(); \
    GAPB3(o[0]=__builtin_amdgcn_mfma_f32_32x32x16_bf16(PAF(0),VFR(0),o[0],0,0,0), C0,0, VLD(0,2,0)); \
    GAPB3(o[1]=__builtin_amdgcn_mfma_f32_32x32x16_bf16(PAF(0),VFR(1),o[1],0,0,0), C0,4, VLD(1,6,0)); \
    KRD(GL,0); GAPB3(o[0]=__builtin_amdgcn_mfma_f32_32x32x16_bf16(PAF(1),VFR(2),o[0],0,0,0), C0,8, VLD(2,3,0)); \
    KRD(GL,1); GAPB3(o[1]=__builtin_amdgcn_mfma_f32_32x32x16_bf16(PAF(1),VFR(3),o[1],0,0,0), C0,12, VLD(3,7,0)); \
    KRD(GL,2); GAPB3(o[0]=__builtin_amdgcn_mfma_f32_32x32x16_bf16(PAF(2),VFR(0),o[0],0,0,0), C1,0, VLD(0,0,V2OFF)); \
    KRD(GL,3); GAPB3(o[1]=__builtin_amdgcn_mfma_f32_32x32x16_bf16(PAF(2),VFR(1),o[1],0,0,0), C1,4, VLD(1,4,V2OFF)); \
    GAPB3(o[0]=__builtin_amdgcn_mfma_f32_32x32x16_bf16(PAF(3),VFR(2),o[0],0,0,0), C1,8, VLD(2,1,V2OFF)); \
    GAPB3(o[1]=__builtin_amdgcn_mfma_f32_32x32x16_bf16(PAF(3),VFR(3),o[1],0,0,0), C1,12, VLD(3,5,V2OFF)); \
    const float nm_=-mhat; \
    o[2]=__builtin_amdgcn_mfma_f32_32x32x16_bf16(PAF(0),VFR(0),o[2],0,0,0); VLD(0,2,V2OFF); P0[0]=nm_;P0[1]=nm_;P0[2]=nm_;P0[3]=nm_; PIN(P0); SBAR(); \
    o[3]=__builtin_amdgcn_mfma_f32_32x32x16_bf16(PAF(0),VFR(1),o[3],0,0,0); VLD(1,6,V2OFF); P0[4]=nm_;P0[5]=nm_;P0[6]=nm_;P0[7]=nm_; PIN(P0); SBAR(); \
    o[2]=__builtin_amdgcn_mfma_f32_32x32x16_bf16(PAF(1),VFR(2),o[2],0,0,0); VLD(2,3,V2OFF); P0[8]=nm_;P0[9]=nm_;P0[10]=nm_;P0[11]=nm_; PIN(P0); SBAR(); \
    o[3]=__builtin_amdgcn_mfma_f32_32x32x16_bf16(PAF(1),VFR(3),o[3],0,0,0); VLD(3,7,V2OFF); P0[12]=nm_;P0[13]=nm_;P0[14]=nm_;P0[15]=nm_; PIN(P0); SBAR(); \
    o[2]=__builtin_amdgcn_mfma_f32_32x32x16_bf16(PAF(2),VFR(0),o[2],0,0,0); P1[0]=nm_;P1[1]=nm_;P1[2]=nm_;P1[3]=nm_; PIN(P1); SBAR(); \
    o[3]=__builtin_amdgcn_mfma_f32_32x32x16_bf16(PAF(2),VFR(1),o[3],0,0,0); P1[4]=nm_;P1[5]=nm_;P1[6]=nm_;P1[7]=nm_; PIN(P1); SBAR(); \
    o[2]=__builtin_amdgcn_mfma_f32_32x32x16_bf16(PAF(3),VFR(2),o[2],0,0,0); P1[8]=nm_;P1[9]=nm_;P1[10]=nm_;P1[11]=nm_; PIN(P1); SBAR(); \
    o[3]=__builtin_amdgcn_mfma_f32_32x32x16_bf16(PAF(3),VFR(3),o[3],0,0,0); P1[12]=nm_;P1[13]=nm_;P1[14]=nm_;P1[15]=nm_; PIN(P1); SBAR(); \
    }while(0)
  _Pragma("unroll") for(int r=0;r<16;++r){pB0[r]=-mhat;pB1[r]=-mhat;}
  int t=1;
  #undef CMASK
  #define CMASK(P0,P1,t) do{}while(0)
  for(;t+5<NT;t+=2){
    STEP(pB0,pB1,pA0,pA1,t,true,true,true);     WAIT_BAR(3); RESC(); ROT();
    STEP(pA0,pA1,pB0,pB1,t+1,true,true,true);   WAIT_BAR(3); RESC(); ROT();
  }
  #undef CMASK
  int hi_b=hi,qrel_b=qrel; asm volatile("":"+v"(hi_b),"+v"(qrel_b));
  #define CMASK(P0,P1,t) do{int jb_=(t)-(NT-4); if(jb_>=0)cmask(P0,P1,jb_,qrel_b,hi_b);}while(0)
  #define ENDW(tt) do{ if((tt)+3<NT){WAIT_BAR(3);} else if((tt)+2<NT){WAIT_BAR(2);} else {WAIT_BAR(0);} }while(0)
  for(;t+1<NT;t+=2){
    STEP(pB0,pB1,pA0,pA1,t,(t+3<NT),(t+1<NT),(t+1<NT));       ENDW(t);   RESC(); ROT();
    STEP(pA0,pA1,pB0,pB1,t+1,(t+4<NT),(t+2<NT),(t+2<NT));     ENDW(t+1); RESC(); ROT();
  }
  STEP(pB0,pB1,pA0,pA1,NT-1,false,false,false); RESC();
  { float sacc=pB0[0]+pB0[1]; _Pragma("unroll") for(int r=2;r<16;++r)sacc+=pB0[r]; _Pragma("unroll") for(int r=0;r<16;++r)sacc+=pB1[r]; l_reg+=sacc;
    pw0=(u32x4){PKW(pB0,0),PKW(pB0,2),PKW(pB0,4),PKW(pB0,6)};pw1=(u32x4){PKW(pB0,8),PKW(pB0,10),PKW(pB0,12),PKW(pB0,14)};pw2=(u32x4){PKW(pB1,0),PKW(pB1,2),PKW(pB1,4),PKW(pB1,6)};pw3=(u32x4){PKW(pB1,8),PKW(pB1,10),PKW(pB1,12),PKW(pB1,14)};
    SBAR(); pv(o,vb0+sl_cur,PAF(0),PAF(1),PAF(2),PAF(3)); pv(o+2,vb0+V2OFF+sl_cur,PAF(0),PAF(1),PAF(2),PAF(3)); }
  #undef PKW
  #undef PAF
  #undef VFR
  #undef PIN
  #undef MX3
  #undef GAPA
  #undef GAPB
  #undef EX
  #undef VRD
  #undef KRD
  #undef VLD
  #undef GAPB3
  #undef STEP
  #undef ENDW
  {auto rr=__builtin_amdgcn_permlane32_swap(__float_as_uint(l_reg),__float_as_uint(l_reg),false,false);l_reg=__uint_as_float(rr[0])+__uint_as_float(rr[1]);}
  if(hi==0)wsf[32+r32]=l_reg;asm volatile("s_waitcnt lgkmcnt(0)":::"memory");
  float rli[16];
  #pragma unroll
  for(int r=0;r<16;++r)rli[r]=__builtin_amdgcn_rcpf(wsf[32+crow(r,hi)]);
  bf16*Ow=O+(rowbase+q0+wid*QBLK)*OP;
  { bf16*stg=(bf16*)(shm+LDS2_OST)+wid*2048;
    #pragma unroll
    for(int hh=0;hh<2;++hh){
      #pragma unroll
      for(int r=0;r<16;++r){const int orow=crow(r,hi);
        #pragma unroll
        for(int d0=0;d0<2;++d0)stg[orow*64+d0*32+r32]=__float2bfloat16(o[2*hh+d0][r]*rli[r]);}
      asm volatile("s_waitcnt lgkmcnt(0)":::"memory");
      #pragma unroll
      for(int i=0;i<4;++i){const int row=i*8+(lane>>3),ch=lane&7; const u32x4 v=*(const u32x4*)(stg+row*64+ch*8); ATTN_STORE16(Ow+(long)row*OP+hh*64+ch*8,v);}
      asm volatile("s_waitcnt lgkmcnt(0)":::"memory"); } }
  asm volatile("s_waitcnt lgkmcnt(0)\n\ts_barrier":::"memory");
  #undef DMA_K
  #undef DMA_V
  #undef CMASK
  #undef START
  #undef RESC
  #undef ROT
}
constexpr int ATTN_LDS_BYTES=LDS_BYTES;
#undef SBAR
#undef WAIT_BAR
}
#define GAS __attribute__((address_space(1)))
#define LAS __attribute__((address_space(3)))
typedef unsigned short bf16;
typedef unsigned v4u __attribute__((ext_vector_type(4)));
typedef float f32x4 __attribute__((ext_vector_type(4)));
typedef short bf16x8 __attribute__((ext_vector_type(8)));
typedef GAS unsigned gu32;
typedef GAS unsigned long long gu64;
#define RLX_AGENT __ATOMIC_RELAXED, __HIP_MEMORY_SCOPE_AGENT
#define LDS_WAIT() asm volatile("s_waitcnt lgkmcnt(0)" ::: "memory")
#define VM_WAIT() asm volatile("s_waitcnt vmcnt(0)" ::: "memory")
__device__ __forceinline__ unsigned long long rt() { return __builtin_amdgcn_s_memrealtime(); }
__device__ __forceinline__ unsigned f2bf(float f) { unsigned u = __builtin_bit_cast(unsigned, f); return (u + 0x7fffu + ((u >> 16) & 1u)) >> 16; }
__device__ __forceinline__ unsigned pk2(float lo, float hi) { return f2bf(lo) | (f2bf(hi) << 16); }

#define XB_TMO      128
#define XB_XCNT(j)  (256  + 64 * (j))
#define XB_XSUB(j)  (1280 + 64 * (j))
#define XB_XGEN(j)  (2304 + 64 * (j))
#define XB_TOP      3328
#define XB_TOPGEN   3392
#define XCD_BAR_WORDS 3456
#define XB_SPIN_CAP (1u << 18)

__device__ __forceinline__ unsigned xb_ld(unsigned* p)              { return __hip_atomic_load(p, __ATOMIC_RELAXED, __HIP_MEMORY_SCOPE_AGENT); }
__device__ __forceinline__ unsigned xb_add(unsigned* p, unsigned v) { return __hip_atomic_fetch_add(p, v, __ATOMIC_RELAXED, __HIP_MEMORY_SCOPE_AGENT); }
__device__ __forceinline__ unsigned xb_xcc_id() { return (unsigned)__builtin_amdgcn_s_getreg((3 << 11) | 20) & 0xFu; }
#define XB_SPIN(cond, bar) do { unsigned _sp = 0; while (cond) { __builtin_amdgcn_s_sleep(1); \
    if ((++_sp & 255u) == 0u) { if (xb_ld(&(bar)[XB_TMO])) break; if (_sp > XB_SPIN_CAP) { atomicAdd(&(bar)[XB_TMO], 1u); break; } } } } while (0)

struct XcdBarrier {
    unsigned* bar; unsigned x;
    volatile LAS unsigned* st;
};

__device__ __forceinline__ XcdBarrier xcd_barrier_post(unsigned* bar, volatile LAS unsigned* st) {
    XcdBarrier b; b.bar = bar; b.x = xb_xcc_id(); b.st = st;
    if (threadIdx.x == 0) { const unsigned r_ = xb_add(&bar[XB_XCNT(b.x)], 1u); st[2] = r_; st[3] = b.x; }
    return b;
}
__device__ __forceinline__ void xcd_barrier_complete(unsigned* bar, unsigned x, unsigned& nloc, unsigned& nx, unsigned& regular) {
    const unsigned G = gridDim.x * gridDim.y * gridDim.z;
    unsigned sum, cnt, mine, sp = 0u;
    for (;;) {
        sum = 0u; cnt = 0u; mine = 0u; regular = 1u;
#pragma unroll
        for (unsigned j = 0; j < 16; ++j) { const unsigned c = xb_ld(&bar[XB_XCNT(j)]); sum += c; cnt += (c > 0u) ? 1u : 0u; mine = (j == x) ? c : mine; regular &= (c == 0u || c == 32u) ? 1u : 0u; }
        if (sum == G) break;
        __builtin_amdgcn_s_sleep(1);
        if ((++sp & 255u) == 0u) { if (xb_ld(&bar[XB_TMO])) break; if (sp > XB_SPIN_CAP) { atomicAdd(&bar[XB_TMO], 1u); break; } }
    }
    nloc = mine > 0u ? mine : 1u; nx = cnt > 0u ? cnt : 1u; regular = (regular != 0u && cnt == 8u && sum == G) ? 1u : 0u;
}

__device__ __forceinline__ void xcd_barrier(const XcdBarrier& b, int wave_) {
    asm volatile("s_waitcnt vmcnt(0)" ::: "memory");
    __syncthreads();
    if (wave_ == 0 && lane_id_now() == 0) {
        unsigned* bar = b.bar;
        __builtin_amdgcn_s_waitcnt(0);
        unsigned nloc = b.st[0], nx = b.st[1];
        if (nloc == 0u) { unsigned reg_; xcd_barrier_complete(bar, b.x, nloc, nx, reg_); b.st[0] = nloc; b.st[1] = nx; b.st[5] = reg_; }
        const unsigned old = xb_add(&bar[XB_XSUB(b.x)], 1u);
        const unsigned gen = old / nloc;
        if (old + 1u == (gen + 1u) * nloc) {
            __builtin_amdgcn_fence(__ATOMIC_RELEASE, "agent");
            asm volatile("s_waitcnt vmcnt(0)" ::: "memory");
            const unsigned og = xb_add(&bar[XB_TOP], 1u);
            const unsigned tg = og / nx;
            if (og + 1u == (tg + 1u) * nx) xb_add(&bar[XB_TOPGEN], 1u);
            else XB_SPIN(xb_ld(&bar[XB_TOPGEN]) == tg, bar);
            __builtin_amdgcn_fence(__ATOMIC_ACQUIRE, "agent");
            xb_add(&bar[XB_XGEN(b.x)], 1u);
            asm volatile("s_waitcnt vmcnt(0)" ::: "memory");
        } else {
            XB_SPIN(xb_ld(&bar[XB_XGEN(b.x)]) == gen, bar);
            __builtin_amdgcn_fence(__ATOMIC_ACQUIRE, "agent");
            asm volatile("s_waitcnt vmcnt(0)" ::: "memory");
        }
    }
    __syncthreads();
}
constexpr int NWAVES = 8;
constexpr int BATCH = 4, T = 4096, D = 1024, M = BATCH * T;
constexpr int NPROJ = 5120;
constexpr int NE = 32, TOPK = 4, FF = 1024;
constexpr int MAXT = (M * TOPK) / 256 + NE;
constexpr float EPS = 1e-5f;
constexpr float F8_XSCALE = 32.0f, F8_WSCALE = 512.0f, F8_ASCALE = 8.0f, F8_YSCALE = 64.0f;
constexpr float LAMBDA_INIT = 0.2f;

constexpr size_t MiB = 1u << 20;
constexpr size_t WS_CTL = 0, CTL_ZERO_BYTES = 128 * 1024;
constexpr size_t WS_ROPE = 1 * MiB;
constexpr size_t WS_ROUTE = 2 * MiB;
constexpr size_t WS_WLG = 3 * MiB;
constexpr size_t WS_WGU = 4 * MiB;
constexpr size_t WS_WD = 132 * MiB;
constexpr size_t WS_WIN = 196 * MiB;
constexpr size_t WS_WDA = 206 * MiB, WS_WSB = 207 * MiB, WS_WO = 208 * MiB;
constexpr size_t WS_A0 = 210 * MiB;
constexpr size_t WS_H = WS_A0;
constexpr size_t WS_P = WS_A0 + 32 * MiB;
constexpr size_t WS_VBT = WS_A0 + 192 * MiB;
constexpr size_t WS_ODA = WS_A0 + 208 * MiB;
constexpr size_t WS_DA = WS_A0 + 240 * MiB;
constexpr size_t WS_SB = WS_A0 + 256 * MiB;
constexpr size_t WS_YS = WS_A0 + 144 * MiB;
constexpr size_t WS_ACT = WS_A0;
constexpr size_t WS_LIST = WS_A0 + 288 * MiB;
constexpr size_t WS_END = WS_A0 + 292 * MiB;
static_assert(WS_SB + 16 * MiB <= WS_END && WS_END <= 512 * MiB, "d_ws map");
constexpr int CW_TMO = 0, CW_CODE = 1;
constexpr int CW_CNT = 1024;
constexpr int CW_BAR = 4096;
constexpr int CW_RANK = 8192;
constexpr int CW_GRP = 9216;
constexpr int CW_XL = 13312;
constexpr int CW_RDY = 14336;
static_assert((CW_RDY + 16 * MAXT) * 4 <= (int)CTL_ZERO_BYTES, "control words");

constexpr int RING_OFF = 0, RING_BYTES = 131072;
constexpr int RT_STRIDE = 36, RT_BYTES = 1024 * RT_STRIDE * 4;
constexpr int LDSCTL_OFF = 147456, MISC_OFF = LDSCTL_OFF + 320, TAB_OFF = LDSCTL_OFF + 1024;
constexpr int JUNK_OFF = RING_BYTES, TOK_OFF = RING_BYTES;
constexpr int EPISTG_OFF = LDSCTL_OFF + 4096;
constexpr int LDS_BYTES = 163840;
static_assert(RT_BYTES <= LDSCTL_OFF && TAB_OFF + 4 * 768 <= LDS_BYTES && TOK_OFF + 16384 <= LDSCTL_OFF, "LDS map");
#define LANE_NOW (lane_id_now())
struct Frame {
    LAS unsigned char* lds;
    volatile LAS unsigned* MISC;
    gu32* ctl;
    int wave;
    int vcu, G;
};
__device__ __forceinline__ float wave_sum(float v) {
#pragma unroll
    for (int o = 1; o < 64; o <<= 1) v += __shfl_xor(v, o);
    return v;
}
__device__ __forceinline__ unsigned cvtpk2(float lo, float hi) { unsigned r; asm volatile("v_cvt_pk_bf16_f32 %0, %1, %2" : "=v"(r) : "v"(lo), "v"(hi)); return r; }
__device__ __forceinline__ void tb_load(float (&tv)[32], const float* W, int ldw, int lane) {
#pragma unroll
    for (int i = 0; i < 32; ++i) tv[i] = __builtin_nontemporal_load(W + (size_t)(2 * i + (lane >> 5)) * ldw + (lane & 31));
}
__device__ __forceinline__ void tb_finish(const float (&tv)[32], bf16* WT, int ldt, const float* gk, LAS float* scr, int lane) {
    if (gk) {
#pragma unroll
        for (int i = 0; i < 32; ++i) scr[(2 * i + (lane >> 5)) * 33 + (lane & 31)] = tv[i] * gk[2 * i + (lane >> 5)];
    } else {
#pragma unroll
        for (int i = 0; i < 32; ++i) scr[(2 * i + (lane >> 5)) * 33 + (lane & 31)] = tv[i];
    }
    LDS_WAIT(); asm volatile("" ::: "memory");
    const int c = lane & 7;
#pragma unroll
    for (int j = 0; j < 4; ++j) { const int n = (lane >> 3) + 8 * j; const LAS float* s = scr + (8 * c) * 33 + n;
        v4u o; o.x = cvtpk2(s[0 * 33], s[1 * 33]); o.y = cvtpk2(s[2 * 33], s[3 * 33]); o.z = cvtpk2(s[4 * 33], s[5 * 33]); o.w = cvtpk2(s[6 * 33], s[7 * 33]);
        __builtin_nontemporal_store(o, (GAS v4u*)(WT + (size_t)n * ldt + 8 * c)); }
    LDS_WAIT(); asm volatile("" ::: "memory");
}
struct XItem { const float* src; int ldw; bf16* dst; int ldt; const float* gk; bf16* dst2; float f8; };
__device__ __forceinline__ void tb_load64(float (&tv)[64], const float* W, int ldw, int lane) {
#pragma unroll
    for (int i = 0; i < 64; ++i) tv[i] = __builtin_nontemporal_load(W + (size_t)i * ldw + lane);
}
__device__ __forceinline__ void tb_finish64(const float (&tv)[64], const XItem& it, LAS float* scr, int lane) {
    if (it.f8 != 0.f) {
#pragma unroll
        for (int i = 0; i < 64; ++i) scr[i * 65 + lane] = __builtin_amdgcn_fmed3f(tv[i] * (it.gk ? it.gk[i] * it.f8 : it.f8), -448.0f, 448.0f);
        LDS_WAIT(); asm volatile("" ::: "memory");
        const int c4 = lane & 3;
#pragma unroll
        for (int j = 0; j < 4; ++j) { const int n = (lane >> 2) + 16 * j; const LAS float* s = scr + (16 * c4) * 65 + n; int w[4];
#pragma unroll
            for (int q = 0; q < 4; ++q) { int t = 0; t = __builtin_amdgcn_cvt_pk_fp8_f32(s[(4 * q) * 65], s[(4 * q + 1) * 65], t, false); t = __builtin_amdgcn_cvt_pk_fp8_f32(s[(4 * q + 2) * 65], s[(4 * q + 3) * 65], t, true); w[q] = t; }
            v4u o; o.x = (unsigned)w[0]; o.y = (unsigned)w[1]; o.z = (unsigned)w[2]; o.w = (unsigned)w[3];
            __builtin_nontemporal_store(o, (GAS v4u*)((unsigned char*)it.dst + (size_t)n * it.ldt + 16 * c4)); }
        LDS_WAIT(); asm volatile("" ::: "memory");
        return;
    }
    if (it.gk) {
#pragma unroll
        for (int i = 0; i < 64; ++i) scr[i * 65 + lane] = tv[i] * it.gk[i];
    } else {
#pragma unroll
        for (int i = 0; i < 64; ++i) scr[i * 65 + lane] = tv[i];
    }
    LDS_WAIT(); asm volatile("" ::: "memory");
    const int c = lane & 7;
#pragma unroll
    for (int j = 0; j < 8; ++j) { const int n = (lane >> 3) + 8 * j; const LAS float* s = scr + (8 * c) * 65 + n;
        v4u o; o.x = cvtpk2(s[0 * 65], s[1 * 65]); o.y = cvtpk2(s[2 * 65], s[3 * 65]); o.z = cvtpk2(s[4 * 65], s[5 * 65]); o.w = cvtpk2(s[6 * 65], s[7 * 65]);
        bf16* rowp = (j < 4) ? it.dst + (size_t)n * it.ldt : it.dst2 + (size_t)(n - 32) * it.ldt;
        *(GAS v4u*)(rowp + 8 * c) = o; }
    LDS_WAIT(); asm volatile("" ::: "memory");
}
__device__ __forceinline__ void rms_row_to_bf16(int lane, const float* xrow, const float* g, bf16* orow) {
    const GAS f32x4* xr = (const GAS f32x4*)xrow + lane; const GAS f32x4* gr = (const GAS f32x4*)g + lane;
    f32x4 v[4]; float s = 0.f;
#pragma unroll
    for (int j = 0; j < 4; ++j) { v[j] = xr[64 * j]; s += (v[j].x * v[j].x + v[j].y * v[j].y) + (v[j].z * v[j].z + v[j].w * v[j].w); }
    const float rstd = 1.f / sqrtf(wave_sum(s) * (1.f / D) + EPS);
    GAS unsigned long long* o8 = (GAS unsigned long long*)orow + lane;
#pragma unroll
    for (int j = 0; j < 4; ++j) { const f32x4 gg = gr[64 * j]; const f32x4 y = v[j] * rstd * gg;
        o8[64 * j] = (unsigned long long)cvtpk2(y.x, y.y) | ((unsigned long long)cvtpk2(y.z, y.w) << 32); }
}

struct Args { const float* in[21]; float* out; unsigned char* ws; int ph_lo, ph_hi; };
__device__ const float INV_FREQ[32] = {1.000000000e+00f, 7.498942018e-01f, 5.623413324e-01f, 4.216965139e-01f, 3.162277639e-01f, 2.371373922e-01f, 1.778279394e-01f, 1.333521456e-01f, 1.000000015e-01f, 7.498941571e-02f, 5.623412877e-02f, 4.216964915e-02f, 3.162277862e-02f, 2.371373586e-02f, 1.778279431e-02f, 1.333521493e-02f, 9.999999776e-03f, 7.498942316e-03f, 5.623413250e-03f, 4.216964822e-03f, 3.162277862e-03f, 2.371373819e-03f, 1.778279431e-03f, 1.333521446e-03f, 1.000000047e-03f, 7.498941850e-04f, 5.623413017e-04f, 4.216965463e-04f, 3.162277862e-04f, 2.371373848e-04f, 1.778279402e-04f, 1.333521504e-04f};

__device__ __forceinline__ void p0_prologue(Frame& F, const Args& a, unsigned char* ws) {
    LAS float* scr = (LAS float*)(F.lds + RING_OFF + F.wave * 16384);
    const int gw = F.vcu * NWAVES + F.wave, NGW = F.G * NWAVES;
    const float* x = a.in[0]; const float* g_mix = a.in[1]; const float* w_in = a.in[2];
    const float* w_da = a.in[8]; const float* w_sb = a.in[9]; const float* w_o = a.in[10];
    const float* w_gate = a.in[14]; const float* w_up = a.in[16]; const float* w_down = a.in[18]; const float* g_ffn_p = a.in[11];
    bf16* WIN = (bf16*)(ws + WS_WIN); bf16* WDA = (bf16*)(ws + WS_WDA); bf16* WSB = (bf16*)(ws + WS_WSB); bf16* WO = (bf16*)(ws + WS_WO);
    bf16* WGU = (bf16*)(ws + WS_WGU); bf16* WD = (bf16*)(ws + WS_WD);
    constexpr int I_IN = 16 * 80, I_DA = 8 * 16, I_SB = 8 * 16, I_O = 16 * 16, I_EXP = 16 * 16;
    constexpr int NITEMS = I_IN + I_DA + I_SB + I_O + 96 * I_EXP;
    auto item = [&](int it) -> XItem {
        int r = it;
        if (r < I_IN) { const int kb = r / 80, nb = r % 80, n0 = 64 * nb;
            if (n0 < 1024) { const int pn = n0 >> 8, w = n0 & 255, drow = 256 * pn + 32 * (w >> 6);
                return XItem{w_in + (size_t)(64 * kb) * NPROJ + n0, NPROJ, WIN + (size_t)drow * 1024 + 64 * kb, 1024, nullptr, WIN + (size_t)(drow + 128) * 1024 + 64 * kb, 0.f}; }
            return XItem{w_in + (size_t)(64 * kb) * NPROJ + n0, NPROJ, WIN + (size_t)n0 * 1024 + 64 * kb, 1024, nullptr, WIN + (size_t)(n0 + 32) * 1024 + 64 * kb, 0.f}; }
        r -= I_IN;
        if (r < I_DA) { const int kb = r / 16, n0 = 64 * (r % 16); unsigned char* d = (unsigned char*)WDA + (size_t)n0 * 512 + 64 * kb; return XItem{w_da + (size_t)(64 * kb) * 1024 + n0, 1024, (bf16*)d, 512, nullptr, (bf16*)d, F8_WSCALE}; }
        r -= I_DA;
        if (r < I_SB) { const int kb = r / 16, n0 = 64 * (r % 16); unsigned char* d = (unsigned char*)WSB + (size_t)n0 * 512 + 64 * kb; return XItem{w_sb + (size_t)(64 * kb) * 1024 + n0, 1024, (bf16*)d, 512, nullptr, (bf16*)d, F8_WSCALE}; }
        r -= I_SB;
        if (r < I_O) { const int kb = r / 16, n0 = 64 * (r % 16); unsigned char* d = (unsigned char*)WO + (size_t)n0 * 1024 + 64 * kb; return XItem{w_o + (size_t)(64 * kb) * 1024 + n0, 1024, (bf16*)d, 1024, nullptr, (bf16*)d, F8_WSCALE}; }
        r -= I_O;
        const int mat = r / I_EXP, q = r % I_EXP, kb = q / 16, n0 = 64 * (q % 16), e = mat / 3, kind = mat % 3;
        const size_t eoff = (size_t)e * 1024 * 1024;
        if (kind == 2) { unsigned char* d = (unsigned char*)WD + (((size_t)e * 16 + kb) * 1024 + n0) * 64; return XItem{w_down + eoff + (size_t)(64 * kb) * 1024 + n0, 1024, (bf16*)d, 64, nullptr, (bf16*)d, F8_WSCALE}; }
        unsigned char* d = (unsigned char*)WGU + (((size_t)e * 16 + kb) * 2048 + 256 * (n0 >> 7) + (kind == 1 ? 128 : 0) + (n0 & 127)) * 64;
        return XItem{(kind == 0 ? w_gate : w_up) + eoff + (size_t)(64 * kb) * 1024 + n0, 1024, (bf16*)d, 64, g_ffn_p + 64 * kb, (bf16*)d, F8_WSCALE};
    };
    { LAS float* scr64 = (LAS float*)(F.lds + F.wave * 16640);
      float tvn[64]; XItem nx = item(gw < NITEMS ? gw : 0);
      if (gw < NITEMS) tb_load64(tvn, nx.src, nx.ldw, LANE_NOW);
      for (int it = gw; it < NITEMS; it += NGW) {
          const XItem cu = nx; float tv[64];
#pragma unroll
          for (int i = 0; i < 64; ++i) tv[i] = tvn[i];
          if (it + NGW < NITEMS) { nx = item(it + NGW); tb_load64(tvn, nx.src, nx.ldw, LANE_NOW); }
          tb_finish64(tv, cu, scr64, LANE_NOW);
      } }
    bf16* H = (bf16*)(ws + WS_H);
    { const int lane_ = LANE_NOW; const GAS f32x4* gr = (const GAS f32x4*)g_mix + lane_; f32x4 gg[4];
#pragma unroll
      for (int j = 0; j < 4; ++j) gg[j] = gr[64 * j];
      for (int mb = gw; mb < M; mb += 8 * NGW) { f32x4 v[8][4];
#pragma unroll
          for (int i = 0; i < 8; ++i) { const int mm = (mb + i * NGW < M) ? mb + i * NGW : mb; const GAS f32x4* xr = (const GAS f32x4*)(x + (size_t)mm * D) + lane_;
#pragma unroll
              for (int j = 0; j < 4; ++j) v[i][j] = __builtin_nontemporal_load(xr + 64 * j); }
#pragma unroll
          for (int i = 0; i < 8; ++i) { const int mrow = mb + i * NGW; if (mrow >= M) break; float s = 0.f;
#pragma unroll
              for (int j = 0; j < 4; ++j) s += (v[i][j].x * v[i][j].x + v[i][j].y * v[i][j].y) + (v[i][j].z * v[i][j].z + v[i][j].w * v[i][j].w);
              const float rms_ = sqrtf(wave_sum(s) * (1.f / D) + EPS), rstd = 1.f / rms_;
              if (lane_ == 0) ((float*)(ws + WS_WLG + 512 * 1024))[mrow] = rms_;
              GAS unsigned long long* o8 = (GAS unsigned long long*)(H + (size_t)mrow * D) + lane_;
#pragma unroll
              for (int j = 0; j < 4; ++j) { const f32x4 y = v[i][j] * rstd * gg[j]; o8[64 * j] = (unsigned long long)cvtpk2(y.x, y.y) | ((unsigned long long)cvtpk2(y.z, y.w) << 32); } } } }
    { const float* w_r = a.in[12]; float* WLG = (float*)(ws + WS_WLG);
      for (int idx = gw * 64 + LANE_NOW; idx < 1024 * 32; idx += NGW * 64) { const int k = idx >> 5, e = idx & 31;
          const float w = w_r[idx] * g_ffn_p[k]; const unsigned hi = f2bf(w), lo = f2bf(w - __uint_as_float(hi << 16));
          unsigned short* d = (unsigned short*)WLG + (size_t)(((((k >> 6) * 2 + ((k >> 3) & 1)) * 2) * 4 + ((k >> 4) & 3)) * 32 + e) * 8 + (k & 7);
          d[0] = (unsigned short)hi; d[4 * 32 * 8] = (unsigned short)lo; } }
    float* rope = (float*)(ws + WS_ROPE);
    for (int idx = gw * 64 + LANE_NOW; idx < 4096 * 32; idx += NGW * 64) { const int pos = idx >> 5, i = idx & 31;
        const float ang = (float)pos * INV_FREQ[i];
        const double rev = (double)ang * 0.15915494309189535; const double fr = rev - __builtin_rint(rev); const float rf = (float)fr;
        rope[idx] = __builtin_amdgcn_cosf(rf); rope[4096 * 32 + idx] = __builtin_amdgcn_sinf(rf); }
}

typedef float f32x16 __attribute__((ext_vector_type(16)));
typedef short s16x4 __attribute__((ext_vector_type(4)));
__device__ __forceinline__ int crow_(int r, int hi) { return (r & 3) + 8 * (r >> 2) + 4 * hi; }
__device__ __forceinline__ void sb_item(int b, int h, int qt, const bf16* P, const bf16* VT, bf16* O, int lane_) {
    int lane = lane_; asm volatile("" : "+v"(lane));
    const int r32 = lane & 31, hi = lane >> 5;
    const int q0 = qt * 32; const size_t tokq = (size_t)b * T + q0 + r32;
    const bf16* Qp = P + tokq * NPROJ + 1536 + h * 64 + hi * 8;
    bf16x8 qf[4];
#pragma unroll
    for (int d0 = 0; d0 < 4; ++d0) qf[d0] = *(const bf16x8*)(Qp + d0 * 16);
    f32x16 o0, o1;
#pragma unroll
    for (int r = 0; r < 16; ++r) { o0[r] = 0.f; o1[r] = 0.f; }
    float R = 0.f;
    const bf16* Kb = P + ((size_t)b * T + r32) * NPROJ + 2048 + h * 64 + hi * 8;
    const bf16* Vb = VT + (size_t)(h * 64 + r32) * M + (size_t)b * T + 4 * hi;
    bf16x8 kfN[4]; s16x4 vlN[2][2], vhN[2][2];
#define SB_LOAD(kt_) do { const int kv0_ = (kt_) * 32; \
        _Pragma("unroll") for (int d0 = 0; d0 < 4; ++d0) kfN[d0] = *(const bf16x8*)(Kb + (size_t)kv0_ * NPROJ + d0 * 16); \
        _Pragma("unroll") for (int s = 0; s < 2; ++s) _Pragma("unroll") for (int d0 = 0; d0 < 2; ++d0) { const bf16* vp = Vb + (size_t)(d0 * 32) * M + kv0_ + 16 * s; vlN[s][d0] = *(const s16x4*)vp; vhN[s][d0] = *(const s16x4*)(vp + 8); } } while (0)
    SB_LOAD(qt);
    for (int kt = qt; kt >= 0; --kt) {
        bf16x8 kf[4]; s16x4 vl[2][2], vh[2][2];
#pragma unroll
        for (int d0 = 0; d0 < 4; ++d0) kf[d0] = kfN[d0];
#pragma unroll
        for (int s = 0; s < 2; ++s)
#pragma unroll
            for (int d0 = 0; d0 < 2; ++d0) { vl[s][d0] = vlN[s][d0]; vh[s][d0] = vhN[s][d0]; }
        if (kt > 0) SB_LOAD(kt - 1);
        f32x16 sc;
#pragma unroll
        for (int r = 0; r < 16; ++r) sc[r] = 0.f;
#pragma unroll
        for (int d0 = 0; d0 < 4; ++d0) sc = __builtin_amdgcn_mfma_f32_32x32x16_bf16(kf[d0], qf[d0], sc, 0, 0, 0);
        const int lim = (kt == qt) ? r32 : 64;
        float c[16];
#pragma unroll
        for (int r = 0; r < 16; ++r) { const float z = sc[r]; const float sp = fmaxf(z, 0.f) + __logf(1.0f + __expf(-fabsf(z))); c[r] = (crow_(r, hi) < lim) ? sp : 0.f; }
        float g[4], gp[4], Tt[4], A[4];
#pragma unroll
        for (int m = 0; m < 4; ++m) { g[m] = (c[4 * m] + c[4 * m + 1]) + (c[4 * m + 2] + c[4 * m + 3]); gp[m] = __shfl_xor(g[m], 32); Tt[m] = g[m] + gp[m]; }
        const float suf3 = 0.f, suf2 = Tt[3], suf1 = suf2 + Tt[2], suf0 = suf1 + Tt[1];
        A[0] = suf0 + (hi ? 0.f : gp[0]); A[1] = suf1 + (hi ? 0.f : gp[1]); A[2] = suf2 + (hi ? 0.f : gp[2]); A[3] = suf3 + (hi ? 0.f : gp[3]);
        float av[16];
#pragma unroll
        for (int m = 0; m < 4; ++m) { float run = R + A[m];
#pragma unroll
            for (int e = 3; e >= 0; --e) { const int r = 4 * m + e; run += c[r]; av[r] = (crow_(r, hi) < lim) ? __expf(sc[r] - run) : 0.f; } }
        R += suf0 + Tt[0];
        const bool sb_done = __all(R > 96.0f);
        v4u pw0, pw1;
        pw0.x = cvtpk2(av[0], av[1]); pw0.y = cvtpk2(av[2], av[3]); pw0.z = cvtpk2(av[4], av[5]); pw0.w = cvtpk2(av[6], av[7]);
        pw1.x = cvtpk2(av[8], av[9]); pw1.y = cvtpk2(av[10], av[11]); pw1.z = cvtpk2(av[12], av[13]); pw1.w = cvtpk2(av[14], av[15]);
        const bf16x8 pf0 = __builtin_bit_cast(bf16x8, pw0), pf1 = __builtin_bit_cast(bf16x8, pw1);
#define VF(s, d0) (bf16x8){vl[s][d0][0], vl[s][d0][1], vl[s][d0][2], vl[s][d0][3], vh[s][d0][0], vh[s][d0][1], vh[s][d0][2], vh[s][d0][3]}
        o0 = __builtin_amdgcn_mfma_f32_32x32x16_bf16(VF(0, 0), pf0, o0, 0, 0, 0);
        o1 = __builtin_amdgcn_mfma_f32_32x32x16_bf16(VF(0, 1), pf0, o1, 0, 0, 0);
        o0 = __builtin_amdgcn_mfma_f32_32x32x16_bf16(VF(1, 0), pf1, o0, 0, 0, 0);
        o1 = __builtin_amdgcn_mfma_f32_32x32x16_bf16(VF(1, 1), pf1, o1, 0, 0, 0);
#undef VF
        if (sb_done) break;
    }
#undef SB_LOAD
    bf16* Op = O + tokq * 512 + h * 64 + 4 * hi;
#pragma unroll
    for (int gi = 0; gi < 4; ++gi) {
        *(unsigned long long*)(Op + 8 * gi) = (unsigned long long)cvtpk2(o0[4 * gi], o0[4 * gi + 1]) | ((unsigned long long)cvtpk2(o0[4 * gi + 2], o0[4 * gi + 3]) << 32);
        *(unsigned long long*)(Op + 32 + 8 * gi) = (unsigned long long)cvtpk2(o1[4 * gi], o1[4 * gi + 1]) | ((unsigned long long)cvtpk2(o1[4 * gi + 2], o1[4 * gi + 3]) << 32);
    }
}


constexpr int SBL_KST = 448 * 16, SBL_V = 8 * SBL_KST, SBL_FLAG = 2 * SBL_V;
__device__ __forceinline__ void sb_unit(int wave, int b, int h, int qblk, const bf16* P, bf16* O, char* shm) {
    int lane = LANE_NOW; asm volatile("" : "+v"(lane));
    const int r32 = lane & 31, hi = lane >> 5;
    const int q0 = qblk * 256; const size_t tokq = (size_t)b * T + q0 + wave * 32 + r32;
    const int nb = (qblk == 0) ? 0 : 6;
    const unsigned lds0 = (unsigned)(uintptr_t)shm;
    typedef __attribute__((address_space(3))) const char* lptr;
    const lptr shm3 = (lptr)shm;
    volatile LAS unsigned* flags = (volatile LAS unsigned*)((LAS unsigned char*)shm3 + SBL_FLAG);
    const bf16* Kh = P + (size_t)b * T * NPROJ + 2048 + h * 64 + wave * 8;
    const bf16* Vh = P + (size_t)b * T * NPROJ + 2560 + h * 64 + (wave >> 2) * 32 + (lane & 3) * 8;
#define SB_DMA(start_, n64_) do { \
        for (int j_ = 0; j_ < (n64_); ++j_) { int rk_ = (start_) + 64 * j_ + lane; rk_ = rk_ < 0 ? 0 : rk_; int rv_ = (start_) + 64 * j_ + 16 * (wave & 3) + (lane >> 2); rv_ = rv_ < 0 ? 0 : rv_; \
            attn_body::glds16(Kh + (size_t)rk_ * NPROJ, (unsigned)__builtin_amdgcn_readfirstlane(lds0 + wave * SBL_KST + j_ * 1024)); \
            attn_body::glds16(Vh + (size_t)rv_ * NPROJ, (unsigned)__builtin_amdgcn_readfirstlane(lds0 + SBL_V + j_ * 8192 + wave * 1024)); } } while (0)
    int start = q0 - 32 * nb;
    SB_DMA(start, 7);
    if (wave == 0 && lane == 0) { flags[0] = 0u; flags[1] = 0u; }
    const bf16* Qp = P + tokq * NPROJ + 1536 + h * 64 + hi * 8;
    bf16x8 qf[4];
#pragma unroll
    for (int d0 = 0; d0 < 4; ++d0) qf[d0] = *(const bf16x8*)(Qp + d0 * 16);
    f32x16 o0, o1;
#pragma unroll
    for (int r = 0; r < 16; ++r) { o0[r] = 0.f; o1[r] = 0.f; }
    float R = 1.0f; bool done = false;
    const lptr kb = shm3 + hi * SBL_KST + r32 * 16;
    const lptr vb = shm3 + SBL_V + (4 * hi + ((lane & 15) >> 2)) * 64 + ((lane >> 4) & 1) * 32 + (lane & 3) * 8;
    for (int c = 0; ; ++c) {
        asm volatile("s_waitcnt vmcnt(0) lgkmcnt(0)\n\ts_barrier" ::: "memory");
        for (int jt = (c == 0) ? nb + wave : 7; jt >= 0 && !done; --jt) {
            if (start + 32 * jt < 0) break;
            bf16x8 kf[4];
#pragma unroll
            for (int d0 = 0; d0 < 4; ++d0) kf[d0] = *(const __attribute__((address_space(3))) bf16x8*)(kb + d0 * (2 * SBL_KST) + jt * 512);
            s16x4 vl[2][2], vh[2][2];
#pragma unroll
            for (int s = 0; s < 2; ++s)
#pragma unroll
                for (int d0 = 0; d0 < 2; ++d0) { const lptr vp = vb + (jt >> 1) * 8192 + d0 * 4096 + ((jt & 1) * 32 + 16 * s) * 64;
                    vl[s][d0] = __builtin_bit_cast(s16x4, __builtin_amdgcn_ds_read_tr16_b64_v4i16((__attribute__((address_space(3))) attn_body::v4i16_t*)vp));
                    vh[s][d0] = __builtin_bit_cast(s16x4, __builtin_amdgcn_ds_read_tr16_b64_v4i16((__attribute__((address_space(3))) attn_body::v4i16_t*)(vp + 512))); }
            f32x16 sc;
#pragma unroll
            for (int r = 0; r < 16; ++r) sc[r] = 0.f;
#pragma unroll
            for (int d0 = 0; d0 < 4; ++d0) sc = __builtin_amdgcn_mfma_f32_32x32x16_bf16(kf[d0], qf[d0], sc, 0, 0, 0);
            const int lim = (c == 0 && jt == nb + wave) ? r32 : 64;
            float cc[16];
#pragma unroll
            for (int r = 0; r < 16; ++r) { const float sg = __builtin_amdgcn_rcpf(1.0f + __builtin_amdgcn_exp2f(sc[r])); cc[r] = (crow_(r, hi) < lim) ? sg : 1.0f; }
            float g[4], gp[4], Tt[4], A[4];
#pragma unroll
            for (int m = 0; m < 4; ++m) { g[m] = (cc[4 * m] * cc[4 * m + 1]) * (cc[4 * m + 2] * cc[4 * m + 3]); gp[m] = __shfl_xor(g[m], 32); Tt[m] = g[m] * gp[m]; }
            const float suf3 = 1.0f, suf2 = Tt[3], suf1 = suf2 * Tt[2], suf0 = suf1 * Tt[1];
            A[0] = suf0 * (hi ? 1.0f : gp[0]); A[1] = suf1 * (hi ? 1.0f : gp[1]); A[2] = suf2 * (hi ? 1.0f : gp[2]); A[3] = suf3 * (hi ? 1.0f : gp[3]);
            float av[16];
#pragma unroll
            for (int m = 0; m < 4; ++m) { float run = R * A[m];
#pragma unroll
                for (int e = 3; e >= 0; --e) { const int r = 4 * m + e; av[r] = (1.0f - cc[r]) * run; run *= cc[r]; } }
            R *= suf0 * Tt[0];
            done = __all(R < 0x1p-40f);
            v4u pw0, pw1;
            pw0.x = cvtpk2(av[0], av[1]); pw0.y = cvtpk2(av[2], av[3]); pw0.z = cvtpk2(av[4], av[5]); pw0.w = cvtpk2(av[6], av[7]);
            pw1.x = cvtpk2(av[8], av[9]); pw1.y = cvtpk2(av[10], av[11]); pw1.z = cvtpk2(av[12], av[13]); pw1.w = cvtpk2(av[14], av[15]);
            const bf16x8 pf0 = __builtin_bit_cast(bf16x8, pw0), pf1 = __builtin_bit_cast(bf16x8, pw1);
#define VF(s, d0) (bf16x8){vl[s][d0][0], vl[s][d0][1], vl[s][d0][2], vl[s][d0][3], vh[s][d0][0], vh[s][d0][1], vh[s][d0][2], vh[s][d0][3]}
            o0 = __builtin_amdgcn_mfma_f32_32x32x16_bf16(VF(0, 0), pf0, o0, 0, 0, 0);
            o1 = __builtin_amdgcn_mfma_f32_32x32x16_bf16(VF(0, 1), pf0, o1, 0, 0, 0);
            o0 = __builtin_amdgcn_mfma_f32_32x32x16_bf16(VF(1, 0), pf1, o0, 0, 0, 0);
            o1 = __builtin_amdgcn_mfma_f32_32x32x16_bf16(VF(1, 1), pf1, o1, 0, 0, 0);
#undef VF
        }
        if (start <= 0) done = true;
        const int fb = c & 1;
        if (!done && lane == 0) flags[fb] = 1u;
        asm volatile("s_waitcnt lgkmcnt(0)\n\ts_barrier" ::: "memory");
        const unsigned want = flags[fb];
        if (wave == 0 && lane == 0) flags[fb ^ 1] = 0u;
        if (__builtin_amdgcn_readfirstlane(want) == 0u) break;
        start -= 256; SB_DMA(start, 4);
    }
    asm volatile("s_waitcnt lgkmcnt(0)\n\ts_barrier" ::: "memory");
#undef SB_DMA
    unsigned char* Op = (unsigned char*)O + tokq * 512 + h * 64 + 4 * hi;
#define SB_F8(a_, b_, c_, d_) ({ int w_ = 0; w_ = __builtin_amdgcn_cvt_pk_fp8_f32(__builtin_amdgcn_fmed3f((a_) * F8_XSCALE, -448.0f, 448.0f), __builtin_amdgcn_fmed3f((b_) * F8_XSCALE, -448.0f, 448.0f), w_, false); \
        w_ = __builtin_amdgcn_cvt_pk_fp8_f32(__builtin_amdgcn_fmed3f((c_) * F8_XSCALE, -448.0f, 448.0f), __builtin_amdgcn_fmed3f((d_) * F8_XSCALE, -448.0f, 448.0f), w_, true); w_; })
#pragma unroll
    for (int gi = 0; gi < 4; ++gi) {
        *(int*)(Op + 8 * gi) = SB_F8(o0[4 * gi], o0[4 * gi + 1], o0[4 * gi + 2], o0[4 * gi + 3]);
        *(int*)(Op + 32 + 8 * gi) = SB_F8(o1[4 * gi], o1[4 * gi + 1], o1[4 * gi + 2], o1[4 * gi + 3]);
    }
#undef SB_F8
}

__device__ __forceinline__ void cnt_barrier(unsigned* word, unsigned target, unsigned* bar, int wave_) {
    asm volatile("s_waitcnt vmcnt(0)" ::: "memory");
    __syncthreads();
    if (wave_ == 0 && lane_id_now() == 0) {
        __builtin_amdgcn_s_waitcnt(0);
        (void)xb_add(word, 1u);
        XB_SPIN(xb_ld(word) < target, bar);
        __builtin_amdgcn_fence(__ATOMIC_ACQUIRE, "agent");
        asm volatile("s_waitcnt vmcnt(0)" ::: "memory");
    }
    __syncthreads();
}
#define CG_WORD() ((int)__builtin_amdgcn_readfirstlane((int)F.MISC[12]))

__global__ void __launch_bounds__(NWAVES * 64, 2) mk_fwd(Args args) {
    extern __shared__ __attribute__((aligned(16))) unsigned char lds[];
    Frame F;
    F.lds = (LAS unsigned char*)lds;
    F.MISC = (volatile LAS unsigned*)(F.lds + MISC_OFF);
    F.wave = __builtin_amdgcn_readfirstlane((int)threadIdx.x >> 6);
    F.G = gridDim.x; { const int bx = blockIdx.x; F.vcu = (F.G % 8 == 0) ? (bx % 8) * (F.G / 8) + bx / 8 : bx; }
    unsigned char* ws = args.ws;
    F.ctl = (gu32*)(ws + WS_CTL);
    for (int u = (F.wave * 64 + LANE_NOW); u < (LDS_BYTES - LDSCTL_OFF) / 4; u += NWAVES * 64) ((LAS unsigned*)(F.lds + LDSCTL_OFF))[u] = 0u;
    __syncthreads();
    const int lo = args.ph_lo, hi_ = args.ph_hi;
    const bool one_launch = (hi_ - lo) > 1;
    XcdBarrier bar; bar.bar = (unsigned*)(F.ctl + CW_BAR); bar.x = 0; bar.st = nullptr;
    if (one_launch) bar = xcd_barrier_post((unsigned*)(F.ctl + CW_BAR), F.MISC + 8);
#ifndef PH_MASK
#define PH_MASK 0xffff
#endif
#define IN(k) ((((PH_MASK) >> (k)) & 1) && lo <= (k) && (k) < hi_)
#ifndef MK_PREFETCH
#define MK_PREFETCH 0
#endif
#ifndef PROBE_DUP
#define PROBE_DUP -1
#endif
#define NREP(k) ((PROBE_DUP == (k)) ? 2 : 1)
#define LSEAM(k, word, target) do { if (IN(k) && IN((k) + 1)) { if (grouped) cnt_barrier((unsigned*)(F.ctl + (word)), (target), (unsigned*)(F.ctl + CW_BAR), F.wave); else xcd_barrier(bar, F.wave); } } while (0)
#define SEAM(k) do { if (IN(k) && IN((k) + 1)) { xcd_barrier(bar, F.wave); if (PROBE_DUP == 20) xcd_barrier(bar, F.wave); } } while (0)
    const int gw = F.vcu * NWAVES + F.wave, NGW = F.G * NWAVES;

    bf16* WIN = (bf16*)(ws + WS_WIN); bf16* WDA = (bf16*)(ws + WS_WDA); bf16* WSB = (bf16*)(ws + WS_WSB); bf16* WO = (bf16*)(ws + WS_WO);
    bf16* WGU = (bf16*)(ws + WS_WGU); bf16* WD = (bf16*)(ws + WS_WD);
    bf16* H = (bf16*)(ws + WS_H); bf16* P = (bf16*)(ws + WS_P); bf16* VBT = (bf16*)(ws + WS_VBT); bf16* ODA = (bf16*)(ws + WS_ODA);
    bf16* DA = (bf16*)(ws + WS_DA); bf16* SBO = (bf16*)(ws + WS_SB); bf16* MX = (bf16*)(ws + WS_H); unsigned char* MX8 = ws + WS_VBT;
    bf16* ACT = (bf16*)(ws + WS_ACT); bf16* YS = (bf16*)(ws + WS_YS);
    float* rope = (float*)(ws + WS_ROPE);
    int* tok_e = (int*)(ws + WS_ROUTE); int* tok_pos = tok_e + M * 4;
    float* rstd_tok = (float*)(ws + WS_ROUTE + 768 * 1024);
    int* list_tok = (int*)(ws + WS_LIST); float* list_gate = (float*)(ws + WS_LIST + 2 * MiB);
    bf16* X1 = (bf16*)args.out; constexpr int X1P = 2 * D;

    if (IN(0)) for (int rep_ = 0; rep_ < NREP(0); ++rep_) { p0_prologue(F, args, ws); }
    SEAM(0);
    if (IN(1)) {
        { pg8::Gemm g{H, WIN, M, NPROJ, D}; pg8::DupOrder S; S.S.init(M, NPROJ, F.G, (int)blockIdx.x); S.n = 5; S.reps = NREP(21);
          pg8::EpiInProj E{P, rope, 0.125f * 1.4426950408889634f};
          pg8::gemm_phase<pg8::EpiInProj, pg8::DupOrder, true, true>(F.lds + RING_OFF, g, S, E, F.wave); }
#ifdef SB_WAVE_FORM
        for (int rep_ = 0; rep_ < NREP(11); ++rep_)
        { pg8::Gemm g{WIN + (size_t)2560 * 1024, H, 512, M, D}; pg8::StaticOrder S; S.init(512, M, F.G, (int)blockIdx.x);
          pg8::EpiPlain E{VBT, M};
          pg8::gemm_phase<pg8::EpiPlain, pg8::StaticOrder, true, true>(F.lds + RING_OFF, g, S, E, F.wave); }
    #endif
    }
    SEAM(1);
    if (IN(2)) {
#ifndef DA_SPLIT_V
        for (int rep_ = 0; rep_ < NREP(2); ++rep_)
        for (int i = 0; i < 2; ++i) {
            const int bh = F.vcu >> 3, s = F.vcu & 7; const int qb = (i == 0) ? s : 15 - s;
            const int b = bh >> 3, hq = bh & 7;
            if (bh < BATCH * 8)
                attn_body::attn_unit2<8, NPROJ, NPROJ, NPROJ, 1024>(F.wave, b, qb, (const attn_body::bf16*)(P + hq * 64), (const attn_body::bf16*)(P + 512 + hq * 64),
                    (const attn_body::bf16*)(P + 1024 + (hq >> 1) * 128), (attn_body::bf16*)(ODA + hq * 128), (char*)lds + RING_OFF);
        }
#else
        for (int rep_ = 0; rep_ < NREP(2); ++rep_)
        for (int i = 0; i < 4; ++i) {
            const int bh = F.vcu >> 2, s = F.vcu & 3; const int qb = (i == 0) ? s : (i == 1) ? 7 - s : (i == 2) ? 8 + s : 15 - s;
            const int b = bh >> 4, vh = bh & 15;
            if (bh < BATCH * 16)
                attn_body::attn_unit<8, NPROJ, NPROJ, NPROJ, 1024>(F.wave, b, qb, (const attn_body::bf16*)(P + (vh >> 1) * 64), (const attn_body::bf16*)(P + 512 + (vh >> 1) * 64),
                    (const attn_body::bf16*)(P + 1024 + (vh >> 2) * 128 + (vh & 1) * 64), (attn_body::bf16*)(ODA + vh * 64), (char*)lds + RING_OFF);
        }
#endif
#ifndef SB_WAVE_FORM
        for (int rep_ = 0; rep_ < NREP(12); ++rep_)
        for (int i = 0; i < 2; ++i) {
            const int bh = F.vcu >> 3, s = F.vcu & 7; const int qblk = (i == 0) ? s : 15 - s;
            if (bh < BATCH * 8) sb_unit(F.wave, bh >> 3, bh & 7, qblk, P, SBO, (char*)lds + RING_OFF);
        }
#else
        for (int rep_ = 0; rep_ < NREP(12); ++rep_)
        for (int w = gw; w < 2048; w += NGW) { const int bh = w >> 6, j = w & 63; sb_item(bh >> 3, bh & 7, j, P, VBT, SBO, LANE_NOW); sb_item(bh >> 3, bh & 7, 127 - j, P, VBT, SBO, LANE_NOW); }
#endif
    }
    float lam3 = 0.f; f32x4 ga3 = {0.f, 0.f, 0.f, 0.f}, gb3 = {0.f, 0.f, 0.f, 0.f};
    if (IN(3)) { const float* lq1 = args.in[3]; const float* lk1 = args.in[4]; const float* lq2 = args.in[5]; const float* lk2 = args.in[6]; const float* sg = args.in[7];
        lam3 = __expf(wave_sum(lq1[LANE_NOW] * lk1[LANE_NOW])) - __expf(wave_sum(lq2[LANE_NOW] * lk2[LANE_NOW])) + LAMBDA_INIT;
        const int c0_ = 8 * (LANE_NOW & 15); ga3 = *(const f32x4*)(sg + c0_); gb3 = *(const f32x4*)(sg + c0_ + 4); }
    SEAM(2);
    { const bool reg_ = one_launch && F.MISC[13] != 0u && F.G == 256 && PROBE_DUP < 0 && F.MISC[10] < 32u && F.MISC[11] < 8u;
      if (F.wave == 0 && LANE_NOW == 0) F.MISC[12] = reg_ ? (0x10000u | (8u * F.MISC[10] + F.MISC[11])) : (unsigned)blockIdx.x;
      __syncthreads(); }
    const bool grouped = (CG_WORD() >> 16) != 0; const int cg = CG_WORD() & 0xffff;
    int gpm, gpn; { pg8::StaticOrder S_; S_.init(M, D, F.G, cg); pg8::Unit u_; S_.next(0, u_); gpm = u_.pm; gpn = u_.pn; }
    if (IN(3)) for (int rep_ = 0; rep_ < NREP(3); ++rep_) {
        const float* lq1 = args.in[3]; const float* lk1 = args.in[4]; const float* lq2 = args.in[5]; const float* lk2 = args.in[6]; const float* sg = args.in[7];
        const float lam = lam3;
        const int l = LANE_NOW, hh = l >> 4, c0 = 8 * (l & 15), half = c0 >> 6, cc = c0 & 63;
        const f32x4 ga = ga3, gb = gb3;
        const int m_lo = grouped ? gpm * 256 + gpn * 64 + F.wave : gw, m_hi = grouped ? gpm * 256 + gpn * 64 + 64 : M, m_st = grouped ? NWAVES : NGW;
        for (int mb = m_lo; mb < m_hi; mb += 8 * m_st) {
          v4u w0s[8], w1s[8];
#pragma unroll
          for (int i = 0; i < 8; ++i) { const int mm = (mb + i * m_st < m_hi) ? mb + i * m_st : mb;
              w0s[i] = __builtin_nontemporal_load((const v4u*)(ODA + (size_t)mm * 1024 + (4 * hh + half) * 64 + cc)); w1s[i] = __builtin_nontemporal_load((const v4u*)(ODA + (size_t)mm * 1024 + (4 * hh + 2 + half) * 64 + cc)); }
#pragma unroll
          for (int i = 0; i < 8; ++i) { const int m = mb + i * m_st; if (m >= m_hi) break;
            const v4u w0 = w0s[i], w1 = w1s[i];
            f32x4 a0, a1, b0, b1; pg8::unpack8(w0, a0, a1); pg8::unpack8(w1, b0, b1);
            const f32x4 d0 = a0 - b0 * lam, d1 = a1 - b1 * lam;
            float ss = (d0[0] * d0[0] + d0[1] * d0[1]) + (d0[2] * d0[2] + d0[3] * d0[3]) + (d1[0] * d1[0] + d1[1] * d1[1]) + (d1[2] * d1[2] + d1[3] * d1[3]);
            ss += __shfl_xor(ss, 1); ss += __shfl_xor(ss, 2); ss += __shfl_xor(ss, 4); ss += __shfl_xor(ss, 8);
            const float rs = (1.0f - LAMBDA_INIT) / sqrtf(ss * (1.0f / 128.0f) + EPS);
            *(unsigned long long*)((unsigned char*)DA + (size_t)m * 512 + hh * 128 + c0) = pg8::pack8_f8(d0 * rs * ga, d1 * rs * gb, F8_XSCALE);
          }
        }
    }
#define LARRIVE(k, word) do { if (IN(k) && IN((k) + 1)) { if (grouped) { asm volatile("s_waitcnt vmcnt(0)" ::: "memory"); __syncthreads(); if (F.wave == 0 && LANE_NOW == 0) { __builtin_amdgcn_s_waitcnt(0); (void)xb_add((unsigned*)(F.ctl + (word)), 1u); } } else xcd_barrier(bar, F.wave); } } while (0)
    LARRIVE(3, CW_GRP + 64 * gpm);
    if (IN(4)) {
        { pg8::StaticOrder S0; S0.init(M, D, F.G, cg); pg8::Unit u0;
          if (MK_PREFETCH && S0.next(0, u0)) { const char* gbase = (const char*)(P + (size_t)u0.pm * 256 * NPROJ + 3072 + u0.pn * 256); const int tid_ = F.wave * 64 + LANE_NOW;
#pragma unroll
            for (int i = 0; i < 4; ++i) { const int line = tid_ + 512 * (i & 1), row = line >> 2, seg = line & 3;
                attn_body::glds16(gbase + (size_t)row * (NPROJ * 2) + (i >> 1) * 2048 + seg * 128, (unsigned)__builtin_amdgcn_readfirstlane((unsigned)(uintptr_t)lds + JUNK_OFF + F.wave * 1024)); } } }
        if (NREP(24) == 1) { pg8::Gemm g{DA, WDA, M, D, 256, SBO, WSB}; pg8::DualOrderF8 S; S.S.init(M, D, F.G, cg); S.reps = 1; S.fsc = 0x01010101 * (127 - 7); if (grouped && IN(3)) { S.sw = (unsigned*)(F.ctl + CW_GRP + 64 * gpm); S.st = 4u; S.tmo = (unsigned*)(F.ctl + CW_BAR) + XB_TMO; } pg8::EpiMixDual E{P, MX, MX8};
          pg8::gemm_phase<pg8::EpiMixDual, pg8::DualOrderF8, true, true>(F.lds + RING_OFF, g, S, E, F.wave); }
    }
    LARRIVE(4, CW_GRP + 64 * gpm);
    if (IN(5)) for (int rep_ = 0; rep_ < NREP(5); ++rep_) {
        pg8::Gemm g{(const bf16*)MX8, WO, M, D, D / 2}; pg8::StaticOrderF8 S; S.init(M, D, F.G, cg); S.fsc = 0x01010101 * (127 - 7); if (grouped && IN(4)) { S.sw = (unsigned*)(F.ctl + CW_GRP + 64 * gpm); S.st = 8u; S.tmo = (unsigned*)(F.ctl + CW_BAR) + XB_TMO; } pg8::EpiResidBf E{args.in[0], X1, D, X1P, (unsigned char*)args.out + 2048, 4096, F8_XSCALE, H, args.in[1], (const float*)(ws + WS_WLG + 512 * 1024)};
        { pg8::Unit u0;
          if (MK_PREFETCH && S.next(0, u0)) { const char* xbase = (const char*)(args.in[0] + (size_t)u0.pm * 256 * D + u0.pn * 256); const int tid_ = F.wave * 64 + LANE_NOW;
#pragma unroll
            for (int i = 0; i < 4; ++i) { const int line = tid_ + 512 * i, row = line >> 3, seg = line & 7;
                attn_body::glds16(xbase + (size_t)row * (D * 4) + seg * 128, (unsigned)__builtin_amdgcn_readfirstlane((unsigned)(uintptr_t)lds + JUNK_OFF + F.wave * 1024)); } } }
        pg8::gemm_phase<pg8::EpiResidBf, pg8::StaticOrderF8, true, true>(F.lds + RING_OFF, g, S, E, F.wave);
    }
    bool wl_loaded = false;
    if (IN(5) && IN(6)) {
        if (grouped) {
            unsigned* word_ = (unsigned*)(F.ctl + CW_GRP + 64 * gpm);
            asm volatile("s_waitcnt vmcnt(0)" ::: "memory");
            __syncthreads();
            if (F.wave == 0 && LANE_NOW == 0) { __builtin_amdgcn_s_waitcnt(0); (void)xb_add(word_, 1u); }
            { const char* wlg = (const char*)(ws + WS_WLG) + F.wave * 1024 + LANE_NOW * 16; const unsigned wl0 = (unsigned)(uintptr_t)F.lds + (unsigned)F.wave * 1024u;
#pragma unroll
              for (int j = 0; j < 16; ++j) attn_body::glds16(wlg + j * 8192, (unsigned)__builtin_amdgcn_readfirstlane(wl0 + j * 8192u)); }
            if (F.wave == 0 && LANE_NOW == 0) { XB_SPIN(xb_ld(word_) < 12u, (unsigned*)(F.ctl + CW_BAR)); __builtin_amdgcn_fence(__ATOMIC_ACQUIRE, "agent"); }
            asm volatile("s_waitcnt vmcnt(0)" ::: "memory");
            __syncthreads();
            wl_loaded = true;
        } else xcd_barrier(bar, F.wave);
    }
    if (IN(6)) for (int rep_ = 0; rep_ < NREP(6); ++rep_) {
        const int cnt_bank = (rep_ + 1 < NREP(6)) ? 4096 * 16 : 0;
        const float* g_ffn = args.in[11]; const float* w_r = args.in[12]; const float* b_r = args.in[13];
        LAS float* WL = (LAS float*)(F.lds);
        LAS float* LG = (LAS float*)(F.lds + RING_BYTES);
        LAS float* RS = (LAS float*)(F.lds + RING_BYTES + 8192);
        LAS unsigned* LC = (LAS unsigned*)(F.lds + LDSCTL_OFF + 8192);
        LAS int* PEND = (LAS int*)(F.lds + LDSCTL_OFF + 8192 + 512) + F.wave * 128;
        const int tid_ = F.wave * 64 + LANE_NOW, lane = LANE_NOW;
        if (tid_ < 64) LC[tid_] = 0u;
        if (!wl_loaded) for (int reps_ = 0; reps_ < NREP(60); ++reps_)
        { const char* wlg = (const char*)(ws + WS_WLG) + F.wave * 1024 + lane * 16; const unsigned wl0 = (unsigned)(uintptr_t)F.lds + (unsigned)F.wave * 1024u;
#pragma unroll
          for (int j = 0; j < 16; ++j) attn_body::glds16(wlg + j * 8192, (unsigned)__builtin_amdgcn_readfirstlane(wl0 + j * 8192u));
          asm volatile("s_waitcnt vmcnt(0)" ::: "memory"); }
        __syncthreads();
        const int tok0 = grouped ? (gpm * 4 + gpn) * 64 : F.vcu * 64;
        for (int repa_ = 0; repa_ < NREP(61); ++repa_)
        {
            const int tg = F.wave >> 1, eh = F.wave & 1, tl = lane & 15, kq = lane >> 4;
            const bf16* xrow = X1 + (size_t)(tok0 + 16 * tg + tl) * X1P + 16 * kq;
            const LAS unsigned char* wlb = (const LAS unsigned char*)WL + (size_t)(kq * 32 + 16 * eh + tl) * 16;
            f32x4 acc = {0.f, 0.f, 0.f, 0.f}; float ss = 0.f;
            v4u awa[16][2];
#pragma unroll
            for (int jj = 0; jj < 16; ++jj) { awa[jj][0] = *(const v4u*)(xrow + 64 * jj); awa[jj][1] = *(const v4u*)(xrow + 64 * jj + 8); }
#pragma unroll
            for (int jj = 0; jj < 16; ++jj) {
#pragma unroll
                for (int p = 0; p < 2; ++p) { const v4u aw = awa[jj][p];
                    const float a0 = pg8::bf_lo(aw.x), a1 = pg8::bf_hi(aw.x), a2 = pg8::bf_lo(aw.y), a3 = pg8::bf_hi(aw.y), a4 = pg8::bf_lo(aw.z), a5 = pg8::bf_hi(aw.z), a6 = pg8::bf_lo(aw.w), a7 = pg8::bf_hi(aw.w);
                    ss += (a0 * a0 + a1 * a1) + (a2 * a2 + a3 * a3) + (a4 * a4 + a5 * a5) + (a6 * a6 + a7 * a7);
                    const bf16x8 af = __builtin_bit_cast(bf16x8, aw);
                    const bf16x8 bh = *(const LAS bf16x8*)(wlb + (size_t)((jj * 2 + p) * 2 + 0) * 2048), bl = *(const LAS bf16x8*)(wlb + (size_t)((jj * 2 + p) * 2 + 1) * 2048);
                    acc = __builtin_amdgcn_mfma_f32_16x16x32_bf16(af, bh, acc, 0, 0, 0); acc = __builtin_amdgcn_mfma_f32_16x16x32_bf16(af, bl, acc, 0, 0, 0); } }
            ss += __shfl_xor(ss, 16); ss += __shfl_xor(ss, 32);
            const float rstd = 1.f / sqrtf(ss * (1.f / D) + EPS);
            if (eh == 0 && kq == 0) rstd_tok[tok0 + 16 * tg + tl] = rstd;
            const float bias = b_r[16 * eh + tl];
#pragma unroll
            for (int r = 0; r < 4; ++r) { const float rs = __shfl(rstd, 4 * kq + r); LG[(16 * tg + 4 * kq + r) * 32 + 16 * eh + tl] = acc[r] * rs + bias; }
        }
        __syncthreads();
        for (int it = 0; it < 4; ++it) { const int half = lane >> 5, eme = lane & 31, tw = 2 * it + half, tl = F.wave * 8 + tw;
            const LAS f32x4* lrow = (const LAS f32x4*)(LG + tl * 32);
            f32x4 q[8];
#pragma unroll
            for (int c = 0; c < 8; ++c) q[c] = lrow[c];
            const float cur = LG[tl * 32 + eme];
            int rank = 0;
#pragma unroll
            for (int j = 0; j < 32; ++j) { const float vj = q[j >> 2][j & 3]; rank += (vj > cur || (vj == cur && j < eme)) ? 1 : 0; }
            int sel[4]; float sv[4];
#pragma unroll
            for (int k = 0; k < 4; ++k) { const unsigned long long bal = __ballot(rank == k); const int lnA = __ffs((int)(unsigned)bal) - 1, lnB = __ffs((int)(unsigned)(bal >> 32)) - 1;
                const float sA = __int_as_float(__builtin_amdgcn_readlane(__float_as_int(cur), lnA & 31)), sB = __int_as_float(__builtin_amdgcn_readlane(__float_as_int(cur), 32 + (lnB & 31)));
                sel[k] = half ? lnB : lnA; sv[k] = half ? sB : sA; }
            const float p1 = __expf(sv[1] - sv[0]), p2 = __expf(sv[2] - sv[0]), p3 = __expf(sv[3] - sv[0]); const float inv = 1.0f / (1.0f + p1 + p2 + p3);
            if (eme < 4) { const int k = eme; const int e = (k == 0) ? sel[0] : (k == 1) ? sel[1] : (k == 2) ? sel[2] : sel[3];
                const float gt = ((k == 0) ? 1.0f : (k == 1) ? p1 : (k == 2) ? p2 : p3) * inv;
                const unsigned pl = __hip_atomic_fetch_add(LC + e, 1u, __ATOMIC_RELAXED, __HIP_MEMORY_SCOPE_WORKGROUP);
                LAS int* pe = PEND + tw * 12 + k * 3; pe[0] = e; pe[1] = (int)pl; pe[2] = __float_as_int(gt); }
        }
        for (int repc_ = 0; repc_ < NREP(63); ++repc_) { const int bank_ = (repc_ + 1 < NREP(63)) ? 4096 * 24 : cnt_bank;
        __syncthreads();
        if (tid_ < NE) LC[32 + tid_] = __hip_atomic_fetch_add((unsigned*)(F.ctl + CW_CNT + bank_ + 64 * tid_), LC[tid_], __ATOMIC_RELAXED, __HIP_MEMORY_SCOPE_AGENT);
        __syncthreads();
        if (lane < 32) { const int it = lane >> 2, k = lane & 3, mtok = tok0 + F.wave * 8 + it; const LAS int* pe = PEND + it * 12 + k * 3;     const int e = pe[0]; const unsigned pos = LC[32 + e] + (unsigned)pe[1];
            tok_e[mtok * 4 + k] = e; tok_pos[mtok * 4 + k] = (int)pos; if (cnt_bank == 0) { list_tok[e * 16384 + pos] = mtok; list_gate[e * 16384 + pos] = __int_as_float(pe[2]); } }
        }
        __syncthreads();
    }
    SEAM(6);
    LAS int* TAB = (LAS int*)(F.lds + TAB_OFF);
    if (IN(8) || IN(9) || IN(10)) {
        const int tid_ = F.wave * 64 + LANE_NOW;
        if (tid_ < NE) TAB[328 + tid_] = (int)__hip_atomic_load((unsigned*)(F.ctl + CW_CNT + 64 * tid_), __ATOMIC_RELAXED, __HIP_MEMORY_SCOPE_AGENT);
        __syncthreads();
        if (F.wave == 0) { const int l_ = LANE_NOW, e_ = l_ & 31;
            const int nt_ = (TAB[328 + e_] + 255) >> 8; int inc_ = nt_;
#pragma unroll
            for (int o_ = 1; o_ < 32; o_ <<= 1) { const int up_ = __shfl_up(inc_, o_, 32); inc_ += (e_ >= o_) ? up_ : 0; }
            const int t0_ = inc_ - nt_;
            if (l_ < 32) { TAB[e_] = t0_; for (int t = 0; t < nt_; ++t) TAB[40 + t0_ + t] = e_; if (e_ == 31) TAB[32] = inc_; } }
        __syncthreads();
        { const int nTl = TAB[32]; const bool live = tid_ < nTl; int isfull = 0;
          if (live) { const int e = TAB[40 + tid_]; isfull = (TAB[328 + e] - (tid_ - TAB[e]) * 256 > 128) ? 1 : 0; }
          const unsigned long long bal = __ballot(live && isfull);
          if (LANE_NOW == 0) TAB[752 + F.wave] = __popcll(bal);
          __syncthreads();
          int before = 0, nF = 0;
#pragma unroll
          for (int w = 0; w < NWAVES; ++w) { const int cw = TAB[752 + w]; nF += cw; if (w < F.wave) before += cw; }
          const int fi = before + __popcll(bal & ((1ull << LANE_NOW) - 1ull)), si = tid_ - fi, nS = nTl - nF;
          if (live) { const int idx = isfull ? fi : si, n = isfull ? nF : nS; int x = 0;
#pragma unroll
              for (int q = 1; q < 8; ++q) if (idx >= q * n / 8) x = q;
              const int f0 = x * nF / 8, f1 = (x + 1) * nF / 8, s0 = x * nS / 8;
              TAB[360 + x * 48 + (isfull ? (fi - f0) : (f1 - f0) + (si - s0))] = tid_; }
          if (tid_ < 8) { const int x = tid_; TAB[744 + x] = ((x + 1) * nF / 8 - x * nF / 8) + ((x + 1) * nS / 8 - x * nS / 8); } }
        __syncthreads();
    }
    if (IN(8)) for (int rep_ = 0; rep_ < NREP(8); ++rep_) {
        const int nT = __builtin_amdgcn_readfirstlane(TAB[32]);
        pg8::MoeOrderG S; S.npn = 8; S.G = F.G; S.c = CG_WORD() & 0xffff; S.rdy = (unsigned*)(F.ctl + CW_RDY); S.tmo = (unsigned*)(F.ctl + CW_BAR) + XB_TMO; S.mode = (NREP(8) == 1) ? 1 : 0; S.nb64 = 2048 * 64; S.ebytes = 2048 * 1024; S.tab = (const LAS int*)TAB; S.tokl = (const LAS int*)(F.lds + TOK_OFF);
        { LAS int* TOK = (LAS int*)(F.lds + TOK_OFF); const int tid_ = F.wave * 64 + LANE_NOW; pg8::Unit u;
          int tk[12];
          int e_l, lt_l, cnt_l; const int ok_l = S.next_v(LANE_NOW < 12 ? LANE_NOW : 0, e_l, lt_l, cnt_l) ? 1 : 0;
#pragma unroll
          for (int i = 0; i < 12; ++i) { const bool ok = __builtin_amdgcn_readlane(ok_l, i) != 0; const int ue = __builtin_amdgcn_readlane(e_l, i), ult = __builtin_amdgcn_readlane(lt_l, i), ucnt = __builtin_amdgcn_readlane(cnt_l, i);
              const int p = ult * 256 + (tid_ & 255); const bool live = ok && p < ucnt; const int v = list_tok[live ? ue * 16384 + p : 0]; tk[i] = live ? v : 0; }
#pragma unroll
          for (int i = 0; i < 12; ++i) if (tid_ < 256) TOK[i * 256 + tid_] = tk[i];
          __syncthreads(); }
        pg8::Gemm g{(const bf16*)((const unsigned char*)args.out + 2048), WGU, M, 2048, D / 2, nullptr, nullptr}; S.pitch = X1P; S.fsc = 0x01010101 * (127 - 7);
        pg8::EpiMoe1 E{(unsigned char*)ACT, F8_ASCALE, args.in[15], args.in[17], rstd_tok, (const LAS int*)(F.lds + TOK_OFF), (LAS float*)(F.lds + EPISTG_OFF)};
        pg8::gemm_phase<pg8::EpiMoe1, pg8::MoeOrderG, true, true>(F.lds + RING_OFF, g, S, E, F.wave);
    }
    if (!grouped || PROBE_DUP >= 0) SEAM(8);
    if (IN(9)) for (int rep_ = 0; rep_ < NREP(9); ++rep_) {
        const int nT = __builtin_amdgcn_readfirstlane(TAB[32]);
        pg8::Gemm g{ACT, WD, MAXT * 256, 1024, FF / 2, nullptr, nullptr}; pg8::MoeOrder S{4, F.G, CG_WORD() & 0xffff, (const LAS int*)TAB}; S.rdy = (unsigned*)(F.ctl + CW_RDY); S.tmo = (unsigned*)(F.ctl + CW_BAR) + XB_TMO; S.mode = (NREP(8) == 1) ? 2 : 0; S.nb64 = 1024 * 64; S.ebytes = 1024 * 1024; S.pkl = (LAS unsigned*)(F.lds + LDSCTL_OFF + 8192); S.fsc = 0x01010101 * (127 - 6);
        pg8::EpiMoe2 E{(unsigned char*)YS, F8_YSCALE, args.in[19], list_gate, (LAS float*)(F.lds + EPISTG_OFF)};
        pg8::gemm_phase<pg8::EpiMoe2, pg8::MoeOrder, true, true>(F.lds + RING_OFF, g, S, E, F.wave);
    }
    typedef int i32x4 __attribute__((ext_vector_type(4)));
    i32x4 te10 = {0, 0, 0, 0}, tp10 = {0, 0, 0, 0}; unsigned long long xa10[4] = {0ull, 0ull, 0ull, 0ull};
    if (IN(10) && gw < M) { te10 = *(const i32x4*)(tok_e + gw * 4); tp10 = *(const i32x4*)(tok_pos + gw * 4);
#pragma unroll
        for (int j = 0; j < 4; ++j) xa10[j] = __builtin_nontemporal_load((const unsigned long long*)(X1 + (size_t)gw * X1P + 4 * LANE_NOW + 256 * j)); }
    SEAM(9);
    if (IN(10)) {
        float* const OUTP = args.out;
        const float* g_fin = args.in[20];
        unsigned poison = (__hip_atomic_load(F.ctl + CW_TMO, RLX_AGENT) != 0u) || (__hip_atomic_load((gu32*)((unsigned*)(F.ctl + CW_BAR) + XB_TMO), RLX_AGENT) != 0u);
        f32x4 gg[4];
#pragma unroll
        for (int j = 0; j < 4; ++j) gg[j] = *(const f32x4*)(g_fin + 4 * LANE_NOW + 256 * j);
        int ya[4][4];
#pragma unroll
        for (int k = 0; k < 4; ++k)
#pragma unroll
            for (int j = 0; j < 4; ++j) ya[k][j] = 0;
        if (gw < M) {
#pragma unroll
            for (int k = 0; k < 4; ++k) { const size_t slot = (size_t)TAB[te10[k]] * 256 + tp10[k];
#pragma unroll
                for (int j = 0; j < 4; ++j) ya[k][j] = __builtin_nontemporal_load((const int*)((const unsigned char*)YS + slot * D + 4 * LANE_NOW + 256 * j)); } }
        i32x4 ne = {0, 0, 0, 0}, np = {0, 0, 0, 0};
        if (gw + NGW < M) { ne = *(const i32x4*)(tok_e + (gw + NGW) * 4); np = *(const i32x4*)(tok_pos + (gw + NGW) * 4); }
        for (int m = gw; m < M; m += NGW) {
            const int mn = m + NGW; const bool hn = mn < M;
            unsigned long long xb[4] = {0ull, 0ull, 0ull, 0ull}; int yb[4][4];
#pragma unroll
            for (int k = 0; k < 4; ++k)
#pragma unroll
                for (int j = 0; j < 4; ++j) yb[k][j] = 0;
            if (hn) {
#pragma unroll
                for (int j = 0; j < 4; ++j) xb[j] = __builtin_nontemporal_load((const unsigned long long*)(X1 + (size_t)mn * X1P + 4 * LANE_NOW + 256 * j));
#pragma unroll
                for (int k = 0; k < 4; ++k) { const size_t slot = (size_t)TAB[ne[k]] * 256 + np[k];
#pragma unroll
                    for (int j = 0; j < 4; ++j) yb[k][j] = __builtin_nontemporal_load((const int*)((const unsigned char*)YS + slot * D + 4 * LANE_NOW + 256 * j)); } }
            if (mn + NGW < M) { ne = *(const i32x4*)(tok_e + (mn + NGW) * 4); np = *(const i32x4*)(tok_pos + (mn + NGW) * 4); }
            f32x4 v[4];
#pragma unroll
            for (int j = 0; j < 4; ++j) { const unsigned xl = (unsigned)xa10[j], xh = (unsigned)(xa10[j] >> 32); v[j] = (f32x4){pg8::bf_lo(xl), pg8::bf_hi(xl), pg8::bf_lo(xh), pg8::bf_hi(xh)}; }
            f32x4 ys[4] = {{0.f, 0.f, 0.f, 0.f}, {0.f, 0.f, 0.f, 0.f}, {0.f, 0.f, 0.f, 0.f}, {0.f, 0.f, 0.f, 0.f}};
#pragma unroll
            for (int k = 0; k < 4; ++k)
#pragma unroll
                for (int j = 0; j < 4; ++j) { const int w = ya[k][j];
                    const pg8::f32x2 lo = __builtin_amdgcn_cvt_pk_f32_fp8(w, false), hi = __builtin_amdgcn_cvt_pk_f32_fp8(w, true);
                    ys[j] = ys[j] + (f32x4){lo[0], lo[1], hi[0], hi[1]}; }
#pragma unroll
            for (int j = 0; j < 4; ++j) v[j] = v[j] + ys[j] * (1.0f / F8_YSCALE);
            float s = 0.f;
#pragma unroll
            for (int j = 0; j < 4; ++j) s += (v[j].x * v[j].x + v[j].y * v[j].y) + (v[j].z * v[j].z + v[j].w * v[j].w);
            const float rstd = 1.f / sqrtf(wave_sum(s) * (1.f / D) + EPS);
#pragma unroll
            for (int j = 0; j < 4; ++j) { f32x4 o = v[j] * rstd * gg[j];
                if (poison) { const float q = __builtin_nanf(""); o = (f32x4){q, q, q, q}; }
                __builtin_nontemporal_store(o, (f32x4*)(OUTP + (size_t)m * D + 4 * LANE_NOW + 256 * j)); }
#pragma unroll
            for (int j = 0; j < 4; ++j) xa10[j] = xb[j];
#pragma unroll
            for (int k = 0; k < 4; ++k)
#pragma unroll
                for (int j = 0; j < 4; ++j) ya[k][j] = yb[k][j];
        }
    }
#undef IN
#undef SEAM
}

#ifndef MK_ONE_LAUNCH
#define MK_ONE_LAUNCH 1
#endif
constexpr int N_PHASES = 11;
extern "C" void kernel_launch(void* const* d_in, const int* in_sizes, int n_in, void* d_out, int out_size, void* d_ws, size_t ws_size, hipStream_t stream) {
    static int grid = 0;
    if (grid == 0) {
        if (n_in != 21 || in_sizes[0] != M * D || out_size != M * D || ws_size < WS_END) { fprintf(stderr, "kernel_launch: unexpected shapes: n_in %d in0 %d out %d ws %zu (need %zu); nothing launched\n", n_in, n_in > 0 ? in_sizes[0] : -1, out_size, ws_size, (size_t)WS_END); grid = -1; return; }
        int dev = 0, cus = 0, per_cu = 0;
        if (hipGetDevice(&dev) != hipSuccess || hipDeviceGetAttribute(&cus, hipDeviceAttributeMultiprocessorCount, dev) != hipSuccess) { grid = -1; return; }
        if (hipFuncSetAttribute((const void*)mk_fwd, hipFuncAttributeMaxDynamicSharedMemorySize, LDS_BYTES) != hipSuccess) { fprintf(stderr, "kernel_launch: hipFuncSetAttribute failed\n"); grid = -1; return; }
        if (hipOccupancyMaxActiveBlocksPerMultiprocessor(&per_cu, (const void*)mk_fwd, NWAVES * 64, LDS_BYTES) != hipSuccess || per_cu < 1) { fprintf(stderr, "kernel_launch: occupancy query says %d blocks per CU\n", per_cu); (void)hipGetLastError(); grid = -1; return; }
        grid = cus;
        if (grid != 256) fprintf(stderr, "kernel_launch: note: %d CUs\n", grid);
    }
    if (grid < 0) return;
    if (hipMemsetAsync((char*)d_ws + WS_CTL, 0, CTL_ZERO_BYTES, stream) != hipSuccess) return;
    Args a{};
    for (int i = 0; i < 21; ++i) a.in[i] = (const float*)d_in[i];
    a.out = (float*)d_out; a.ws = (unsigned char*)d_ws;
#if MK_ONE_LAUNCH
    a.ph_lo = 0; a.ph_hi = N_PHASES;
    hipLaunchKernelGGL(mk_fwd, dim3(grid), dim3(NWAVES * 64), LDS_BYTES, stream, a);
#else
    for (int p = 0; p < N_PHASES; ++p) { a.ph_lo = p; a.ph_hi = p + 1; hipLaunchKernelGGL(mk_fwd, dim3(grid), dim3(NWAVES * 64), LDS_BYTES, stream, a); }
#endif
}
```
